# Optimizing an MI355X kernel written in HIP

```python
import math
import jax, jax.numpy as jnp
from jax import lax
import numpy as np

D_MODEL = 1024
BATCH = 4
SEQ = 4096
DEPTH = 4

GRID_W = 64
RET_HEADS = 4
RET_DK = 256
RET_DV = 512
RET_CHUNK = 128
ROPE_BASE = 10000.0
NA_HEADS = 16
NA_HD = 64
NA_KH = 8
NA_KW = 16
N_EXPERTS = 32
N_GROUPS = 8
EXPERTS_PER_GROUP = N_EXPERTS // N_GROUPS
TOP_K = 2
D_EXPERT = 512
MOE_BLOCK = 256
LN_EPS = 1e-5
GN_EPS = 1e-5
DEEPNORM_ALPHA = (2 * DEPTH) ** 0.25
DEEPNORM_BETA = (8 * DEPTH) ** -0.25

RET_QK_W = RET_HEADS * RET_DK
RET_V_W = RET_HEADS * RET_DV
NA_W = NA_HEADS * NA_HD
IN_SIZES = (RET_QK_W, RET_QK_W, RET_V_W, RET_V_W, NA_W, NA_W, NA_W, 2 * D_MODEL)
D_IN = RET_QK_W * 2 + RET_V_W * 2 + NA_W * 3 + 2 * D_MODEL

kernel_name = "hybrid_retention_natten_grouped_moe_deepnorm"


def _split_points():
    pts, acc = [], 0
    for s in IN_SIZES[:-1]:
        acc += s
        pts.append(acc)
    return tuple(pts)


def layernorm(x, g, b):
    xf = x.astype(jnp.float32)
    mu = jnp.mean(xf, axis=-1, keepdims=True)
    var = jnp.mean(jnp.square(xf - mu), axis=-1, keepdims=True)
    y = (xf - mu) * lax.rsqrt(var + LN_EPS) * g.astype(jnp.float32) + b.astype(jnp.float32)
    return y.astype(x.dtype)


def head_norm(y):
    mu = jnp.mean(y, axis=-1, keepdims=True)
    var = jnp.mean(jnp.square(y - mu), axis=-1, keepdims=True)
    return (y - mu) * lax.rsqrt(var + GN_EPS)


def rotary(x):
    S, d = x.shape[1], x.shape[-1]
    half = d // 2
    pos = jnp.arange(S, dtype=jnp.float32)
    freqs = ROPE_BASE ** (-jnp.arange(half, dtype=jnp.float32) / half)
    ang = pos[:, None] * freqs[None, :]
    cos = jnp.cos(ang)[None, :, None, :].astype(x.dtype)
    sin = jnp.sin(ang)[None, :, None, :].astype(x.dtype)
    x1, x2 = x[..., :half], x[..., half:]
    return jnp.concatenate([x1 * cos - x2 * sin, x1 * sin + x2 * cos], axis=-1)


def retention_one_direction(q, k, v, log_g, strict):
    B, H, S, dk = q.shape
    dv = v.shape[-1]
    C = RET_CHUNK
    nc = S // C
    pos = jnp.arange(C, dtype=jnp.float32)
    diff = pos[:, None] - pos[None, :]
    mask = (diff > 0) if strict else (diff >= 0)
    intra = jnp.where(mask[None], jnp.exp(log_g[:, None, None] * jnp.maximum(diff, 0.0)[None]), 0.0)
    qc = q.reshape(B, H, nc, C, dk)
    kc = k.reshape(B, H, nc, C, dk)
    vc = v.reshape(B, H, nc, C, dv)
    scores = jnp.einsum('bhnid,bhnjd->bhnij', qc, kc) * intra[None, :, None]
    inner = jnp.einsum('bhnij,bhnje->bhnie', scores, vc)
    q_dec = jnp.exp(log_g[:, None] * (pos + 1.0))
    k_dec = jnp.exp(log_g[:, None] * (C - 1.0 - pos))
    chunk_dec = jnp.exp(log_g * C)
    xs = (jnp.moveaxis(qc * q_dec[None, :, None, :, None], 2, 0),
          jnp.moveaxis(kc * k_dec[None, :, None, :, None], 2, 0),
          jnp.moveaxis(vc, 2, 0))

    def step(state, inp):
        qi, ki, vi = inp
        cross = jnp.einsum('bhid,bhde->bhie', qi, state)
        state = state * chunk_dec[None, :, None, None] + jnp.einsum('bhjd,bhje->bhde', ki, vi)
        return state, cross

    state0 = jnp.zeros((B, H, dk, dv), jnp.float32)
    _, cross = lax.scan(step, state0, xs)
    out = inner + jnp.moveaxis(cross, 0, 2)
    return out.reshape(B, H, S, dv)


def bidirectional_retention(q, k, v, decay_logit):
    log_g = jax.nn.log_sigmoid(decay_logit.astype(jnp.float32))
    qh = q.astype(jnp.float32).transpose(0, 2, 1, 3)
    kh = k.astype(jnp.float32).transpose(0, 2, 1, 3)
    vh = v.astype(jnp.float32).transpose(0, 2, 1, 3)
    fwd = retention_one_direction(qh, kh, vh, log_g[0], strict=False)
    bwd = jnp.flip(retention_one_direction(jnp.flip(qh, 2), jnp.flip(kh, 2), jnp.flip(vh, 2),
                                           log_g[1], strict=True), 2)
    return (fwd + bwd).transpose(0, 2, 1, 3)


def neighbourhood_attention(q, k, v, rpb):
    B, S, H, hd = q.shape
    rows = S // GRID_W
    kh = min(NA_KH, rows)
    kw = NA_KW
    qg = q.reshape(B, rows, GRID_W, H, hd)
    kg = k.reshape(B, rows, GRID_W, H, hd)
    vg = v.reshape(B, rows, GRID_W, H, hd)
    col = jnp.arange(GRID_W)
    col_start = jnp.clip(col - kw // 2, 0, GRID_W - kw)
    col_idx = col_start[:, None] + jnp.arange(kw)[None, :]
    col_off = col_idx - col[:, None] + (NA_KW - 1)

    def one_row(r):
        row_start = jnp.clip(r - kh // 2, 0, rows - kh)
        k_rows = lax.dynamic_slice_in_dim(kg, row_start, kh, axis=1)
        v_rows = lax.dynamic_slice_in_dim(vg, row_start, kh, axis=1)
        k_nb = k_rows[:, :, col_idx]
        v_nb = v_rows[:, :, col_idx]
        q_r = lax.dynamic_index_in_dim(qg, r, axis=1, keepdims=False)
        row_off = row_start + jnp.arange(kh) - r + (NA_KH - 1)
        bias = rpb[:, row_off[:, None, None], col_off[None, :, :]]
        s = jnp.einsum('bwhd,biwjhd->bhwij', q_r, k_nb).astype(jnp.float32)
        s = s + bias.transpose(0, 2, 1, 3)[None].astype(jnp.float32)
        p = jax.nn.softmax(s.reshape(B, H, GRID_W, kh * kw), axis=-1).reshape(B, H, GRID_W, kh, kw)
        return jnp.einsum('bhwij,biwjhd->bwhd', p.astype(v.dtype), v_nb)

    out = lax.map(one_row, jnp.arange(rows))
    return out.transpose(1, 0, 2, 3, 4).reshape(B, S, H * hd)


def hybrid_mixer(x, w_in, decay_logit, w_ret_o, rpb, w_na_o, w_out):
    B, S, _ = x.shape
    proj = jnp.einsum('bsd,de->bse', x, w_in)
    q_r, k_r, v_r, g_r, q_n, k_n, v_n, gate_logits = jnp.split(proj, _split_points(), axis=-1)
    q_r = rotary(q_r.reshape(B, S, RET_HEADS, RET_DK))
    k_r = rotary(k_r.reshape(B, S, RET_HEADS, RET_DK)) * (RET_DK ** -0.5)
    v_r = v_r.reshape(B, S, RET_HEADS, RET_DV)
    ret = head_norm(bidirectional_retention(q_r, k_r, v_r, decay_logit)).reshape(B, S, RET_V_W)
    y_ret = jnp.einsum('bse,ed->bsd', (jax.nn.silu(g_r.astype(jnp.float32)) * ret).astype(x.dtype), w_ret_o)
    na = neighbourhood_attention(q_n.reshape(B, S, NA_HEADS, NA_HD) * (NA_HD ** -0.5),
                                 k_n.reshape(B, S, NA_HEADS, NA_HD),
                                 v_n.reshape(B, S, NA_HEADS, NA_HD), rpb)
    y_na = jnp.einsum('bse,ed->bsd', na, w_na_o)
    gates = jax.nn.sigmoid(gate_logits)
    merged = gates[..., :D_MODEL] * y_ret + gates[..., D_MODEL:] * y_na
    return jnp.einsum('bsd,de->bse', merged, w_out)


def route(h, router_w, router_bias):
    T = h.shape[0]
    scores = jax.nn.sigmoid(jnp.dot(h.astype(jnp.float32), router_w.astype(jnp.float32)))
    sel = scores + router_bias.astype(jnp.float32)[None, :]
    sel_g = sel.reshape(T, N_GROUPS, EXPERTS_PER_GROUP)
    group_score = jnp.sum(lax.top_k(sel_g, TOP_K)[0], axis=-1)
    g_best = jnp.argmax(group_score, axis=-1).astype(jnp.int32)
    in_group = jnp.take_along_axis(sel_g, g_best[:, None, None], axis=1)[:, 0]
    _, local = lax.top_k(in_group, TOP_K)
    expert_idx = g_best[:, None] * EXPERTS_PER_GROUP + local.astype(jnp.int32)
    w = jnp.take_along_axis(scores, expert_idx, axis=1)
    w = w / jnp.sum(w, axis=-1, keepdims=True)
    return expert_idx, w


def swiglu(xb, wg, wu, wd):
    return jnp.dot(jax.nn.silu(jnp.dot(xb, wg)) * jnp.dot(xb, wu), wd)


def moe(h, router_w, router_bias, w_gate, w_up, w_down):
    T, D = h.shape
    expert_idx, gate_w = route(h, router_w, router_bias)
    TK = T * TOP_K
    flat_e = expert_idx.reshape(TK)
    flat_tok = jnp.repeat(jnp.arange(T, dtype=jnp.int32), TOP_K)
    flat_w = gate_w.reshape(TK)
    order = jnp.argsort(flat_e)
    e_sorted = flat_e[order]
    tok_sorted = flat_tok[order]
    w_sorted = flat_w[order]
    counts = jnp.bincount(flat_e, length=N_EXPERTS)
    starts = jnp.cumsum(counts) - counts
    padded = ((counts + MOE_BLOCK - 1) // MOE_BLOCK) * MOE_BLOCK
    ends_pad = jnp.cumsum(padded)
    starts_pad = ends_pad - padded
    rank = jnp.arange(TK, dtype=jnp.int32) - starts[e_sorted]
    dest = starts_pad[e_sorted] + rank
    n_blocks = (TK + N_EXPERTS * (MOE_BLOCK - 1) + MOE_BLOCK - 1) // MOE_BLOCK
    buf = jnp.zeros((n_blocks * MOE_BLOCK, D), h.dtype).at[dest].set(h[tok_sorted])
    block_e = jnp.clip(jnp.searchsorted(ends_pad, jnp.arange(n_blocks) * MOE_BLOCK, side='right'),
                       0, N_EXPERTS - 1)

    def expert_block(args):
        xb, e = args
        return swiglu(xb, w_gate[e], w_up[e], w_down[e])

    y_blocks = lax.map(expert_block, (buf.reshape(n_blocks, MOE_BLOCK, D), block_e))
    y = y_blocks.reshape(n_blocks * MOE_BLOCK, D)[dest] * w_sorted[:, None].astype(h.dtype)
    return jax.ops.segment_sum(y, tok_sorted, num_segments=T)


def setup_inputs(seed: int = 0) -> dict:
    key = jax.random.key(seed)
    ks = jax.random.split(key, 16)
    f32 = jnp.float32
    nrm = lambda k, shape, scale: jax.random.normal(k, shape, f32) * scale
    base_logit = jnp.log(2.0 ** (5.0 + jnp.arange(RET_HEADS, dtype=f32)) - 1.0)
    decay = base_logit[None, None, :] + nrm(ks[2], (DEPTH, 2, RET_HEADS), 0.1)
    return {
        "x": nrm(ks[0], (BATCH, SEQ, D_MODEL), 1.0),
        "w_in": nrm(ks[1], (DEPTH, D_MODEL, D_IN), D_MODEL ** -0.5),
        "ret_decay_logit": decay,
        "w_ret_o": nrm(ks[3], (DEPTH, RET_V_W, D_MODEL), RET_V_W ** -0.5),
        "na_rpb": nrm(ks[4], (DEPTH, NA_HEADS, 2 * NA_KH - 1, 2 * NA_KW - 1), 0.02),
        "w_na_o": nrm(ks[5], (DEPTH, NA_W, D_MODEL), NA_W ** -0.5),
        "w_out": nrm(ks[6], (DEPTH, D_MODEL, D_MODEL), D_MODEL ** -0.5 * DEEPNORM_BETA),
        "ln_mix_g": 1.0 + nrm(ks[7], (DEPTH, D_MODEL), 0.02),
        "ln_mix_b": nrm(ks[8], (DEPTH, D_MODEL), 0.02),
        "router_w": nrm(ks[9], (D_MODEL, N_EXPERTS), D_MODEL ** -0.5),
        "router_bias": nrm(ks[10], (N_EXPERTS,), 0.01),
        "w_exp_gate": nrm(ks[11], (DEPTH, N_EXPERTS, D_MODEL, D_EXPERT), D_MODEL ** -0.5),
        "w_exp_up": nrm(ks[12], (DEPTH, N_EXPERTS, D_MODEL, D_EXPERT), D_MODEL ** -0.5),
        "w_exp_down": nrm(ks[13], (DEPTH, N_EXPERTS, D_EXPERT, D_MODEL), D_EXPERT ** -0.5 * DEEPNORM_BETA),
        "ln_ffn_g": 1.0 + nrm(ks[14], (DEPTH, D_MODEL), 0.02),
        "ln_ffn_b": nrm(ks[15], (DEPTH, D_MODEL), 0.02),
    }


def reference(x, w_in, ret_decay_logit, w_ret_o, na_rpb, w_na_o, w_out, ln_mix_g, ln_mix_b,
              router_w, router_bias, w_exp_gate, w_exp_up, w_exp_down, ln_ffn_g, ln_ffn_b):
    B, S, D = x.shape
    for l in range(DEPTH):
        mix = hybrid_mixer(x, w_in[l], ret_decay_logit[l], w_ret_o[l], na_rpb[l], w_na_o[l], w_out[l])
        x = layernorm(DEEPNORM_ALPHA * x + mix, ln_mix_g[l], ln_mix_b[l])
        ffn = moe(x.reshape(B * S, D), router_w, router_bias,
                  w_exp_gate[l], w_exp_up[l], w_exp_down[l]).reshape(B, S, D)
        x = layernorm(DEEPNORM_ALPHA * x + ffn, ln_ffn_g[l], ln_ffn_b[l])
    return x
```

```cpp
#include <hip/hip_runtime.h>
#include <cstdio>
#include <cstdint>

#ifndef MK_ONE_LAUNCH
#define MK_ONE_LAUNCH 1
#endif

#define LAS __attribute__((address_space(3)))
typedef unsigned short bf16_t;
typedef short bf16x8 __attribute__((ext_vector_type(8)));
typedef float f32x4 __attribute__((ext_vector_type(4)));
typedef float f32x2 __attribute__((ext_vector_type(2)));
typedef unsigned u32x4 __attribute__((ext_vector_type(4)));
typedef unsigned u32x2 __attribute__((ext_vector_type(2)));

constexpr int D = 1024, BATCH = 4, SEQ = 4096, T = BATCH * SEQ, DEPTH = 4;
constexpr int DIN = 11264;
constexpr int NE = 32;
constexpr int NPH = 1 + DEPTH * 12;
constexpr float ALPHA = 1.681792830507429f;
constexpr float LOG2E = 1.4426950408889634f;

constexpr size_t MiB = 1u << 20;
constexpr size_t WS_CTL = 0, CTL_ZERO_BYTES = 1 * MiB;
constexpr size_t WS_TAB = 2 * MiB;
constexpr size_t WS_TOK = 10 * MiB;
constexpr size_t WS_WIN = 12 * MiB;
constexpr size_t WS_WRET = 34 * MiB;
constexpr size_t WS_WNA = 38 * MiB;
constexpr size_t WS_WOUT = 40 * MiB;
constexpr size_t WS_WGU = 42 * MiB;
constexpr size_t WS_WD = 106 * MiB;
constexpr size_t WS_XB = 138 * MiB;
constexpr size_t WS_Q = 170 * MiB;
constexpr size_t WS_K = 202 * MiB;
constexpr size_t WS_ACAT = 234 * MiB;
constexpr size_t WS_BCAT = 362 * MiB;
constexpr size_t WS_KDT = 490 * MiB;
constexpr size_t WS_KV = 554 * MiB;
constexpr size_t WS_SG = 682 * MiB;
constexpr size_t WS_QN = 746 * MiB;
constexpr size_t WS_KN = 778 * MiB;
constexpr size_t WS_VNT = 810 * MiB;
constexpr size_t WS_G = 842 * MiB;
constexpr size_t WS_NAO = 906 * MiB;
constexpr size_t WS_END = 938 * MiB;
constexpr int CW_BAR = 4096;
constexpr int CW_CNT = 16384;

constexpr int LDS_STAGE = 131072;
constexpr int LDS_MISC = 131072;
constexpr int LM_BAR = 0;
constexpr int LM_HIST = 64;
constexpr int LM_BASE = 192;
constexpr int LM_ROW = 512;
constexpr int LM_NT = 2048;
constexpr int LM_TSTART = 2112;
constexpr int LM_TILEE = 2304;
constexpr int LDS_BYTES = 147456;

#define LDS_WAIT() asm volatile("s_waitcnt lgkmcnt(0)" ::: "memory")
#define VM_WAIT() asm volatile("s_waitcnt vmcnt(0)" ::: "memory")
__device__ __forceinline__ unsigned cvt_pk_bf16(float lo, float hi) { unsigned r; asm("v_cvt_pk_bf16_f32 %0, %1, %2" : "=v"(r) : "v"(lo), "v"(hi)); return r; }
__device__ __forceinline__ u32x4 pack8(const f32x4 a, const f32x4 b) { u32x4 w; w.x = cvt_pk_bf16(a[0], a[1]); w.y = cvt_pk_bf16(a[2], a[3]); w.z = cvt_pk_bf16(b[0], b[1]); w.w = cvt_pk_bf16(b[2], b[3]); return w; }
__device__ __forceinline__ u32x2 pack4(const f32x4 a) { u32x2 w; w.x = cvt_pk_bf16(a[0], a[1]); w.y = cvt_pk_bf16(a[2], a[3]); return w; }
__device__ __forceinline__ float bf_lo(unsigned u) { return __uint_as_float(u << 16); }
__device__ __forceinline__ float bf_hi(unsigned u) { return __uint_as_float(u & 0xffff0000u); }
__device__ __forceinline__ float wave_sum(float v) {
#pragma unroll
    for (int o = 1; o < 64; o <<= 1) v += __shfl_xor(v, o);
    return v;
}
template <class Tp> __device__ __forceinline__ Tp* launder_s(Tp* p) { asm volatile("" : "+s"(p)); return p; }
__device__ __forceinline__ int launder_v(int v) { asm volatile("" : "+v"(v)); return v; }
__device__ __forceinline__ int launder_si(int v) { asm volatile("" : "+s"(v)); return v; }
__device__ __forceinline__ float fast_exp2(float x) { return __builtin_amdgcn_exp2f(x); }
__device__ __forceinline__ float fast_rcp(float x) { return __builtin_amdgcn_rcpf(x); }
__device__ __forceinline__ float sigmoid_f(float v) { return fast_rcp(1.0f + fast_exp2(-v * LOG2E)); }
__device__ __forceinline__ float log2_sigmoid(float x) { return -log1pf(expf(-x)) * LOG2E; }

#define XB_TMO      128
#define XB_XCNT(j)  (256  + 64 * (j))
#define XB_XSUB(j)  (1280 + 64 * (j))
#define XB_XGEN(j)  (2304 + 64 * (j))
#define XB_TOP      3328
#define XB_TOPGEN   3392
#define XCD_BAR_WORDS 3456
#define XB_SPIN_CAP (1u << 18)

__device__ __forceinline__ unsigned xb_ld(unsigned* p)              { return __hip_atomic_load(p, __ATOMIC_RELAXED, __HIP_MEMORY_SCOPE_AGENT); }
__device__ __forceinline__ unsigned xb_add(unsigned* p, unsigned v) { return __hip_atomic_fetch_add(p, v, __ATOMIC_RELAXED, __HIP_MEMORY_SCOPE_AGENT); }
__device__ __forceinline__ unsigned xb_xcc_id() { return (unsigned)__builtin_amdgcn_s_getreg((3 << 11) | 20) & 0xFu; }
#define XB_SPIN(cond, bar) do { unsigned _sp = 0; while (cond) { __builtin_amdgcn_s_sleep(1); \
    if ((++_sp & 255u) == 0u) { if (xb_ld(&(bar)[XB_TMO])) break; if (_sp > XB_SPIN_CAP) { atomicAdd(&(bar)[XB_TMO], 1u); break; } } } } while (0)

struct XcdBarrier {
    unsigned* bar; unsigned x;
    volatile LAS unsigned* st;
};
__device__ __forceinline__ XcdBarrier xcd_barrier_post(unsigned* bar, volatile LAS unsigned* st) {
    XcdBarrier b; b.bar = bar; b.x = xb_xcc_id(); b.st = st;
    if (threadIdx.x == 0) (void)xb_add(&bar[XB_XCNT(b.x)], 1u);
    return b;
}
__device__ __forceinline__ void xcd_barrier_complete(unsigned* bar, unsigned x, unsigned& nloc, unsigned& nx) {
    const unsigned G = gridDim.x * gridDim.y * gridDim.z;
    unsigned sum, cnt, mine, sp = 0u;
    for (;;) {
        sum = 0u; cnt = 0u; mine = 0u;
#pragma unroll
        for (unsigned j = 0; j < 16; ++j) { const unsigned c = xb_ld(&bar[XB_XCNT(j)]); sum += c; cnt += (c > 0u) ? 1u : 0u; mine = (j == x) ? c : mine; }
        if (sum == G) break;
        __builtin_amdgcn_s_sleep(1);
        if ((++sp & 255u) == 0u) { if (xb_ld(&bar[XB_TMO])) break; if (sp > XB_SPIN_CAP) { atomicAdd(&bar[XB_TMO], 1u); break; } }
    }
    nloc = mine > 0u ? mine : 1u; nx = cnt > 0u ? cnt : 1u;
}
__device__ __forceinline__ void xcd_barrier(const XcdBarrier& b) {
    asm volatile("s_waitcnt vmcnt(0)" ::: "memory");
    __syncthreads();
    if (threadIdx.x == 0) {
        unsigned* bar = b.bar;
        __builtin_amdgcn_s_waitcnt(0);
        unsigned nloc = b.st[0], nx = b.st[1];
        if (nloc == 0u) { xcd_barrier_complete(bar, b.x, nloc, nx); b.st[0] = nloc; b.st[1] = nx; }
        const unsigned old = xb_add(&bar[XB_XSUB(b.x)], 1u);
        const unsigned gen = old / nloc;
        if (old + 1u == (gen + 1u) * nloc) {
            __builtin_amdgcn_fence(__ATOMIC_RELEASE, "agent");
            asm volatile("s_waitcnt vmcnt(0)" ::: "memory");
            const unsigned og = xb_add(&bar[XB_TOP], 1u);
            const unsigned tg = og / nx;
            if (og + 1u == (tg + 1u) * nx) xb_add(&bar[XB_TOPGEN], 1u);
            else XB_SPIN(xb_ld(&bar[XB_TOPGEN]) == tg, bar);
            __builtin_amdgcn_fence(__ATOMIC_ACQUIRE, "agent");
            xb_add(&bar[XB_XGEN(b.x)], 1u);
            asm volatile("s_waitcnt vmcnt(0)" ::: "memory");
        } else {
            XB_SPIN(xb_ld(&bar[XB_XGEN(b.x)]) == gen, bar);
            __builtin_amdgcn_fence(__ATOMIC_ACQUIRE, "agent");
            asm volatile("s_waitcnt vmcnt(0)" ::: "memory");
        }
    }
    __syncthreads();
}

namespace pg {
constexpr int BM = 256, BK = 64, HALF = 128, HTB = HALF * BK * 2, STAGE_BYTES = 8 * HTB;
__device__ __forceinline__ int lds_byte(int r, int c) { const int st = (r >> 4) * 2 + (c >> 5), rr = r & 15, cc = c & 31, ob = rr * 64 + cc * 2; return st * 1024 + (ob ^ (((ob >> 9) & 1) << 5)); }
__device__ __forceinline__ void stage_rc(int b, int& R, int& C) { const int st = b / 1024, sb = b % 1024, swz = sb ^ (((sb >> 9) & 1) << 5); R = (st >> 1) * 16 + swz / 64; C = (st & 1) * 32 + (swz % 64) / 2; }
__device__ __forceinline__ int perm32(int rho) { const int n = rho >> 4, i = rho & 15; return 8 * (i >> 2) + 4 * n + (i & 3); }

struct Unit { const char* A; const char* B; int kind, a, b, c; };

template <class Epi, class Dec>
__device__ __forceinline__ void gemm_phase(LAS unsigned char* lds, const int K, const int lda, const int ldb, const int nunits, const Dec& dec, const Epi& E) {
    const int tid = launder_v((int)threadIdx.x), wid = __builtin_amdgcn_readfirstlane(tid >> 6), lane = tid & 63, wr = wid >> 2, wc = wid & 3, fr = lane & 15, fq = lane >> 4;
    const int nt = K / BK;
    const int G = launder_si((int)gridDim.x); int uidx = launder_si((int)blockIdx.x);
    if (uidx >= nunits) return;
    unsigned voffA[2], voffB[2];
#pragma unroll
    for (int i = 0; i < 2; ++i) { int R, C; stage_rc(tid * 16 + i * 8192, R, C); const int Rb = (R & ~31) + perm32(R & 31);
        voffA[i] = (unsigned)(R * lda + C) * 2u; voffB[i] = (unsigned)(Rb * ldb + C) * 2u; }
    const size_t kstep = (size_t)(BK * 2);
    const size_t hstepA = (size_t)HALF * lda * 2, hstepB = (size_t)HALF * ldb * 2;
    const unsigned ldsw = (unsigned)wid * 1024u;
    const int aoff = lds_byte(wr * 64 + fr, fq * 8), boff = lds_byte(wc * 32 + fr, fq * 8);
#define PG_SA(b, h) (((b) * 2 + (h)) * HTB)
#define PG_SB(b, h) ((4 + (b) * 2 + (h)) * HTB)
#define PG_STAGE(bufoff, gbase, voff) do { _Pragma("unroll") for (int _i = 0; _i < 2; ++_i) \
        __builtin_amdgcn_global_load_lds((const unsigned*)((const char*)(gbase) + (voff)[_i]), (LAS unsigned*)(lds + (bufoff) + ldsw + _i * 8192), 16, 0, 0); } while (0)
#define PG_LDA(dst, b, h) do { _Pragma("unroll") for (int m = 0; m < 4; ++m) _Pragma("unroll") for (int k = 0; k < 2; ++k) dst[m][k] = *(const LAS bf16x8*)(lds + PG_SA(b, h) + aoff + m * 2048 + k * 1024); } while (0)
#define PG_LDB(dst, b, h) do { _Pragma("unroll") for (int n = 0; n < 2; ++n) _Pragma("unroll") for (int k = 0; k < 2; ++k) dst[n][k] = *(const LAS bf16x8*)(lds + PG_SB(b, h) + boff + n * 2048 + k * 1024); } while (0)
#define PG_MMA(ai, bj, At, Bt) do { __builtin_amdgcn_s_setprio(1); _Pragma("unroll") for (int m = 0; m < 4; ++m) _Pragma("unroll") for (int n = 0; n < 2; ++n) _Pragma("unroll") for (int k = 0; k < 2; ++k) \
        acc[ai][bj][m][n] = __builtin_amdgcn_mfma_f32_16x16x32_bf16(Bt[n][k], At[m][k], acc[ai][bj][m][n], 0, 0, 0); __builtin_amdgcn_s_setprio(0); } while (0)
#define PG_WAIT_V(n) asm volatile("s_waitcnt vmcnt(" #n ")" ::: "memory")
#define PG_WAIT_L(n) asm volatile("s_waitcnt lgkmcnt(" #n ")" ::: "memory")
#define PG_BAR __builtin_amdgcn_s_barrier()
#define PG_SCHED __builtin_amdgcn_sched_barrier(0)
    Unit cur, nxt;
    dec(uidx, cur);
    f32x4 acc[2][2][4][2];
#pragma unroll
    for (int a = 0; a < 2; ++a)
#pragma unroll
        for (int b = 0; b < 2; ++b)
#pragma unroll
            for (int m = 0; m < 4; ++m)
#pragma unroll
                for (int n = 0; n < 2; ++n) acc[a][b][m][n] = (f32x4){0.f, 0.f, 0.f, 0.f};
    bf16x8 At[4][2], B0[2][2], B1[2][2];
    const char* cA = cur.A; const char* cB = cur.B;
    PG_STAGE(PG_SB(0, 0), cB, voffB); PG_STAGE(PG_SB(0, 1), cB + hstepB, voffB); PG_STAGE(PG_SA(0, 0), cA, voffA); PG_STAGE(PG_SA(0, 1), cA + hstepA, voffA);
    if (wr == 1) PG_BAR;
    PG_WAIT_V(2); PG_BAR;
    PG_STAGE(PG_SB(1, 0), cB + kstep, voffB); PG_STAGE(PG_SA(1, 0), cA + kstep, voffA); PG_STAGE(PG_SB(1, 1), cB + hstepB + kstep, voffB);
    PG_WAIT_V(6); PG_BAR;
    for (;;) {
        const bool has_next = (uidx + G < nunits);
        if (has_next) dec(uidx + G, nxt);
        const char* nA = has_next ? nxt.A : cA; const char* nB = has_next ? nxt.B : cB;
#pragma nounroll
        for (int t = 0; t < nt; t += 2) {
            const bool last = (t == nt - 2);
            const char* a1 = cA + (size_t)(t + 1) * kstep;
            const char* a2 = last ? nA : cA + (size_t)(t + 2) * kstep; const char* b2 = last ? nB : cB + (size_t)(t + 2) * kstep;
            const char* a3 = a2 + kstep; const char* b3 = b2 + kstep;
            PG_LDB(B0, 0, 0); PG_LDB(B1, 0, 1); PG_SCHED; PG_LDA(At, 0, 0); PG_STAGE(PG_SA(1, 1), a1 + hstepA, voffA);
            PG_WAIT_V(8); PG_WAIT_L(0); PG_BAR; PG_MMA(0, 0, At, B0); PG_MMA(0, 1, At, B1); PG_BAR; PG_SCHED;
            PG_LDA(At, 0, 1); PG_STAGE(PG_SB(0, 0), b2, voffB); PG_STAGE(PG_SB(0, 1), b2 + hstepB, voffB); PG_STAGE(PG_SA(0, 0), a2, voffA);
            PG_WAIT_V(8); PG_WAIT_L(0); PG_BAR; PG_MMA(1, 0, At, B0); PG_MMA(1, 1, At, B1); PG_BAR; PG_SCHED;
            PG_LDB(B0, 1, 0); PG_LDB(B1, 1, 1); PG_SCHED; PG_LDA(At, 1, 0); PG_STAGE(PG_SA(0, 1), a2 + hstepA, voffA);
            PG_WAIT_V(8); PG_WAIT_L(0); PG_BAR; PG_MMA(0, 0, At, B0); PG_MMA(0, 1, At, B1); PG_BAR; PG_SCHED;
            PG_LDA(At, 1, 1); PG_STAGE(PG_SB(1, 0), b3, voffB); PG_STAGE(PG_SB(1, 1), b3 + hstepB, voffB); PG_STAGE(PG_SA(1, 0), a3, voffA);
            PG_WAIT_V(8); PG_WAIT_L(0); PG_BAR; PG_MMA(1, 0, At, B0); PG_MMA(1, 1, At, B1); PG_BAR; PG_SCHED;
        }
        if (wr == 0) PG_BAR;
        E(acc, cur, wr, wc, fr, fq);
        if (!has_next) break;
#pragma unroll
        for (int a = 0; a < 2; ++a)
#pragma unroll
            for (int b = 0; b < 2; ++b)
#pragma unroll
                for (int m = 0; m < 4; ++m)
#pragma unroll
                    for (int n = 0; n < 2; ++n) acc[a][b][m][n] = (f32x4){0.f, 0.f, 0.f, 0.f};
        cur = nxt; cA = nA; cB = nB; uidx += G;
        if (wr == 1) PG_BAR;
    }
    PG_WAIT_V(0);
    PG_BAR;
#undef PG_SA
#undef PG_SB
#undef PG_STAGE
#undef PG_LDA
#undef PG_LDB
#undef PG_MMA
#undef PG_WAIT_V
#undef PG_WAIT_L
#undef PG_BAR
#undef PG_SCHED
}
}
using pg::Unit;

enum { KQ = 0, KK = 1, KPL_SILU = 2, KPL_SCALE = 3, KPL_SIG = 4, KKT = 5, KVT = 6, KVNT = 7 };

struct DecInProj {
    const char* xb; const char* WinT;
    __device__ __forceinline__ void operator()(int u, Unit& o) const {
        if (u < 2048) {
            const int g = u >> 8, r = u & 255, pm = g * 8 + (r & 7), j = r >> 3;
            const int wt = j < 8 ? j : (j < 24 ? j + 8 : j + 12);
            o.A = xb + (size_t)pm * (256 * 1024 * 2); o.B = WinT + (size_t)wt * (256 * 1024 * 2); o.b = pm * 256; o.c = 0;
            if (wt < 4) { o.kind = KQ; o.a = wt; }
            else if (wt < 8) { o.kind = KK; o.a = wt - 4; }
            else if (wt < 24) { o.kind = KPL_SILU; o.a = (wt - 16) * 256; }
            else if (wt < 28) { o.kind = KPL_SCALE; o.a = (wt - 24) * 256; o.c = 0; }
            else if (wt < 32) { o.kind = KPL_SCALE; o.a = (wt - 28) * 256; o.c = 1; }
            else { o.kind = KPL_SIG; o.a = (wt - 36) * 256; }
        } else {
            const int v = u - 2048, g = v >> 8, r = v & 255, tt = g * 16 + (r & 15), ci = r >> 4;
            int ct;
            if (ci < 4) { ct = 4 + ci; o.kind = KKT; o.a = ci; o.c = 0; }
            else if (ci < 12) { ct = 8 + (ci - 4); o.kind = KVT; o.a = (ci - 4) >> 1; o.c = (ci - 4) & 1; }
            else { ct = 32 + (ci - 12); o.kind = KVNT; o.a = ci - 12; o.c = 0; }
            o.A = WinT + (size_t)ct * (256 * 1024 * 2); o.B = xb + (size_t)tt * (256 * 1024 * 2); o.b = tt * 256;
        }
    }
};
struct EpiInProj {
    unsigned char* ws_;
    const float* decay;
    __device__ __forceinline__ void operator()(const f32x4 (&acc)[2][2][4][2], const Unit& u, int wr, int wc, int fr, int fq) const {
        unsigned char* w = launder_s(ws_);
        bf16_t* const Q = (bf16_t*)(w + WS_Q); bf16_t* const Kb = (bf16_t*)(w + WS_K); bf16_t* const ACAT = (bf16_t*)(w + WS_ACAT); bf16_t* const BCAT = (bf16_t*)(w + WS_BCAT);
        bf16_t* const KDT = (bf16_t*)(w + WS_KDT); bf16_t* const SG = (bf16_t*)(w + WS_SG); bf16_t* const QN = (bf16_t*)(w + WS_QN); bf16_t* const KN = (bf16_t*)(w + WS_KN);
        bf16_t* const VNT = (bf16_t*)(w + WS_VNT); bf16_t* const Gt = (bf16_t*)(w + WS_G);
        const float* const cosN = (const float*)(w + WS_TAB); const float* const sinN = cosN + 4096 * 128; const float* const cosT = sinN + 4096 * 128; const float* const sinT = cosT + 4096 * 128;
        const int kind = u.kind, c8 = wc * 32 + fq * 8;
        if (kind == KQ || kind == KK) {
            const int h = u.a, t0 = u.b;
            float lf = 0.f, lb = 0.f;
            if (kind == KQ) { lf = log2_sigmoid(decay[h]); lb = log2_sigmoid(decay[4 + h]); }
#pragma unroll
            for (int ai = 0; ai < 2; ++ai)
#pragma unroll
                for (int m = 0; m < 4; ++m) {
                    const int t = t0 + ai * 128 + wr * 64 + m * 16 + fr, pos = t & 4095;
                    const float* cp = cosN + (size_t)pos * 128 + c8; const float* sp = sinN + (size_t)pos * 128 + c8;
                    const f32x4 c0 = *(const f32x4*)cp, c1 = *(const f32x4*)(cp + 4), s0 = *(const f32x4*)sp, s1 = *(const f32x4*)(sp + 4);
                    const f32x4 x1a = acc[ai][0][m][0], x1b = acc[ai][0][m][1], x2a = acc[ai][1][m][0], x2b = acc[ai][1][m][1];
                    f32x4 q1a = x1a * c0 - x2a * s0, q1b = x1b * c1 - x2b * s1, q2a = x1a * s0 + x2a * c0, q2b = x1b * s1 + x2b * c1;
                    if (kind == KQ) {
                        bf16_t* qp = Q + (size_t)t * 1024 + h * 256 + c8;
                        *(u32x4*)qp = pack8(q1a, q1b); *(u32x4*)(qp + 128) = pack8(q2a, q2b);
                        const int p = t & 511; const float df = fast_exp2(lf * (float)(p + 1)), db = fast_exp2(lb * (float)(512 - p));
                        bf16_t* ap = ACAT + ((size_t)t * 4 + h) * 1024 + 512 + c8;
                        *(u32x4*)ap = pack8(q1a * df, q1b * df); *(u32x4*)(ap + 128) = pack8(q2a * df, q2b * df);
                        *(u32x4*)(ap + 256) = pack8(q1a * db, q1b * db); *(u32x4*)(ap + 384) = pack8(q2a * db, q2b * db);
                    } else {
                        bf16_t* kp = Kb + (size_t)t * 1024 + h * 256 + c8;
                        *(u32x4*)kp = pack8(q1a * 0.0625f, q1b * 0.0625f); *(u32x4*)(kp + 128) = pack8(q2a * 0.0625f, q2b * 0.0625f);
                    }
                    __builtin_amdgcn_sched_barrier(0);
                }
        } else if (kind == KPL_SILU || kind == KPL_SCALE || kind == KPL_SIG) {
            const int t0 = u.b;
            bf16_t* dst; int ld; float sc = 1.f;
            if (kind == KPL_SILU) { dst = SG; ld = 2048; }
            else if (kind == KPL_SIG) { dst = Gt; ld = 2048; }
            else { ld = 1024; if (u.c == 0) { dst = QN; sc = 0.125f; } else { dst = KN; } }
            dst += u.a + c8;
#pragma unroll
            for (int ai = 0; ai < 2; ++ai)
#pragma unroll
                for (int m = 0; m < 4; ++m) {
                    const int t = t0 + ai * 128 + wr * 64 + m * 16 + fr;
#pragma unroll
                    for (int bj = 0; bj < 2; ++bj) {
                        f32x4 v0 = acc[ai][bj][m][0], v1 = acc[ai][bj][m][1];
                        if (kind == KPL_SCALE) { v0 = v0 * sc; v1 = v1 * sc; }
                        else {
#pragma unroll
                            for (int i = 0; i < 4; ++i) { const float g0 = sigmoid_f(v0[i]), g1 = sigmoid_f(v1[i]); v0[i] = (kind == KPL_SILU) ? v0[i] * g0 : g0; v1[i] = (kind == KPL_SILU) ? v1[i] * g1 : g1; }
                        }
                        *(u32x4*)(dst + (size_t)t * ld + bj * 128) = pack8(v0, v1);
                    }
                }
        } else {
            const int t0 = u.b, bb = t0 >> 12, s0 = t0 & 4095, cc = s0 >> 9, j0 = s0 & 511;
            if (kind == KKT) {
                const int h = u.a;
                const float lf = log2_sigmoid(decay[h]), lb = log2_sigmoid(decay[4 + h]);
#pragma unroll
                for (int bj = 0; bj < 2; ++bj) {
                    const int col8 = bj * 128 + c8, s = s0 + col8, j = j0 + col8;
                    f32x4 df0, df1, db0, db1;
#pragma unroll
                    for (int i = 0; i < 4; ++i) { df0[i] = 0.0625f * fast_exp2(lf * (float)(511 - (j + i))); df1[i] = 0.0625f * fast_exp2(lf * (float)(511 - (j + 4 + i)));
                                                  db0[i] = 0.0625f * fast_exp2(lb * (float)(j + i)); db1[i] = 0.0625f * fast_exp2(lb * (float)(j + 4 + i)); }
#pragma unroll
                    for (int m = 0; m < 4; ++m) {
                        const int dl = wr * 64 + m * 16 + fr;
                        const float* cp = cosT + (size_t)dl * 4096 + s; const float* sp = sinT + (size_t)dl * 4096 + s;
                        const f32x4 c0 = *(const f32x4*)cp, c1 = *(const f32x4*)(cp + 4), sn0 = *(const f32x4*)sp, sn1 = *(const f32x4*)(sp + 4);
                        const f32x4 x1a = acc[0][bj][m][0], x1b = acc[0][bj][m][1], x2a = acc[1][bj][m][0], x2b = acc[1][bj][m][1];
                        const f32x4 k1a = x1a * c0 - x2a * sn0, k1b = x1b * c1 - x2b * sn1, k2a = x1a * sn0 + x2a * c0, k2b = x1b * sn1 + x2b * c1;
                        bf16_t* kp = KDT + ((((size_t)(bb * 4 + h) * 8 + cc) * 2) * 256 + dl) * 512 + j;
                        *(u32x4*)kp = pack8(k1a * df0, k1b * df1); *(u32x4*)(kp + 128 * 512) = pack8(k2a * df0, k2b * df1);
                        *(u32x4*)(kp + 256 * 512) = pack8(k1a * db0, k1b * db1); *(u32x4*)(kp + 384 * 512) = pack8(k2a * db0, k2b * db1);
                        __builtin_amdgcn_sched_barrier(0);
                    }
                }
            } else if (kind == KVT) {
                const int h = u.a;
#pragma unroll
                for (int ai = 0; ai < 2; ++ai)
#pragma unroll
                    for (int m = 0; m < 4; ++m) {
                        const int e = u.c * 256 + ai * 128 + wr * 64 + m * 16 + fr;
                        bf16_t* vp = BCAT + (((size_t)(bb * 4 + h) * 8 + cc) * 512 + e) * 1024 + j0 + c8;
#pragma unroll
                        for (int bj = 0; bj < 2; ++bj) *(u32x4*)(vp + bj * 128) = pack8(acc[ai][bj][m][0], acc[ai][bj][m][1]);
                    }
            } else {
#pragma unroll
                for (int ai = 0; ai < 2; ++ai)
#pragma unroll
                    for (int m = 0; m < 4; ++m) {
                        const int ch = u.a * 256 + ai * 128 + wr * 64 + m * 16 + fr;
                        bf16_t* vp = VNT + ((size_t)bb * 1024 + ch) * 4096 + s0 + c8;
#pragma unroll
                        for (int bj = 0; bj < 2; ++bj) *(u32x4*)(vp + bj * 128) = pack8(acc[ai][bj][m][0], acc[ai][bj][m][1]);
                    }
            }
        }
    }
};

struct DecR1 {
    const char* Q; const char* Kb;
    __device__ __forceinline__ void operator()(int u, Unit& o) const {
        const int pn2 = u & 1, pm2 = (u >> 1) & 1, cc = (u >> 2) & 7, bh = u >> 5, b = bh >> 2, h = bh & 3;
        const int ti = b * 4096 + cc * 512 + pm2 * 256, tj = b * 4096 + cc * 512 + pn2 * 256;
        o.A = Q + ((size_t)ti * 1024 + h * 256) * 2; o.B = Kb + ((size_t)tj * 1024 + h * 256) * 2;
        o.kind = 0; o.a = h; o.b = ti; o.c = pm2 * 2 + pn2;
    }
};
struct EpiR1 {
    bf16_t* ACAT; const float* decay;
    __device__ __forceinline__ void operator()(const f32x4 (&acc)[2][2][4][2], const Unit& u, int wr, int wc, int fr, int fq) const {
        const int h = u.a, ti0 = u.b, i0 = (u.c >> 1) * 256, j0 = (u.c & 1) * 256, c8 = wc * 32 + fq * 8;
        const float lf = log2_sigmoid(decay[h]), lb = log2_sigmoid(decay[4 + h]);
#pragma unroll
        for (int ai = 0; ai < 2; ++ai)
#pragma unroll
            for (int m = 0; m < 4; ++m) {
                const int r = ai * 128 + wr * 64 + m * 16 + fr, i = i0 + r;
                bf16_t* ap = ACAT + ((size_t)(ti0 + r) * 4 + h) * 1024 + j0 + c8;
#pragma unroll
                for (int bj = 0; bj < 2; ++bj) {
                    f32x4 v0 = acc[ai][bj][m][0], v1 = acc[ai][bj][m][1];
                    const int jb = j0 + bj * 128 + c8;
#pragma unroll
                    for (int q = 0; q < 4; ++q) {
                        const int d0 = i - (jb + q), d1 = i - (jb + 4 + q);
                        v0[q] *= fast_exp2(d0 >= 0 ? lf * (float)d0 : lb * (float)(-d0));
                        v1[q] *= fast_exp2(d1 >= 0 ? lf * (float)d1 : lb * (float)(-d1));
                    }
                    *(u32x4*)(ap + bj * 128) = pack8(v0, v1);
                }
                __builtin_amdgcn_sched_barrier(0);
            }
    }
};
struct DecR2 {
    const char* BCAT; const char* KDT;
    __device__ __forceinline__ void operator()(int u, Unit& o) const {
        const int pm2 = u & 1, v = u >> 1, pr = v % 14, bh = v / 14;
        const int dir = pr < 7 ? 0 : 1, cc = pr < 7 ? pr : pr - 6;
        o.A = BCAT + (((size_t)(bh * 8 + cc) * 512 + pm2 * 256) * 1024) * 2;
        o.B = KDT + ((((size_t)(bh * 8 + cc) * 2 + dir) * 256) * 512) * 2;
        o.kind = 0; o.a = (bh * 8 + cc) * 2 + dir; o.b = pm2 * 256; o.c = 0;
    }
};
struct EpiR2 {
    float* KV;
    __device__ __forceinline__ void operator()(const f32x4 (&acc)[2][2][4][2], const Unit& u, int wr, int wc, int fr, int fq) const {
        const int c8 = wc * 32 + fq * 8;
#pragma unroll
        for (int ai = 0; ai < 2; ++ai)
#pragma unroll
            for (int m = 0; m < 4; ++m) {
                const int e = u.b + ai * 128 + wr * 64 + m * 16 + fr;
                float* kp = KV + ((size_t)u.a * 512 + e) * 256 + c8;
#pragma unroll
                for (int bj = 0; bj < 2; ++bj) { *(f32x4*)(kp + bj * 128) = acc[ai][bj][m][0]; *(f32x4*)(kp + bj * 128 + 4) = acc[ai][bj][m][1]; }
            }
    }
};
struct DecR4 {
    const char* ACAT; const char* BCAT;
    __device__ __forceinline__ void operator()(int u, Unit& o) const {
        const int pn2 = u & 1, pm2 = (u >> 1) & 1, cc = (u >> 2) & 7, bh = u >> 5, b = bh >> 2, h = bh & 3;
        const int ti = b * 4096 + cc * 512 + pm2 * 256;
        o.A = ACAT + (((size_t)ti * 4 + h) * 1024) * 2; o.B = BCAT + (((size_t)(bh * 8 + cc) * 512 + pn2 * 256) * 1024) * 2;
        o.kind = 0; o.a = h * 512 + pn2 * 256; o.b = ti; o.c = 0;
    }
};
struct EpiR4 {
    bf16_t* RET;
    __device__ __forceinline__ void operator()(const f32x4 (&acc)[2][2][4][2], const Unit& u, int wr, int wc, int fr, int fq) const {
        const int c8 = wc * 32 + fq * 8;
#pragma unroll
        for (int ai = 0; ai < 2; ++ai)
#pragma unroll
            for (int m = 0; m < 4; ++m) {
                const int t = u.b + ai * 128 + wr * 64 + m * 16 + fr;
                bf16_t* rp = RET + (size_t)t * 2048 + u.a + c8;
#pragma unroll
                for (int bj = 0; bj < 2; ++bj) *(u32x4*)(rp + bj * 128) = pack8(acc[ai][bj][m][0], acc[ai][bj][m][1]);
            }
    }
};
struct DecDense {
    const char* A; const char* B; int lda2, ldb2;
    __device__ __forceinline__ void operator()(int u, Unit& o) const {
        const int pn = u >> 6, pm = u & 63;
        o.A = A + (size_t)pm * 256 * lda2; o.B = B + (size_t)pn * 256 * ldb2; o.kind = 0; o.a = pn * 256; o.b = pm * 256; o.c = 0;
    }
};
template <int MODE> struct EpiMerge {
    bf16_t* MG; const bf16_t* Gt;
    __device__ __forceinline__ void operator()(const f32x4 (&acc)[2][2][4][2], const Unit& u, int wr, int wc, int fr, int fq) const {
        const int c8 = wc * 32 + fq * 8;
#pragma unroll
        for (int ai = 0; ai < 2; ++ai)
#pragma unroll
            for (int m = 0; m < 4; ++m) {
                const int t = u.b + ai * 128 + wr * 64 + m * 16 + fr;
#pragma unroll
                for (int bj = 0; bj < 2; ++bj) {
                    const int c = u.a + bj * 128 + c8;
                    const u32x4 g = *(const u32x4*)(Gt + (size_t)t * 2048 + MODE * 1024 + c);
                    f32x4 v0 = acc[ai][bj][m][0], v1 = acc[ai][bj][m][1];
                    v0[0] *= bf_lo(g.x); v0[1] *= bf_hi(g.x); v0[2] *= bf_lo(g.y); v0[3] *= bf_hi(g.y);
                    v1[0] *= bf_lo(g.z); v1[1] *= bf_hi(g.z); v1[2] *= bf_lo(g.w); v1[3] *= bf_hi(g.w);
                    bf16_t* mp = MG + (size_t)t * 1024 + c;
                    if (MODE == 1) { const u32x4 o = *(const u32x4*)mp;
                        v0[0] += bf_lo(o.x); v0[1] += bf_hi(o.x); v0[2] += bf_lo(o.y); v0[3] += bf_hi(o.y);
                        v1[0] += bf_lo(o.z); v1[1] += bf_hi(o.z); v1[2] += bf_lo(o.w); v1[3] += bf_hi(o.w); }
                    *(u32x4*)mp = pack8(v0, v1);
                }
            }
    }
};
struct EpiPre {
    float* PRE; const float* xin;
    __device__ __forceinline__ void operator()(const f32x4 (&acc)[2][2][4][2], const Unit& u, int wr, int wc, int fr, int fq) const {
        const int c8 = wc * 32 + fq * 8;
#pragma unroll
        for (int ai = 0; ai < 2; ++ai)
#pragma unroll
            for (int m = 0; m < 4; ++m) {
                const int t = u.b + ai * 128 + wr * 64 + m * 16 + fr;
#pragma unroll
                for (int bj = 0; bj < 2; ++bj) {
                    const size_t o = (size_t)t * 1024 + u.a + bj * 128 + c8;
                    const f32x4 x0 = *(const f32x4*)(xin + o), x1 = *(const f32x4*)(xin + o + 4);
                    *(f32x4*)(PRE + o) = x0 * ALPHA + acc[ai][bj][m][0]; *(f32x4*)(PRE + o + 4) = x1 * ALPHA + acc[ai][bj][m][1];
                }
            }
    }
};
struct DecMoe {
    const char* A; const char* W; int lda2, wexp2, ldb2; const LAS int* tile_e;
    __device__ __forceinline__ void operator()(int u, Unit& o) const {
        const int a = u >> 2, pn = u & 3, e = tile_e[a];
        o.A = A + (size_t)a * 256 * lda2; o.B = W + (size_t)e * wexp2 + (size_t)pn * 256 * ldb2; o.kind = 0; o.a = pn; o.b = a * 256; o.c = 0;
    }
};
struct EpiUp {
    bf16_t* H;
    __device__ __forceinline__ void operator()(const f32x4 (&acc)[2][2][4][2], const Unit& u, int wr, int wc, int fr, int fq) const {
        const int c8 = wc * 32 + fq * 8;
#pragma unroll
        for (int ai = 0; ai < 2; ++ai)
#pragma unroll
            for (int m = 0; m < 4; ++m) {
                const int r = u.b + ai * 128 + wr * 64 + m * 16 + fr;
                f32x4 g0 = acc[ai][0][m][0], g1 = acc[ai][0][m][1]; const f32x4 u0 = acc[ai][1][m][0], u1 = acc[ai][1][m][1];
#pragma unroll
                for (int i = 0; i < 4; ++i) { g0[i] = g0[i] * sigmoid_f(g0[i]) * u0[i]; g1[i] = g1[i] * sigmoid_f(g1[i]) * u1[i]; }
                *(u32x4*)(H + (size_t)r * 512 + u.a * 128 + c8) = pack8(g0, g1);
            }
    }
};
struct EpiDown {
    bf16_t* Y;
    __device__ __forceinline__ void operator()(const f32x4 (&acc)[2][2][4][2], const Unit& u, int wr, int wc, int fr, int fq) const {
        const int c8 = wc * 32 + fq * 8;
#pragma unroll
        for (int ai = 0; ai < 2; ++ai)
#pragma unroll
            for (int m = 0; m < 4; ++m) {
                const int r = u.b + ai * 128 + wr * 64 + m * 16 + fr;
                bf16_t* yp = Y + (size_t)r * 1024 + u.a * 256 + c8;
#pragma unroll
                for (int bj = 0; bj < 2; ++bj) *(u32x4*)(yp + bj * 128) = pack8(acc[ai][bj][m][0], acc[ai][bj][m][1]);
            }
    }
};

__device__ __forceinline__ void tr_item(const float* W, int ldw, bf16_t* WT, int ldwt, int k0, int n0, int drow0, LAS float* scr, int lane) {
#pragma unroll 8
    for (int i = 0; i < 32; ++i) { const int kk = 2 * i + (lane >> 5); scr[kk * 33 + (lane & 31)] = W[(size_t)(k0 + kk) * ldw + n0 + (lane & 31)]; }
    LDS_WAIT();
    const int c = lane & 7;
#pragma unroll
    for (int j = 0; j < 4; ++j) { const int n = (lane >> 3) + 8 * j; const LAS float* s = scr + (8 * c) * 33 + n;
        u32x4 o; o.x = cvt_pk_bf16(s[0 * 33], s[1 * 33]); o.y = cvt_pk_bf16(s[2 * 33], s[3 * 33]); o.z = cvt_pk_bf16(s[4 * 33], s[5 * 33]); o.w = cvt_pk_bf16(s[6 * 33], s[7 * 33]);
        *(u32x4*)(WT + (size_t)(drow0 + n) * ldwt + k0 + 8 * c) = o; }
    LDS_WAIT();
}
struct Params {
    const float* x; const float* w_in; const float* decay; const float* w_ret_o; const float* rpb; const float* w_na_o; const float* w_out;
    const float* ln_mix_g; const float* ln_mix_b; const float* router_w; const float* router_bias;
    const float* w_gate; const float* w_up; const float* w_down; const float* ln_ffn_g; const float* ln_ffn_b;
    float* out; unsigned char* ws; int ph_lo, ph_hi;
};
__device__ __forceinline__ Params load_params() {
    typedef __attribute__((address_space(4))) const Params CP;
    CP* pk = (CP*)__builtin_amdgcn_kernarg_segment_ptr();
    asm volatile("" : "+s"(pk));
    Params r;
    r.x = pk->x; r.w_in = pk->w_in; r.decay = pk->decay; r.w_ret_o = pk->w_ret_o; r.rpb = pk->rpb; r.w_na_o = pk->w_na_o; r.w_out = pk->w_out;
    r.ln_mix_g = pk->ln_mix_g; r.ln_mix_b = pk->ln_mix_b; r.router_w = pk->router_w; r.router_bias = pk->router_bias;
    r.w_gate = pk->w_gate; r.w_up = pk->w_up; r.w_down = pk->w_down; r.ln_ffn_g = pk->ln_ffn_g; r.ln_ffn_b = pk->ln_ffn_b;
    r.out = pk->out; r.ws = pk->ws; r.ph_lo = pk->ph_lo; r.ph_hi = pk->ph_hi;
    return r;
}
__device__ __forceinline__ void convert_layer(const Params& P, int l, LAS unsigned char* lds, int gw, int NGW, int wave, int lane) {
    LAS float* scr = (LAS float*)(lds + wave * 16384);
    unsigned char* ws = P.ws;
    constexpr int I0 = 16 * 352, I1 = 32 * 32, I2 = 16 * 32, I3 = 16 * 32, I4 = 32 * 256, I5 = 32 * 256, I6 = 32 * 256;
    constexpr int NIT = I0 + I1 + I2 + I3 + I4 + I5 + I6;
    for (int it = gw; it < NIT; it += NGW) {
        int r = it;
        if (r < I0) { const int kb = r / 352, nb = r % 352; tr_item(P.w_in + (size_t)l * 1024 * DIN, DIN, (bf16_t*)(ws + WS_WIN), 1024, kb * 64, nb * 32, nb * 32, scr, lane); continue; } r -= I0;
        if (r < I1) { const int kb = r >> 5, nb = r & 31; tr_item(P.w_ret_o + (size_t)l * 2048 * 1024, 1024, (bf16_t*)(ws + WS_WRET), 2048, kb * 64, nb * 32, nb * 32, scr, lane); continue; } r -= I1;
        if (r < I2) { const int kb = r >> 5, nb = r & 31; tr_item(P.w_na_o + (size_t)l * 1024 * 1024, 1024, (bf16_t*)(ws + WS_WNA), 1024, kb * 64, nb * 32, nb * 32, scr, lane); continue; } r -= I2;
        if (r < I3) { const int kb = r >> 5, nb = r & 31; tr_item(P.w_out + (size_t)l * 1024 * 1024, 1024, (bf16_t*)(ws + WS_WOUT), 1024, kb * 64, nb * 32, nb * 32, scr, lane); continue; } r -= I3;
        if (r < I4 + I5) { const int up = r >= I4 ? 1 : 0; if (up) r -= I4; const int e = r >> 8, q = r & 255, kb = q >> 4, nb = q & 15, n0 = nb * 32;
            const float* src = (up ? P.w_up : P.w_gate) + ((size_t)l * NE + e) * 1024 * 512;
            tr_item(src, 512, (bf16_t*)(ws + WS_WGU), 1024, kb * 64, n0, e * 1024 + (n0 >> 7) * 256 + up * 128 + (n0 & 127), scr, lane); continue; } r -= I4 + I5;
        { const int e = r >> 8, q = r & 255, kb = q >> 5, nb = q & 31;
          tr_item(P.w_down + ((size_t)l * NE + e) * 512 * 1024, 1024, (bf16_t*)(ws + WS_WD), 512, kb * 64, nb * 32, e * 1024 + nb * 32, scr, lane); }
    }
}
__device__ __forceinline__ void sincos_d(double a, float& s, float& c) {
    const double k = rint(a * 0.63661977236758134308);
    double y = fma(-k, 1.5707963267948966192, a); y = fma(-k, 6.123233995736766036e-17, y);
    const double y2 = y * y;
    double sp = -1.0 / 1307674368000.0; sp = fma(sp, y2, 1.0 / 6227020800.0); sp = fma(sp, y2, -1.0 / 39916800.0); sp = fma(sp, y2, 1.0 / 362880.0); sp = fma(sp, y2, -1.0 / 5040.0); sp = fma(sp, y2, 1.0 / 120.0); sp = fma(sp, y2, -1.0 / 6.0); sp = fma(sp * y2, y, y);
    double cp = 1.0 / 20922789888000.0; cp = fma(cp, y2, -1.0 / 87178291200.0); cp = fma(cp, y2, 1.0 / 479001600.0); cp = fma(cp, y2, -1.0 / 3628800.0); cp = fma(cp, y2, 1.0 / 40320.0); cp = fma(cp, y2, -1.0 / 720.0); cp = fma(cp, y2, 1.0 / 24.0); cp = fma(cp, y2, -0.5); cp = fma(cp, y2, 1.0);
    const int q = (int)((long long)k & 3);
    const double sv = (q == 0) ? sp : (q == 1) ? cp : (q == 2) ? -sp : -cp;
    const double cv = (q == 0) ? cp : (q == 1) ? -sp : (q == 2) ? -cp : sp;
    s = (float)sv; c = (float)cv;
}
__device__ __forceinline__ void phase_init(const Params& P, LAS unsigned char* lds, int gw, int NGW, int wave, int lane) {
    unsigned char* ws = P.ws;
    float* cosN = (float*)(ws + WS_TAB); float* sinN = cosN + 4096 * 128; float* cosT = sinN + 4096 * 128; float* sinT = cosT + 4096 * 128;
    const int gtid = gw * 64 + lane, NT_ = NGW * 64;
    for (int i = gtid; i < 4096 * 128; i += NT_) {
        const int pos = i >> 7, j = i & 127;
        const double freq = exp(-(double)j * (9.210340371976184 / 128.0));
        float s, c; sincos_d((double)pos * freq, s, c);
        cosN[i] = c; sinN[i] = s; cosT[(size_t)j * 4096 + pos] = c; sinT[(size_t)j * 4096 + pos] = s;
    }
    bf16_t* xb = (bf16_t*)(ws + WS_XB);
    for (int i = gtid; i < T * D / 8; i += NT_) {
        const f32x4 a = *(const f32x4*)(P.x + (size_t)i * 8), b = *(const f32x4*)(P.x + (size_t)i * 8 + 4);
        *(u32x4*)(xb + (size_t)i * 8) = pack8(a, b);
    }
    convert_layer(P, 0, lds, gw, NGW, wave, lane);
}
__device__ __forceinline__ void phase_prefix(const Params& P, int l, int gw, int NGW, int lane) {
    const float* KV = (const float*)(P.ws + WS_KV); bf16_t* BCAT = (bf16_t*)(P.ws + WS_BCAT);
    const float* decay = P.decay + l * 8;
    const int gtid = gw * 64 + lane, NT_ = NGW * 64;
    for (int idx = gtid; idx < 16 * 2 * 512 * 32; idx += NT_) {
        const int dg = idx & 31, e = (idx >> 5) & 511, dir = (idx >> 14) & 1, bh = idx >> 15, h = bh & 3;
        const float cd = fast_exp2(log2_sigmoid(decay[dir * 4 + h]) * 512.0f);
        f32x4 s0 = {0.f, 0.f, 0.f, 0.f}, s1 = {0.f, 0.f, 0.f, 0.f};
        for (int q = 0; q < 8; ++q) {
            const int cc = dir ? 7 - q : q;
            *(u32x4*)(BCAT + ((size_t)(bh * 8 + cc) * 512 + e) * 1024 + 512 + dir * 256 + dg * 8) = pack8(s0, s1);
            if (q < 7) { const float* kp = KV + ((size_t)((bh * 8 + cc) * 2 + dir) * 512 + e) * 256 + dg * 8;
                s0 = s0 * cd + *(const f32x4*)kp; s1 = s1 * cd + *(const f32x4*)(kp + 4); }
        }
    }
}
__device__ __forceinline__ void phase_headnorm(const Params& P, int gw, int NGW, int lane) {
    const bf16_t* RET = (const bf16_t*)(P.ws + WS_KV); const bf16_t* SG = (const bf16_t*)(P.ws + WS_SG); bf16_t* AR = (bf16_t*)(P.ws + WS_KDT);
    for (int it = gw; it < T * 4; it += NGW) {
        const size_t off = (size_t)it * 512 + lane * 8;
        const u32x4 r = *(const u32x4*)(RET + off), g = *(const u32x4*)(SG + off);
        float v[8] = {bf_lo(r.x), bf_hi(r.x), bf_lo(r.y), bf_hi(r.y), bf_lo(r.z), bf_hi(r.z), bf_lo(r.w), bf_hi(r.w)};
        float s = 0.f;
#pragma unroll
        for (int i = 0; i < 8; ++i) s += v[i];
        const float mean = wave_sum(s) * (1.0f / 512.0f);
        float q = 0.f;
#pragma unroll
        for (int i = 0; i < 8; ++i) { v[i] -= mean; q += v[i] * v[i]; }
        const float rstd = 1.0f / sqrtf(wave_sum(q) * (1.0f / 512.0f) + 1e-5f);
        const float gg[8] = {bf_lo(g.x), bf_hi(g.x), bf_lo(g.y), bf_hi(g.y), bf_lo(g.z), bf_hi(g.z), bf_lo(g.w), bf_hi(g.w)};
        u32x4 o; o.x = cvt_pk_bf16(v[0] * rstd * gg[0], v[1] * rstd * gg[1]); o.y = cvt_pk_bf16(v[2] * rstd * gg[2], v[3] * rstd * gg[3]);
        o.z = cvt_pk_bf16(v[4] * rstd * gg[4], v[5] * rstd * gg[5]); o.w = cvt_pk_bf16(v[6] * rstd * gg[6], v[7] * rstd * gg[7]);
        *(u32x4*)(AR + off) = o;
    }
}
__device__ __forceinline__ void phase_na(const Params& P, int l, int gw, int NGW, int lane) {
    const bf16_t* QN = (const bf16_t*)(P.ws + WS_QN); const bf16_t* KN = (const bf16_t*)(P.ws + WS_KN); const bf16_t* VNT = (const bf16_t*)(P.ws + WS_VNT);
    bf16_t* NAO = (bf16_t*)(P.ws + WS_NAO);
    const float* rpb = P.rpb + (size_t)l * 16 * 15 * 31;
    const int fr = lane & 15, fq = lane >> 4;
    for (int id = gw; id < 16384; id += NGW) {
        const int cb = id & 3, r = (id >> 2) & 63, h = (id >> 8) & 15, b = id >> 12;
        const int rs = min(max(r - 4, 0), 56), c0 = cb * 16, cs = min(max(c0 - 8, 0), 32);
        const int c = c0 + fr, cst = min(max(c - 8, 0), 48);
        const size_t tq = (size_t)b * 4096 + r * 64 + c;
        const bf16x8 yq0 = *(const bf16x8*)(QN + tq * 1024 + h * 64 + 8 * fq), yq1 = *(const bf16x8*)(QN + tq * 1024 + h * 64 + 32 + 8 * fq);
        f32x4 S[16];
#pragma unroll
        for (int kt = 0; kt < 16; ++kt) {
            const int kr = rs + (kt >> 1), kcb = cs + (kt & 1) * 16;
            const size_t tk = (size_t)b * 4096 + kr * 64 + kcb + fr;
            const bf16x8 xk0 = *(const bf16x8*)(KN + tk * 1024 + h * 64 + 8 * fq), xk1 = *(const bf16x8*)(KN + tk * 1024 + h * 64 + 32 + 8 * fq);
            f32x4 z = {0.f, 0.f, 0.f, 0.f};
            z = __builtin_amdgcn_mfma_f32_16x16x32_bf16(xk0, yq0, z, 0, 0, 0);
            z = __builtin_amdgcn_mfma_f32_16x16x32_bf16(xk1, yq1, z, 0, 0, 0);
            const float* bp = rpb + (h * 15 + (kr - r + 7)) * 31;
#pragma unroll
            for (int j = 0; j < 4; ++j) {
                const int kc = kcb + 4 * fq + j; const bool valid = (kc >= cst) && (kc < cst + 16);
                const int co = min(max(kc - c + 15, 0), 30);
                const float bias = bp[co];
                z[j] = valid ? z[j] + bias : -INFINITY;
            }
            S[kt] = z;
        }
        float mx = -INFINITY;
#pragma unroll
        for (int kt = 0; kt < 16; ++kt)
#pragma unroll
            for (int j = 0; j < 4; ++j) mx = fmaxf(mx, S[kt][j]);
        mx = fmaxf(mx, __shfl_xor(mx, 16)); mx = fmaxf(mx, __shfl_xor(mx, 32));
        float sum = 0.f;
#pragma unroll
        for (int kt = 0; kt < 16; ++kt)
#pragma unroll
            for (int j = 0; j < 4; ++j) { const float p = fast_exp2((S[kt][j] - mx) * LOG2E); S[kt][j] = p; sum += p; }
        sum += __shfl_xor(sum, 16); sum += __shfl_xor(sum, 32);
        f32x4 O[4];
#pragma unroll
        for (int ht = 0; ht < 4; ++ht) O[ht] = (f32x4){0.f, 0.f, 0.f, 0.f};
#pragma unroll
        for (int p = 0; p < 8; ++p) {
            const u32x4 yw = pack8(S[2 * p], S[2 * p + 1]);
            const bf16x8 yp = __builtin_bit_cast(bf16x8, yw);
            const size_t sk = (size_t)(rs + p) * 64 + cs + 4 * fq;
#pragma unroll
            for (int ht = 0; ht < 4; ++ht) {
                const bf16_t* vp = VNT + ((size_t)b * 1024 + h * 64 + ht * 16 + fr) * 4096 + sk;
                const u32x2 lo = *(const u32x2*)vp, hi = *(const u32x2*)(vp + 16);
                const u32x4 xw = {lo.x, lo.y, hi.x, hi.y};
                O[ht] = __builtin_amdgcn_mfma_f32_16x16x32_bf16(__builtin_bit_cast(bf16x8, xw), yp, O[ht], 0, 0, 0);
            }
        }
        const float inv = 1.0f / sum;
#pragma unroll
        for (int ht = 0; ht < 4; ++ht) *(u32x2*)(NAO + tq * 1024 + h * 64 + ht * 16 + 4 * fq) = pack4(O[ht] * inv);
    }
}
__device__ __forceinline__ void ln_row(f32x4 (&v)[4], const f32x4 (&g)[4], const f32x4 (&bb)[4]) {
    float s = 0.f;
#pragma unroll
    for (int j = 0; j < 4; ++j) s += (v[j][0] + v[j][1]) + (v[j][2] + v[j][3]);
    const float mean = wave_sum(s) * (1.0f / 1024.0f);
    float q = 0.f;
#pragma unroll
    for (int j = 0; j < 4; ++j) { v[j] = v[j] - mean; q += (v[j][0] * v[j][0] + v[j][1] * v[j][1]) + (v[j][2] * v[j][2] + v[j][3] * v[j][3]); }
    const float rstd = 1.0f / sqrtf(wave_sum(q) * (1.0f / 1024.0f) + 1e-5f);
#pragma unroll
    for (int j = 0; j < 4; ++j) v[j] = v[j] * rstd * g[j] + bb[j];
}
__device__ __forceinline__ void phase_ln_router(const Params& P, int l, LAS unsigned char* lds, int wave, int lane) {
    unsigned char* ws = P.ws;
    const float* PRE = (const float*)(ws + WS_ACAT); float* X1 = (float*)(ws + WS_ACAT + 64 * MiB); bf16_t* X1B = (bf16_t*)(ws + WS_K);
    int* tok_e = (int*)(ws + WS_TOK); int* tok_rank = tok_e + T * 2; float* tok_w = (float*)(tok_rank + T * 2);
    unsigned* cnt = (unsigned*)(ws + WS_CTL) + CW_CNT + l * 64;
    LAS float* rwT = (LAS float*)lds;
    LAS int* hist = (LAS int*)(lds + LDS_MISC + LM_HIST); LAS int* basee = (LAS int*)(lds + LDS_MISC + LM_BASE); LAS int* rowi = (LAS int*)(lds + LDS_MISC + LM_ROW);
    const int tid = launder_v((int)threadIdx.x);
    for (int i = tid; i < 32 * 1024; i += 512) { const int e = i >> 10, d = i & 1023; rwT[i] = P.router_w[d * 32 + e]; }
    f32x4 g[4], bb[4];
#pragma unroll
    for (int j = 0; j < 4; ++j) { g[j] = *(const f32x4*)(P.ln_mix_g + l * 1024 + 4 * lane + 256 * j); bb[j] = *(const f32x4*)(P.ln_mix_b + l * 1024 + 4 * lane + 256 * j); }
    const float rbias = P.router_bias[lane & 31];
    for (int chunk = launder_si((int)blockIdx.x); chunk < T / 64; chunk += gridDim.x) {
        if (tid < 32) hist[tid] = 0;
        __syncthreads();
        for (int pr = 0; pr < 4; ++pr) {
            const int lr = wave * 8 + pr * 2, ta = chunk * 64 + lr;
            f32x4 va[4], vb[4];
#pragma unroll
            for (int j = 0; j < 4; ++j) { va[j] = *(const f32x4*)(PRE + (size_t)ta * 1024 + 4 * lane + 256 * j); vb[j] = *(const f32x4*)(PRE + (size_t)(ta + 1) * 1024 + 4 * lane + 256 * j); }
            ln_row(va, g, bb); ln_row(vb, g, bb);
#pragma unroll
            for (int j = 0; j < 4; ++j) {
                *(f32x4*)(X1 + (size_t)ta * 1024 + 4 * lane + 256 * j) = va[j]; *(f32x4*)(X1 + (size_t)(ta + 1) * 1024 + 4 * lane + 256 * j) = vb[j];
                *(u32x2*)(X1B + (size_t)ta * 1024 + 4 * lane + 256 * j) = pack4(va[j]); *(u32x2*)(X1B + (size_t)(ta + 1) * 1024 + 4 * lane + 256 * j) = pack4(vb[j]);
            }
            float la = 0.f, lb = 0.f;
#pragma nounroll
            for (int e = 0; e < 32; ++e) {
                float pa = 0.f, pb = 0.f;
#pragma unroll
                for (int j = 0; j < 4; ++j) { const f32x4 w = *(const LAS f32x4*)(rwT + e * 1024 + 4 * lane + 256 * j);
                    pa += (va[j][0] * w[0] + va[j][1] * w[1]) + (va[j][2] * w[2] + va[j][3] * w[3]); pb += (vb[j][0] * w[0] + vb[j][1] * w[1]) + (vb[j][2] * w[2] + vb[j][3] * w[3]); }
                pa = wave_sum(pa); pb = wave_sum(pb);
                if ((lane & 31) == e) { la = pa; lb = pb; }
            }
#pragma unroll
            for (int rr = 0; rr < 2; ++rr) {
                const float logit = rr ? lb : la;
                const float score = 1.0f / (1.0f + expf(-logit)), sel = score + rbias;
                const int gb = lane & 28;
                const float v0 = __shfl(sel, gb), v1 = __shfl(sel, gb + 1), v2 = __shfl(sel, gb + 2), v3 = __shfl(sel, gb + 3);
                const float a = fmaxf(v0, v1), b2 = fminf(v0, v1), c = fmaxf(v2, v3), d2 = fminf(v2, v3);
                const float gs = fmaxf(a, c) + fmaxf(fminf(a, c), fmaxf(b2, d2));
                int bg = 0; float best = __shfl(gs, 0);
#pragma unroll
                for (int q = 1; q < 8; ++q) { const float xg = __shfl(gs, 4 * q); if (xg > best) { best = xg; bg = q; } }
                const float u0 = __shfl(sel, 4 * bg), u1 = __shfl(sel, 4 * bg + 1), u2 = __shfl(sel, 4 * bg + 2), u3 = __shfl(sel, 4 * bg + 3);
                int i1 = 0; float t1 = u0;
                if (u1 > t1) { t1 = u1; i1 = 1; } if (u2 > t1) { t1 = u2; i1 = 2; } if (u3 > t1) { t1 = u3; i1 = 3; }
                int i2 = -1; float t2 = -INFINITY;
                if (i1 != 0 && u0 > t2) { t2 = u0; i2 = 0; } if (i1 != 1 && u1 > t2) { t2 = u1; i2 = 1; } if (i1 != 2 && u2 > t2) { t2 = u2; i2 = 2; } if (i1 != 3 && u3 > t2) { t2 = u3; i2 = 3; }
                if (i2 < 0) i2 = (i1 + 1) & 3;
                const int e1 = 4 * bg + i1, e2 = 4 * bg + i2;
                const float s1 = __shfl(score, e1), s2 = __shfl(score, e2), inv = 1.0f / (s1 + s2);
                if (lane == 0) {
                    const int r1 = __hip_atomic_fetch_add(hist + e1, 1, __ATOMIC_RELAXED, __HIP_MEMORY_SCOPE_WORKGROUP);
                    const int r2 = __hip_atomic_fetch_add(hist + e2, 1, __ATOMIC_RELAXED, __HIP_MEMORY_SCOPE_WORKGROUP);
                    const int q = lr + rr;
                    rowi[q] = e1; rowi[64 + q] = e2; rowi[128 + q] = r1; rowi[192 + q] = r2; rowi[256 + q] = __float_as_int(s1 * inv); rowi[320 + q] = __float_as_int(s2 * inv);
                }
            }
        }
        __syncthreads();
        if (tid < 32) basee[tid] = (int)__hip_atomic_fetch_add(cnt + tid, (unsigned)hist[tid], __ATOMIC_RELAXED, __HIP_MEMORY_SCOPE_AGENT);
        __syncthreads();
        if (tid < 64) {
            const int t = chunk * 64 + tid, e1 = rowi[tid], e2 = rowi[64 + tid];
            tok_e[2 * t] = e1; tok_e[2 * t + 1] = e2;
            tok_rank[2 * t] = basee[e1] + rowi[128 + tid]; tok_rank[2 * t + 1] = basee[e2] + rowi[192 + tid];
            tok_w[2 * t] = __int_as_float(rowi[256 + tid]); tok_w[2 * t + 1] = __int_as_float(rowi[320 + tid]);
        }
        __syncthreads();
    }
}
__device__ __forceinline__ void build_tiles(const Params& P, int l, LAS unsigned char* lds) {
    const unsigned* cnt = (const unsigned*)(P.ws + WS_CTL) + CW_CNT + l * 64;
    LAS int* tstart = (LAS int*)(lds + LDS_MISC + LM_TSTART); LAS int* tile_e = (LAS int*)(lds + LDS_MISC + LM_TILEE); LAS int* ntp = (LAS int*)(lds + LDS_MISC + LM_NT);
    __syncthreads();
    if (launder_v((int)threadIdx.x) == 0) {
        int a = 0;
#pragma nounroll
        for (int e = 0; e < 32; ++e) { const int c = (int)__hip_atomic_load(cnt + e, __ATOMIC_RELAXED, __HIP_MEMORY_SCOPE_AGENT); const int n = (c + 255) >> 8; tstart[e] = a;
            for (int q = 0; q < n; ++q) { if (a + q < 192) tile_e[a + q] = e; } a += n; }
        tstart[32] = a; ntp[0] = a < 160 ? a : 160;
    }
    __syncthreads();
}
__device__ __forceinline__ void phase_gather(const Params& P, int l, LAS unsigned char* lds, int gw, int NGW, int lane) {
    unsigned char* ws = P.ws;
    const bf16_t* X1B = (const bf16_t*)(ws + WS_K); bf16_t* XG = (bf16_t*)(ws + WS_KV);
    const int* tok_e = (const int*)(ws + WS_TOK); const int* tok_rank = tok_e + T * 2; int* tok_dest = (int*)(ws + WS_TOK) + T * 6;
    build_tiles(P, l, lds);
    const LAS int* tstart = (const LAS int*)(lds + LDS_MISC + LM_TSTART);
    for (int pr = gw; pr < T * 2; pr += NGW) {
        const int e = tok_e[pr], dest = tstart[e] * 256 + tok_rank[pr];
        if (lane == 0) tok_dest[pr] = dest;
        const u32x4* src = (const u32x4*)(X1B + (size_t)(pr >> 1) * 1024); u32x4* dst = (u32x4*)(XG + (size_t)dest * 1024);
        dst[lane] = src[lane]; dst[lane + 64] = src[lane + 64];
    }
}
__device__ __forceinline__ void phase_combine(const Params& P, int l, int gw, int NGW, int lane) {
    unsigned char* ws = P.ws;
    const float* X1 = (const float*)(ws + WS_ACAT + 64 * MiB); const bf16_t* Y = (const bf16_t*)(ws + WS_BCAT + 40 * MiB);
    const float* tok_w = (const float*)(ws + WS_TOK) + T * 4; const int* tok_dest = (const int*)(ws + WS_TOK) + T * 6;
    bf16_t* xb = (bf16_t*)(ws + WS_XB);
    f32x4 g[4], bb[4];
#pragma unroll
    for (int j = 0; j < 4; ++j) { g[j] = *(const f32x4*)(P.ln_ffn_g + l * 1024 + 4 * lane + 256 * j); bb[j] = *(const f32x4*)(P.ln_ffn_b + l * 1024 + 4 * lane + 256 * j); }
    for (int t = gw; t < T; t += NGW) {
        const int d0 = tok_dest[2 * t], d1 = tok_dest[2 * t + 1]; const float w0 = tok_w[2 * t], w1 = tok_w[2 * t + 1];
        f32x4 v[4];
#pragma unroll
        for (int j = 0; j < 4; ++j) {
            const f32x4 x1 = *(const f32x4*)(X1 + (size_t)t * 1024 + 4 * lane + 256 * j);
            const u32x2 y0 = *(const u32x2*)(Y + (size_t)d0 * 1024 + 4 * lane + 256 * j), y1 = *(const u32x2*)(Y + (size_t)d1 * 1024 + 4 * lane + 256 * j);
            v[j][0] = x1[0] * ALPHA + w0 * bf_lo(y0.x) + w1 * bf_lo(y1.x); v[j][1] = x1[1] * ALPHA + w0 * bf_hi(y0.x) + w1 * bf_hi(y1.x);
            v[j][2] = x1[2] * ALPHA + w0 * bf_lo(y0.y) + w1 * bf_lo(y1.y); v[j][3] = x1[3] * ALPHA + w0 * bf_hi(y0.y) + w1 * bf_hi(y1.y);
        }
        ln_row(v, g, bb);
#pragma unroll
        for (int j = 0; j < 4; ++j) { *(f32x4*)(P.out + (size_t)t * 1024 + 4 * lane + 256 * j) = v[j]; *(u32x2*)(xb + (size_t)t * 1024 + 4 * lane + 256 * j) = pack4(v[j]); }
    }
}

__global__ void __launch_bounds__(512, 2) fwd_kernel(Params P) {
    extern __shared__ __attribute__((aligned(16))) unsigned char lds_raw[];
    LAS unsigned char* lds = (LAS unsigned char*)lds_raw;
    const int NGW = gridDim.x * 8;
    for (int u = threadIdx.x; u < (LDS_BYTES - LDS_MISC) / 4; u += 512) ((LAS unsigned*)(lds + LDS_MISC))[u] = 0u;
#define PHASE_CTX() const Params PP = load_params(); unsigned char* ws = PP.ws; const int tid = launder_v((int)threadIdx.x), lane = tid & 63, wave = __builtin_amdgcn_readfirstlane(tid >> 6), gw = launder_si((int)blockIdx.x) * 8 + wave; (void)ws; (void)lane; (void)gw
    __syncthreads();
#if MK_ONE_LAUNCH
    XcdBarrier bar = xcd_barrier_post((unsigned*)(P.ws + WS_CTL) + CW_BAR, (volatile LAS unsigned*)(lds + LDS_MISC + LM_BAR));
#define GRID_BAR() xcd_barrier(bar)
#else
#define GRID_BAR() do { } while (0)
#endif
    const int lo = P.ph_lo, hi = P.ph_hi;
#define IN(k) (lo <= (k) && (k) < hi)
#define SEAM(k) do { if (IN(k) && IN((k) + 1)) GRID_BAR(); } while (0)

    if (IN(0)) { PHASE_CTX(); phase_init(PP, lds, gw, NGW, wave, lane); SEAM(0); }

    for (int l = 0; l < DEPTH; ++l) {
        const int pb = 1 + l * 12;
        if (IN(pb + 0)) { PHASE_CTX(); const float* decay = PP.decay + l * 8; (void)decay;
            DecInProj dec{(const char*)(ws + WS_XB), (const char*)(ws + WS_WIN)};
            EpiInProj E{ws, decay};
            pg::gemm_phase(lds, 1024, 1024, 1024, 3072, dec, E);
            SEAM(pb + 0);
        }
        if (IN(pb + 1)) { PHASE_CTX(); const float* decay = PP.decay + l * 8; (void)decay;
            { DecR1 dec{(const char*)(ws + WS_Q), (const char*)(ws + WS_K)}; EpiR1 E{(bf16_t*)(ws + WS_ACAT), decay};
              pg::gemm_phase(lds, 256, 1024, 1024, 512, dec, E); }
            { DecR2 dec{(const char*)(ws + WS_BCAT), (const char*)(ws + WS_KDT)}; EpiR2 E{(float*)(ws + WS_KV)};
              pg::gemm_phase(lds, 512, 1024, 512, 448, dec, E); }
            phase_na(PP, l, gw, NGW, lane);
            SEAM(pb + 1);
        }
        if (IN(pb + 2)) { PHASE_CTX(); const float* decay = PP.decay + l * 8; (void)decay; phase_prefix(PP, l, gw, NGW, lane); SEAM(pb + 2); }
        if (IN(pb + 3)) { PHASE_CTX(); const float* decay = PP.decay + l * 8; (void)decay;
            DecR4 dec{(const char*)(ws + WS_ACAT), (const char*)(ws + WS_BCAT)}; EpiR4 E{(bf16_t*)(ws + WS_KV)};
            pg::gemm_phase(lds, 1024, 4096, 1024, 512, dec, E);
            SEAM(pb + 3);
        }
        if (IN(pb + 4)) { PHASE_CTX(); const float* decay = PP.decay + l * 8; (void)decay; phase_headnorm(PP, gw, NGW, lane); SEAM(pb + 4); }
        if (IN(pb + 5)) { PHASE_CTX(); const float* decay = PP.decay + l * 8; (void)decay;
            { DecDense dec{(const char*)(ws + WS_KDT), (const char*)(ws + WS_WRET), 2048 * 2, 2048 * 2}; EpiMerge<0> E{(bf16_t*)(ws + WS_Q), (const bf16_t*)(ws + WS_G)};
              pg::gemm_phase(lds, 2048, 2048, 2048, 256, dec, E); }
            { DecDense dec{(const char*)(ws + WS_NAO), (const char*)(ws + WS_WNA), 1024 * 2, 1024 * 2}; EpiMerge<1> E{(bf16_t*)(ws + WS_Q), (const bf16_t*)(ws + WS_G)};
              pg::gemm_phase(lds, 1024, 1024, 1024, 256, dec, E); }
            SEAM(pb + 5);
        }
        if (IN(pb + 6)) { PHASE_CTX(); const float* decay = PP.decay + l * 8; (void)decay;
            DecDense dec{(const char*)(ws + WS_Q), (const char*)(ws + WS_WOUT), 1024 * 2, 1024 * 2}; EpiPre E{(float*)(ws + WS_ACAT), l == 0 ? PP.x : (const float*)PP.out};
            pg::gemm_phase(lds, 1024, 1024, 1024, 256, dec, E);
            SEAM(pb + 6);
        }
        if (IN(pb + 7)) { PHASE_CTX(); const float* decay = PP.decay + l * 8; (void)decay; phase_ln_router(PP, l, lds, wave, lane); SEAM(pb + 7); }
        if (IN(pb + 8)) { PHASE_CTX(); const float* decay = PP.decay + l * 8; (void)decay; phase_gather(PP, l, lds, gw, NGW, lane); SEAM(pb + 8); }
        if (IN(pb + 9)) { PHASE_CTX(); const float* decay = PP.decay + l * 8; (void)decay;
            build_tiles(PP, l, lds);
            const int nt = *(const LAS int*)(lds + LDS_MISC + LM_NT);
            DecMoe dec{(const char*)(ws + WS_KV), (const char*)(ws + WS_WGU), 1024 * 2, 1024 * 1024 * 2, 1024 * 2, (const LAS int*)(lds + LDS_MISC + LM_TILEE)}; EpiUp E{(bf16_t*)(ws + WS_BCAT)};
            pg::gemm_phase(lds, 1024, 1024, 1024, nt * 4, dec, E);
            SEAM(pb + 9);
        }
        if (IN(pb + 10)) { PHASE_CTX(); const float* decay = PP.decay + l * 8; (void)decay;
            build_tiles(PP, l, lds);
            const int nt = *(const LAS int*)(lds + LDS_MISC + LM_NT);
            DecMoe dec{(const char*)(ws + WS_BCAT), (const char*)(ws + WS_WD), 512 * 2, 1024 * 512 * 2, 512 * 2, (const LAS int*)(lds + LDS_MISC + LM_TILEE)}; EpiDown E{(bf16_t*)(ws + WS_BCAT + 40 * MiB)};
            pg::gemm_phase(lds, 512, 512, 512, nt * 4, dec, E);
            SEAM(pb + 10);
        }
        if (IN(pb + 11)) { PHASE_CTX(); const float* decay = PP.decay + l * 8; (void)decay;
            phase_combine(PP, l, gw, NGW, lane);
            if (l + 1 < DEPTH) convert_layer(PP, l + 1, lds, gw, NGW, wave, lane);
            SEAM(pb + 11);
        }
    }
#undef IN
#undef SEAM
}

extern "C" void kernel_launch(void* const* d_in, const int* in_sizes, int n_in, void* d_out, int out_size, void* d_ws, size_t ws_size, hipStream_t stream) {
    static int grid = 0;
    if (grid == 0) {
        if (n_in != 16 || in_sizes[0] != T * D || out_size != T * D || ws_size < WS_END) {
            fprintf(stderr, "kernel_launch: unexpected shapes / workspace (n_in %d, in0 %d, out %d, ws %zu < %zu); nothing launched\n", n_in, n_in > 0 ? in_sizes[0] : -1, out_size, ws_size, (size_t)WS_END); grid = -1; return; }
        int dev = 0, cus = 0, per_cu = 0;
        if (hipGetDevice(&dev) != hipSuccess || hipDeviceGetAttribute(&cus, hipDeviceAttributeMultiprocessorCount, dev) != hipSuccess) { grid = -1; return; }
        if (hipFuncSetAttribute((const void*)fwd_kernel, hipFuncAttributeMaxDynamicSharedMemorySize, LDS_BYTES) != hipSuccess) { fprintf(stderr, "kernel_launch: hipFuncSetAttribute failed\n"); grid = -1; return; }
        if (hipOccupancyMaxActiveBlocksPerMultiprocessor(&per_cu, (const void*)fwd_kernel, 512, LDS_BYTES) != hipSuccess || per_cu < 1)
            fprintf(stderr, "kernel_launch: occupancy query reports %d workgroups per CU\n", per_cu);
        (void)hipGetLastError();
        grid = cus;
    }
    if (grid < 0) return;
    if (hipMemsetAsync((char*)d_ws + WS_CTL, 0, CTL_ZERO_BYTES, stream) != hipSuccess) return;
    Params p{};
    p.x = (const float*)d_in[0]; p.w_in = (const float*)d_in[1]; p.decay = (const float*)d_in[2]; p.w_ret_o = (const float*)d_in[3]; p.rpb = (const float*)d_in[4];
    p.w_na_o = (const float*)d_in[5]; p.w_out = (const float*)d_in[6]; p.ln_mix_g = (const float*)d_in[7]; p.ln_mix_b = (const float*)d_in[8];
    p.router_w = (const float*)d_in[9]; p.router_bias = (const float*)d_in[10]; p.w_gate = (const float*)d_in[11]; p.w_up = (const float*)d_in[12]; p.w_down = (const float*)d_in[13];
    p.ln_ffn_g = (const float*)d_in[14]; p.ln_ffn_b = (const float*)d_in[15];
    p.out = (float*)d_out; p.ws = (unsigned char*)d_ws;
#if MK_ONE_LAUNCH
    p.ph_lo = 0; p.ph_hi = NPH;
    hipLaunchKernelGGL(fwd_kernel, dim3(grid), dim3(512), LDS_BYTES, stream, p);
#else
    for (int ph = 0; ph < NPH; ++ph) { p.ph_lo = ph; p.ph_hi = ph + 1; hipLaunchKernelGGL(fwd_kernel, dim3(grid), dim3(512), LDS_BYTES, stream, p); }
#endif
}
```

```cpp
#include <hip/hip_runtime.h>
#include <cstdio>
#include <cstdint>

#ifndef MK_ONE_LAUNCH
#define MK_ONE_LAUNCH 1
#endif

#define LAS __attribute__((address_space(3)))
#define GAS __attribute__((address_space(1)))
typedef unsigned short bf16_t;
typedef short bf16x8 __attribute__((ext_vector_type(8)));
typedef float f32x4 __attribute__((ext_vector_type(4)));
typedef float f32x2 __attribute__((ext_vector_type(2)));
typedef unsigned u32x4 __attribute__((ext_vector_type(4)));
typedef unsigned u32x2 __attribute__((ext_vector_type(2)));

constexpr int D = 1024, BATCH = 4, SEQ = 4096, T = BATCH * SEQ, DEPTH = 4;
constexpr int DIN = 11264;
constexpr int NE = 32;
constexpr int NPH = 1 + DEPTH * 12;
constexpr float ALPHA = 1.681792830507429f;
constexpr float LOG2E = 1.4426950408889634f;

constexpr size_t MiB = 1u << 20;
constexpr size_t WS_CTL = 0, CTL_ZERO_BYTES = 1 * MiB;
constexpr size_t WS_TAB = 2 * MiB;
constexpr size_t WS_TOK = 10 * MiB;
constexpr size_t WS_WIN = 12 * MiB;
constexpr size_t WS_WRET = 34 * MiB;
constexpr size_t WS_WNA = 38 * MiB;
constexpr size_t WS_WOUT = 40 * MiB;
constexpr size_t WS_WGU = 42 * MiB;
constexpr size_t WS_WD = 106 * MiB;
constexpr size_t WS_XB = 138 * MiB;
constexpr size_t WS_Q = 170 * MiB;
constexpr size_t WS_K = 202 * MiB;
constexpr size_t WS_ACAT = 234 * MiB;
constexpr size_t WS_BCAT = 362 * MiB;
constexpr size_t WS_KDT = 490 * MiB;
constexpr size_t WS_KV = 554 * MiB;
constexpr size_t WS_SG = 682 * MiB;
constexpr size_t WS_QN = 746 * MiB;
constexpr size_t WS_KN = 778 * MiB;
constexpr size_t WS_VNT = 810 * MiB;
constexpr size_t WS_G = 842 * MiB;
constexpr size_t WS_NAO = 906 * MiB;
constexpr size_t WS_END = 938 * MiB;
constexpr int CW_BAR = 4096;
constexpr int CW_CNT = 16384;

constexpr int LDS_STAGE = 131072;
constexpr int LDS_MISC = 131072;
constexpr int LM_BAR = 0;
constexpr int LM_HIST = 64;
constexpr int LM_BASE = 192;
constexpr int LM_ROW = 512;
constexpr int LM_NT = 2048;
constexpr int LM_TSTART = 2112;
constexpr int LM_TILEE = 2304;
constexpr int LDS_BYTES = 147456;

#define LDS_WAIT() asm volatile("s_waitcnt lgkmcnt(0)" ::: "memory")
#define VM_WAIT() asm volatile("s_waitcnt vmcnt(0)" ::: "memory")
__device__ __forceinline__ unsigned cvt_pk_bf16(float lo, float hi) { unsigned r; asm("v_cvt_pk_bf16_f32 %0, %1, %2" : "=v"(r) : "v"(lo), "v"(hi)); return r; }
__device__ __forceinline__ u32x4 pack8(const f32x4 a, const f32x4 b) { u32x4 w; w.x = cvt_pk_bf16(a[0], a[1]); w.y = cvt_pk_bf16(a[2], a[3]); w.z = cvt_pk_bf16(b[0], b[1]); w.w = cvt_pk_bf16(b[2], b[3]); return w; }
__device__ __forceinline__ u32x2 pack4(const f32x4 a) { u32x2 w; w.x = cvt_pk_bf16(a[0], a[1]); w.y = cvt_pk_bf16(a[2], a[3]); return w; }
__device__ __forceinline__ float bf_lo(unsigned u) { return __uint_as_float(u << 16); }
__device__ __forceinline__ float bf_hi(unsigned u) { return __uint_as_float(u & 0xffff0000u); }
__device__ __forceinline__ float wave_sum(float v) {
#pragma unroll
    for (int o = 1; o < 64; o <<= 1) v += __shfl_xor(v, o);
    return v;
}
template <class Tp> __device__ __forceinline__ Tp* launder_s(Tp* p) { asm volatile("" : "+s"(p)); return p; }
__device__ __forceinline__ int launder_v(int v) { asm volatile("" : "+v"(v)); return v; }
__device__ __forceinline__ int launder_si(int v) { asm volatile("" : "+s"(v)); return v; }
__device__ __forceinline__ float fast_exp2(float x) { return __builtin_amdgcn_exp2f(x); }
__device__ __forceinline__ float fast_rcp(float x) { return __builtin_amdgcn_rcpf(x); }
__device__ __forceinline__ float sigmoid_f(float v) { return fast_rcp(1.0f + fast_exp2(-v * LOG2E)); }
__device__ __forceinline__ float log2_sigmoid(float x) { return -log1pf(expf(-x)) * LOG2E; }

#define XB_TMO      128
#define XB_XCNT(j)  (256  + 64 * (j))
#define XB_XSUB(j)  (1280 + 64 * (j))
#define XB_XGEN(j)  (2304 + 64 * (j))
#define XB_TOP      3328
#define XB_TOPGEN   3392
#define XCD_BAR_WORDS 3456
#define XB_SPIN_CAP (1u << 18)

__device__ __forceinline__ unsigned xb_ld(unsigned* p)              { return __hip_atomic_load(p, __ATOMIC_RELAXED, __HIP_MEMORY_SCOPE_AGENT); }
__device__ __forceinline__ unsigned xb_add(unsigned* p, unsigned v) { return __hip_atomic_fetch_add(p, v, __ATOMIC_RELAXED, __HIP_MEMORY_SCOPE_AGENT); }
__device__ __forceinline__ unsigned xb_xcc_id() { return (unsigned)__builtin_amdgcn_s_getreg((3 << 11) | 20) & 0xFu; }
#define XB_SPIN(cond, bar) do { unsigned _sp = 0; while (cond) { __builtin_amdgcn_s_sleep(1); \
    if ((++_sp & 255u) == 0u) { if (xb_ld(&(bar)[XB_TMO])) break; if (_sp > XB_SPIN_CAP) { atomicAdd(&(bar)[XB_TMO], 1u); break; } } } } while (0)

struct XcdBarrier {
    unsigned* bar; unsigned x;
    volatile LAS unsigned* st;
};
__device__ __forceinline__ XcdBarrier xcd_barrier_post(unsigned* bar, volatile LAS unsigned* st) {
    XcdBarrier b; b.bar = bar; b.x = xb_xcc_id(); b.st = st;
    if (threadIdx.x == 0) (void)xb_add(&bar[XB_XCNT(b.x)], 1u);
    return b;
}
__device__ __forceinline__ void xcd_barrier_complete(unsigned* bar, unsigned x, unsigned& nloc, unsigned& nx) {
    const unsigned G = gridDim.x * gridDim.y * gridDim.z;
    unsigned sum, cnt, mine, sp = 0u;
    for (;;) {
        sum = 0u; cnt = 0u; mine = 0u;
#pragma unroll
        for (unsigned j = 0; j < 16; ++j) { const unsigned c = xb_ld(&bar[XB_XCNT(j)]); sum += c; cnt += (c > 0u) ? 1u : 0u; mine = (j == x) ? c : mine; }
        if (sum == G) break;
        __builtin_amdgcn_s_sleep(1);
        if ((++sp & 255u) == 0u) { if (xb_ld(&bar[XB_TMO])) break; if (sp > XB_SPIN_CAP) { atomicAdd(&bar[XB_TMO], 1u); break; } }
    }
    nloc = mine > 0u ? mine : 1u; nx = cnt > 0u ? cnt : 1u;
}
__device__ __forceinline__ void xcd_barrier(const XcdBarrier& b) {
    asm volatile("s_waitcnt vmcnt(0)" ::: "memory");
    __syncthreads();
    if (threadIdx.x == 0) {
        unsigned* bar = b.bar;
        __builtin_amdgcn_s_waitcnt(0);
        unsigned nloc = b.st[0], nx = b.st[1];
        if (nloc == 0u) { xcd_barrier_complete(bar, b.x, nloc, nx); b.st[0] = nloc; b.st[1] = nx; }
        const unsigned old = xb_add(&bar[XB_XSUB(b.x)], 1u);
        const unsigned gen = old / nloc;
        if (old + 1u == (gen + 1u) * nloc) {
            __builtin_amdgcn_fence(__ATOMIC_RELEASE, "agent");
            asm volatile("s_waitcnt vmcnt(0)" ::: "memory");
            const unsigned og = xb_add(&bar[XB_TOP], 1u);
            const unsigned tg = og / nx;
            if (og + 1u == (tg + 1u) * nx) xb_add(&bar[XB_TOPGEN], 1u);
            else XB_SPIN(xb_ld(&bar[XB_TOPGEN]) == tg, bar);
            __builtin_amdgcn_fence(__ATOMIC_ACQUIRE, "agent");
            xb_add(&bar[XB_XGEN(b.x)], 1u);
            asm volatile("s_waitcnt vmcnt(0)" ::: "memory");
        } else {
            XB_SPIN(xb_ld(&bar[XB_XGEN(b.x)]) == gen, bar);
            __builtin_amdgcn_fence(__ATOMIC_ACQUIRE, "agent");
            asm volatile("s_waitcnt vmcnt(0)" ::: "memory");
        }
    }
    __syncthreads();
}

namespace pg {
constexpr int BM = 256, BK = 64, HALF = 128, HTB = HALF * BK * 2, STAGE_BYTES = 8 * HTB;
__device__ __forceinline__ int lds_byte(int r, int c) { const int st = (r >> 4) * 2 + (c >> 5), rr = r & 15, cc = c & 31, ob = rr * 64 + cc * 2; return st * 1024 + (ob ^ (((ob >> 9) & 1) << 5)); }
__device__ __forceinline__ void stage_rc(int b, int& R, int& C) { const int st = b / 1024, sb = b % 1024, swz = sb ^ (((sb >> 9) & 1) << 5); R = (st >> 1) * 16 + swz / 64; C = (st & 1) * 32 + (swz % 64) / 2; }
__device__ __forceinline__ int perm32(int rho) { const int n = rho >> 4, i = rho & 15; return 8 * (i >> 2) + 4 * n + (i & 3); }

struct Unit { const char* A; const char* B; int kind, a, b, c; };

template <class Epi, class Dec>
__device__ __forceinline__ void gemm_phase(LAS unsigned char* lds, const int K, const int lda, const int ldb, const int nunits, const Dec& dec, const Epi& E) {
    const int tid = launder_v((int)threadIdx.x), wid = __builtin_amdgcn_readfirstlane(tid >> 6), lane = tid & 63, wr = wid >> 2, wc = wid & 3, fr = lane & 15, fq = lane >> 4;
    const int nt = K / BK;
    const int G = launder_si((int)gridDim.x); int uidx = launder_si((int)blockIdx.x);
    if (uidx >= nunits) return;
    unsigned voffA[2], voffB[2];
#pragma unroll
    for (int i = 0; i < 2; ++i) { int R, C; stage_rc(tid * 16 + i * 8192, R, C); const int Rb = (R & ~31) + perm32(R & 31);
        voffA[i] = (unsigned)(R * lda + C) * 2u; voffB[i] = (unsigned)(Rb * ldb + C) * 2u; }
    const size_t kstep = (size_t)(BK * 2);
    const size_t hstepA = (size_t)HALF * lda * 2, hstepB = (size_t)HALF * ldb * 2;
    const unsigned ldsw = (unsigned)wid * 1024u;
    const int aoff = lds_byte(wr * 64 + fr, fq * 8), boff = lds_byte(wc * 32 + fr, fq * 8);
#define PG_SA(b, h) (((b) * 2 + (h)) * HTB)
#define PG_SB(b, h) ((4 + (b) * 2 + (h)) * HTB)
#define PG_STAGE(bufoff, gbase, voff) do { _Pragma("unroll") for (int _i = 0; _i < 2; ++_i) \
        __builtin_amdgcn_global_load_lds((const unsigned*)((const char*)(gbase) + (voff)[_i]), (LAS unsigned*)(lds + (bufoff) + ldsw + _i * 8192), 16, 0, 0); } while (0)
#define PG_LDA(dst, b, h) do { _Pragma("unroll") for (int m = 0; m < 4; ++m) _Pragma("unroll") for (int k = 0; k < 2; ++k) dst[m][k] = *(const LAS bf16x8*)(lds + PG_SA(b, h) + aoff + m * 2048 + k * 1024); } while (0)
#define PG_LDB(dst, b, h) do { _Pragma("unroll") for (int n = 0; n < 2; ++n) _Pragma("unroll") for (int k = 0; k < 2; ++k) dst[n][k] = *(const LAS bf16x8*)(lds + PG_SB(b, h) + boff + n * 2048 + k * 1024); } while (0)
#define PG_MMA(ai, bj, At, Bt) do { __builtin_amdgcn_s_setprio(1); _Pragma("unroll") for (int m = 0; m < 4; ++m) _Pragma("unroll") for (int n = 0; n < 2; ++n) _Pragma("unroll") for (int k = 0; k < 2; ++k) \
        acc[ai][bj][m][n] = __builtin_amdgcn_mfma_f32_16x16x32_bf16(Bt[n][k], At[m][k], acc[ai][bj][m][n], 0, 0, 0); __builtin_amdgcn_s_setprio(0); } while (0)
#define PG_WAIT_V(n) asm volatile("s_waitcnt vmcnt(" #n ")" ::: "memory")
#define PG_WAIT_L(n) asm volatile("s_waitcnt lgkmcnt(" #n ")" ::: "memory")
#define PG_BAR __builtin_amdgcn_s_barrier()
#define PG_SCHED __builtin_amdgcn_sched_barrier(0)
    Unit cur, nxt;
    dec(uidx, cur);
    f32x4 acc[2][2][4][2];
#pragma unroll
    for (int a = 0; a < 2; ++a)
#pragma unroll
        for (int b = 0; b < 2; ++b)
#pragma unroll
            for (int m = 0; m < 4; ++m)
#pragma unroll
                for (int n = 0; n < 2; ++n) acc[a][b][m][n] = (f32x4){0.f, 0.f, 0.f, 0.f};
    bf16x8 At[4][2], B0[2][2], B1[2][2];
    const char* cA = cur.A; const char* cB = cur.B;
    PG_STAGE(PG_SB(0, 0), cB, voffB); PG_STAGE(PG_SB(0, 1), cB + hstepB, voffB); PG_STAGE(PG_SA(0, 0), cA, voffA); PG_STAGE(PG_SA(0, 1), cA + hstepA, voffA);
    if (wr == 1) PG_BAR;
    PG_WAIT_V(2); PG_BAR;
    PG_STAGE(PG_SB(1, 0), cB + kstep, voffB); PG_STAGE(PG_SA(1, 0), cA + kstep, voffA); PG_STAGE(PG_SB(1, 1), cB + hstepB + kstep, voffB);
    PG_WAIT_V(6); PG_BAR;
    for (;;) {
        const bool has_next = (uidx + G < nunits);
        if (has_next) dec(uidx + G, nxt);
        const char* nA = has_next ? nxt.A : cA; const char* nB = has_next ? nxt.B : cB;
#pragma nounroll
        for (int t = 0; t < nt; t += 2) {
            const bool last = (t == nt - 2);
            const char* a1 = cA + (size_t)(t + 1) * kstep;
            const char* a2 = last ? nA : cA + (size_t)(t + 2) * kstep; const char* b2 = last ? nB : cB + (size_t)(t + 2) * kstep;
            const char* a3 = a2 + kstep; const char* b3 = b2 + kstep;
            PG_LDB(B0, 0, 0); PG_LDB(B1, 0, 1); PG_SCHED; PG_LDA(At, 0, 0); PG_STAGE(PG_SA(1, 1), a1 + hstepA, voffA);
            PG_WAIT_V(8); PG_WAIT_L(0); PG_BAR; PG_MMA(0, 0, At, B0); PG_MMA(0, 1, At, B1); PG_BAR; PG_SCHED;
            PG_LDA(At, 0, 1); PG_STAGE(PG_SB(0, 0), b2, voffB); PG_STAGE(PG_SB(0, 1), b2 + hstepB, voffB); PG_STAGE(PG_SA(0, 0), a2, voffA);
            PG_WAIT_V(8); PG_WAIT_L(0); PG_BAR; PG_MMA(1, 0, At, B0); PG_MMA(1, 1, At, B1); PG_BAR; PG_SCHED;
            PG_LDB(B0, 1, 0); PG_LDB(B1, 1, 1); PG_SCHED; PG_LDA(At, 1, 0); PG_STAGE(PG_SA(0, 1), a2 + hstepA, voffA);
            PG_WAIT_V(8); PG_WAIT_L(0); PG_BAR; PG_MMA(0, 0, At, B0); PG_MMA(0, 1, At, B1); PG_BAR; PG_SCHED;
            PG_LDA(At, 1, 1); PG_STAGE(PG_SB(1, 0), b3, voffB); PG_STAGE(PG_SB(1, 1), b3 + hstepB, voffB); PG_STAGE(PG_SA(1, 0), a3, voffA);
            PG_WAIT_V(8); PG_WAIT_L(0); PG_BAR; PG_MMA(1, 0, At, B0); PG_MMA(1, 1, At, B1); PG_BAR; PG_SCHED;
        }
        if (wr == 0) PG_BAR;
        E(acc, cur, wr, wc, fr, fq);
        if (!has_next) break;
#pragma unroll
        for (int a = 0; a < 2; ++a)
#pragma unroll
            for (int b = 0; b < 2; ++b)
#pragma unroll
                for (int m = 0; m < 4; ++m)
#pragma unroll
                    for (int n = 0; n < 2; ++n) acc[a][b][m][n] = (f32x4){0.f, 0.f, 0.f, 0.f};
        cur = nxt; cA = nA; cB = nB; uidx += G;
        if (wr == 1) PG_BAR;
    }
    PG_WAIT_V(0);
    PG_BAR;
#undef PG_SA
#undef PG_SB
#undef PG_STAGE
#undef PG_LDA
#undef PG_LDB
#undef PG_MMA
#undef PG_WAIT_V
#undef PG_WAIT_L
#undef PG_BAR
#undef PG_SCHED
}
}
using pg::Unit;

enum { KQ = 0, KK = 1, KPL_SILU = 2, KPL_SCALE = 3, KPL_SIG = 4, KKT = 5, KVT = 6, KVNT = 7 };

struct DecInProj {
    const char* xb; const char* WinT;
    __device__ __forceinline__ void operator()(int u, Unit& o) const {
        if (u < 2048) {
            const int g = u >> 8, r = u & 255, x = r & 7, idx = r >> 3, pm = g * 8 + (idx & 7), j = ((x + g) & 7) * 4 + (idx >> 3);
            const int wt = j < 8 ? j : (j < 24 ? j + 8 : j + 12);
            o.A = xb + (size_t)pm * (256 * 1024 * 2); o.B = WinT + (size_t)wt * (256 * 1024 * 2); o.b = pm * 256; o.c = 0;
            if (wt < 4) { o.kind = KQ; o.a = wt; }
            else if (wt < 8) { o.kind = KK; o.a = wt - 4; }
            else if (wt < 24) { o.kind = KPL_SILU; o.a = (wt - 16) * 256; }
            else if (wt < 28) { o.kind = KPL_SCALE; o.a = (wt - 24) * 256; o.c = 0; }
            else if (wt < 32) { o.kind = KPL_SCALE; o.a = (wt - 28) * 256; o.c = 1; }
            else { o.kind = KPL_SIG; o.a = (wt - 36) * 256; }
        } else {
            const int v = u - 2048, g = v >> 8, r = v & 255, x = r & 7, idx = r >> 3, ci = ((x + g) & 3) * 4 + (idx >> 3), tt = (x >> 2) * 32 + g * 8 + (idx & 7);
            int ct;
            if (ci < 4) { ct = 4 + ci; o.kind = KKT; o.a = ci; o.c = 0; }
            else if (ci < 12) { ct = 8 + (ci - 4); o.kind = KVT; o.a = (ci - 4) >> 1; o.c = (ci - 4) & 1; }
            else { ct = 32 + (ci - 12); o.kind = KVNT; o.a = ci - 12; o.c = 0; }
            o.A = WinT + (size_t)ct * (256 * 1024 * 2); o.B = xb + (size_t)tt * (256 * 1024 * 2); o.b = tt * 256;
        }
    }
};
struct EpiInProj {
    unsigned char* ws_;
    const float* decay;
    __device__ __forceinline__ void operator()(const f32x4 (&acc)[2][2][4][2], const Unit& u, int wr, int wc, int fr, int fq) const {
        unsigned char* w = launder_s(ws_);
        bf16_t* const Q = (bf16_t*)(w + WS_Q); bf16_t* const Kb = (bf16_t*)(w + WS_K); bf16_t* const ACAT = (bf16_t*)(w + WS_ACAT); bf16_t* const BCAT = (bf16_t*)(w + WS_BCAT);
        bf16_t* const KDT = (bf16_t*)(w + WS_KDT); bf16_t* const SG = (bf16_t*)(w + WS_SG); bf16_t* const QN = (bf16_t*)(w + WS_QN); bf16_t* const KN = (bf16_t*)(w + WS_KN);
        bf16_t* const VNT = (bf16_t*)(w + WS_VNT); bf16_t* const Gt = (bf16_t*)(w + WS_G);
        const float* const cosN = (const float*)(w + WS_TAB); const float* const sinN = cosN + 4096 * 128; const float* const cosT = sinN + 4096 * 128; const float* const sinT = cosT + 4096 * 128;
        const int kind = u.kind, c8 = wc * 32 + fq * 8;
        if (kind == KQ || kind == KK) {
            const int h = u.a, t0 = u.b;
            float lf = 0.f, lb = 0.f;
            if (kind == KQ) { lf = log2_sigmoid(decay[h]); lb = log2_sigmoid(decay[4 + h]); }
#pragma unroll
            for (int ai = 0; ai < 2; ++ai)
#pragma unroll
                for (int m = 0; m < 4; ++m) {
                    const int t = t0 + ai * 128 + wr * 64 + m * 16 + fr, pos = t & 4095;
                    const float* cp = cosN + (size_t)pos * 128 + c8; const float* sp = sinN + (size_t)pos * 128 + c8;
                    const f32x4 c0 = *(const GAS f32x4*)cp, c1 = *(const GAS f32x4*)(cp + 4), s0 = *(const GAS f32x4*)sp, s1 = *(const GAS f32x4*)(sp + 4);
                    const f32x4 x1a = acc[ai][0][m][0], x1b = acc[ai][0][m][1], x2a = acc[ai][1][m][0], x2b = acc[ai][1][m][1];
                    f32x4 q1a = x1a * c0 - x2a * s0, q1b = x1b * c1 - x2b * s1, q2a = x1a * s0 + x2a * c0, q2b = x1b * s1 + x2b * c1;
                    if (kind == KQ) {
                        bf16_t* qp = Q + (size_t)t * 1024 + h * 256 + c8;
                        *(GAS u32x4*)qp = pack8(q1a, q1b); *(GAS u32x4*)(qp + 128) = pack8(q2a, q2b);
                        const int p = t & 511; const float df = fast_exp2(lf * (float)(p + 1)), db = fast_exp2(lb * (float)(512 - p));
                        bf16_t* ap = ACAT + ((size_t)t * 4 + h) * 1024 + 512 + c8;
                        *(GAS u32x4*)ap = pack8(q1a * df, q1b * df); *(GAS u32x4*)(ap + 128) = pack8(q2a * df, q2b * df);
                        *(GAS u32x4*)(ap + 256) = pack8(q1a * db, q1b * db); *(GAS u32x4*)(ap + 384) = pack8(q2a * db, q2b * db);
                    } else {
                        bf16_t* kp = Kb + (size_t)t * 1024 + h * 256 + c8;
                        *(GAS u32x4*)kp = pack8(q1a * 0.0625f, q1b * 0.0625f); *(GAS u32x4*)(kp + 128) = pack8(q2a * 0.0625f, q2b * 0.0625f);
                    }
                    __builtin_amdgcn_sched_barrier(0);
                }
        } else if (kind == KPL_SILU || kind == KPL_SCALE || kind == KPL_SIG) {
            const int t0 = u.b;
            bf16_t* dst; int ld; float sc = 1.f;
            if (kind == KPL_SILU) { dst = SG; ld = 2048; }
            else if (kind == KPL_SIG) { dst = Gt; ld = 2048; }
            else { ld = 1024; if (u.c == 0) { dst = QN; sc = 0.125f; } else { dst = KN; } }
            dst += u.a + c8;
#pragma unroll
            for (int ai = 0; ai < 2; ++ai)
#pragma unroll
                for (int m = 0; m < 4; ++m) {
                    const int t = t0 + ai * 128 + wr * 64 + m * 16 + fr;
#pragma unroll
                    for (int bj = 0; bj < 2; ++bj) {
                        f32x4 v0 = acc[ai][bj][m][0], v1 = acc[ai][bj][m][1];
                        if (kind == KPL_SCALE) { v0 = v0 * sc; v1 = v1 * sc; }
                        else {
#pragma unroll
                            for (int i = 0; i < 4; ++i) { const float g0 = sigmoid_f(v0[i]), g1 = sigmoid_f(v1[i]); v0[i] = (kind == KPL_SILU) ? v0[i] * g0 : g0; v1[i] = (kind == KPL_SILU) ? v1[i] * g1 : g1; }
                        }
                        *(GAS u32x4*)(dst + (size_t)t * ld + bj * 128) = pack8(v0, v1);
                    }
                }
        } else {
            const int t0 = u.b, bb = t0 >> 12, s0 = t0 & 4095, cc = s0 >> 9, j0 = s0 & 511;
            if (kind == KKT) {
                const int h = u.a;
                const float lf = log2_sigmoid(decay[h]), lb = log2_sigmoid(decay[4 + h]);
#pragma unroll
                for (int bj = 0; bj < 2; ++bj) {
                    const int col8 = bj * 128 + c8, s = s0 + col8, j = j0 + col8;
                    f32x4 df0, df1, db0, db1;
#pragma unroll
                    for (int i = 0; i < 4; ++i) { df0[i] = 0.0625f * fast_exp2(lf * (float)(511 - (j + i))); df1[i] = 0.0625f * fast_exp2(lf * (float)(511 - (j + 4 + i)));
                                                  db0[i] = 0.0625f * fast_exp2(lb * (float)(j + i)); db1[i] = 0.0625f * fast_exp2(lb * (float)(j + 4 + i)); }
#pragma unroll
                    for (int m = 0; m < 4; ++m) {
                        const int dl = wr * 64 + m * 16 + fr;
                        const float* cp = cosT + (size_t)dl * 4096 + s; const float* sp = sinT + (size_t)dl * 4096 + s;
                        const f32x4 c0 = *(const GAS f32x4*)cp, c1 = *(const GAS f32x4*)(cp + 4), sn0 = *(const GAS f32x4*)sp, sn1 = *(const GAS f32x4*)(sp + 4);
                        const f32x4 x1a = acc[0][bj][m][0], x1b = acc[0][bj][m][1], x2a = acc[1][bj][m][0], x2b = acc[1][bj][m][1];
                        const f32x4 k1a = x1a * c0 - x2a * sn0, k1b = x1b * c1 - x2b * sn1, k2a = x1a * sn0 + x2a * c0, k2b = x1b * sn1 + x2b * c1;
                        bf16_t* kp = KDT + ((((size_t)(bb * 4 + h) * 8 + cc) * 2) * 256 + dl) * 512 + j;
                        *(GAS u32x4*)kp = pack8(k1a * df0, k1b * df1); *(GAS u32x4*)(kp + 128 * 512) = pack8(k2a * df0, k2b * df1);
                        *(GAS u32x4*)(kp + 256 * 512) = pack8(k1a * db0, k1b * db1); *(GAS u32x4*)(kp + 384 * 512) = pack8(k2a * db0, k2b * db1);
                        __builtin_amdgcn_sched_barrier(0);
                    }
                }
            } else if (kind == KVT) {
                const int h = u.a;
#pragma unroll
                for (int ai = 0; ai < 2; ++ai)
#pragma unroll
                    for (int m = 0; m < 4; ++m) {
                        const int e = u.c * 256 + ai * 128 + wr * 64 + m * 16 + fr;
                        bf16_t* vp = BCAT + (((size_t)(bb * 4 + h) * 8 + cc) * 512 + e) * 1024 + j0 + c8;
#pragma unroll
                        for (int bj = 0; bj < 2; ++bj) *(GAS u32x4*)(vp + bj * 128) = pack8(acc[ai][bj][m][0], acc[ai][bj][m][1]);
                    }
            } else {
#pragma unroll
                for (int ai = 0; ai < 2; ++ai)
#pragma unroll
                    for (int m = 0; m < 4; ++m) {
                        const int ch = u.a * 256 + ai * 128 + wr * 64 + m * 16 + fr;
                        bf16_t* vp = VNT + ((size_t)bb * 1024 + ch) * 4096 + s0 + c8;
#pragma unroll
                        for (int bj = 0; bj < 2; ++bj) *(GAS u32x4*)(vp + bj * 128) = pack8(acc[ai][bj][m][0], acc[ai][bj][m][1]);
                    }
            }
        }
    }
};

struct DecR1 {
    const char* Q; const char* Kb;
    __device__ __forceinline__ void operator()(int u, Unit& o) const {
        const int pn2 = u & 1, pm2 = (u >> 1) & 1, cc = (u >> 2) & 7, bh = u >> 5, b = bh >> 2, h = bh & 3;
        const int ti = b * 4096 + cc * 512 + pm2 * 256, tj = b * 4096 + cc * 512 + pn2 * 256;
        o.A = Q + ((size_t)ti * 1024 + h * 256) * 2; o.B = Kb + ((size_t)tj * 1024 + h * 256) * 2;
        o.kind = 0; o.a = h; o.b = ti; o.c = pm2 * 2 + pn2;
    }
};
struct EpiR1 {
    bf16_t* ACAT; const float* decay;
    __device__ __forceinline__ void operator()(const f32x4 (&acc)[2][2][4][2], const Unit& u, int wr, int wc, int fr, int fq) const {
        const int h = u.a, ti0 = u.b, i0 = (u.c >> 1) * 256, j0 = (u.c & 1) * 256, c8 = wc * 32 + fq * 8;
        const float lf = log2_sigmoid(decay[h]), lb = log2_sigmoid(decay[4 + h]);
#pragma unroll
        for (int ai = 0; ai < 2; ++ai)
#pragma unroll
            for (int m = 0; m < 4; ++m) {
                const int r = ai * 128 + wr * 64 + m * 16 + fr, i = i0 + r;
                bf16_t* ap = ACAT + ((size_t)(ti0 + r) * 4 + h) * 1024 + j0 + c8;
#pragma unroll
                for (int bj = 0; bj < 2; ++bj) {
                    f32x4 v0 = acc[ai][bj][m][0], v1 = acc[ai][bj][m][1];
                    const int jb = j0 + bj * 128 + c8;
#pragma unroll
                    for (int q = 0; q < 4; ++q) {
                        const int d0 = i - (jb + q), d1 = i - (jb + 4 + q);
                        v0[q] *= fast_exp2(d0 >= 0 ? lf * (float)d0 : lb * (float)(-d0));
                        v1[q] *= fast_exp2(d1 >= 0 ? lf * (float)d1 : lb * (float)(-d1));
                    }
                    *(GAS u32x4*)(ap + bj * 128) = pack8(v0, v1);
                }
                __builtin_amdgcn_sched_barrier(0);
            }
    }
};
struct DecR2 {
    const char* BCAT; const char* KDT;
    __device__ __forceinline__ void operator()(int u, Unit& o) const {
        const int pm2 = u & 1, v = u >> 1, pr = v % 14, bh = v / 14;
        const int dir = pr < 7 ? 0 : 1, cc = pr < 7 ? pr : pr - 6;
        o.A = BCAT + (((size_t)(bh * 8 + cc) * 512 + pm2 * 256) * 1024) * 2;
        o.B = KDT + ((((size_t)(bh * 8 + cc) * 2 + dir) * 256) * 512) * 2;
        o.kind = 0; o.a = (bh * 8 + cc) * 2 + dir; o.b = pm2 * 256; o.c = 0;
    }
};
struct EpiR2 {
    float* KV;
    __device__ __forceinline__ void operator()(const f32x4 (&acc)[2][2][4][2], const Unit& u, int wr, int wc, int fr, int fq) const {
        const int c8 = wc * 32 + fq * 8;
#pragma unroll
        for (int ai = 0; ai < 2; ++ai)
#pragma unroll
            for (int m = 0; m < 4; ++m) {
                const int e = u.b + ai * 128 + wr * 64 + m * 16 + fr;
                float* kp = KV + ((size_t)u.a * 512 + e) * 256 + c8;
#pragma unroll
                for (int bj = 0; bj < 2; ++bj) { *(GAS f32x4*)(kp + bj * 128) = acc[ai][bj][m][0]; *(GAS f32x4*)(kp + bj * 128 + 4) = acc[ai][bj][m][1]; }
            }
    }
};
struct DecR4 {
    const char* ACAT; const char* BCAT;
    __device__ __forceinline__ void operator()(int u, Unit& o) const {
        const int pn2 = u & 1, pm2 = (u >> 1) & 1, cc = (u >> 2) & 7, bh = u >> 5, b = bh >> 2, h = bh & 3;
        const int ti = b * 4096 + cc * 512 + pm2 * 256;
        o.A = ACAT + (((size_t)ti * 4 + h) * 1024) * 2; o.B = BCAT + (((size_t)(bh * 8 + cc) * 512 + pn2 * 256) * 1024) * 2;
        o.kind = 0; o.a = h * 512 + pn2 * 256; o.b = ti; o.c = 0;
    }
};
struct EpiR4 {
    bf16_t* RET;
    __device__ __forceinline__ void operator()(const f32x4 (&acc)[2][2][4][2], const Unit& u, int wr, int wc, int fr, int fq) const {
        const int c8 = wc * 32 + fq * 8;
#pragma unroll
        for (int ai = 0; ai < 2; ++ai)
#pragma unroll
            for (int m = 0; m < 4; ++m) {
                const int t = u.b + ai * 128 + wr * 64 + m * 16 + fr;
                bf16_t* rp = RET + (size_t)t * 2048 + u.a + c8;
#pragma unroll
                for (int bj = 0; bj < 2; ++bj) *(GAS u32x4*)(rp + bj * 128) = pack8(acc[ai][bj][m][0], acc[ai][bj][m][1]);
            }
    }
};
struct DecDense {
    const char* A; const char* B; int lda2, ldb2;
    __device__ __forceinline__ void operator()(int u, Unit& o) const {
        const int pn = u >> 6, pm = u & 63;
        o.A = A + (size_t)pm * 256 * lda2; o.B = B + (size_t)pn * 256 * ldb2; o.kind = 0; o.a = pn * 256; o.b = pm * 256; o.c = 0;
    }
};
template <int MODE> struct EpiMerge {
    bf16_t* MG; const bf16_t* Gt;
    __device__ __forceinline__ void operator()(const f32x4 (&acc)[2][2][4][2], const Unit& u, int wr, int wc, int fr, int fq) const {
        const int c8 = wc * 32 + fq * 8;
#pragma unroll
        for (int ai = 0; ai < 2; ++ai)
#pragma unroll
            for (int m = 0; m < 4; ++m) {
                const int t = u.b + ai * 128 + wr * 64 + m * 16 + fr;
#pragma unroll
                for (int bj = 0; bj < 2; ++bj) {
                    const int c = u.a + bj * 128 + c8;
                    const u32x4 g = *(const GAS u32x4*)(Gt + (size_t)t * 2048 + MODE * 1024 + c);
                    f32x4 v0 = acc[ai][bj][m][0], v1 = acc[ai][bj][m][1];
                    v0[0] *= bf_lo(g.x); v0[1] *= bf_hi(g.x); v0[2] *= bf_lo(g.y); v0[3] *= bf_hi(g.y);
                    v1[0] *= bf_lo(g.z); v1[1] *= bf_hi(g.z); v1[2] *= bf_lo(g.w); v1[3] *= bf_hi(g.w);
                    bf16_t* mp = MG + (size_t)t * 1024 + c;
                    if (MODE == 1) { const u32x4 o = *(const GAS u32x4*)mp;
                        v0[0] += bf_lo(o.x); v0[1] += bf_hi(o.x); v0[2] += bf_lo(o.y); v0[3] += bf_hi(o.y);
                        v1[0] += bf_lo(o.z); v1[1] += bf_hi(o.z); v1[2] += bf_lo(o.w); v1[3] += bf_hi(o.w); }
                    *(GAS u32x4*)mp = pack8(v0, v1);
                }
            }
    }
};
struct EpiPre {
    float* PRE; const float* xin;
    __device__ __forceinline__ void operator()(const f32x4 (&acc)[2][2][4][2], const Unit& u, int wr, int wc, int fr, int fq) const {
        const int c8 = wc * 32 + fq * 8;
#pragma unroll
        for (int ai = 0; ai < 2; ++ai)
#pragma unroll
            for (int m = 0; m < 4; ++m) {
                const int t = u.b + ai * 128 + wr * 64 + m * 16 + fr;
#pragma unroll
                for (int bj = 0; bj < 2; ++bj) {
                    const size_t o = (size_t)t * 1024 + u.a + bj * 128 + c8;
                    const f32x4 x0 = *(const GAS f32x4*)(xin + o), x1 = *(const GAS f32x4*)(xin + o + 4);
                    *(GAS f32x4*)(PRE + o) = x0 * ALPHA + acc[ai][bj][m][0]; *(GAS f32x4*)(PRE + o + 4) = x1 * ALPHA + acc[ai][bj][m][1];
                }
            }
    }
};
struct DecMoe {
    const char* A; const char* W; int lda2, wexp2, ldb2; const LAS int* tile_e;
    __device__ __forceinline__ void operator()(int u, Unit& o) const {
        const int a = u >> 2, pn = u & 3, e = tile_e[a];
        o.A = A + (size_t)a * 256 * lda2; o.B = W + (size_t)e * wexp2 + (size_t)pn * 256 * ldb2; o.kind = 0; o.a = pn; o.b = a * 256; o.c = 0;
    }
};
struct EpiUp {
    bf16_t* H;
    __device__ __forceinline__ void operator()(const f32x4 (&acc)[2][2][4][2], const Unit& u, int wr, int wc, int fr, int fq) const {
        const int c8 = wc * 32 + fq * 8;
#pragma unroll
        for (int ai = 0; ai < 2; ++ai)
#pragma unroll
            for (int m = 0; m < 4; ++m) {
                const int r = u.b + ai * 128 + wr * 64 + m * 16 + fr;
                f32x4 g0 = acc[ai][0][m][0], g1 = acc[ai][0][m][1]; const f32x4 u0 = acc[ai][1][m][0], u1 = acc[ai][1][m][1];
#pragma unroll
                for (int i = 0; i < 4; ++i) { g0[i] = g0[i] * sigmoid_f(g0[i]) * u0[i]; g1[i] = g1[i] * sigmoid_f(g1[i]) * u1[i]; }
                *(GAS u32x4*)(H + (size_t)r * 512 + u.a * 128 + c8) = pack8(g0, g1);
            }
    }
};
struct EpiDown {
    bf16_t* Y;
    __device__ __forceinline__ void operator()(const f32x4 (&acc)[2][2][4][2], const Unit& u, int wr, int wc, int fr, int fq) const {
        const int c8 = wc * 32 + fq * 8;
#pragma unroll
        for (int ai = 0; ai < 2; ++ai)
#pragma unroll
            for (int m = 0; m < 4; ++m) {
                const int r = u.b + ai * 128 + wr * 64 + m * 16 + fr;
                bf16_t* yp = Y + (size_t)r * 1024 + u.a * 256 + c8;
#pragma unroll
                for (int bj = 0; bj < 2; ++bj) *(GAS u32x4*)(yp + bj * 128) = pack8(acc[ai][bj][m][0], acc[ai][bj][m][1]);
            }
    }
};

__device__ __forceinline__ void tr_item(const float* W, int ldw, bf16_t* WT, int ldwt, int k0, int n0, int drow0, LAS float* scr, int lane) {
#pragma unroll 8
    for (int i = 0; i < 32; ++i) { const int kk = 2 * i + (lane >> 5); scr[kk * 33 + (lane & 31)] = ((const GAS float*)W)[(size_t)(k0 + kk) * ldw + n0 + (lane & 31)]; }
    LDS_WAIT();
    const int c = lane & 7;
#pragma unroll
    for (int j = 0; j < 4; ++j) { const int n = (lane >> 3) + 8 * j; const LAS float* s = scr + (8 * c) * 33 + n;
        u32x4 o; o.x = cvt_pk_bf16(s[0 * 33], s[1 * 33]); o.y = cvt_pk_bf16(s[2 * 33], s[3 * 33]); o.z = cvt_pk_bf16(s[4 * 33], s[5 * 33]); o.w = cvt_pk_bf16(s[6 * 33], s[7 * 33]);
        *(GAS u32x4*)(WT + (size_t)(drow0 + n) * ldwt + k0 + 8 * c) = o; }
    LDS_WAIT();
}
struct Params {
    const float* x; const float* w_in; const float* decay; const float* w_ret_o; const float* rpb; const float* w_na_o; const float* w_out;
    const float* ln_mix_g; const float* ln_mix_b; const float* router_w; const float* router_bias;
    const float* w_gate; const float* w_up; const float* w_down; const float* ln_ffn_g; const float* ln_ffn_b;
    float* out; unsigned char* ws; int ph_lo, ph_hi;
};
__device__ __forceinline__ Params load_params() {
    typedef __attribute__((address_space(4))) const Params CP;
    CP* pk = (CP*)__builtin_amdgcn_kernarg_segment_ptr();
    asm volatile("" : "+s"(pk));
    Params r;
    r.x = pk->x; r.w_in = pk->w_in; r.decay = pk->decay; r.w_ret_o = pk->w_ret_o; r.rpb = pk->rpb; r.w_na_o = pk->w_na_o; r.w_out = pk->w_out;
    r.ln_mix_g = pk->ln_mix_g; r.ln_mix_b = pk->ln_mix_b; r.router_w = pk->router_w; r.router_bias = pk->router_bias;
    r.w_gate = pk->w_gate; r.w_up = pk->w_up; r.w_down = pk->w_down; r.ln_ffn_g = pk->ln_ffn_g; r.ln_ffn_b = pk->ln_ffn_b;
    r.out = pk->out; r.ws = pk->ws; r.ph_lo = pk->ph_lo; r.ph_hi = pk->ph_hi;
    return r;
}
__device__ __forceinline__ void convert_layer(const Params& P, int l, LAS unsigned char* lds, int gw, int NGW, int wave, int lane) {
    LAS float* scr = (LAS float*)(lds + wave * 16384);
    unsigned char* ws = P.ws;
    constexpr int I0 = 16 * 352, I1 = 32 * 32, I2 = 16 * 32, I3 = 16 * 32, I4 = 32 * 256, I5 = 32 * 256, I6 = 32 * 256;
    constexpr int NIT = I0 + I1 + I2 + I3 + I4 + I5 + I6;
    for (int it = gw; it < NIT; it += NGW) {
        int r = it;
        if (r < I0) { const int kb = r / 352, nb = r % 352; tr_item(P.w_in + (size_t)l * 1024 * DIN, DIN, (bf16_t*)(ws + WS_WIN), 1024, kb * 64, nb * 32, nb * 32, scr, lane); continue; } r -= I0;
        if (r < I1) { const int kb = r >> 5, nb = r & 31; tr_item(P.w_ret_o + (size_t)l * 2048 * 1024, 1024, (bf16_t*)(ws + WS_WRET), 2048, kb * 64, nb * 32, nb * 32, scr, lane); continue; } r -= I1;
        if (r < I2) { const int kb = r >> 5, nb = r & 31; tr_item(P.w_na_o + (size_t)l * 1024 * 1024, 1024, (bf16_t*)(ws + WS_WNA), 1024, kb * 64, nb * 32, nb * 32, scr, lane); continue; } r -= I2;
        if (r < I3) { const int kb = r >> 5, nb = r & 31; tr_item(P.w_out + (size_t)l * 1024 * 1024, 1024, (bf16_t*)(ws + WS_WOUT), 1024, kb * 64, nb * 32, nb * 32, scr, lane); continue; } r -= I3;
        if (r < I4 + I5) { const int up = r >= I4 ? 1 : 0; if (up) r -= I4; const int e = r >> 8, q = r & 255, kb = q >> 4, nb = q & 15, n0 = nb * 32;
            const float* src = (up ? P.w_up : P.w_gate) + ((size_t)l * NE + e) * 1024 * 512;
            tr_item(src, 512, (bf16_t*)(ws + WS_WGU), 1024, kb * 64, n0, e * 1024 + (n0 >> 7) * 256 + up * 128 + (n0 & 127), scr, lane); continue; } r -= I4 + I5;
        { const int e = r >> 8, q = r & 255, kb = q >> 5, nb = q & 31;
          tr_item(P.w_down + ((size_t)l * NE + e) * 512 * 1024, 1024, (bf16_t*)(ws + WS_WD), 512, kb * 64, nb * 32, e * 1024 + nb * 32, scr, lane); }
    }
}
__device__ __forceinline__ void sincos_d(double a, float& s, float& c) {
    const double k = rint(a * 0.63661977236758134308);
    double y = fma(-k, 1.5707963267948966192, a); y = fma(-k, 6.123233995736766036e-17, y);
    const double y2 = y * y;
    double sp = -1.0 / 1307674368000.0; sp = fma(sp, y2, 1.0 / 6227020800.0); sp = fma(sp, y2, -1.0 / 39916800.0); sp = fma(sp, y2, 1.0 / 362880.0); sp = fma(sp, y2, -1.0 / 5040.0); sp = fma(sp, y2, 1.0 / 120.0); sp = fma(sp, y2, -1.0 / 6.0); sp = fma(sp * y2, y, y);
    double cp = 1.0 / 20922789888000.0; cp = fma(cp, y2, -1.0 / 87178291200.0); cp = fma(cp, y2, 1.0 / 479001600.0); cp = fma(cp, y2, -1.0 / 3628800.0); cp = fma(cp, y2, 1.0 / 40320.0); cp = fma(cp, y2, -1.0 / 720.0); cp = fma(cp, y2, 1.0 / 24.0); cp = fma(cp, y2, -0.5); cp = fma(cp, y2, 1.0);
    const int q = (int)((long long)k & 3);
    const double sv = (q == 0) ? sp : (q == 1) ? cp : (q == 2) ? -sp : -cp;
    const double cv = (q == 0) ? cp : (q == 1) ? -sp : (q == 2) ? -cp : sp;
    s = (float)sv; c = (float)cv;
}
__device__ __forceinline__ void phase_init(const Params& P, LAS unsigned char* lds, int gw, int NGW, int wave, int lane) {
    unsigned char* ws = P.ws;
    float* cosN = (float*)(ws + WS_TAB); float* sinN = cosN + 4096 * 128; float* cosT = sinN + 4096 * 128; float* sinT = cosT + 4096 * 128;
    const int gtid = gw * 64 + lane, NT_ = NGW * 64;
    for (int i = gtid; i < 4096 * 128; i += NT_) {
        const int pos = i >> 7, j = i & 127;
        const double freq = exp(-(double)j * (9.210340371976184 / 128.0));
        float s, c; sincos_d((double)pos * freq, s, c);
        cosN[i] = c; sinN[i] = s; cosT[(size_t)j * 4096 + pos] = c; sinT[(size_t)j * 4096 + pos] = s;
    }
    bf16_t* xb = (bf16_t*)(ws + WS_XB);
    for (int i = gtid; i < T * D / 8; i += NT_) {
        const f32x4 a = *(const GAS f32x4*)(P.x + (size_t)i * 8), b = *(const GAS f32x4*)(P.x + (size_t)i * 8 + 4);
        *(GAS u32x4*)(xb + (size_t)i * 8) = pack8(a, b);
    }
    convert_layer(P, 0, lds, gw, NGW, wave, lane);
}
__device__ __forceinline__ void phase_prefix(const Params& P, int l, int gw, int NGW, int lane) {
    const float* KV = (const float*)(P.ws + WS_KV); bf16_t* BCAT = (bf16_t*)(P.ws + WS_BCAT);
    const float* decay = P.decay + l * 8;
    const int gtid = gw * 64 + lane, NT_ = NGW * 64;
    for (int idx = gtid; idx < 16 * 2 * 512 * 32; idx += NT_) {
        const int dg = idx & 31, e = (idx >> 5) & 511, dir = (idx >> 14) & 1, bh = idx >> 15, h = bh & 3;
        const float cd = fast_exp2(log2_sigmoid(decay[dir * 4 + h]) * 512.0f);
        f32x4 s0 = {0.f, 0.f, 0.f, 0.f}, s1 = {0.f, 0.f, 0.f, 0.f};
        for (int q = 0; q < 8; ++q) {
            const int cc = dir ? 7 - q : q;
            *(GAS u32x4*)(BCAT + ((size_t)(bh * 8 + cc) * 512 + e) * 1024 + 512 + dir * 256 + dg * 8) = pack8(s0, s1);
            if (q < 7) { const float* kp = KV + ((size_t)((bh * 8 + cc) * 2 + dir) * 512 + e) * 256 + dg * 8;
                s0 = s0 * cd + *(const GAS f32x4*)kp; s1 = s1 * cd + *(const GAS f32x4*)(kp + 4); }
        }
    }
}
__device__ __forceinline__ void phase_headnorm(const Params& P, int gw, int NGW, int lane) {
    const bf16_t* RET = (const bf16_t*)(P.ws + WS_KV); const bf16_t* SG = (const bf16_t*)(P.ws + WS_SG); bf16_t* AR = (bf16_t*)(P.ws + WS_KDT);
    for (int it = gw; it < T * 4; it += NGW) {
        const size_t off = (size_t)it * 512 + lane * 8;
        const u32x4 r = *(const GAS u32x4*)(RET + off), g = *(const GAS u32x4*)(SG + off);
        float v[8] = {bf_lo(r.x), bf_hi(r.x), bf_lo(r.y), bf_hi(r.y), bf_lo(r.z), bf_hi(r.z), bf_lo(r.w), bf_hi(r.w)};
        float s = 0.f;
#pragma unroll
        for (int i = 0; i < 8; ++i) s += v[i];
        const float mean = wave_sum(s) * (1.0f / 512.0f);
        float q = 0.f;
#pragma unroll
        for (int i = 0; i < 8; ++i) { v[i] -= mean; q += v[i] * v[i]; }
        const float rstd = 1.0f / sqrtf(wave_sum(q) * (1.0f / 512.0f) + 1e-5f);
        const float gg[8] = {bf_lo(g.x), bf_hi(g.x), bf_lo(g.y), bf_hi(g.y), bf_lo(g.z), bf_hi(g.z), bf_lo(g.w), bf_hi(g.w)};
        u32x4 o; o.x = cvt_pk_bf16(v[0] * rstd * gg[0], v[1] * rstd * gg[1]); o.y = cvt_pk_bf16(v[2] * rstd * gg[2], v[3] * rstd * gg[3]);
        o.z = cvt_pk_bf16(v[4] * rstd * gg[4], v[5] * rstd * gg[5]); o.w = cvt_pk_bf16(v[6] * rstd * gg[6], v[7] * rstd * gg[7]);
        *(GAS u32x4*)(AR + off) = o;
    }
}
__device__ __forceinline__ void phase_na(const Params& P, int l, int gw, int NGW, int lane) {
    const bf16_t* QN = (const bf16_t*)(P.ws + WS_QN); const bf16_t* KN = (const bf16_t*)(P.ws + WS_KN); const bf16_t* VNT = (const bf16_t*)(P.ws + WS_VNT);
    bf16_t* NAO = (bf16_t*)(P.ws + WS_NAO);
    const float* rpb = P.rpb + (size_t)l * 16 * 15 * 31;
    const int fr = lane & 15, fq = lane >> 4;
    for (int id = gw; id < 16384; id += NGW) {
        const int cb = id & 3, r = (id >> 2) & 63, h = (id >> 8) & 15, b = id >> 12;
        const int rs = min(max(r - 4, 0), 56), c0 = cb * 16, cs = min(max(c0 - 8, 0), 32);
        const int c = c0 + fr, cst = min(max(c - 8, 0), 48);
        const size_t tq = (size_t)b * 4096 + r * 64 + c;
        const bf16x8 yq0 = *(const GAS bf16x8*)(QN + tq * 1024 + h * 64 + 8 * fq), yq1 = *(const GAS bf16x8*)(QN + tq * 1024 + h * 64 + 32 + 8 * fq);
        f32x4 S[16];
#pragma unroll
        for (int kt = 0; kt < 16; ++kt) {
            const int kr = rs + (kt >> 1), kcb = cs + (kt & 1) * 16;
            const size_t tk = (size_t)b * 4096 + kr * 64 + kcb + fr;
            const bf16x8 xk0 = *(const GAS bf16x8*)(KN + tk * 1024 + h * 64 + 8 * fq), xk1 = *(const GAS bf16x8*)(KN + tk * 1024 + h * 64 + 32 + 8 * fq);
            f32x4 z = {0.f, 0.f, 0.f, 0.f};
            z = __builtin_amdgcn_mfma_f32_16x16x32_bf16(xk0, yq0, z, 0, 0, 0);
            z = __builtin_amdgcn_mfma_f32_16x16x32_bf16(xk1, yq1, z, 0, 0, 0);
            const float* bp = rpb + (h * 15 + (kr - r + 7)) * 31;
#pragma unroll
            for (int j = 0; j < 4; ++j) {
                const int kc = kcb + 4 * fq + j; const bool valid = (kc >= cst) && (kc < cst + 16);
                const int co = min(max(kc - c + 15, 0), 30);
                const float bias = ((const GAS float*)bp)[co];
                z[j] = valid ? z[j] + bias : -INFINITY;
            }
            S[kt] = z;
        }
        float mx = -INFINITY;
#pragma unroll
        for (int kt = 0; kt < 16; ++kt)
#pragma unroll
            for (int j = 0; j < 4; ++j) mx = fmaxf(mx, S[kt][j]);
        mx = fmaxf(mx, __shfl_xor(mx, 16)); mx = fmaxf(mx, __shfl_xor(mx, 32));
        float sum = 0.f;
#pragma unroll
        for (int kt = 0; kt < 16; ++kt)
#pragma unroll
            for (int j = 0; j < 4; ++j) { const float p = fast_exp2((S[kt][j] - mx) * LOG2E); S[kt][j] = p; sum += p; }
        sum += __shfl_xor(sum, 16); sum += __shfl_xor(sum, 32);
        f32x4 O[4];
#pragma unroll
        for (int ht = 0; ht < 4; ++ht) O[ht] = (f32x4){0.f, 0.f, 0.f, 0.f};
#pragma unroll
        for (int p = 0; p < 8; ++p) {
            const u32x4 yw = pack8(S[2 * p], S[2 * p + 1]);
            const bf16x8 yp = __builtin_bit_cast(bf16x8, yw);
            const size_t sk = (size_t)(rs + p) * 64 + cs + 4 * fq;
#pragma unroll
            for (int ht = 0; ht < 4; ++ht) {
                const bf16_t* vp = VNT + ((size_t)b * 1024 + h * 64 + ht * 16 + fr) * 4096 + sk;
                const u32x2 lo = *(const GAS u32x2*)vp, hi = *(const GAS u32x2*)(vp + 16);
                const u32x4 xw = {lo.x, lo.y, hi.x, hi.y};
                O[ht] = __builtin_amdgcn_mfma_f32_16x16x32_bf16(__builtin_bit_cast(bf16x8, xw), yp, O[ht], 0, 0, 0);
            }
        }
        const float inv = 1.0f / sum;
#pragma unroll
        for (int ht = 0; ht < 4; ++ht) *(GAS u32x2*)(NAO + tq * 1024 + h * 64 + ht * 16 + 4 * fq) = pack4(O[ht] * inv);
    }
}
__device__ __forceinline__ void ln_row(f32x4 (&v)[4], const f32x4 (&g)[4], const f32x4 (&bb)[4]) {
    float s = 0.f;
#pragma unroll
    for (int j = 0; j < 4; ++j) s += (v[j][0] + v[j][1]) + (v[j][2] + v[j][3]);
    const float mean = wave_sum(s) * (1.0f / 1024.0f);
    float q = 0.f;
#pragma unroll
    for (int j = 0; j < 4; ++j) { v[j] = v[j] - mean; q += (v[j][0] * v[j][0] + v[j][1] * v[j][1]) + (v[j][2] * v[j][2] + v[j][3] * v[j][3]); }
    const float rstd = 1.0f / sqrtf(wave_sum(q) * (1.0f / 1024.0f) + 1e-5f);
#pragma unroll
    for (int j = 0; j < 4; ++j) v[j] = v[j] * rstd * g[j] + bb[j];
}
__device__ __forceinline__ void phase_ln_router(const Params& P, int l, LAS unsigned char* lds, int wave, int lane) {
    unsigned char* ws = P.ws;
    const float* PRE = (const float*)(ws + WS_ACAT); float* X1 = (float*)(ws + WS_ACAT + 64 * MiB); bf16_t* X1B = (bf16_t*)(ws + WS_K);
    int* tok_e = (int*)(ws + WS_TOK); int* tok_rank = tok_e + T * 2; float* tok_w = (float*)(tok_rank + T * 2);
    unsigned* cnt = (unsigned*)(ws + WS_CTL) + CW_CNT + l * 64;
    LAS float* rwT = (LAS float*)lds;
    LAS int* hist = (LAS int*)(lds + LDS_MISC + LM_HIST); LAS int* basee = (LAS int*)(lds + LDS_MISC + LM_BASE); LAS int* rowi = (LAS int*)(lds + LDS_MISC + LM_ROW);
    const int tid = launder_v((int)threadIdx.x);
    for (int i = tid; i < 32 * 1024; i += 512) { const int e = i >> 10, d = i & 1023; rwT[i] = ((const GAS float*)P.router_w)[d * 32 + e]; }
    f32x4 g[4], bb[4];
#pragma unroll
    for (int j = 0; j < 4; ++j) { g[j] = *(const GAS f32x4*)(P.ln_mix_g + l * 1024 + 4 * lane + 256 * j); bb[j] = *(const GAS f32x4*)(P.ln_mix_b + l * 1024 + 4 * lane + 256 * j); }
    const float rbias = P.router_bias[lane & 31];
    for (int chunk = launder_si((int)blockIdx.x); chunk < T / 64; chunk += gridDim.x) {
        if (tid < 32) hist[tid] = 0;
        __syncthreads();
        for (int pr = 0; pr < 4; ++pr) {
            const int lr = wave * 8 + pr * 2, ta = chunk * 64 + lr;
            f32x4 va[4], vb[4];
#pragma unroll
            for (int j = 0; j < 4; ++j) { va[j] = *(const GAS f32x4*)(PRE + (size_t)ta * 1024 + 4 * lane + 256 * j); vb[j] = *(const GAS f32x4*)(PRE + (size_t)(ta + 1) * 1024 + 4 * lane + 256 * j); }
            ln_row(va, g, bb); ln_row(vb, g, bb);
#pragma unroll
            for (int j = 0; j < 4; ++j) {
                *(GAS f32x4*)(X1 + (size_t)ta * 1024 + 4 * lane + 256 * j) = va[j]; *(GAS f32x4*)(X1 + (size_t)(ta + 1) * 1024 + 4 * lane + 256 * j) = vb[j];
                *(GAS u32x2*)(X1B + (size_t)ta * 1024 + 4 * lane + 256 * j) = pack4(va[j]); *(GAS u32x2*)(X1B + (size_t)(ta + 1) * 1024 + 4 * lane + 256 * j) = pack4(vb[j]);
            }
            float la = 0.f, lb = 0.f;
#pragma nounroll
            for (int e = 0; e < 32; ++e) {
                float pa = 0.f, pb = 0.f;
#pragma unroll
                for (int j = 0; j < 4; ++j) { const f32x4 w = *(const LAS f32x4*)(rwT + e * 1024 + 4 * lane + 256 * j);
                    pa += (va[j][0] * w[0] + va[j][1] * w[1]) + (va[j][2] * w[2] + va[j][3] * w[3]); pb += (vb[j][0] * w[0] + vb[j][1] * w[1]) + (vb[j][2] * w[2] + vb[j][3] * w[3]); }
                pa = wave_sum(pa); pb = wave_sum(pb);
                if ((lane & 31) == e) { la = pa; lb = pb; }
            }
#pragma unroll
            for (int rr = 0; rr < 2; ++rr) {
                const float logit = rr ? lb : la;
                const float score = 1.0f / (1.0f + expf(-logit)), sel = score + rbias;
                const int gb = lane & 28;
                const float v0 = __shfl(sel, gb), v1 = __shfl(sel, gb + 1), v2 = __shfl(sel, gb + 2), v3 = __shfl(sel, gb + 3);
                const float a = fmaxf(v0, v1), b2 = fminf(v0, v1), c = fmaxf(v2, v3), d2 = fminf(v2, v3);
                const float gs = fmaxf(a, c) + fmaxf(fminf(a, c), fmaxf(b2, d2));
                int bg = 0; float best = __shfl(gs, 0);
#pragma unroll
                for (int q = 1; q < 8; ++q) { const float xg = __shfl(gs, 4 * q); if (xg > best) { best = xg; bg = q; } }
                const float u0 = __shfl(sel, 4 * bg), u1 = __shfl(sel, 4 * bg + 1), u2 = __shfl(sel, 4 * bg + 2), u3 = __shfl(sel, 4 * bg + 3);
                int i1 = 0; float t1 = u0;
                if (u1 > t1) { t1 = u1; i1 = 1; } if (u2 > t1) { t1 = u2; i1 = 2; } if (u3 > t1) { t1 = u3; i1 = 3; }
                int i2 = -1; float t2 = -INFINITY;
                if (i1 != 0 && u0 > t2) { t2 = u0; i2 = 0; } if (i1 != 1 && u1 > t2) { t2 = u1; i2 = 1; } if (i1 != 2 && u2 > t2) { t2 = u2; i2 = 2; } if (i1 != 3 && u3 > t2) { t2 = u3; i2 = 3; }
                if (i2 < 0) i2 = (i1 + 1) & 3;
                const int e1 = 4 * bg + i1, e2 = 4 * bg + i2;
                const float s1 = __shfl(score, e1), s2 = __shfl(score, e2), inv = 1.0f / (s1 + s2);
                if (lane == 0) {
                    const int r1 = __hip_atomic_fetch_add(hist + e1, 1, __ATOMIC_RELAXED, __HIP_MEMORY_SCOPE_WORKGROUP);
                    const int r2 = __hip_atomic_fetch_add(hist + e2, 1, __ATOMIC_RELAXED, __HIP_MEMORY_SCOPE_WORKGROUP);
                    const int q = lr + rr;
                    rowi[q] = e1; rowi[64 + q] = e2; rowi[128 + q] = r1; rowi[192 + q] = r2; rowi[256 + q] = __float_as_int(s1 * inv); rowi[320 + q] = __float_as_int(s2 * inv);
                }
            }
        }
        __syncthreads();
        if (tid < 32) basee[tid] = (int)__hip_atomic_fetch_add(cnt + tid, (unsigned)hist[tid], __ATOMIC_RELAXED, __HIP_MEMORY_SCOPE_AGENT);
        __syncthreads();
        if (tid < 64) {
            const int t = chunk * 64 + tid, e1 = rowi[tid], e2 = rowi[64 + tid];
            tok_e[2 * t] = e1; tok_e[2 * t + 1] = e2;
            tok_rank[2 * t] = basee[e1] + rowi[128 + tid]; tok_rank[2 * t + 1] = basee[e2] + rowi[192 + tid];
            tok_w[2 * t] = __int_as_float(rowi[256 + tid]); tok_w[2 * t + 1] = __int_as_float(rowi[320 + tid]);
        }
        __syncthreads();
    }
}
__device__ __forceinline__ void build_tiles(const Params& P, int l, LAS unsigned char* lds) {
    const unsigned* cnt = (const unsigned*)(P.ws + WS_CTL) + CW_CNT + l * 64;
    LAS int* tstart = (LAS int*)(lds + LDS_MISC + LM_TSTART); LAS int* tile_e = (LAS int*)(lds + LDS_MISC + LM_TILEE); LAS int* ntp = (LAS int*)(lds + LDS_MISC + LM_NT);
    __syncthreads();
    if (launder_v((int)threadIdx.x) == 0) {
        int a = 0;
#pragma nounroll
        for (int e = 0; e < 32; ++e) { const int c = (int)__hip_atomic_load(cnt + e, __ATOMIC_RELAXED, __HIP_MEMORY_SCOPE_AGENT); const int n = (c + 255) >> 8; tstart[e] = a;
            for (int q = 0; q < n; ++q) { if (a + q < 192) tile_e[a + q] = e; } a += n; }
        tstart[32] = a; ntp[0] = a < 160 ? a : 160;
    }
    __syncthreads();
}
__device__ __forceinline__ void phase_gather(const Params& P, int l, LAS unsigned char* lds, int gw, int NGW, int lane) {
    unsigned char* ws = P.ws;
    const bf16_t* X1B = (const bf16_t*)(ws + WS_K); bf16_t* XG = (bf16_t*)(ws + WS_KV);
    const int* tok_e = (const int*)(ws + WS_TOK); const int* tok_rank = tok_e + T * 2; int* tok_dest = (int*)(ws + WS_TOK) + T * 6;
    build_tiles(P, l, lds);
    const LAS int* tstart = (const LAS int*)(lds + LDS_MISC + LM_TSTART);
    for (int pr = gw; pr < T * 2; pr += NGW) {
        const int e = tok_e[pr], dest = tstart[e] * 256 + tok_rank[pr];
        if (lane == 0) tok_dest[pr] = dest;
        const GAS u32x4* src = (const GAS u32x4*)(X1B + (size_t)(pr >> 1) * 1024); GAS u32x4* dst = (GAS u32x4*)(XG + (size_t)dest * 1024);
        dst[lane] = src[lane]; dst[lane + 64] = src[lane + 64];
    }
}
__device__ __forceinline__ void phase_combine(const Params& P, int l, int gw, int NGW, int lane) {
    unsigned char* ws = P.ws;
    const float* X1 = (const float*)(ws + WS_ACAT + 64 * MiB); const bf16_t* Y = (const bf16_t*)(ws + WS_BCAT + 40 * MiB);
    const float* tok_w = (const float*)(ws + WS_TOK) + T * 4; const int* tok_dest = (const int*)(ws + WS_TOK) + T * 6;
    bf16_t* xb = (bf16_t*)(ws + WS_XB);
    f32x4 g[4], bb[4];
#pragma unroll
    for (int j = 0; j < 4; ++j) { g[j] = *(const GAS f32x4*)(P.ln_ffn_g + l * 1024 + 4 * lane + 256 * j); bb[j] = *(const GAS f32x4*)(P.ln_ffn_b + l * 1024 + 4 * lane + 256 * j); }
    for (int t = gw; t < T; t += NGW) {
        const int d0 = tok_dest[2 * t], d1 = tok_dest[2 * t + 1]; const float w0 = tok_w[2 * t], w1 = tok_w[2 * t + 1];
        f32x4 v[4];
#pragma unroll
        for (int j = 0; j < 4; ++j) {
            const f32x4 x1 = *(const GAS f32x4*)(X1 + (size_t)t * 1024 + 4 * lane + 256 * j);
            const u32x2 y0 = *(const GAS u32x2*)(Y + (size_t)d0 * 1024 + 4 * lane + 256 * j), y1 = *(const GAS u32x2*)(Y + (size_t)d1 * 1024 + 4 * lane + 256 * j);
            v[j][0] = x1[0] * ALPHA + w0 * bf_lo(y0.x) + w1 * bf_lo(y1.x); v[j][1] = x1[1] * ALPHA + w0 * bf_hi(y0.x) + w1 * bf_hi(y1.x);
            v[j][2] = x1[2] * ALPHA + w0 * bf_lo(y0.y) + w1 * bf_lo(y1.y); v[j][3] = x1[3] * ALPHA + w0 * bf_hi(y0.y) + w1 * bf_hi(y1.y);
        }
        ln_row(v, g, bb);
#pragma unroll
        for (int j = 0; j < 4; ++j) { *(GAS f32x4*)(P.out + (size_t)t * 1024 + 4 * lane + 256 * j) = v[j]; *(GAS u32x2*)(xb + (size_t)t * 1024 + 4 * lane + 256 * j) = pack4(v[j]); }
    }
}

__global__ void __launch_bounds__(512, 2) fwd_kernel(Params P) {
    extern __shared__ __attribute__((aligned(16))) unsigned char lds_raw[];
    LAS unsigned char* lds = (LAS unsigned char*)lds_raw;
    const int NGW = gridDim.x * 8;
    for (int u = threadIdx.x; u < (LDS_BYTES - LDS_MISC) / 4; u += 512) ((LAS unsigned*)(lds + LDS_MISC))[u] = 0u;
#define PHASE_CTX() const Params PP = load_params(); unsigned char* ws = PP.ws; const int tid = launder_v((int)threadIdx.x), lane = tid & 63, wave = __builtin_amdgcn_readfirstlane(tid >> 6), gw = launder_si((int)blockIdx.x) * 8 + wave; (void)ws; (void)lane; (void)gw
    __syncthreads();
#if MK_ONE_LAUNCH
    XcdBarrier bar = xcd_barrier_post((unsigned*)(P.ws + WS_CTL) + CW_BAR, (volatile LAS unsigned*)(lds + LDS_MISC + LM_BAR));
#define GRID_BAR() xcd_barrier(bar)
#else
#define GRID_BAR() do { } while (0)
#endif
    const int lo = P.ph_lo, hi = P.ph_hi;
#define IN(k) (lo <= (k) && (k) < hi)
#define SEAM(k) do { if (IN(k) && IN((k) + 1)) GRID_BAR(); } while (0)
#ifndef PROBE_MASK
#define PROBE_MASK 0
#endif
#define REP(b) for (int rep_ = 0; rep_ < (((PROBE_MASK) >> (b)) & 1) + 1; ++rep_)

    if (IN(0)) { PHASE_CTX(); phase_init(PP, lds, gw, NGW, wave, lane); SEAM(0); }

    for (int l = 0; l < DEPTH; ++l) {
        const int pb = 1 + l * 12;
        if (IN(pb + 0)) { PHASE_CTX(); const float* decay = PP.decay + l * 8; (void)decay;
            DecInProj dec{(const char*)(ws + WS_XB), (const char*)(ws + WS_WIN)};
            EpiInProj E{ws, decay};
            REP(0) pg::gemm_phase(lds, 1024, 1024, 1024, 3072, dec, E);
            SEAM(pb + 0);
        }
        if (IN(pb + 1)) { PHASE_CTX(); const float* decay = PP.decay + l * 8; (void)decay;
            { DecR1 dec{(const char*)(ws + WS_Q), (const char*)(ws + WS_K)}; EpiR1 E{(bf16_t*)(ws + WS_ACAT), decay};
              REP(1) pg::gemm_phase(lds, 256, 1024, 1024, 512, dec, E); }
            { DecR2 dec{(const char*)(ws + WS_BCAT), (const char*)(ws + WS_KDT)}; EpiR2 E{(float*)(ws + WS_KV)};
              REP(2) pg::gemm_phase(lds, 512, 1024, 512, 448, dec, E); }
            REP(3) phase_na(PP, l, gw, NGW, lane);
            SEAM(pb + 1);
        }
        if (IN(pb + 2)) { PHASE_CTX(); const float* decay = PP.decay + l * 8; (void)decay; REP(4) phase_prefix(PP, l, gw, NGW, lane); SEAM(pb + 2); }
        if (IN(pb + 3)) { PHASE_CTX(); const float* decay = PP.decay + l * 8; (void)decay;
            DecR4 dec{(const char*)(ws + WS_ACAT), (const char*)(ws + WS_BCAT)}; EpiR4 E{(bf16_t*)(ws + WS_KV)};
            REP(5) pg::gemm_phase(lds, 1024, 4096, 1024, 512, dec, E);
            SEAM(pb + 3);
        }
        if (IN(pb + 4)) { PHASE_CTX(); const float* decay = PP.decay + l * 8; (void)decay; REP(6) phase_headnorm(PP, gw, NGW, lane); SEAM(pb + 4); }
        if (IN(pb + 5)) { PHASE_CTX(); const float* decay = PP.decay + l * 8; (void)decay;
            REP(7) {
            { DecDense dec{(const char*)(ws + WS_KDT), (const char*)(ws + WS_WRET), 2048 * 2, 2048 * 2}; EpiMerge<0> E{(bf16_t*)(ws + WS_Q), (const bf16_t*)(ws + WS_G)};
              pg::gemm_phase(lds, 2048, 2048, 2048, 256, dec, E); }
            { DecDense dec{(const char*)(ws + WS_NAO), (const char*)(ws + WS_WNA), 1024 * 2, 1024 * 2}; EpiMerge<1> E{(bf16_t*)(ws + WS_Q), (const bf16_t*)(ws + WS_G)};
              pg::gemm_phase(lds, 1024, 1024, 1024, 256, dec, E); }
            }
            SEAM(pb + 5);
        }
        if (IN(pb + 6)) { PHASE_CTX(); const float* decay = PP.decay + l * 8; (void)decay;
            DecDense dec{(const char*)(ws + WS_Q), (const char*)(ws + WS_WOUT), 1024 * 2, 1024 * 2}; EpiPre E{(float*)(ws + WS_ACAT), l == 0 ? PP.x : (const float*)PP.out};
            REP(8) pg::gemm_phase(lds, 1024, 1024, 1024, 256, dec, E);
            SEAM(pb + 6);
        }
        if (IN(pb + 7)) { PHASE_CTX(); const float* decay = PP.decay + l * 8; (void)decay; phase_ln_router(PP, l, lds, wave, lane); SEAM(pb + 7); }
        if (IN(pb + 8)) { PHASE_CTX(); const float* decay = PP.decay + l * 8; (void)decay; REP(9) phase_gather(PP, l, lds, gw, NGW, lane); SEAM(pb + 8); }
        if (IN(pb + 9)) { PHASE_CTX(); const float* decay = PP.decay + l * 8; (void)decay;
            build_tiles(PP, l, lds);
            const int nt = *(const LAS int*)(lds + LDS_MISC + LM_NT);
            DecMoe dec{(const char*)(ws + WS_KV), (const char*)(ws + WS_WGU), 1024 * 2, 1024 * 1024 * 2, 1024 * 2, (const LAS int*)(lds + LDS_MISC + LM_TILEE)}; EpiUp E{(bf16_t*)(ws + WS_BCAT)};
            REP(10) pg::gemm_phase(lds, 1024, 1024, 1024, nt * 4, dec, E);
            SEAM(pb + 9);
        }
        if (IN(pb + 10)) { PHASE_CTX(); const float* decay = PP.decay + l * 8; (void)decay;
            build_tiles(PP, l, lds);
            const int nt = *(const LAS int*)(lds + LDS_MISC + LM_NT);
            DecMoe dec{(const char*)(ws + WS_BCAT), (const char*)(ws + WS_WD), 512 * 2, 1024 * 512 * 2, 512 * 2, (const LAS int*)(lds + LDS_MISC + LM_TILEE)}; EpiDown E{(bf16_t*)(ws + WS_BCAT + 40 * MiB)};
            REP(11) pg::gemm_phase(lds, 512, 512, 512, nt * 4, dec, E);
            SEAM(pb + 10);
        }
        if (IN(pb + 11)) { PHASE_CTX(); const float* decay = PP.decay + l * 8; (void)decay;
            REP(12) phase_combine(PP, l, gw, NGW, lane);
            REP(13) if (l + 1 < DEPTH) convert_layer(PP, l + 1, lds, gw, NGW, wave, lane);
            SEAM(pb + 11);
        }
    }
#undef IN
#undef SEAM
}

extern "C" void kernel_launch(void* const* d_in, const int* in_sizes, int n_in, void* d_out, int out_size, void* d_ws, size_t ws_size, hipStream_t stream) {
    static int grid = 0;
    if (grid == 0) {
        if (n_in != 16 || in_sizes[0] != T * D || out_size != T * D || ws_size < WS_END) {
            fprintf(stderr, "kernel_launch: unexpected shapes / workspace (n_in %d, in0 %d, out %d, ws %zu < %zu); nothing launched\n", n_in, n_in > 0 ? in_sizes[0] : -1, out_size, ws_size, (size_t)WS_END); grid = -1; return; }
        int dev = 0, cus = 0, per_cu = 0;
        if (hipGetDevice(&dev) != hipSuccess || hipDeviceGetAttribute(&cus, hipDeviceAttributeMultiprocessorCount, dev) != hipSuccess) { grid = -1; return; }
        if (hipFuncSetAttribute((const void*)fwd_kernel, hipFuncAttributeMaxDynamicSharedMemorySize, LDS_BYTES) != hipSuccess) { fprintf(stderr, "kernel_launch: hipFuncSetAttribute failed\n"); grid = -1; return; }
        if (hipOccupancyMaxActiveBlocksPerMultiprocessor(&per_cu, (const void*)fwd_kernel, 512, LDS_BYTES) != hipSuccess || per_cu < 1)
            fprintf(stderr, "kernel_launch: occupancy query reports %d workgroups per CU\n", per_cu);
        (void)hipGetLastError();
        grid = cus;
    }
    if (grid < 0) return;
    if (hipMemsetAsync((char*)d_ws + WS_CTL, 0, CTL_ZERO_BYTES, stream) != hipSuccess) return;
    Params p{};
    p.x = (const float*)d_in[0]; p.w_in = (const float*)d_in[1]; p.decay = (const float*)d_in[2]; p.w_ret_o = (const float*)d_in[3]; p.rpb = (const float*)d_in[4];
    p.w_na_o = (const float*)d_in[5]; p.w_out = (const float*)d_in[6]; p.ln_mix_g = (const float*)d_in[7]; p.ln_mix_b = (const float*)d_in[8];
    p.router_w = (const float*)d_in[9]; p.router_bias = (const float*)d_in[10]; p.w_gate = (const float*)d_in[11]; p.w_up = (const float*)d_in[12]; p.w_down = (const float*)d_in[13];
    p.ln_ffn_g = (const float*)d_in[14]; p.ln_ffn_b = (const float*)d_in[15];
    p.out = (float*)d_out; p.ws = (unsigned char*)d_ws;
#if MK_ONE_LAUNCH
    p.ph_lo = 0; p.ph_hi = NPH;
    hipLaunchKernelGGL(fwd_kernel, dim3(grid), dim3(512), LDS_BYTES, stream, p);
#else
    for (int ph = 0; ph < NPH; ++ph) { p.ph_lo = ph; p.ph_hi = ph + 1; hipLaunchKernelGGL(fwd_kernel, dim3(grid), dim3(512), LDS_BYTES, stream, p); }
#endif
}
```

```cpp
#include <hip/hip_runtime.h>
#include <cstdio>
#include <cstdint>

#ifndef MK_ONE_LAUNCH
#define MK_ONE_LAUNCH 1
#endif

#define LAS __attribute__((address_space(3)))
#define GAS __attribute__((address_space(1)))
typedef unsigned short bf16_t;
typedef short bf16x8 __attribute__((ext_vector_type(8)));
typedef float f32x4 __attribute__((ext_vector_type(4)));
typedef float f32x2 __attribute__((ext_vector_type(2)));
typedef unsigned u32x4 __attribute__((ext_vector_type(4)));
typedef unsigned u32x2 __attribute__((ext_vector_type(2)));

constexpr int D = 1024, BATCH = 4, SEQ = 4096, T = BATCH * SEQ, DEPTH = 4;
constexpr int DIN = 11264;
constexpr int NE = 32;
constexpr int NPH = 1 + DEPTH * 12;
constexpr float ALPHA = 1.681792830507429f;
constexpr float LOG2E = 1.4426950408889634f;

constexpr size_t MiB = 1u << 20;
constexpr size_t WS_CTL = 0, CTL_ZERO_BYTES = 1 * MiB;
constexpr size_t WS_TAB = 2 * MiB;
constexpr size_t WS_TOK = 10 * MiB;
constexpr size_t WS_WRT = 11 * MiB;
constexpr size_t WS_WIN = 12 * MiB;
constexpr size_t WS_WRET = 34 * MiB;
constexpr size_t WS_WNA = 38 * MiB;
constexpr size_t WS_WOUT = 40 * MiB;
constexpr size_t WS_WGU = 42 * MiB;
constexpr size_t WS_WD = 106 * MiB;
constexpr size_t WS_XB = 138 * MiB;
constexpr size_t WS_Q = 170 * MiB;
constexpr size_t WS_K = 202 * MiB;
constexpr size_t WS_ACAT = 234 * MiB;
constexpr size_t WS_BCAT = 362 * MiB;
constexpr size_t WS_KDT = 490 * MiB;
constexpr size_t WS_KV = 554 * MiB;
constexpr size_t WS_SG = 682 * MiB;
constexpr size_t WS_QN = 746 * MiB;
constexpr size_t WS_KN = 778 * MiB;
constexpr size_t WS_VNT = 810 * MiB;
constexpr size_t WS_G = 842 * MiB;
constexpr size_t WS_NAO = 906 * MiB;
constexpr size_t WS_END = 938 * MiB;
constexpr int CW_BAR = 4096;
constexpr int CW_CNT = 16384;

constexpr int LDS_STAGE = 131072;
constexpr int LDS_MISC = 131072;
constexpr int LM_BAR = 0;
constexpr int LM_HIST = 64;
constexpr int LM_BASE = 192;
constexpr int LM_ROW = 512;
constexpr int LM_NT = 2048;
constexpr int LM_TSTART = 2112;
constexpr int LM_TILEE = 2304;
constexpr int LDS_BYTES = 147456;

#define LDS_WAIT() asm volatile("s_waitcnt lgkmcnt(0)" ::: "memory")
#define VM_WAIT() asm volatile("s_waitcnt vmcnt(0)" ::: "memory")
__device__ __forceinline__ unsigned cvt_pk_bf16(float lo, float hi) { unsigned r; asm("v_cvt_pk_bf16_f32 %0, %1, %2" : "=v"(r) : "v"(lo), "v"(hi)); return r; }
__device__ __forceinline__ u32x4 pack8(const f32x4 a, const f32x4 b) { u32x4 w; w.x = cvt_pk_bf16(a[0], a[1]); w.y = cvt_pk_bf16(a[2], a[3]); w.z = cvt_pk_bf16(b[0], b[1]); w.w = cvt_pk_bf16(b[2], b[3]); return w; }
__device__ __forceinline__ u32x2 pack4(const f32x4 a) { u32x2 w; w.x = cvt_pk_bf16(a[0], a[1]); w.y = cvt_pk_bf16(a[2], a[3]); return w; }
__device__ __forceinline__ float bf_lo(unsigned u) { return __uint_as_float(u << 16); }
__device__ __forceinline__ float bf_hi(unsigned u) { return __uint_as_float(u & 0xffff0000u); }
__device__ __forceinline__ float wave_sum(float v) {
#pragma unroll
    for (int o = 1; o < 64; o <<= 1) v += __shfl_xor(v, o);
    return v;
}
template <class Tp> __device__ __forceinline__ Tp* launder_s(Tp* p) { asm volatile("" : "+s"(p)); return p; }
__device__ __forceinline__ int launder_v(int v) { asm volatile("" : "+v"(v)); return v; }
__device__ __forceinline__ int launder_si(int v) { asm volatile("" : "+s"(v)); return v; }
__device__ __forceinline__ float fast_exp2(float x) { return __builtin_amdgcn_exp2f(x); }
__device__ __forceinline__ float fast_rcp(float x) { return __builtin_amdgcn_rcpf(x); }
__device__ __forceinline__ float sigmoid_f(float v) { return fast_rcp(1.0f + fast_exp2(-v * LOG2E)); }
__device__ __forceinline__ float log2_sigmoid(float x) { return -log1pf(expf(-x)) * LOG2E; }

#define XB_TMO      128
#define XB_XCNT(j)  (256  + 64 * (j))
#define XB_XSUB(j)  (1280 + 64 * (j))
#define XB_XGEN(j)  (2304 + 64 * (j))
#define XB_TOP      3328
#define XB_TOPGEN   3392
#define XCD_BAR_WORDS 3456
#define XB_SPIN_CAP (1u << 18)

__device__ __forceinline__ unsigned xb_ld(unsigned* p)              { return __hip_atomic_load(p, __ATOMIC_RELAXED, __HIP_MEMORY_SCOPE_AGENT); }
__device__ __forceinline__ unsigned xb_add(unsigned* p, unsigned v) { return __hip_atomic_fetch_add(p, v, __ATOMIC_RELAXED, __HIP_MEMORY_SCOPE_AGENT); }
__device__ __forceinline__ unsigned xb_xcc_id() { return (unsigned)__builtin_amdgcn_s_getreg((3 << 11) | 20) & 0xFu; }
#define XB_SPIN(cond, bar) do { unsigned _sp = 0; while (cond) { __builtin_amdgcn_s_sleep(1); \
    if ((++_sp & 255u) == 0u) { if (xb_ld(&(bar)[XB_TMO])) break; if (_sp > XB_SPIN_CAP) { atomicAdd(&(bar)[XB_TMO], 1u); break; } } } } while (0)

struct XcdBarrier {
    unsigned* bar; unsigned x;
    volatile LAS unsigned* st;
};
__device__ __forceinline__ XcdBarrier xcd_barrier_post(unsigned* bar, volatile LAS unsigned* st) {
    XcdBarrier b; b.bar = bar; b.x = xb_xcc_id(); b.st = st;
    if (threadIdx.x == 0) (void)xb_add(&bar[XB_XCNT(b.x)], 1u);
    return b;
}
__device__ __forceinline__ void xcd_barrier_complete(unsigned* bar, unsigned x, unsigned& nloc, unsigned& nx) {
    const unsigned G = gridDim.x * gridDim.y * gridDim.z;
    unsigned sum, cnt, mine, sp = 0u;
    for (;;) {
        sum = 0u; cnt = 0u; mine = 0u;
#pragma unroll
        for (unsigned j = 0; j < 16; ++j) { const unsigned c = xb_ld(&bar[XB_XCNT(j)]); sum += c; cnt += (c > 0u) ? 1u : 0u; mine = (j == x) ? c : mine; }
        if (sum == G) break;
        __builtin_amdgcn_s_sleep(1);
        if ((++sp & 255u) == 0u) { if (xb_ld(&bar[XB_TMO])) break; if (sp > XB_SPIN_CAP) { atomicAdd(&bar[XB_TMO], 1u); break; } }
    }
    nloc = mine > 0u ? mine : 1u; nx = cnt > 0u ? cnt : 1u;
}
__device__ __forceinline__ void xcd_barrier(const XcdBarrier& b) {
    asm volatile("s_waitcnt vmcnt(0)" ::: "memory");
    __syncthreads();
    if (threadIdx.x == 0) {
        unsigned* bar = b.bar;
        __builtin_amdgcn_s_waitcnt(0);
        unsigned nloc = b.st[0], nx = b.st[1];
        if (nloc == 0u) { xcd_barrier_complete(bar, b.x, nloc, nx); b.st[0] = nloc; b.st[1] = nx; }
        const unsigned old = xb_add(&bar[XB_XSUB(b.x)], 1u);
        const unsigned gen = old / nloc;
        if (old + 1u == (gen + 1u) * nloc) {
            __builtin_amdgcn_fence(__ATOMIC_RELEASE, "agent");
            asm volatile("s_waitcnt vmcnt(0)" ::: "memory");
            const unsigned og = xb_add(&bar[XB_TOP], 1u);
            const unsigned tg = og / nx;
            if (og + 1u == (tg + 1u) * nx) xb_add(&bar[XB_TOPGEN], 1u);
            else XB_SPIN(xb_ld(&bar[XB_TOPGEN]) == tg, bar);
            __builtin_amdgcn_fence(__ATOMIC_ACQUIRE, "agent");
            xb_add(&bar[XB_XGEN(b.x)], 1u);
            asm volatile("s_waitcnt vmcnt(0)" ::: "memory");
        } else {
            XB_SPIN(xb_ld(&bar[XB_XGEN(b.x)]) == gen, bar);
            __builtin_amdgcn_fence(__ATOMIC_ACQUIRE, "agent");
            asm volatile("s_waitcnt vmcnt(0)" ::: "memory");
        }
    }
    __syncthreads();
}

namespace pg {
constexpr int BM = 256, BK = 64, HALF = 128, HTB = HALF * BK * 2, STAGE_BYTES = 8 * HTB;
__device__ __forceinline__ int lds_byte(int r, int c) { const int st = (r >> 4) * 2 + (c >> 5), rr = r & 15, cc = c & 31, ob = rr * 64 + cc * 2; return st * 1024 + (ob ^ (((ob >> 9) & 1) << 5)); }
__device__ __forceinline__ void stage_rc(int b, int& R, int& C) { const int st = b / 1024, sb = b % 1024, swz = sb ^ (((sb >> 9) & 1) << 5); R = (st >> 1) * 16 + swz / 64; C = (st & 1) * 32 + (swz % 64) / 2; }
__device__ __forceinline__ int perm32(int rho) { const int n = rho >> 4, i = rho & 15; return 8 * (i >> 2) + 4 * n + (i & 3); }

struct Unit { const char* A; const char* B; int kind, a, b, c; };

template <class Epi, class Dec>
__device__ __forceinline__ void gemm_phase(LAS unsigned char* lds, const int K, const int lda, const int ldb, const int nunits, const Dec& dec, const Epi& E) {
    const int tid = launder_v((int)threadIdx.x), wid = __builtin_amdgcn_readfirstlane(tid >> 6), lane = tid & 63, wr = wid >> 2, wc = wid & 3, fr = lane & 15, fq = lane >> 4;
    const int nt = K / BK;
    const int G = launder_si((int)gridDim.x); int uidx = launder_si((int)blockIdx.x);
    if (uidx >= nunits) return;
    unsigned voffA[2], voffB[2];
#pragma unroll
    for (int i = 0; i < 2; ++i) { int R, C; stage_rc(tid * 16 + i * 8192, R, C); const int Rb = (R & ~31) + perm32(R & 31);
        voffA[i] = (unsigned)(R * lda + C) * 2u; voffB[i] = (unsigned)(Rb * ldb + C) * 2u; }
    const size_t kstep = (size_t)(BK * 2);
    const size_t hstepA = (size_t)HALF * lda * 2, hstepB = (size_t)HALF * ldb * 2;
    const unsigned ldsw = (unsigned)wid * 1024u;
    const int aoff = lds_byte(wr * 64 + fr, fq * 8), boff = lds_byte(wc * 32 + fr, fq * 8);
#define PG_SA(b, h) (((b) * 2 + (h)) * HTB)
#define PG_SB(b, h) ((4 + (b) * 2 + (h)) * HTB)
#define PG_STAGE(bufoff, gbase, voff) do { _Pragma("unroll") for (int _i = 0; _i < 2; ++_i) \
        __builtin_amdgcn_global_load_lds((const unsigned*)((const char*)(gbase) + (voff)[_i]), (LAS unsigned*)(lds + (bufoff) + ldsw + _i * 8192), 16, 0, 0); } while (0)
#define PG_LDA(dst, b, h) do { _Pragma("unroll") for (int m = 0; m < 4; ++m) _Pragma("unroll") for (int k = 0; k < 2; ++k) dst[m][k] = *(const LAS bf16x8*)(lds + PG_SA(b, h) + aoff + m * 2048 + k * 1024); } while (0)
#define PG_LDB(dst, b, h) do { _Pragma("unroll") for (int n = 0; n < 2; ++n) _Pragma("unroll") for (int k = 0; k < 2; ++k) dst[n][k] = *(const LAS bf16x8*)(lds + PG_SB(b, h) + boff + n * 2048 + k * 1024); } while (0)
#define PG_MMA(ai, bj, At, Bt) do { __builtin_amdgcn_s_setprio(1); _Pragma("unroll") for (int m = 0; m < 4; ++m) _Pragma("unroll") for (int n = 0; n < 2; ++n) _Pragma("unroll") for (int k = 0; k < 2; ++k) \
        acc[ai][bj][m][n] = __builtin_amdgcn_mfma_f32_16x16x32_bf16(Bt[n][k], At[m][k], acc[ai][bj][m][n], 0, 0, 0); __builtin_amdgcn_s_setprio(0); } while (0)
#define PG_WAIT_V(n) asm volatile("s_waitcnt vmcnt(" #n ")" ::: "memory")
#define PG_WAIT_L(n) asm volatile("s_waitcnt lgkmcnt(" #n ")" ::: "memory")
#define PG_BAR __builtin_amdgcn_s_barrier()
#define PG_SCHED __builtin_amdgcn_sched_barrier(0)
    Unit cur, nxt;
    dec(uidx, cur);
    f32x4 acc[2][2][4][2];
#pragma unroll
    for (int a = 0; a < 2; ++a)
#pragma unroll
        for (int b = 0; b < 2; ++b)
#pragma unroll
            for (int m = 0; m < 4; ++m)
#pragma unroll
                for (int n = 0; n < 2; ++n) acc[a][b][m][n] = (f32x4){0.f, 0.f, 0.f, 0.f};
    bf16x8 At[4][2], B0[2][2], B1[2][2];
    const char* cA = cur.A; const char* cB = cur.B;
    PG_STAGE(PG_SB(0, 0), cB, voffB); PG_STAGE(PG_SB(0, 1), cB + hstepB, voffB); PG_STAGE(PG_SA(0, 0), cA, voffA); PG_STAGE(PG_SA(0, 1), cA + hstepA, voffA);
    if (wr == 1) PG_BAR;
    PG_WAIT_V(2); PG_BAR;
    PG_STAGE(PG_SB(1, 0), cB + kstep, voffB); PG_STAGE(PG_SA(1, 0), cA + kstep, voffA); PG_STAGE(PG_SB(1, 1), cB + hstepB + kstep, voffB);
    PG_WAIT_V(6); PG_BAR;
    for (;;) {
        const bool has_next = (uidx + G < nunits);
        if (has_next) dec(uidx + G, nxt);
        const char* nA = has_next ? nxt.A : cA; const char* nB = has_next ? nxt.B : cB;
#pragma nounroll
        for (int t = 0; t < nt; t += 2) {
            const bool last = (t == nt - 2);
            const char* a1 = cA + (size_t)(t + 1) * kstep;
            const char* a2 = last ? nA : cA + (size_t)(t + 2) * kstep; const char* b2 = last ? nB : cB + (size_t)(t + 2) * kstep;
            const char* a3 = a2 + kstep; const char* b3 = b2 + kstep;
            PG_LDB(B0, 0, 0); PG_LDB(B1, 0, 1); PG_SCHED; PG_LDA(At, 0, 0); PG_STAGE(PG_SA(1, 1), a1 + hstepA, voffA);
            PG_WAIT_V(8); PG_WAIT_L(0); PG_BAR; PG_MMA(0, 0, At, B0); PG_MMA(0, 1, At, B1); PG_BAR; PG_SCHED;
            PG_LDA(At, 0, 1); PG_STAGE(PG_SB(0, 0), b2, voffB); PG_STAGE(PG_SB(0, 1), b2 + hstepB, voffB); PG_STAGE(PG_SA(0, 0), a2, voffA);
            PG_WAIT_V(8); PG_WAIT_L(0); PG_BAR; PG_MMA(1, 0, At, B0); PG_MMA(1, 1, At, B1); PG_BAR; PG_SCHED;
            PG_LDB(B0, 1, 0); PG_LDB(B1, 1, 1); PG_SCHED; PG_LDA(At, 1, 0); PG_STAGE(PG_SA(0, 1), a2 + hstepA, voffA);
            PG_WAIT_V(8); PG_WAIT_L(0); PG_BAR; PG_MMA(0, 0, At, B0); PG_MMA(0, 1, At, B1); PG_BAR; PG_SCHED;
            PG_LDA(At, 1, 1); PG_STAGE(PG_SB(1, 0), b3, voffB); PG_STAGE(PG_SB(1, 1), b3 + hstepB, voffB); PG_STAGE(PG_SA(1, 0), a3, voffA);
            PG_WAIT_V(8); PG_WAIT_L(0); PG_BAR; PG_MMA(1, 0, At, B0); PG_MMA(1, 1, At, B1); PG_BAR; PG_SCHED;
        }
        if (wr == 0) PG_BAR;
        E(acc, cur, wr, wc, fr, fq);
        if (!has_next) break;
#pragma unroll
        for (int a = 0; a < 2; ++a)
#pragma unroll
            for (int b = 0; b < 2; ++b)
#pragma unroll
                for (int m = 0; m < 4; ++m)
#pragma unroll
                    for (int n = 0; n < 2; ++n) acc[a][b][m][n] = (f32x4){0.f, 0.f, 0.f, 0.f};
        cur = nxt; cA = nA; cB = nB; uidx += G;
        if (wr == 1) PG_BAR;
    }
    PG_WAIT_V(0);
    PG_BAR;
#undef PG_SA
#undef PG_SB
#undef PG_STAGE
#undef PG_LDA
#undef PG_LDB
#undef PG_MMA
#undef PG_WAIT_V
#undef PG_WAIT_L
#undef PG_BAR
#undef PG_SCHED
}
}
using pg::Unit;

enum { KQ = 0, KK = 1, KPL_SILU = 2, KPL_SCALE = 3, KPL_SIG = 4, KKT = 5, KVT = 6, KVNT = 7 };

struct DecInProj {
    const char* xb; const char* WinT;
    __device__ __forceinline__ void operator()(int u, Unit& o) const {
        if (u < 2048) {
            const int g = u >> 8, r = u & 255, x = r & 7, idx = r >> 3, pm = g * 8 + (idx & 7), j = ((x + g) & 7) * 4 + (idx >> 3);
            const int wt = j < 8 ? j : (j < 24 ? j + 8 : j + 12);
            o.A = xb + (size_t)pm * (256 * 1024 * 2); o.B = WinT + (size_t)wt * (256 * 1024 * 2); o.b = pm * 256; o.c = 0;
            if (wt < 4) { o.kind = KQ; o.a = wt; }
            else if (wt < 8) { o.kind = KK; o.a = wt - 4; }
            else if (wt < 24) { o.kind = KPL_SILU; o.a = (wt - 16) * 256; }
            else if (wt < 28) { o.kind = KPL_SCALE; o.a = (wt - 24) * 256; o.c = 0; }
            else if (wt < 32) { o.kind = KPL_SCALE; o.a = (wt - 28) * 256; o.c = 1; }
            else { o.kind = KPL_SIG; o.a = (wt - 36) * 256; }
        } else {
            const int v = u - 2048, g = v >> 8, r = v & 255, x = r & 7, idx = r >> 3, ci = ((x + g) & 3) * 4 + (idx >> 3), tt = (x >> 2) * 32 + g * 8 + (idx & 7);
            int ct;
            if (ci < 4) { ct = 4 + ci; o.kind = KKT; o.a = ci; o.c = 0; }
            else if (ci < 12) { ct = 8 + (ci - 4); o.kind = KVT; o.a = (ci - 4) >> 1; o.c = (ci - 4) & 1; }
            else { ct = 32 + (ci - 12); o.kind = KVNT; o.a = ci - 12; o.c = 0; }
            o.A = WinT + (size_t)ct * (256 * 1024 * 2); o.B = xb + (size_t)tt * (256 * 1024 * 2); o.b = tt * 256;
        }
    }
};
struct EpiInProj {
    unsigned char* ws_;
    const float* decay;
    __device__ __forceinline__ void operator()(const f32x4 (&acc)[2][2][4][2], const Unit& u, int wr, int wc, int fr, int fq) const {
        unsigned char* w = launder_s(ws_);
        bf16_t* const Q = (bf16_t*)(w + WS_Q); bf16_t* const Kb = (bf16_t*)(w + WS_K); bf16_t* const ACAT = (bf16_t*)(w + WS_ACAT); bf16_t* const BCAT = (bf16_t*)(w + WS_BCAT);
        bf16_t* const KDT = (bf16_t*)(w + WS_KDT); bf16_t* const SG = (bf16_t*)(w + WS_SG); bf16_t* const QN = (bf16_t*)(w + WS_QN); bf16_t* const KN = (bf16_t*)(w + WS_KN);
        bf16_t* const VNT = (bf16_t*)(w + WS_VNT); bf16_t* const Gt = (bf16_t*)(w + WS_G);
        const float* const cosN = (const float*)(w + WS_TAB); const float* const sinN = cosN + 4096 * 128; const float* const cosT = sinN + 4096 * 128; const float* const sinT = cosT + 4096 * 128;
        const int kind = u.kind, c8 = wc * 32 + fq * 8;
        if (kind == KQ || kind == KK) {
            const int h = u.a, t0 = u.b;
            float lf = 0.f, lb = 0.f;
            if (kind == KQ) { lf = log2_sigmoid(decay[h]); lb = log2_sigmoid(decay[4 + h]); }
#pragma unroll
            for (int ai = 0; ai < 2; ++ai)
#pragma unroll
                for (int m = 0; m < 4; ++m) {
                    const int t = t0 + ai * 128 + wr * 64 + m * 16 + fr, pos = t & 4095;
                    const float* cp = cosN + (size_t)pos * 128 + c8; const float* sp = sinN + (size_t)pos * 128 + c8;
                    const f32x4 c0 = *(const GAS f32x4*)cp, c1 = *(const GAS f32x4*)(cp + 4), s0 = *(const GAS f32x4*)sp, s1 = *(const GAS f32x4*)(sp + 4);
                    const f32x4 x1a = acc[ai][0][m][0], x1b = acc[ai][0][m][1], x2a = acc[ai][1][m][0], x2b = acc[ai][1][m][1];
                    f32x4 q1a = x1a * c0 - x2a * s0, q1b = x1b * c1 - x2b * s1, q2a = x1a * s0 + x2a * c0, q2b = x1b * s1 + x2b * c1;
                    if (kind == KQ) {
                        bf16_t* qp = Q + (size_t)t * 1024 + h * 256 + c8;
                        *(GAS u32x4*)qp = pack8(q1a, q1b); *(GAS u32x4*)(qp + 128) = pack8(q2a, q2b);
                        const int p = t & 511; const float df = fast_exp2(lf * (float)(p + 1)), db = fast_exp2(lb * (float)(512 - p));
                        bf16_t* ap = ACAT + ((size_t)t * 4 + h) * 1024 + 512 + c8;
                        *(GAS u32x4*)ap = pack8(q1a * df, q1b * df); *(GAS u32x4*)(ap + 128) = pack8(q2a * df, q2b * df);
                        *(GAS u32x4*)(ap + 256) = pack8(q1a * db, q1b * db); *(GAS u32x4*)(ap + 384) = pack8(q2a * db, q2b * db);
                    } else {
                        bf16_t* kp = Kb + (size_t)t * 1024 + h * 256 + c8;
                        *(GAS u32x4*)kp = pack8(q1a * 0.0625f, q1b * 0.0625f); *(GAS u32x4*)(kp + 128) = pack8(q2a * 0.0625f, q2b * 0.0625f);
                    }
                    __builtin_amdgcn_sched_barrier(0);
                }
        } else if (kind == KPL_SILU || kind == KPL_SCALE || kind == KPL_SIG) {
            const int t0 = u.b;
            bf16_t* dst; int ld; float sc = 1.f;
            if (kind == KPL_SILU) { dst = SG; ld = 2048; }
            else if (kind == KPL_SIG) { dst = Gt; ld = 2048; }
            else { ld = 1024; if (u.c == 0) { dst = QN; sc = 0.125f; } else { dst = KN; } }
            dst += u.a + c8;
#pragma unroll
            for (int ai = 0; ai < 2; ++ai)
#pragma unroll
                for (int m = 0; m < 4; ++m) {
                    const int t = t0 + ai * 128 + wr * 64 + m * 16 + fr;
#pragma unroll
                    for (int bj = 0; bj < 2; ++bj) {
                        f32x4 v0 = acc[ai][bj][m][0], v1 = acc[ai][bj][m][1];
                        if (kind == KPL_SCALE) { v0 = v0 * sc; v1 = v1 * sc; }
                        else {
#pragma unroll
                            for (int i = 0; i < 4; ++i) { const float g0 = sigmoid_f(v0[i]), g1 = sigmoid_f(v1[i]); v0[i] = (kind == KPL_SILU) ? v0[i] * g0 : g0; v1[i] = (kind == KPL_SILU) ? v1[i] * g1 : g1; }
                        }
                        *(GAS u32x4*)(dst + (size_t)t * ld + bj * 128) = pack8(v0, v1);
                    }
                }
        } else {
            const int t0 = u.b, bb = t0 >> 12, s0 = t0 & 4095, cc = s0 >> 9, j0 = s0 & 511;
            if (kind == KKT) {
                const int h = u.a;
                const float lf = log2_sigmoid(decay[h]), lb = log2_sigmoid(decay[4 + h]);
#pragma unroll
                for (int bj = 0; bj < 2; ++bj) {
                    const int col8 = bj * 128 + c8, s = s0 + col8, j = j0 + col8;
                    f32x4 df0, df1, db0, db1;
#pragma unroll
                    for (int i = 0; i < 4; ++i) { df0[i] = 0.0625f * fast_exp2(lf * (float)(511 - (j + i))); df1[i] = 0.0625f * fast_exp2(lf * (float)(511 - (j + 4 + i)));
                                                  db0[i] = 0.0625f * fast_exp2(lb * (float)(j + i)); db1[i] = 0.0625f * fast_exp2(lb * (float)(j + 4 + i)); }
#pragma unroll
                    for (int m = 0; m < 4; ++m) {
                        const int dl = wr * 64 + m * 16 + fr;
                        const float* cp = cosT + (size_t)dl * 4096 + s; const float* sp = sinT + (size_t)dl * 4096 + s;
                        const f32x4 c0 = *(const GAS f32x4*)cp, c1 = *(const GAS f32x4*)(cp + 4), sn0 = *(const GAS f32x4*)sp, sn1 = *(const GAS f32x4*)(sp + 4);
                        const f32x4 x1a = acc[0][bj][m][0], x1b = acc[0][bj][m][1], x2a = acc[1][bj][m][0], x2b = acc[1][bj][m][1];
                        const f32x4 k1a = x1a * c0 - x2a * sn0, k1b = x1b * c1 - x2b * sn1, k2a = x1a * sn0 + x2a * c0, k2b = x1b * sn1 + x2b * c1;
                        bf16_t* kp = KDT + ((((size_t)(bb * 4 + h) * 8 + cc) * 2) * 256 + dl) * 512 + j;
                        *(GAS u32x4*)kp = pack8(k1a * df0, k1b * df1); *(GAS u32x4*)(kp + 128 * 512) = pack8(k2a * df0, k2b * df1);
                        *(GAS u32x4*)(kp + 256 * 512) = pack8(k1a * db0, k1b * db1); *(GAS u32x4*)(kp + 384 * 512) = pack8(k2a * db0, k2b * db1);
                        __builtin_amdgcn_sched_barrier(0);
                    }
                }
            } else if (kind == KVT) {
                const int h = u.a;
#pragma unroll
                for (int ai = 0; ai < 2; ++ai)
#pragma unroll
                    for (int m = 0; m < 4; ++m) {
                        const int e = u.c * 256 + ai * 128 + wr * 64 + m * 16 + fr;
                        bf16_t* vp = BCAT + (((size_t)(bb * 4 + h) * 8 + cc) * 512 + e) * 1024 + j0 + c8;
#pragma unroll
                        for (int bj = 0; bj < 2; ++bj) *(GAS u32x4*)(vp + bj * 128) = pack8(acc[ai][bj][m][0], acc[ai][bj][m][1]);
                    }
            } else {
#pragma unroll
                for (int ai = 0; ai < 2; ++ai)
#pragma unroll
                    for (int m = 0; m < 4; ++m) {
                        const int ch = u.a * 256 + ai * 128 + wr * 64 + m * 16 + fr;
                        bf16_t* vp = VNT + ((size_t)bb * 1024 + ch) * 4096 + s0 + c8;
#pragma unroll
                        for (int bj = 0; bj < 2; ++bj) *(GAS u32x4*)(vp + bj * 128) = pack8(acc[ai][bj][m][0], acc[ai][bj][m][1]);
                    }
            }
        }
    }
};

struct DecR1 {
    const char* Q; const char* Kb;
    __device__ __forceinline__ void operator()(int u, Unit& o) const {
        const int pn2 = u & 1, pm2 = (u >> 1) & 1, cc = (u >> 2) & 7, bh = u >> 5, b = bh >> 2, h = bh & 3;
        const int ti = b * 4096 + cc * 512 + pm2 * 256, tj = b * 4096 + cc * 512 + pn2 * 256;
        o.A = Q + ((size_t)ti * 1024 + h * 256) * 2; o.B = Kb + ((size_t)tj * 1024 + h * 256) * 2;
        o.kind = 0; o.a = h; o.b = ti; o.c = pm2 * 2 + pn2;
    }
};
struct EpiR1 {
    bf16_t* ACAT; const float* decay;
    __device__ __forceinline__ void operator()(const f32x4 (&acc)[2][2][4][2], const Unit& u, int wr, int wc, int fr, int fq) const {
        const int h = u.a, ti0 = u.b, i0 = (u.c >> 1) * 256, j0 = (u.c & 1) * 256, c8 = wc * 32 + fq * 8;
        const float lf = log2_sigmoid(decay[h]), lb = log2_sigmoid(decay[4 + h]);
#pragma unroll
        for (int ai = 0; ai < 2; ++ai)
#pragma unroll
            for (int m = 0; m < 4; ++m) {
                const int r = ai * 128 + wr * 64 + m * 16 + fr, i = i0 + r;
                bf16_t* ap = ACAT + ((size_t)(ti0 + r) * 4 + h) * 1024 + j0 + c8;
#pragma unroll
                for (int bj = 0; bj < 2; ++bj) {
                    f32x4 v0 = acc[ai][bj][m][0], v1 = acc[ai][bj][m][1];
                    const int jb = j0 + bj * 128 + c8;
#pragma unroll
                    for (int q = 0; q < 4; ++q) {
                        const int d0 = i - (jb + q), d1 = i - (jb + 4 + q);
                        v0[q] *= fast_exp2(d0 >= 0 ? lf * (float)d0 : lb * (float)(-d0));
                        v1[q] *= fast_exp2(d1 >= 0 ? lf * (float)d1 : lb * (float)(-d1));
                    }
                    *(GAS u32x4*)(ap + bj * 128) = pack8(v0, v1);
                }
                __builtin_amdgcn_sched_barrier(0);
            }
    }
};
struct DecR2 {
    const char* BCAT; const char* KDT;
    __device__ __forceinline__ void operator()(int u, Unit& o) const {
        const int pm2 = u & 1, v = u >> 1, pr = v % 14, bh = v / 14;
        const int dir = pr < 7 ? 0 : 1, cc = pr < 7 ? pr : pr - 6;
        o.A = BCAT + (((size_t)(bh * 8 + cc) * 512 + pm2 * 256) * 1024) * 2;
        o.B = KDT + ((((size_t)(bh * 8 + cc) * 2 + dir) * 256) * 512) * 2;
        o.kind = 0; o.a = (bh * 8 + cc) * 2 + dir; o.b = pm2 * 256; o.c = 0;
    }
};
struct EpiR2 {
    float* KV;
    __device__ __forceinline__ void operator()(const f32x4 (&acc)[2][2][4][2], const Unit& u, int wr, int wc, int fr, int fq) const {
        const int c8 = wc * 32 + fq * 8;
#pragma unroll
        for (int ai = 0; ai < 2; ++ai)
#pragma unroll
            for (int m = 0; m < 4; ++m) {
                const int e = u.b + ai * 128 + wr * 64 + m * 16 + fr;
                float* kp = KV + ((size_t)u.a * 512 + e) * 256 + c8;
#pragma unroll
                for (int bj = 0; bj < 2; ++bj) { *(GAS f32x4*)(kp + bj * 128) = acc[ai][bj][m][0]; *(GAS f32x4*)(kp + bj * 128 + 4) = acc[ai][bj][m][1]; }
            }
    }
};
struct DecR4 {
    const char* ACAT; const char* BCAT;
    __device__ __forceinline__ void operator()(int u, Unit& o) const {
        const int pn2 = u & 1, pm2 = (u >> 1) & 1, cc = (u >> 2) & 7, bh = u >> 5, b = bh >> 2, h = bh & 3;
        const int ti = b * 4096 + cc * 512 + pm2 * 256;
        o.A = ACAT + (((size_t)ti * 4 + h) * 1024) * 2; o.B = BCAT + (((size_t)(bh * 8 + cc) * 512 + pn2 * 256) * 1024) * 2;
        o.kind = 0; o.a = h * 512 + pn2 * 256; o.b = ti; o.c = 0;
    }
};
struct EpiR4 {
    bf16_t* RET;
    __device__ __forceinline__ void operator()(const f32x4 (&acc)[2][2][4][2], const Unit& u, int wr, int wc, int fr, int fq) const {
        const int c8 = wc * 32 + fq * 8;
#pragma unroll
        for (int ai = 0; ai < 2; ++ai)
#pragma unroll
            for (int m = 0; m < 4; ++m) {
                const int t = u.b + ai * 128 + wr * 64 + m * 16 + fr;
                bf16_t* rp = RET + (size_t)t * 2048 + u.a + c8;
#pragma unroll
                for (int bj = 0; bj < 2; ++bj) *(GAS u32x4*)(rp + bj * 128) = pack8(acc[ai][bj][m][0], acc[ai][bj][m][1]);
            }
    }
};
struct DecDense {
    const char* A; const char* B; int lda2, ldb2;
    __device__ __forceinline__ void operator()(int u, Unit& o) const {
        const int pn = u >> 6, pm = u & 63;
        o.A = A + (size_t)pm * 256 * lda2; o.B = B + (size_t)pn * 256 * ldb2; o.kind = 0; o.a = pn * 256; o.b = pm * 256; o.c = 0;
    }
};
template <int MODE> struct EpiMerge {
    bf16_t* MG; const bf16_t* Gt;
    __device__ __forceinline__ void operator()(const f32x4 (&acc)[2][2][4][2], const Unit& u, int wr, int wc, int fr, int fq) const {
        const int c8 = wc * 32 + fq * 8;
#pragma unroll
        for (int ai = 0; ai < 2; ++ai)
#pragma unroll
            for (int m = 0; m < 4; ++m) {
                const int t = u.b + ai * 128 + wr * 64 + m * 16 + fr;
#pragma unroll
                for (int bj = 0; bj < 2; ++bj) {
                    const int c = u.a + bj * 128 + c8;
                    const u32x4 g = *(const GAS u32x4*)(Gt + (size_t)t * 2048 + MODE * 1024 + c);
                    f32x4 v0 = acc[ai][bj][m][0], v1 = acc[ai][bj][m][1];
                    v0[0] *= bf_lo(g.x); v0[1] *= bf_hi(g.x); v0[2] *= bf_lo(g.y); v0[3] *= bf_hi(g.y);
                    v1[0] *= bf_lo(g.z); v1[1] *= bf_hi(g.z); v1[2] *= bf_lo(g.w); v1[3] *= bf_hi(g.w);
                    bf16_t* mp = MG + (size_t)t * 1024 + c;
                    if (MODE == 1) { const u32x4 o = *(const GAS u32x4*)mp;
                        v0[0] += bf_lo(o.x); v0[1] += bf_hi(o.x); v0[2] += bf_lo(o.y); v0[3] += bf_hi(o.y);
                        v1[0] += bf_lo(o.z); v1[1] += bf_hi(o.z); v1[2] += bf_lo(o.w); v1[3] += bf_hi(o.w); }
                    *(GAS u32x4*)mp = pack8(v0, v1);
                }
            }
    }
};
struct EpiPre {
    float* PRE; const float* xin;
    __device__ __forceinline__ void operator()(const f32x4 (&acc)[2][2][4][2], const Unit& u, int wr, int wc, int fr, int fq) const {
        const int c8 = wc * 32 + fq * 8;
#pragma unroll
        for (int ai = 0; ai < 2; ++ai)
#pragma unroll
            for (int m = 0; m < 4; ++m) {
                const int t = u.b + ai * 128 + wr * 64 + m * 16 + fr;
#pragma unroll
                for (int bj = 0; bj < 2; ++bj) {
                    const size_t o = (size_t)t * 1024 + u.a + bj * 128 + c8;
                    const f32x4 x0 = *(const GAS f32x4*)(xin + o), x1 = *(const GAS f32x4*)(xin + o + 4);
                    *(GAS f32x4*)(PRE + o) = x0 * ALPHA + acc[ai][bj][m][0]; *(GAS f32x4*)(PRE + o + 4) = x1 * ALPHA + acc[ai][bj][m][1];
                }
            }
    }
};
struct DecMoe {
    const char* A; const char* W; int lda2, wexp2, ldb2; const LAS int* tile_e;
    __device__ __forceinline__ void operator()(int u, Unit& o) const {
        const int a = u >> 2, pn = u & 3, e = tile_e[a];
        o.A = A + (size_t)a * 256 * lda2; o.B = W + (size_t)e * wexp2 + (size_t)pn * 256 * ldb2; o.kind = 0; o.a = pn; o.b = a * 256; o.c = 0;
    }
};
struct EpiUp {
    bf16_t* H;
    __device__ __forceinline__ void operator()(const f32x4 (&acc)[2][2][4][2], const Unit& u, int wr, int wc, int fr, int fq) const {
        const int c8 = wc * 32 + fq * 8;
#pragma unroll
        for (int ai = 0; ai < 2; ++ai)
#pragma unroll
            for (int m = 0; m < 4; ++m) {
                const int r = u.b + ai * 128 + wr * 64 + m * 16 + fr;
                f32x4 g0 = acc[ai][0][m][0], g1 = acc[ai][0][m][1]; const f32x4 u0 = acc[ai][1][m][0], u1 = acc[ai][1][m][1];
#pragma unroll
                for (int i = 0; i < 4; ++i) { g0[i] = g0[i] * sigmoid_f(g0[i]) * u0[i]; g1[i] = g1[i] * sigmoid_f(g1[i]) * u1[i]; }
                *(GAS u32x4*)(H + (size_t)r * 512 + u.a * 128 + c8) = pack8(g0, g1);
            }
    }
};
struct EpiDown {
    bf16_t* Y;
    __device__ __forceinline__ void operator()(const f32x4 (&acc)[2][2][4][2], const Unit& u, int wr, int wc, int fr, int fq) const {
        const int c8 = wc * 32 + fq * 8;
#pragma unroll
        for (int ai = 0; ai < 2; ++ai)
#pragma unroll
            for (int m = 0; m < 4; ++m) {
                const int r = u.b + ai * 128 + wr * 64 + m * 16 + fr;
                bf16_t* yp = Y + (size_t)r * 1024 + u.a * 256 + c8;
#pragma unroll
                for (int bj = 0; bj < 2; ++bj) *(GAS u32x4*)(yp + bj * 128) = pack8(acc[ai][bj][m][0], acc[ai][bj][m][1]);
            }
    }
};

__device__ __forceinline__ void tr_item(const float* W, int ldw, bf16_t* WT, int ldwt, int k0, int n0, int drow0, LAS float* scr, int lane) {
#pragma unroll 8
    for (int i = 0; i < 32; ++i) { const int kk = 2 * i + (lane >> 5); scr[kk * 33 + (lane & 31)] = ((const GAS float*)W)[(size_t)(k0 + kk) * ldw + n0 + (lane & 31)]; }
    LDS_WAIT();
    const int c = lane & 7;
#pragma unroll
    for (int j = 0; j < 4; ++j) { const int n = (lane >> 3) + 8 * j; const LAS float* s = scr + (8 * c) * 33 + n;
        u32x4 o; o.x = cvt_pk_bf16(s[0 * 33], s[1 * 33]); o.y = cvt_pk_bf16(s[2 * 33], s[3 * 33]); o.z = cvt_pk_bf16(s[4 * 33], s[5 * 33]); o.w = cvt_pk_bf16(s[6 * 33], s[7 * 33]);
        *(GAS u32x4*)(WT + (size_t)(drow0 + n) * ldwt + k0 + 8 * c) = o; }
    LDS_WAIT();
}
struct Params {
    const float* x; const float* w_in; const float* decay; const float* w_ret_o; const float* rpb; const float* w_na_o; const float* w_out;
    const float* ln_mix_g; const float* ln_mix_b; const float* router_w; const float* router_bias;
    const float* w_gate; const float* w_up; const float* w_down; const float* ln_ffn_g; const float* ln_ffn_b;
    float* out; unsigned char* ws; int ph_lo, ph_hi;
};
__device__ __forceinline__ Params load_params() {
    typedef __attribute__((address_space(4))) const Params CP;
    CP* pk = (CP*)__builtin_amdgcn_kernarg_segment_ptr();
    asm volatile("" : "+s"(pk));
    Params r;
    r.x = pk->x; r.w_in = pk->w_in; r.decay = pk->decay; r.w_ret_o = pk->w_ret_o; r.rpb = pk->rpb; r.w_na_o = pk->w_na_o; r.w_out = pk->w_out;
    r.ln_mix_g = pk->ln_mix_g; r.ln_mix_b = pk->ln_mix_b; r.router_w = pk->router_w; r.router_bias = pk->router_bias;
    r.w_gate = pk->w_gate; r.w_up = pk->w_up; r.w_down = pk->w_down; r.ln_ffn_g = pk->ln_ffn_g; r.ln_ffn_b = pk->ln_ffn_b;
    r.out = pk->out; r.ws = pk->ws; r.ph_lo = pk->ph_lo; r.ph_hi = pk->ph_hi;
    return r;
}
__device__ __forceinline__ void convert_layer(const Params& P, int l, LAS unsigned char* lds, int gw, int NGW, int wave, int lane) {
    LAS float* scr = (LAS float*)(lds + wave * 16384);
    unsigned char* ws = P.ws;
    constexpr int I0 = 16 * 352, I1 = 32 * 32, I2 = 16 * 32, I3 = 16 * 32, I4 = 32 * 256, I5 = 32 * 256, I6 = 32 * 256;
    constexpr int NIT = I0 + I1 + I2 + I3 + I4 + I5 + I6;
    for (int it = gw; it < NIT; it += NGW) {
        int r = it;
        if (r < I0) { const int kb = r / 352, nb = r % 352; tr_item(P.w_in + (size_t)l * 1024 * DIN, DIN, (bf16_t*)(ws + WS_WIN), 1024, kb * 64, nb * 32, nb * 32, scr, lane); continue; } r -= I0;
        if (r < I1) { const int kb = r >> 5, nb = r & 31; tr_item(P.w_ret_o + (size_t)l * 2048 * 1024, 1024, (bf16_t*)(ws + WS_WRET), 2048, kb * 64, nb * 32, nb * 32, scr, lane); continue; } r -= I1;
        if (r < I2) { const int kb = r >> 5, nb = r & 31; tr_item(P.w_na_o + (size_t)l * 1024 * 1024, 1024, (bf16_t*)(ws + WS_WNA), 1024, kb * 64, nb * 32, nb * 32, scr, lane); continue; } r -= I2;
        if (r < I3) { const int kb = r >> 5, nb = r & 31; tr_item(P.w_out + (size_t)l * 1024 * 1024, 1024, (bf16_t*)(ws + WS_WOUT), 1024, kb * 64, nb * 32, nb * 32, scr, lane); continue; } r -= I3;
        if (r < I4 + I5) { const int up = r >= I4 ? 1 : 0; if (up) r -= I4; const int e = r >> 8, q = r & 255, kb = q >> 4, nb = q & 15, n0 = nb * 32;
            const float* src = (up ? P.w_up : P.w_gate) + ((size_t)l * NE + e) * 1024 * 512;
            tr_item(src, 512, (bf16_t*)(ws + WS_WGU), 1024, kb * 64, n0, e * 1024 + (n0 >> 7) * 256 + up * 128 + (n0 & 127), scr, lane); continue; } r -= I4 + I5;
        { const int e = r >> 8, q = r & 255, kb = q >> 5, nb = q & 31;
          tr_item(P.w_down + ((size_t)l * NE + e) * 512 * 1024, 1024, (bf16_t*)(ws + WS_WD), 512, kb * 64, nb * 32, e * 1024 + nb * 32, scr, lane); }
    }
}
__device__ __forceinline__ void sincos_d(double a, float& s, float& c) {
    const double k = rint(a * 0.63661977236758134308);
    double y = fma(-k, 1.5707963267948966192, a); y = fma(-k, 6.123233995736766036e-17, y);
    const double y2 = y * y;
    double sp = -1.0 / 1307674368000.0; sp = fma(sp, y2, 1.0 / 6227020800.0); sp = fma(sp, y2, -1.0 / 39916800.0); sp = fma(sp, y2, 1.0 / 362880.0); sp = fma(sp, y2, -1.0 / 5040.0); sp = fma(sp, y2, 1.0 / 120.0); sp = fma(sp, y2, -1.0 / 6.0); sp = fma(sp * y2, y, y);
    double cp = 1.0 / 20922789888000.0; cp = fma(cp, y2, -1.0 / 87178291200.0); cp = fma(cp, y2, 1.0 / 479001600.0); cp = fma(cp, y2, -1.0 / 3628800.0); cp = fma(cp, y2, 1.0 / 40320.0); cp = fma(cp, y2, -1.0 / 720.0); cp = fma(cp, y2, 1.0 / 24.0); cp = fma(cp, y2, -0.5); cp = fma(cp, y2, 1.0);
    const int q = (int)((long long)k & 3);
    const double sv = (q == 0) ? sp : (q == 1) ? cp : (q == 2) ? -sp : -cp;
    const double cv = (q == 0) ? cp : (q == 1) ? -sp : (q == 2) ? -cp : sp;
    s = (float)sv; c = (float)cv;
}
__device__ __forceinline__ void phase_init(const Params& P, LAS unsigned char* lds, int gw, int NGW, int wave, int lane) {
    unsigned char* ws = P.ws;
    float* cosN = (float*)(ws + WS_TAB); float* sinN = cosN + 4096 * 128; float* cosT = sinN + 4096 * 128; float* sinT = cosT + 4096 * 128;
    const int gtid = gw * 64 + lane, NT_ = NGW * 64;
    for (int i = gtid; i < 4096 * 128; i += NT_) {
        const int pos = i >> 7, j = i & 127;
        const double freq = exp(-(double)j * (9.210340371976184 / 128.0));
        float s, c; sincos_d((double)pos * freq, s, c);
        cosN[i] = c; sinN[i] = s; cosT[(size_t)j * 4096 + pos] = c; sinT[(size_t)j * 4096 + pos] = s;
    }
    bf16_t* wrt = (bf16_t*)(ws + WS_WRT);
    for (int i = gtid; i < 32 * 1024; i += NT_) {
        const int e = i >> 10, d = i & 1023; const float w = ((const GAS float*)P.router_w)[d * 32 + e];
        const unsigned h = cvt_pk_bf16(w, 0.f) & 0xffffu; const unsigned lo = cvt_pk_bf16(w - bf_lo(h), 0.f) & 0xffffu;
        wrt[i] = (bf16_t)h; wrt[32 * 1024 + i] = (bf16_t)lo;
    }
    bf16_t* xb = (bf16_t*)(ws + WS_XB);
    for (int i = gtid; i < T * D / 8; i += NT_) {
        const f32x4 a = *(const GAS f32x4*)(P.x + (size_t)i * 8), b = *(const GAS f32x4*)(P.x + (size_t)i * 8 + 4);
        *(GAS u32x4*)(xb + (size_t)i * 8) = pack8(a, b);
    }
    convert_layer(P, 0, lds, gw, NGW, wave, lane);
}
__device__ __forceinline__ void phase_prefix(const Params& P, int l, int gw, int NGW, int lane) {
    const float* KV = (const float*)(P.ws + WS_KV); bf16_t* BCAT = (bf16_t*)(P.ws + WS_BCAT);
    const float* decay = P.decay + l * 8;
    const int gtid = gw * 64 + lane, NT_ = NGW * 64;
    for (int idx = gtid; idx < 16 * 2 * 512 * 32; idx += NT_) {
        const int dg = idx & 31, e = (idx >> 5) & 511, dir = (idx >> 14) & 1, bh = idx >> 15, h = bh & 3;
        const float cd = fast_exp2(log2_sigmoid(decay[dir * 4 + h]) * 512.0f);
        f32x4 s0 = {0.f, 0.f, 0.f, 0.f}, s1 = {0.f, 0.f, 0.f, 0.f};
        for (int q = 0; q < 8; ++q) {
            const int cc = dir ? 7 - q : q;
            *(GAS u32x4*)(BCAT + ((size_t)(bh * 8 + cc) * 512 + e) * 1024 + 512 + dir * 256 + dg * 8) = pack8(s0, s1);
            if (q < 7) { const float* kp = KV + ((size_t)((bh * 8 + cc) * 2 + dir) * 512 + e) * 256 + dg * 8;
                s0 = s0 * cd + *(const GAS f32x4*)kp; s1 = s1 * cd + *(const GAS f32x4*)(kp + 4); }
        }
    }
}
__device__ __forceinline__ void phase_headnorm(const Params& P, int gw, int NGW, int lane) {
    const bf16_t* RET = (const bf16_t*)(P.ws + WS_KV); const bf16_t* SG = (const bf16_t*)(P.ws + WS_SG); bf16_t* AR = (bf16_t*)(P.ws + WS_KDT);
    for (int it = gw; it < T * 4; it += NGW) {
        const size_t off = (size_t)it * 512 + lane * 8;
        const u32x4 r = *(const GAS u32x4*)(RET + off), g = *(const GAS u32x4*)(SG + off);
        float v[8] = {bf_lo(r.x), bf_hi(r.x), bf_lo(r.y), bf_hi(r.y), bf_lo(r.z), bf_hi(r.z), bf_lo(r.w), bf_hi(r.w)};
        float s = 0.f;
#pragma unroll
        for (int i = 0; i < 8; ++i) s += v[i];
        const float mean = wave_sum(s) * (1.0f / 512.0f);
        float q = 0.f;
#pragma unroll
        for (int i = 0; i < 8; ++i) { v[i] -= mean; q += v[i] * v[i]; }
        const float rstd = 1.0f / sqrtf(wave_sum(q) * (1.0f / 512.0f) + 1e-5f);
        const float gg[8] = {bf_lo(g.x), bf_hi(g.x), bf_lo(g.y), bf_hi(g.y), bf_lo(g.z), bf_hi(g.z), bf_lo(g.w), bf_hi(g.w)};
        u32x4 o; o.x = cvt_pk_bf16(v[0] * rstd * gg[0], v[1] * rstd * gg[1]); o.y = cvt_pk_bf16(v[2] * rstd * gg[2], v[3] * rstd * gg[3]);
        o.z = cvt_pk_bf16(v[4] * rstd * gg[4], v[5] * rstd * gg[5]); o.w = cvt_pk_bf16(v[6] * rstd * gg[6], v[7] * rstd * gg[7]);
        *(GAS u32x4*)(AR + off) = o;
    }
}
__device__ __forceinline__ void phase_na(const Params& P, int l, int gw, int NGW, int lane) {
    const bf16_t* QN = (const bf16_t*)(P.ws + WS_QN); const bf16_t* KN = (const bf16_t*)(P.ws + WS_KN); const bf16_t* VNT = (const bf16_t*)(P.ws + WS_VNT);
    bf16_t* NAO = (bf16_t*)(P.ws + WS_NAO);
    const float* rpb = P.rpb + (size_t)l * 16 * 15 * 31;
    const int fr = lane & 15, fq = lane >> 4;
    for (int id = gw; id < 16384; id += NGW) {
        const int cb = id & 3, r = (id >> 2) & 63, h = (id >> 8) & 15, b = id >> 12;
        const int rs = min(max(r - 4, 0), 56), c0 = cb * 16, cs = min(max(c0 - 8, 0), 32);
        const int c = c0 + fr, cst = min(max(c - 8, 0), 48);
        const size_t tq = (size_t)b * 4096 + r * 64 + c;
        const bf16x8 yq0 = *(const GAS bf16x8*)(QN + tq * 1024 + h * 64 + 8 * fq), yq1 = *(const GAS bf16x8*)(QN + tq * 1024 + h * 64 + 32 + 8 * fq);
        f32x4 S[16];
#pragma unroll
        for (int kt = 0; kt < 16; ++kt) {
            const int kr = rs + (kt >> 1), kcb = cs + (kt & 1) * 16;
            const size_t tk = (size_t)b * 4096 + kr * 64 + kcb + fr;
            const bf16x8 xk0 = *(const GAS bf16x8*)(KN + tk * 1024 + h * 64 + 8 * fq), xk1 = *(const GAS bf16x8*)(KN + tk * 1024 + h * 64 + 32 + 8 * fq);
            f32x4 z = {0.f, 0.f, 0.f, 0.f};
            z = __builtin_amdgcn_mfma_f32_16x16x32_bf16(xk0, yq0, z, 0, 0, 0);
            z = __builtin_amdgcn_mfma_f32_16x16x32_bf16(xk1, yq1, z, 0, 0, 0);
            const float* bp = rpb + (h * 15 + (kr - r + 7)) * 31;
#pragma unroll
            for (int j = 0; j < 4; ++j) {
                const int kc = kcb + 4 * fq + j; const bool valid = (kc >= cst) && (kc < cst + 16);
                const int co = min(max(kc - c + 15, 0), 30);
                const float bias = ((const GAS float*)bp)[co];
                z[j] = valid ? z[j] + bias : -INFINITY;
            }
            S[kt] = z;
        }
        float mx = -INFINITY;
#pragma unroll
        for (int kt = 0; kt < 16; ++kt)
#pragma unroll
            for (int j = 0; j < 4; ++j) mx = fmaxf(mx, S[kt][j]);
        mx = fmaxf(mx, __shfl_xor(mx, 16)); mx = fmaxf(mx, __shfl_xor(mx, 32));
        float sum = 0.f;
#pragma unroll
        for (int kt = 0; kt < 16; ++kt)
#pragma unroll
            for (int j = 0; j < 4; ++j) { const float p = fast_exp2((S[kt][j] - mx) * LOG2E); S[kt][j] = p; sum += p; }
        sum += __shfl_xor(sum, 16); sum += __shfl_xor(sum, 32);
        f32x4 O[4];
#pragma unroll
        for (int ht = 0; ht < 4; ++ht) O[ht] = (f32x4){0.f, 0.f, 0.f, 0.f};
#pragma unroll
        for (int p = 0; p < 8; ++p) {
            const u32x4 yw = pack8(S[2 * p], S[2 * p + 1]);
            const bf16x8 yp = __builtin_bit_cast(bf16x8, yw);
            const size_t sk = (size_t)(rs + p) * 64 + cs + 4 * fq;
#pragma unroll
            for (int ht = 0; ht < 4; ++ht) {
                const bf16_t* vp = VNT + ((size_t)b * 1024 + h * 64 + ht * 16 + fr) * 4096 + sk;
                const u32x2 lo = *(const GAS u32x2*)vp, hi = *(const GAS u32x2*)(vp + 16);
                const u32x4 xw = {lo.x, lo.y, hi.x, hi.y};
                O[ht] = __builtin_amdgcn_mfma_f32_16x16x32_bf16(__builtin_bit_cast(bf16x8, xw), yp, O[ht], 0, 0, 0);
            }
        }
        const float inv = 1.0f / sum;
#pragma unroll
        for (int ht = 0; ht < 4; ++ht) *(GAS u32x2*)(NAO + tq * 1024 + h * 64 + ht * 16 + 4 * fq) = pack4(O[ht] * inv);
    }
}
__device__ __forceinline__ void ln_row(f32x4 (&v)[4], const f32x4 (&g)[4], const f32x4 (&bb)[4]) {
    float s = 0.f;
#pragma unroll
    for (int j = 0; j < 4; ++j) s += (v[j][0] + v[j][1]) + (v[j][2] + v[j][3]);
    const float mean = wave_sum(s) * (1.0f / 1024.0f);
    float q = 0.f;
#pragma unroll
    for (int j = 0; j < 4; ++j) { v[j] = v[j] - mean; q += (v[j][0] * v[j][0] + v[j][1] * v[j][1]) + (v[j][2] * v[j][2] + v[j][3] * v[j][3]); }
    const float rstd = 1.0f / sqrtf(wave_sum(q) * (1.0f / 1024.0f) + 1e-5f);
#pragma unroll
    for (int j = 0; j < 4; ++j) v[j] = v[j] * rstd * g[j] + bb[j];
}
__device__ __forceinline__ void phase_ln_router(const Params& P, int l, LAS unsigned char* lds, int wave, int lane) {
    unsigned char* ws = P.ws;
    const float* PRE = (const float*)(ws + WS_ACAT); float* X1 = (float*)(ws + WS_ACAT + 64 * MiB); bf16_t* X1B = (bf16_t*)(ws + WS_K);
    const bf16_t* WRT = (const bf16_t*)(ws + WS_WRT);
    int* tok_e = (int*)(ws + WS_TOK); int* tok_rank = tok_e + T * 2; float* tok_w = (float*)(tok_rank + T * 2);
    unsigned* cnt = (unsigned*)(ws + WS_CTL) + CW_CNT + l * 64;
    LAS int* hist = (LAS int*)(lds + LDS_MISC + LM_HIST); LAS int* basee = (LAS int*)(lds + LDS_MISC + LM_BASE); LAS int* rowi = (LAS int*)(lds + LDS_MISC + LM_ROW);
    const int tid = launder_v((int)threadIdx.x);
    const int fr = lane & 15, fq = lane >> 4;
    f32x4 g[4], bb[4];
#pragma unroll
    for (int j = 0; j < 4; ++j) { g[j] = *(const GAS f32x4*)(P.ln_mix_g + l * 1024 + 4 * lane + 256 * j); bb[j] = *(const GAS f32x4*)(P.ln_mix_b + l * 1024 + 4 * lane + 256 * j); }
    for (int chunk = launder_si((int)blockIdx.x); chunk < T / 64; chunk += gridDim.x) {
        if (tid < 32) hist[tid] = 0;
#pragma nounroll
        for (int rr = 0; rr < 8; ++rr) {
            const int ta = chunk * 64 + wave * 8 + rr;
            f32x4 va[4];
#pragma unroll
            for (int j = 0; j < 4; ++j) va[j] = *(const GAS f32x4*)(PRE + (size_t)ta * 1024 + 4 * lane + 256 * j);
            ln_row(va, g, bb);
#pragma unroll
            for (int j = 0; j < 4; ++j) { *(GAS f32x4*)(X1 + (size_t)ta * 1024 + 4 * lane + 256 * j) = va[j]; *(GAS u32x2*)(X1B + (size_t)ta * 1024 + 4 * lane + 256 * j) = pack4(va[j]); }
        }
        VM_WAIT();
        __syncthreads();
        if (wave < 4) {
            const int t0 = chunk * 64 + wave * 16;
            f32x4 acc0 = {0.f, 0.f, 0.f, 0.f}, acc1 = {0.f, 0.f, 0.f, 0.f};
            const float* yp = X1 + (size_t)(t0 + fr) * 1024 + 8 * fq;
            const bf16_t* wp = WRT + (size_t)fr * 1024 + 8 * fq;
#pragma unroll 4
            for (int s = 0; s < 32; ++s) {
                const f32x4 ya = *(const GAS f32x4*)(yp + 32 * s), yb = *(const GAS f32x4*)(yp + 32 * s + 4);
                const bf16x8 w0h = *(const GAS bf16x8*)(wp + 32 * s), w1h = *(const GAS bf16x8*)(wp + 16 * 1024 + 32 * s);
                const bf16x8 w0l = *(const GAS bf16x8*)(wp + 32 * 1024 + 32 * s), w1l = *(const GAS bf16x8*)(wp + 48 * 1024 + 32 * s);
                u32x4 yh; yh.x = cvt_pk_bf16(ya[0], ya[1]); yh.y = cvt_pk_bf16(ya[2], ya[3]); yh.z = cvt_pk_bf16(yb[0], yb[1]); yh.w = cvt_pk_bf16(yb[2], yb[3]);
                u32x4 yl; yl.x = cvt_pk_bf16(ya[0] - bf_lo(yh.x), ya[1] - bf_hi(yh.x)); yl.y = cvt_pk_bf16(ya[2] - bf_lo(yh.y), ya[3] - bf_hi(yh.y));
                yl.z = cvt_pk_bf16(yb[0] - bf_lo(yh.z), yb[1] - bf_hi(yh.z)); yl.w = cvt_pk_bf16(yb[2] - bf_lo(yh.w), yb[3] - bf_hi(yh.w));
                const bf16x8 yhv = __builtin_bit_cast(bf16x8, yh), ylv = __builtin_bit_cast(bf16x8, yl);
                acc0 = __builtin_amdgcn_mfma_f32_16x16x32_bf16(w0h, yhv, acc0, 0, 0, 0); acc1 = __builtin_amdgcn_mfma_f32_16x16x32_bf16(w1h, yhv, acc1, 0, 0, 0);
                acc0 = __builtin_amdgcn_mfma_f32_16x16x32_bf16(w0h, ylv, acc0, 0, 0, 0); acc1 = __builtin_amdgcn_mfma_f32_16x16x32_bf16(w1h, ylv, acc1, 0, 0, 0);
                acc0 = __builtin_amdgcn_mfma_f32_16x16x32_bf16(w0l, yhv, acc0, 0, 0, 0); acc1 = __builtin_amdgcn_mfma_f32_16x16x32_bf16(w1l, yhv, acc1, 0, 0, 0);
            }
            const f32x4 rb0 = *(const GAS f32x4*)(P.router_bias + 4 * fq), rb1 = *(const GAS f32x4*)(P.router_bias + 16 + 4 * fq);
            f32x4 sc0, sc1, se0, se1;
#pragma unroll
            for (int j = 0; j < 4; ++j) { sc0[j] = 1.0f / (1.0f + expf(-acc0[j])); sc1[j] = 1.0f / (1.0f + expf(-acc1[j])); se0[j] = sc0[j] + rb0[j]; se1[j] = sc1[j] + rb1[j]; }
            float gs0, gs1;
            { const float a = fmaxf(se0[0], se0[1]), b2 = fminf(se0[0], se0[1]), c = fmaxf(se0[2], se0[3]), d2 = fminf(se0[2], se0[3]); gs0 = fmaxf(a, c) + fmaxf(fminf(a, c), fmaxf(b2, d2)); }
            { const float a = fmaxf(se1[0], se1[1]), b2 = fminf(se1[0], se1[1]), c = fmaxf(se1[2], se1[3]), d2 = fminf(se1[2], se1[3]); gs1 = fmaxf(a, c) + fmaxf(fminf(a, c), fmaxf(b2, d2)); }
            float bs = gs0; int bg = fq;
            if (gs1 > gs0) { bs = gs1; bg = 4 + fq; }
#pragma unroll
            for (int o = 16; o < 64; o <<= 1) { const float os = __shfl_xor(bs, o); const int og = __shfl_xor(bg, o); if (os > bs || (os == bs && og < bg)) { bs = os; bg = og; } }
            if ((bg & 3) == fq) {
                const bool hi = bg >= 4;
                const float u0 = hi ? se1[0] : se0[0], u1 = hi ? se1[1] : se0[1], u2 = hi ? se1[2] : se0[2], u3 = hi ? se1[3] : se0[3];
                const float p0 = hi ? sc1[0] : sc0[0], p1 = hi ? sc1[1] : sc0[1], p2 = hi ? sc1[2] : sc0[2], p3 = hi ? sc1[3] : sc0[3];
                int i1 = 0; float t1 = u0;
                if (u1 > t1) { t1 = u1; i1 = 1; } if (u2 > t1) { t1 = u2; i1 = 2; } if (u3 > t1) { t1 = u3; i1 = 3; }
                int i2 = -1; float t2 = -INFINITY;
                if (i1 != 0 && u0 > t2) { t2 = u0; i2 = 0; } if (i1 != 1 && u1 > t2) { t2 = u1; i2 = 1; } if (i1 != 2 && u2 > t2) { t2 = u2; i2 = 2; } if (i1 != 3 && u3 > t2) { t2 = u3; i2 = 3; }
                if (i2 < 0) i2 = (i1 + 1) & 3;
                const float s1 = i1 == 0 ? p0 : i1 == 1 ? p1 : i1 == 2 ? p2 : p3, s2 = i2 == 0 ? p0 : i2 == 1 ? p1 : i2 == 2 ? p2 : p3, inv = 1.0f / (s1 + s2);
                const int e1 = 4 * bg + i1, e2 = 4 * bg + i2;
                const int r1 = __hip_atomic_fetch_add(hist + e1, 1, __ATOMIC_RELAXED, __HIP_MEMORY_SCOPE_WORKGROUP);
                const int r2 = __hip_atomic_fetch_add(hist + e2, 1, __ATOMIC_RELAXED, __HIP_MEMORY_SCOPE_WORKGROUP);
                const int q = wave * 16 + fr;
                rowi[q] = e1; rowi[64 + q] = e2; rowi[128 + q] = r1; rowi[192 + q] = r2; rowi[256 + q] = __float_as_int(s1 * inv); rowi[320 + q] = __float_as_int(s2 * inv);
            }
        }
        __syncthreads();
        if (tid < 32) basee[tid] = (int)__hip_atomic_fetch_add(cnt + tid, (unsigned)hist[tid], __ATOMIC_RELAXED, __HIP_MEMORY_SCOPE_AGENT);
        __syncthreads();
        if (tid < 64) {
            const int t = chunk * 64 + tid, e1 = rowi[tid], e2 = rowi[64 + tid];
            tok_e[2 * t] = e1; tok_e[2 * t + 1] = e2;
            tok_rank[2 * t] = basee[e1] + rowi[128 + tid]; tok_rank[2 * t + 1] = basee[e2] + rowi[192 + tid];
            tok_w[2 * t] = __int_as_float(rowi[256 + tid]); tok_w[2 * t + 1] = __int_as_float(rowi[320 + tid]);
        }
        __syncthreads();
    }
}
__device__ __forceinline__ void build_tiles(const Params& P, int l, LAS unsigned char* lds) {
    const unsigned* cnt = (const unsigned*)(P.ws + WS_CTL) + CW_CNT + l * 64;
    LAS int* tstart = (LAS int*)(lds + LDS_MISC + LM_TSTART); LAS int* tile_e = (LAS int*)(lds + LDS_MISC + LM_TILEE); LAS int* ntp = (LAS int*)(lds + LDS_MISC + LM_NT);
    __syncthreads();
    if (launder_v((int)threadIdx.x) == 0) {
        int a = 0;
#pragma nounroll
        for (int e = 0; e < 32; ++e) { const int c = (int)__hip_atomic_load(cnt + e, __ATOMIC_RELAXED, __HIP_MEMORY_SCOPE_AGENT); const int n = (c + 255) >> 8; tstart[e] = a;
            for (int q = 0; q < n; ++q) { if (a + q < 192) tile_e[a + q] = e; } a += n; }
        tstart[32] = a; ntp[0] = a < 160 ? a : 160;
    }
    __syncthreads();
}
__device__ __forceinline__ void phase_gather(const Params& P, int l, LAS unsigned char* lds, int gw, int NGW, int lane) {
    unsigned char* ws = P.ws;
    const bf16_t* X1B = (const bf16_t*)(ws + WS_K); bf16_t* XG = (bf16_t*)(ws + WS_KV);
    const int* tok_e = (const int*)(ws + WS_TOK); const int* tok_rank = tok_e + T * 2; int* tok_dest = (int*)(ws + WS_TOK) + T * 6;
    build_tiles(P, l, lds);
    const LAS int* tstart = (const LAS int*)(lds + LDS_MISC + LM_TSTART);
    for (int pr = gw; pr < T * 2; pr += NGW) {
        const int e = tok_e[pr], dest = tstart[e] * 256 + tok_rank[pr];
        if (lane == 0) tok_dest[pr] = dest;
        const GAS u32x4* src = (const GAS u32x4*)(X1B + (size_t)(pr >> 1) * 1024); GAS u32x4* dst = (GAS u32x4*)(XG + (size_t)dest * 1024);
        dst[lane] = src[lane]; dst[lane + 64] = src[lane + 64];
    }
}
__device__ __forceinline__ void phase_combine(const Params& P, int l, int gw, int NGW, int lane) {
    unsigned char* ws = P.ws;
    const float* X1 = (const float*)(ws + WS_ACAT + 64 * MiB); const bf16_t* Y = (const bf16_t*)(ws + WS_BCAT + 40 * MiB);
    const float* tok_w = (const float*)(ws + WS_TOK) + T * 4; const int* tok_dest = (const int*)(ws + WS_TOK) + T * 6;
    bf16_t* xb = (bf16_t*)(ws + WS_XB);
    f32x4 g[4], bb[4];
#pragma unroll
    for (int j = 0; j < 4; ++j) { g[j] = *(const GAS f32x4*)(P.ln_ffn_g + l * 1024 + 4 * lane + 256 * j); bb[j] = *(const GAS f32x4*)(P.ln_ffn_b + l * 1024 + 4 * lane + 256 * j); }
    for (int t = gw; t < T; t += NGW) {
        const int d0 = tok_dest[2 * t], d1 = tok_dest[2 * t + 1]; const float w0 = tok_w[2 * t], w1 = tok_w[2 * t + 1];
        f32x4 v[4];
#pragma unroll
        for (int j = 0; j < 4; ++j) {
            const f32x4 x1 = *(const GAS f32x4*)(X1 + (size_t)t * 1024 + 4 * lane + 256 * j);
            const u32x2 y0 = *(const GAS u32x2*)(Y + (size_t)d0 * 1024 + 4 * lane + 256 * j), y1 = *(const GAS u32x2*)(Y + (size_t)d1 * 1024 + 4 * lane + 256 * j);
            v[j][0] = x1[0] * ALPHA + w0 * bf_lo(y0.x) + w1 * bf_lo(y1.x); v[j][1] = x1[1] * ALPHA + w0 * bf_hi(y0.x) + w1 * bf_hi(y1.x);
            v[j][2] = x1[2] * ALPHA + w0 * bf_lo(y0.y) + w1 * bf_lo(y1.y); v[j][3] = x1[3] * ALPHA + w0 * bf_hi(y0.y) + w1 * bf_hi(y1.y);
        }
        ln_row(v, g, bb);
#pragma unroll
        for (int j = 0; j < 4; ++j) { *(GAS f32x4*)(P.out + (size_t)t * 1024 + 4 * lane + 256 * j) = v[j]; *(GAS u32x2*)(xb + (size_t)t * 1024 + 4 * lane + 256 * j) = pack4(v[j]); }
    }
}

__global__ void __launch_bounds__(512, 2) fwd_kernel(Params P) {
    extern __shared__ __attribute__((aligned(16))) unsigned char lds_raw[];
    LAS unsigned char* lds = (LAS unsigned char*)lds_raw;
    const int NGW = gridDim.x * 8;
    for (int u = threadIdx.x; u < (LDS_BYTES - LDS_MISC) / 4; u += 512) ((LAS unsigned*)(lds + LDS_MISC))[u] = 0u;
#define PHASE_CTX() const Params PP = load_params(); unsigned char* ws = PP.ws; const int tid = launder_v((int)threadIdx.x), lane = tid & 63, wave = __builtin_amdgcn_readfirstlane(tid >> 6), gw = launder_si((int)blockIdx.x) * 8 + wave; (void)ws; (void)lane; (void)gw
    __syncthreads();
#if MK_ONE_LAUNCH
    XcdBarrier bar = xcd_barrier_post((unsigned*)(P.ws + WS_CTL) + CW_BAR, (volatile LAS unsigned*)(lds + LDS_MISC + LM_BAR));
#define GRID_BAR() xcd_barrier(bar)
#else
#define GRID_BAR() do { } while (0)
#endif
    const int lo = P.ph_lo, hi = P.ph_hi;
#define IN(k) (lo <= (k) && (k) < hi)
#define SEAM(k) do { if (IN(k) && IN((k) + 1)) GRID_BAR(); } while (0)
#ifndef PROBE_MASK
#define PROBE_MASK 0
#endif
#define REP(b) for (int rep_ = 0; rep_ < (((PROBE_MASK) >> (b)) & 1) + 1; ++rep_)

    if (IN(0)) { PHASE_CTX(); phase_init(PP, lds, gw, NGW, wave, lane); SEAM(0); }

    for (int l = 0; l < DEPTH; ++l) {
        const int pb = 1 + l * 12;
        if (IN(pb + 0)) { PHASE_CTX(); const float* decay = PP.decay + l * 8; (void)decay;
            DecInProj dec{(const char*)(ws + WS_XB), (const char*)(ws + WS_WIN)};
            EpiInProj E{ws, decay};
            REP(0) pg::gemm_phase(lds, 1024, 1024, 1024, 3072, dec, E);
            SEAM(pb + 0);
        }
        if (IN(pb + 1)) { PHASE_CTX(); const float* decay = PP.decay + l * 8; (void)decay;
            { DecR1 dec{(const char*)(ws + WS_Q), (const char*)(ws + WS_K)}; EpiR1 E{(bf16_t*)(ws + WS_ACAT), decay};
              REP(1) pg::gemm_phase(lds, 256, 1024, 1024, 512, dec, E); }
            { DecR2 dec{(const char*)(ws + WS_BCAT), (const char*)(ws + WS_KDT)}; EpiR2 E{(float*)(ws + WS_KV)};
              REP(2) pg::gemm_phase(lds, 512, 1024, 512, 448, dec, E); }
            REP(3) phase_na(PP, l, gw, NGW, lane);
            SEAM(pb + 1);
        }
        if (IN(pb + 2)) { PHASE_CTX(); const float* decay = PP.decay + l * 8; (void)decay; REP(4) phase_prefix(PP, l, gw, NGW, lane); SEAM(pb + 2); }
        if (IN(pb + 3)) { PHASE_CTX(); const float* decay = PP.decay + l * 8; (void)decay;
            DecR4 dec{(const char*)(ws + WS_ACAT), (const char*)(ws + WS_BCAT)}; EpiR4 E{(bf16_t*)(ws + WS_KV)};
            REP(5) pg::gemm_phase(lds, 1024, 4096, 1024, 512, dec, E);
            SEAM(pb + 3);
        }
        if (IN(pb + 4)) { PHASE_CTX(); const float* decay = PP.decay + l * 8; (void)decay; REP(6) phase_headnorm(PP, gw, NGW, lane); SEAM(pb + 4); }
        if (IN(pb + 5)) { PHASE_CTX(); const float* decay = PP.decay + l * 8; (void)decay;
            REP(7) {
            { DecDense dec{(const char*)(ws + WS_KDT), (const char*)(ws + WS_WRET), 2048 * 2, 2048 * 2}; EpiMerge<0> E{(bf16_t*)(ws + WS_Q), (const bf16_t*)(ws + WS_G)};
              pg::gemm_phase(lds, 2048, 2048, 2048, 256, dec, E); }
            { DecDense dec{(const char*)(ws + WS_NAO), (const char*)(ws + WS_WNA), 1024 * 2, 1024 * 2}; EpiMerge<1> E{(bf16_t*)(ws + WS_Q), (const bf16_t*)(ws + WS_G)};
              pg::gemm_phase(lds, 1024, 1024, 1024, 256, dec, E); }
            }
            SEAM(pb + 5);
        }
        if (IN(pb + 6)) { PHASE_CTX(); const float* decay = PP.decay + l * 8; (void)decay;
            DecDense dec{(const char*)(ws + WS_Q), (const char*)(ws + WS_WOUT), 1024 * 2, 1024 * 2}; EpiPre E{(float*)(ws + WS_ACAT), l == 0 ? PP.x : (const float*)PP.out};
            REP(8) pg::gemm_phase(lds, 1024, 1024, 1024, 256, dec, E);
            SEAM(pb + 6);
        }
        if (IN(pb + 7)) { PHASE_CTX(); const float* decay = PP.decay + l * 8; (void)decay; phase_ln_router(PP, l, lds, wave, lane); SEAM(pb + 7); }
        if (IN(pb + 8)) { PHASE_CTX(); const float* decay = PP.decay + l * 8; (void)decay; REP(9) phase_gather(PP, l, lds, gw, NGW, lane); SEAM(pb + 8); }
        if (IN(pb + 9)) { PHASE_CTX(); const float* decay = PP.decay + l * 8; (void)decay;
            build_tiles(PP, l, lds);
            const int nt = *(const LAS int*)(lds + LDS_MISC + LM_NT);
            DecMoe dec{(const char*)(ws + WS_KV), (const char*)(ws + WS_WGU), 1024 * 2, 1024 * 1024 * 2, 1024 * 2, (const LAS int*)(lds + LDS_MISC + LM_TILEE)}; EpiUp E{(bf16_t*)(ws + WS_BCAT)};
            REP(10) pg::gemm_phase(lds, 1024, 1024, 1024, nt * 4, dec, E);
            SEAM(pb + 9);
        }
        if (IN(pb + 10)) { PHASE_CTX(); const float* decay = PP.decay + l * 8; (void)decay;
            build_tiles(PP, l, lds);
            const int nt = *(const LAS int*)(lds + LDS_MISC + LM_NT);
            DecMoe dec{(const char*)(ws + WS_BCAT), (const char*)(ws + WS_WD), 512 * 2, 1024 * 512 * 2, 512 * 2, (const LAS int*)(lds + LDS_MISC + LM_TILEE)}; EpiDown E{(bf16_t*)(ws + WS_BCAT + 40 * MiB)};
            REP(11) pg::gemm_phase(lds, 512, 512, 512, nt * 4, dec, E);
            SEAM(pb + 10);
        }
        if (IN(pb + 11)) { PHASE_CTX(); const float* decay = PP.decay + l * 8; (void)decay;
            REP(12) phase_combine(PP, l, gw, NGW, lane);
            REP(13) if (l + 1 < DEPTH) convert_layer(PP, l + 1, lds, gw, NGW, wave, lane);
            SEAM(pb + 11);
        }
    }
#undef IN
#undef SEAM
}

extern "C" void kernel_launch(void* const* d_in, const int* in_sizes, int n_in, void* d_out, int out_size, void* d_ws, size_t ws_size, hipStream_t stream) {
    static int grid = 0;
    if (grid == 0) {
        if (n_in != 16 || in_sizes[0] != T * D || out_size != T * D || ws_size < WS_END) {
            fprintf(stderr, "kernel_launch: unexpected shapes / workspace (n_in %d, in0 %d, out %d, ws %zu < %zu); nothing launched\n", n_in, n_in > 0 ? in_sizes[0] : -1, out_size, ws_size, (size_t)WS_END); grid = -1; return; }
        int dev = 0, cus = 0, per_cu = 0;
        if (hipGetDevice(&dev) != hipSuccess || hipDeviceGetAttribute(&cus, hipDeviceAttributeMultiprocessorCount, dev) != hipSuccess) { grid = -1; return; }
        if (hipFuncSetAttribute((const void*)fwd_kernel, hipFuncAttributeMaxDynamicSharedMemorySize, LDS_BYTES) != hipSuccess) { fprintf(stderr, "kernel_launch: hipFuncSetAttribute failed\n"); grid = -1; return; }
        if (hipOccupancyMaxActiveBlocksPerMultiprocessor(&per_cu, (const void*)fwd_kernel, 512, LDS_BYTES) != hipSuccess || per_cu < 1)
            fprintf(stderr, "kernel_launch: occupancy query reports %d workgroups per CU\n", per_cu);
        (void)hipGetLastError();
        grid = cus;
    }
    if (grid < 0) return;
    if (hipMemsetAsync((char*)d_ws + WS_CTL, 0, CTL_ZERO_BYTES, stream) != hipSuccess) return;
    Params p{};
    p.x = (const float*)d_in[0]; p.w_in = (const float*)d_in[1]; p.decay = (const float*)d_in[2]; p.w_ret_o = (const float*)d_in[3]; p.rpb = (const float*)d_in[4];
    p.w_na_o = (const float*)d_in[5]; p.w_out = (const float*)d_in[6]; p.ln_mix_g = (const float*)d_in[7]; p.ln_mix_b = (const float*)d_in[8];
    p.router_w = (const float*)d_in[9]; p.router_bias = (const float*)d_in[10]; p.w_gate = (const float*)d_in[11]; p.w_up = (const float*)d_in[12]; p.w_down = (const float*)d_in[13];
    p.ln_ffn_g = (const float*)d_in[14]; p.ln_ffn_b = (const float*)d_in[15];
    p.out = (float*)d_out; p.ws = (unsigned char*)d_ws;
#if MK_ONE_LAUNCH
    p.ph_lo = 0; p.ph_hi = NPH;
    hipLaunchKernelGGL(fwd_kernel, dim3(grid), dim3(512), LDS_BYTES, stream, p);
#else
    for (int ph = 0; ph < NPH; ++ph) { p.ph_lo = ph; p.ph_hi = ph + 1; hipLaunchKernelGGL(fwd_kernel, dim3(grid), dim3(512), LDS_BYTES, stream, p); }
#endif
}
```

```cpp
#include <hip/hip_runtime.h>
#include <cstdio>
#include <cstdint>

#ifndef PROBE_EPI2
#define PROBE_EPI2 0
#endif
#ifndef MK_ONE_LAUNCH
#define MK_ONE_LAUNCH 1
#endif

#define LAS __attribute__((address_space(3)))
#define GAS __attribute__((address_space(1)))
typedef unsigned short bf16_t;
typedef short bf16x8 __attribute__((ext_vector_type(8)));
typedef float f32x4 __attribute__((ext_vector_type(4)));
typedef float f32x2 __attribute__((ext_vector_type(2)));
typedef unsigned u32x4 __attribute__((ext_vector_type(4)));
typedef unsigned u32x2 __attribute__((ext_vector_type(2)));

constexpr int D = 1024, BATCH = 4, SEQ = 4096, T = BATCH * SEQ, DEPTH = 4;
constexpr int DIN = 11264;
constexpr int NE = 32;
constexpr int NPH = 1 + DEPTH * 12;
constexpr float ALPHA = 1.681792830507429f;
constexpr float LOG2E = 1.4426950408889634f;

constexpr size_t MiB = 1u << 20;
constexpr size_t WS_CTL = 0, CTL_ZERO_BYTES = 1 * MiB;
constexpr size_t WS_TAB = 2 * MiB;
constexpr size_t WS_TOK = 10 * MiB;
constexpr size_t WS_WRT = 11 * MiB;
constexpr size_t WS_WIN = 12 * MiB;
constexpr size_t WS_WRET = 34 * MiB;
constexpr size_t WS_WNA = 38 * MiB;
constexpr size_t WS_WOUT = 40 * MiB;
constexpr size_t WS_WGU = 42 * MiB;
constexpr size_t WS_WD = 106 * MiB;
constexpr size_t WS_XB = 138 * MiB;
constexpr size_t WS_Q = 170 * MiB;
constexpr size_t WS_K = 202 * MiB;
constexpr size_t WS_ACAT = 234 * MiB;
constexpr size_t WS_BCAT = 362 * MiB;
constexpr size_t WS_KDT = 490 * MiB;
constexpr size_t WS_KV = 554 * MiB;
constexpr size_t WS_SG = 682 * MiB;
constexpr size_t WS_QN = 746 * MiB;
constexpr size_t WS_KN = 778 * MiB;
constexpr size_t WS_VNT = 810 * MiB;
constexpr size_t WS_G = 842 * MiB;
constexpr size_t WS_NAO = 906 * MiB;
constexpr size_t WS_END = 938 * MiB;
constexpr int CW_BAR = 4096;
constexpr int CW_CNT = 16384;

constexpr int LDS_STAGE = 131072;
constexpr int LDS_MISC = 131072;
constexpr int LM_BAR = 0;
constexpr int LM_HIST = 64;
constexpr int LM_BASE = 192;
constexpr int LM_ROW = 512;
constexpr int LM_NT = 2048;
constexpr int LM_TSTART = 2112;
constexpr int LM_TILEE = 2304;
constexpr int LDS_BYTES = 147456;

#define LDS_WAIT() asm volatile("s_waitcnt lgkmcnt(0)" ::: "memory")
#define VM_WAIT() asm volatile("s_waitcnt vmcnt(0)" ::: "memory")
__device__ __forceinline__ unsigned cvt_pk_bf16(float lo, float hi) { unsigned r; asm("v_cvt_pk_bf16_f32 %0, %1, %2" : "=v"(r) : "v"(lo), "v"(hi)); return r; }
__device__ __forceinline__ u32x4 pack8(const f32x4 a, const f32x4 b) { u32x4 w; w.x = cvt_pk_bf16(a[0], a[1]); w.y = cvt_pk_bf16(a[2], a[3]); w.z = cvt_pk_bf16(b[0], b[1]); w.w = cvt_pk_bf16(b[2], b[3]); return w; }
__device__ __forceinline__ u32x2 pack4(const f32x4 a) { u32x2 w; w.x = cvt_pk_bf16(a[0], a[1]); w.y = cvt_pk_bf16(a[2], a[3]); return w; }
__device__ __forceinline__ float bf_lo(unsigned u) { return __uint_as_float(u << 16); }
__device__ __forceinline__ float bf_hi(unsigned u) { return __uint_as_float(u & 0xffff0000u); }
__device__ __forceinline__ float wave_sum(float v) {
#pragma unroll
    for (int o = 1; o < 64; o <<= 1) v += __shfl_xor(v, o);
    return v;
}
template <class Tp> __device__ __forceinline__ Tp* launder_s(Tp* p) { asm volatile("" : "+s"(p)); return p; }
__device__ __forceinline__ int launder_v(int v) { asm volatile("" : "+v"(v)); return v; }
__device__ __forceinline__ int launder_si(int v) { asm volatile("" : "+s"(v)); return v; }
__device__ __forceinline__ float fast_exp2(float x) { return __builtin_amdgcn_exp2f(x); }
__device__ __forceinline__ float fast_rcp(float x) { return __builtin_amdgcn_rcpf(x); }
__device__ __forceinline__ float sigmoid_f(float v) { return fast_rcp(1.0f + fast_exp2(-v * LOG2E)); }
__device__ __forceinline__ float log2_sigmoid(float x) { return -log1pf(expf(-x)) * LOG2E; }

#define XB_TMO      128
#define XB_XCNT(j)  (256  + 64 * (j))
#define XB_XSUB(j)  (1280 + 64 * (j))
#define XB_XGEN(j)  (2304 + 64 * (j))
#define XB_TOP      3328
#define XB_TOPGEN   3392
#define XCD_BAR_WORDS 3456
#define XB_SPIN_CAP (1u << 18)

__device__ __forceinline__ unsigned xb_ld(unsigned* p)              { return __hip_atomic_load(p, __ATOMIC_RELAXED, __HIP_MEMORY_SCOPE_AGENT); }
__device__ __forceinline__ unsigned xb_add(unsigned* p, unsigned v) { return __hip_atomic_fetch_add(p, v, __ATOMIC_RELAXED, __HIP_MEMORY_SCOPE_AGENT); }
__device__ __forceinline__ unsigned xb_xcc_id() { return (unsigned)__builtin_amdgcn_s_getreg((3 << 11) | 20) & 0xFu; }
#define XB_SPIN(cond, bar) do { unsigned _sp = 0; while (cond) { __builtin_amdgcn_s_sleep(1); \
    if ((++_sp & 255u) == 0u) { if (xb_ld(&(bar)[XB_TMO])) break; if (_sp > XB_SPIN_CAP) { atomicAdd(&(bar)[XB_TMO], 1u); break; } } } } while (0)

struct XcdBarrier {
    unsigned* bar; unsigned x;
    volatile LAS unsigned* st;
};
__device__ __forceinline__ XcdBarrier xcd_barrier_post(unsigned* bar, volatile LAS unsigned* st) {
    XcdBarrier b; b.bar = bar; b.x = xb_xcc_id(); b.st = st;
    if (threadIdx.x == 0) (void)xb_add(&bar[XB_XCNT(b.x)], 1u);
    return b;
}
__device__ __forceinline__ void xcd_barrier_complete(unsigned* bar, unsigned x, unsigned& nloc, unsigned& nx) {
    const unsigned G = gridDim.x * gridDim.y * gridDim.z;
    unsigned sum, cnt, mine, sp = 0u;
    for (;;) {
        sum = 0u; cnt = 0u; mine = 0u;
#pragma unroll
        for (unsigned j = 0; j < 16; ++j) { const unsigned c = xb_ld(&bar[XB_XCNT(j)]); sum += c; cnt += (c > 0u) ? 1u : 0u; mine = (j == x) ? c : mine; }
        if (sum == G) break;
        __builtin_amdgcn_s_sleep(1);
        if ((++sp & 255u) == 0u) { if (xb_ld(&bar[XB_TMO])) break; if (sp > XB_SPIN_CAP) { atomicAdd(&bar[XB_TMO], 1u); break; } }
    }
    nloc = mine > 0u ? mine : 1u; nx = cnt > 0u ? cnt : 1u;
}
__device__ __forceinline__ void xcd_barrier(const XcdBarrier& b) {
    asm volatile("s_waitcnt vmcnt(0)" ::: "memory");
    __syncthreads();
    if (threadIdx.x == 0) {
        unsigned* bar = b.bar;
        __builtin_amdgcn_s_waitcnt(0);
        unsigned nloc = b.st[0], nx = b.st[1];
        if (nloc == 0u) { xcd_barrier_complete(bar, b.x, nloc, nx); b.st[0] = nloc; b.st[1] = nx; }
        const unsigned old = xb_add(&bar[XB_XSUB(b.x)], 1u);
        const unsigned gen = old / nloc;
        if (old + 1u == (gen + 1u) * nloc) {
            __builtin_amdgcn_fence(__ATOMIC_RELEASE, "agent");
            asm volatile("s_waitcnt vmcnt(0)" ::: "memory");
            const unsigned og = xb_add(&bar[XB_TOP], 1u);
            const unsigned tg = og / nx;
            if (og + 1u == (tg + 1u) * nx) xb_add(&bar[XB_TOPGEN], 1u);
            else XB_SPIN(xb_ld(&bar[XB_TOPGEN]) == tg, bar);
            __builtin_amdgcn_fence(__ATOMIC_ACQUIRE, "agent");
            xb_add(&bar[XB_XGEN(b.x)], 1u);
            asm volatile("s_waitcnt vmcnt(0)" ::: "memory");
        } else {
            XB_SPIN(xb_ld(&bar[XB_XGEN(b.x)]) == gen, bar);
            __builtin_amdgcn_fence(__ATOMIC_ACQUIRE, "agent");
            asm volatile("s_waitcnt vmcnt(0)" ::: "memory");
        }
    }
    __syncthreads();
}

namespace pg {
constexpr int BM = 256, BK = 64, HALF = 128, HTB = HALF * BK * 2, STAGE_BYTES = 8 * HTB;
__device__ __forceinline__ int lds_byte(int r, int c) { const int st = (r >> 4) * 2 + (c >> 5), rr = r & 15, cc = c & 31, ob = rr * 64 + cc * 2; return st * 1024 + (ob ^ (((ob >> 9) & 1) << 5)); }
__device__ __forceinline__ void stage_rc(int b, int& R, int& C) { const int st = b / 1024, sb = b % 1024, swz = sb ^ (((sb >> 9) & 1) << 5); R = (st >> 1) * 16 + swz / 64; C = (st & 1) * 32 + (swz % 64) / 2; }
__device__ __forceinline__ int perm32(int rho) { const int n = rho >> 4, i = rho & 15; return 8 * (i >> 2) + 4 * n + (i & 3); }

struct Unit { const char* A; const char* B; int kind, a, b, c; };

template <int EPI_REP = 1, class Epi, class Dec>
__device__ __forceinline__ void gemm_phase(LAS unsigned char* lds, const int K, const int lda, const int ldb, const int nunits, const Dec& dec, const Epi& E) {
    const int tid = launder_v((int)threadIdx.x), wid = __builtin_amdgcn_readfirstlane(tid >> 6), lane = tid & 63, wr = wid >> 2, wc = wid & 3, fr = lane & 15, fq = lane >> 4;
    const int nt = K / BK;
    const int G = launder_si((int)gridDim.x); int uidx = launder_si((int)blockIdx.x);
    if (uidx >= nunits) return;
    unsigned voffA[2], voffB[2];
#pragma unroll
    for (int i = 0; i < 2; ++i) { int R, C; stage_rc(tid * 16 + i * 8192, R, C); const int Rb = (R & ~31) + perm32(R & 31);
        voffA[i] = (unsigned)(R * lda + C) * 2u; voffB[i] = (unsigned)(Rb * ldb + C) * 2u; }
    const size_t kstep = (size_t)(BK * 2);
    const size_t hstepA = (size_t)HALF * lda * 2, hstepB = (size_t)HALF * ldb * 2;
    const unsigned ldsw = (unsigned)wid * 1024u;
    const int aoff = lds_byte(wr * 64 + fr, fq * 8), boff = lds_byte(wc * 32 + fr, fq * 8);
#define PG_SA(b, h) (((b) * 2 + (h)) * HTB)
#define PG_SB(b, h) ((4 + (b) * 2 + (h)) * HTB)
#define PG_STAGE(bufoff, gbase, voff) do { _Pragma("unroll") for (int _i = 0; _i < 2; ++_i) \
        __builtin_amdgcn_global_load_lds((const unsigned*)((const char*)(gbase) + (voff)[_i]), (LAS unsigned*)(lds + (bufoff) + ldsw + _i * 8192), 16, 0, 0); } while (0)
#define PG_LDA(dst, b, h) do { _Pragma("unroll") for (int m = 0; m < 4; ++m) _Pragma("unroll") for (int k = 0; k < 2; ++k) dst[m][k] = *(const LAS bf16x8*)(lds + PG_SA(b, h) + aoff + m * 2048 + k * 1024); } while (0)
#define PG_LDB(dst, b, h) do { _Pragma("unroll") for (int n = 0; n < 2; ++n) _Pragma("unroll") for (int k = 0; k < 2; ++k) dst[n][k] = *(const LAS bf16x8*)(lds + PG_SB(b, h) + boff + n * 2048 + k * 1024); } while (0)
#define PG_MMA(ai, bj, At, Bt) do { __builtin_amdgcn_s_setprio(1); _Pragma("unroll") for (int m = 0; m < 4; ++m) _Pragma("unroll") for (int n = 0; n < 2; ++n) _Pragma("unroll") for (int k = 0; k < 2; ++k) \
        acc[ai][bj][m][n] = __builtin_amdgcn_mfma_f32_16x16x32_bf16(Bt[n][k], At[m][k], acc[ai][bj][m][n], 0, 0, 0); __builtin_amdgcn_s_setprio(0); } while (0)
#define PG_WAIT_V(n) asm volatile("s_waitcnt vmcnt(" #n ")" ::: "memory")
#define PG_WAIT_L(n) asm volatile("s_waitcnt lgkmcnt(" #n ")" ::: "memory")
#define PG_BAR __builtin_amdgcn_s_barrier()
#define PG_SCHED __builtin_amdgcn_sched_barrier(0)
    Unit cur, nxt;
    dec(uidx, cur);
    f32x4 acc[2][2][4][2];
#pragma unroll
    for (int a = 0; a < 2; ++a)
#pragma unroll
        for (int b = 0; b < 2; ++b)
#pragma unroll
            for (int m = 0; m < 4; ++m)
#pragma unroll
                for (int n = 0; n < 2; ++n) acc[a][b][m][n] = (f32x4){0.f, 0.f, 0.f, 0.f};
    bf16x8 At[4][2], B0[2][2], B1[2][2];
    const char* cA = cur.A; const char* cB = cur.B;
    PG_STAGE(PG_SB(0, 0), cB, voffB); PG_STAGE(PG_SB(0, 1), cB + hstepB, voffB); PG_STAGE(PG_SA(0, 0), cA, voffA); PG_STAGE(PG_SA(0, 1), cA + hstepA, voffA);
    if (wr == 1) PG_BAR;
    PG_WAIT_V(2); PG_BAR;
    PG_STAGE(PG_SB(1, 0), cB + kstep, voffB); PG_STAGE(PG_SA(1, 0), cA + kstep, voffA); PG_STAGE(PG_SB(1, 1), cB + hstepB + kstep, voffB);
    PG_WAIT_V(6); PG_BAR;
    for (;;) {
        const bool has_next = (uidx + G < nunits);
        if (has_next) dec(uidx + G, nxt);
        const char* nA = has_next ? nxt.A : cA; const char* nB = has_next ? nxt.B : cB;
#pragma nounroll
        for (int t = 0; t < nt; t += 2) {
            const bool last = (t == nt - 2);
            const char* a1 = cA + (size_t)(t + 1) * kstep;
            const char* a2 = last ? nA : cA + (size_t)(t + 2) * kstep; const char* b2 = last ? nB : cB + (size_t)(t + 2) * kstep;
            const char* a3 = a2 + kstep; const char* b3 = b2 + kstep;
            PG_LDB(B0, 0, 0); PG_LDB(B1, 0, 1); PG_SCHED; PG_LDA(At, 0, 0); PG_STAGE(PG_SA(1, 1), a1 + hstepA, voffA);
            PG_WAIT_V(8); PG_WAIT_L(0); PG_BAR; PG_MMA(0, 0, At, B0); PG_MMA(0, 1, At, B1); PG_BAR; PG_SCHED;
            PG_LDA(At, 0, 1); PG_STAGE(PG_SB(0, 0), b2, voffB); PG_STAGE(PG_SB(0, 1), b2 + hstepB, voffB); PG_STAGE(PG_SA(0, 0), a2, voffA);
            PG_WAIT_V(8); PG_WAIT_L(0); PG_BAR; PG_MMA(1, 0, At, B0); PG_MMA(1, 1, At, B1); PG_BAR; PG_SCHED;
            PG_LDB(B0, 1, 0); PG_LDB(B1, 1, 1); PG_SCHED; PG_LDA(At, 1, 0); PG_STAGE(PG_SA(0, 1), a2 + hstepA, voffA);
            PG_WAIT_V(8); PG_WAIT_L(0); PG_BAR; PG_MMA(0, 0, At, B0); PG_MMA(0, 1, At, B1); PG_BAR; PG_SCHED;
            PG_LDA(At, 1, 1); PG_STAGE(PG_SB(1, 0), b3, voffB); PG_STAGE(PG_SB(1, 1), b3 + hstepB, voffB); PG_STAGE(PG_SA(1, 0), a3, voffA);
            PG_WAIT_V(8); PG_WAIT_L(0); PG_BAR; PG_MMA(1, 0, At, B0); PG_MMA(1, 1, At, B1); PG_BAR; PG_SCHED;
        }
        if (wr == 0) PG_BAR;
        E(acc, cur, wr, wc, fr, fq);
        if constexpr (EPI_REP > 1) E(acc, cur, wr, wc, fr, fq);
        if (!has_next) break;
#pragma unroll
        for (int a = 0; a < 2; ++a)
#pragma unroll
            for (int b = 0; b < 2; ++b)
#pragma unroll
                for (int m = 0; m < 4; ++m)
#pragma unroll
                    for (int n = 0; n < 2; ++n) acc[a][b][m][n] = (f32x4){0.f, 0.f, 0.f, 0.f};
        cur = nxt; cA = nA; cB = nB; uidx += G;
        if (wr == 1) PG_BAR;
    }
    PG_WAIT_V(0);
    PG_BAR;
#undef PG_SA
#undef PG_SB
#undef PG_STAGE
#undef PG_LDA
#undef PG_LDB
#undef PG_MMA
#undef PG_WAIT_V
#undef PG_WAIT_L
#undef PG_BAR
#undef PG_SCHED
}
}
using pg::Unit;

enum { KQ = 0, KK = 1, KPL_SILU = 2, KPL_SCALE = 3, KPL_SIG = 4, KKT = 5, KVT = 6, KVNT = 7 };

struct DecInProj {
    const char* xb; const char* WinT;
    __device__ __forceinline__ void operator()(int u, Unit& o) const {
        if (u < 2048) {
            const int g = u >> 8, r = u & 255, x = r & 7, idx = r >> 3, pm = g * 8 + (idx & 7), j = ((x + g) & 7) * 4 + (idx >> 3);
            const int wt = j < 8 ? j : (j < 24 ? j + 8 : j + 12);
            o.A = xb + (size_t)pm * (256 * 1024 * 2); o.B = WinT + (size_t)wt * (256 * 1024 * 2); o.b = pm * 256; o.c = 0;
            if (wt < 4) { o.kind = KQ; o.a = wt; }
            else if (wt < 8) { o.kind = KK; o.a = wt - 4; }
            else if (wt < 24) { o.kind = KPL_SILU; o.a = (wt - 16) * 256; }
            else if (wt < 28) { o.kind = KPL_SCALE; o.a = (wt - 24) * 256; o.c = 0; }
            else if (wt < 32) { o.kind = KPL_SCALE; o.a = (wt - 28) * 256; o.c = 1; }
            else { o.kind = KPL_SIG; o.a = (wt - 36) * 256; }
        } else {
            const int v = u - 2048, g = v >> 8, r = v & 255, x = r & 7, idx = r >> 3, ci = ((x + g) & 3) * 4 + (idx >> 3), tt = (x >> 2) * 32 + g * 8 + (idx & 7);
            int ct;
            if (ci < 4) { ct = 4 + ci; o.kind = KKT; o.a = ci; o.c = 0; }
            else if (ci < 12) { ct = 8 + (ci - 4); o.kind = KVT; o.a = (ci - 4) >> 1; o.c = (ci - 4) & 1; }
            else { ct = 32 + (ci - 12); o.kind = KVNT; o.a = ci - 12; o.c = 0; }
            o.A = WinT + (size_t)ct * (256 * 1024 * 2); o.B = xb + (size_t)tt * (256 * 1024 * 2); o.b = tt * 256;
        }
    }
};
struct EpiInProj {
    unsigned char* ws_;
    const float* decay;
    __device__ __forceinline__ void operator()(const f32x4 (&acc)[2][2][4][2], const Unit& u, int wr, int wc, int fr, int fq) const {
        unsigned char* w = launder_s(ws_);
        bf16_t* const Q = (bf16_t*)(w + WS_Q); bf16_t* const Kb = (bf16_t*)(w + WS_K); bf16_t* const ACAT = (bf16_t*)(w + WS_ACAT); bf16_t* const BCAT = (bf16_t*)(w + WS_BCAT);
        bf16_t* const KDT = (bf16_t*)(w + WS_KDT); bf16_t* const SG = (bf16_t*)(w + WS_SG); bf16_t* const QN = (bf16_t*)(w + WS_QN); bf16_t* const KN = (bf16_t*)(w + WS_KN);
        bf16_t* const VNT = (bf16_t*)(w + WS_VNT); bf16_t* const Gt = (bf16_t*)(w + WS_G);
        const float* const cosN = (const float*)(w + WS_TAB); const float* const sinN = cosN + 4096 * 128; const float* const cosT = sinN + 4096 * 128; const float* const sinT = cosT + 4096 * 128;
        const int kind = u.kind, c8 = wc * 32 + fq * 8;
        if (kind == KQ || kind == KK) {
            const int h = u.a, t0 = u.b;
            float lf = 0.f, lb = 0.f;
            if (kind == KQ) { lf = log2_sigmoid(decay[h]); lb = log2_sigmoid(decay[4 + h]); }
#pragma unroll
            for (int ai = 0; ai < 2; ++ai)
#pragma unroll
                for (int m = 0; m < 4; ++m) {
                    const int t = t0 + ai * 128 + wr * 64 + m * 16 + fr, pos = t & 4095;
                    const float* cp = cosN + (size_t)pos * 128 + c8; const float* sp = sinN + (size_t)pos * 128 + c8;
                    const f32x4 c0 = *(const GAS f32x4*)cp, c1 = *(const GAS f32x4*)(cp + 4), s0 = *(const GAS f32x4*)sp, s1 = *(const GAS f32x4*)(sp + 4);
                    const f32x4 x1a = acc[ai][0][m][0], x1b = acc[ai][0][m][1], x2a = acc[ai][1][m][0], x2b = acc[ai][1][m][1];
                    f32x4 q1a = x1a * c0 - x2a * s0, q1b = x1b * c1 - x2b * s1, q2a = x1a * s0 + x2a * c0, q2b = x1b * s1 + x2b * c1;
                    if (kind == KQ) {
                        bf16_t* qp = Q + (size_t)t * 1024 + h * 256 + c8;
                        *(GAS u32x4*)qp = pack8(q1a, q1b); *(GAS u32x4*)(qp + 128) = pack8(q2a, q2b);
                        const int p = t & 511; const float df = fast_exp2(lf * (float)(p + 1)), db = fast_exp2(lb * (float)(512 - p));
                        bf16_t* ap = ACAT + ((size_t)t * 4 + h) * 1024 + 512 + c8;
                        *(GAS u32x4*)ap = pack8(q1a * df, q1b * df); *(GAS u32x4*)(ap + 128) = pack8(q2a * df, q2b * df);
                        *(GAS u32x4*)(ap + 256) = pack8(q1a * db, q1b * db); *(GAS u32x4*)(ap + 384) = pack8(q2a * db, q2b * db);
                    } else {
                        bf16_t* kp = Kb + (size_t)t * 1024 + h * 256 + c8;
                        *(GAS u32x4*)kp = pack8(q1a * 0.0625f, q1b * 0.0625f); *(GAS u32x4*)(kp + 128) = pack8(q2a * 0.0625f, q2b * 0.0625f);
                    }
                    __builtin_amdgcn_sched_barrier(0);
                }
        } else if (kind == KPL_SILU || kind == KPL_SCALE || kind == KPL_SIG) {
            const int t0 = u.b;
            bf16_t* dst; int ld; float sc = 1.f;
            if (kind == KPL_SILU) { dst = SG; ld = 2048; }
            else if (kind == KPL_SIG) { dst = Gt; ld = 2048; }
            else { ld = 1024; if (u.c == 0) { dst = QN; sc = 0.125f; } else { dst = KN; } }
            dst += u.a + c8;
#pragma unroll
            for (int ai = 0; ai < 2; ++ai)
#pragma unroll
                for (int m = 0; m < 4; ++m) {
                    const int t = t0 + ai * 128 + wr * 64 + m * 16 + fr;
#pragma unroll
                    for (int bj = 0; bj < 2; ++bj) {
                        f32x4 v0 = acc[ai][bj][m][0], v1 = acc[ai][bj][m][1];
                        if (kind == KPL_SCALE) { v0 = v0 * sc; v1 = v1 * sc; }
                        else {
#pragma unroll
                            for (int i = 0; i < 4; ++i) { const float g0 = sigmoid_f(v0[i]), g1 = sigmoid_f(v1[i]); v0[i] = (kind == KPL_SILU) ? v0[i] * g0 : g0; v1[i] = (kind == KPL_SILU) ? v1[i] * g1 : g1; }
                        }
                        *(GAS u32x4*)(dst + (size_t)t * ld + bj * 128) = pack8(v0, v1);
                    }
                }
        } else {
            const int t0 = u.b, bb = t0 >> 12, s0 = t0 & 4095, cc = s0 >> 9, j0 = s0 & 511;
            if (kind == KKT) {
                const int h = u.a;
                const float lf = log2_sigmoid(decay[h]), lb = log2_sigmoid(decay[4 + h]);
#pragma unroll
                for (int bj = 0; bj < 2; ++bj) {
                    const int col8 = bj * 128 + c8, s = s0 + col8, j = j0 + col8;
                    f32x4 df0, df1, db0, db1;
#pragma unroll
                    for (int i = 0; i < 4; ++i) { df0[i] = 0.0625f * fast_exp2(lf * (float)(511 - (j + i))); df1[i] = 0.0625f * fast_exp2(lf * (float)(511 - (j + 4 + i)));
                                                  db0[i] = 0.0625f * fast_exp2(lb * (float)(j + i)); db1[i] = 0.0625f * fast_exp2(lb * (float)(j + 4 + i)); }
#pragma unroll
                    for (int m = 0; m < 4; ++m) {
                        const int dl = wr * 64 + m * 16 + fr;
                        const float* cp = cosT + (size_t)dl * 4096 + s; const float* sp = sinT + (size_t)dl * 4096 + s;
                        const f32x4 c0 = *(const GAS f32x4*)cp, c1 = *(const GAS f32x4*)(cp + 4), sn0 = *(const GAS f32x4*)sp, sn1 = *(const GAS f32x4*)(sp + 4);
                        const f32x4 x1a = acc[0][bj][m][0], x1b = acc[0][bj][m][1], x2a = acc[1][bj][m][0], x2b = acc[1][bj][m][1];
                        const f32x4 k1a = x1a * c0 - x2a * sn0, k1b = x1b * c1 - x2b * sn1, k2a = x1a * sn0 + x2a * c0, k2b = x1b * sn1 + x2b * c1;
                        bf16_t* kp = KDT + ((((size_t)(bb * 4 + h) * 8 + cc) * 2) * 256 + dl) * 512 + j;
                        *(GAS u32x4*)kp = pack8(k1a * df0, k1b * df1); *(GAS u32x4*)(kp + 128 * 512) = pack8(k2a * df0, k2b * df1);
                        *(GAS u32x4*)(kp + 256 * 512) = pack8(k1a * db0, k1b * db1); *(GAS u32x4*)(kp + 384 * 512) = pack8(k2a * db0, k2b * db1);
                        __builtin_amdgcn_sched_barrier(0);
                    }
                }
            } else if (kind == KVT) {
                const int h = u.a;
#pragma unroll
                for (int ai = 0; ai < 2; ++ai)
#pragma unroll
                    for (int m = 0; m < 4; ++m) {
                        const int e = u.c * 256 + ai * 128 + wr * 64 + m * 16 + fr;
                        bf16_t* vp = BCAT + (((size_t)(bb * 4 + h) * 8 + cc) * 512 + e) * 1024 + j0 + c8;
#pragma unroll
                        for (int bj = 0; bj < 2; ++bj) *(GAS u32x4*)(vp + bj * 128) = pack8(acc[ai][bj][m][0], acc[ai][bj][m][1]);
                    }
            } else {
#pragma unroll
                for (int ai = 0; ai < 2; ++ai)
#pragma unroll
                    for (int m = 0; m < 4; ++m) {
                        const int ch = u.a * 256 + ai * 128 + wr * 64 + m * 16 + fr;
                        bf16_t* vp = VNT + ((size_t)bb * 1024 + ch) * 4096 + s0 + c8;
#pragma unroll
                        for (int bj = 0; bj < 2; ++bj) *(GAS u32x4*)(vp + bj * 128) = pack8(acc[ai][bj][m][0], acc[ai][bj][m][1]);
                    }
            }
        }
    }
};

struct DecR1 {
    const char* Q; const char* Kb;
    __device__ __forceinline__ void operator()(int u, Unit& o) const {
        const int pn2 = u & 1, pm2 = (u >> 1) & 1, cc = (u >> 2) & 7, bh = u >> 5, b = bh >> 2, h = bh & 3;
        const int ti = b * 4096 + cc * 512 + pm2 * 256, tj = b * 4096 + cc * 512 + pn2 * 256;
        o.A = Q + ((size_t)ti * 1024 + h * 256) * 2; o.B = Kb + ((size_t)tj * 1024 + h * 256) * 2;
        o.kind = 0; o.a = h; o.b = ti; o.c = pm2 * 2 + pn2;
    }
};
struct EpiR1 {
    bf16_t* ACAT; const float* decay;
    __device__ __forceinline__ void operator()(const f32x4 (&acc)[2][2][4][2], const Unit& u, int wr, int wc, int fr, int fq) const {
        const int h = u.a, ti0 = u.b, i0 = (u.c >> 1) * 256, j0 = (u.c & 1) * 256, c8 = wc * 32 + fq * 8;
        const float lf = log2_sigmoid(decay[h]), lb = log2_sigmoid(decay[4 + h]);
#pragma unroll
        for (int ai = 0; ai < 2; ++ai)
#pragma unroll
            for (int m = 0; m < 4; ++m) {
                const int r = ai * 128 + wr * 64 + m * 16 + fr, i = i0 + r;
                bf16_t* ap = ACAT + ((size_t)(ti0 + r) * 4 + h) * 1024 + j0 + c8;
#pragma unroll
                for (int bj = 0; bj < 2; ++bj) {
                    f32x4 v0 = acc[ai][bj][m][0], v1 = acc[ai][bj][m][1];
                    const int jb = j0 + bj * 128 + c8;
#pragma unroll
                    for (int q = 0; q < 4; ++q) {
                        const int d0 = i - (jb + q), d1 = i - (jb + 4 + q);
                        v0[q] *= fast_exp2(d0 >= 0 ? lf * (float)d0 : lb * (float)(-d0));
                        v1[q] *= fast_exp2(d1 >= 0 ? lf * (float)d1 : lb * (float)(-d1));
                    }
                    *(GAS u32x4*)(ap + bj * 128) = pack8(v0, v1);
                }
                __builtin_amdgcn_sched_barrier(0);
            }
    }
};
struct DecR2 {
    const char* BCAT; const char* KDT;
    __device__ __forceinline__ void operator()(int u, Unit& o) const {
        const int pm2 = u & 1, v = u >> 1, pr = v % 14, bh = v / 14;
        const int dir = pr < 7 ? 0 : 1, cc = pr < 7 ? pr : pr - 6;
        o.A = BCAT + (((size_t)(bh * 8 + cc) * 512 + pm2 * 256) * 1024) * 2;
        o.B = KDT + ((((size_t)(bh * 8 + cc) * 2 + dir) * 256) * 512) * 2;
        o.kind = 0; o.a = (bh * 8 + cc) * 2 + dir; o.b = pm2 * 256; o.c = 0;
    }
};
struct EpiR2 {
    float* KV;
    __device__ __forceinline__ void operator()(const f32x4 (&acc)[2][2][4][2], const Unit& u, int wr, int wc, int fr, int fq) const {
        const int c8 = wc * 32 + fq * 8;
#pragma unroll
        for (int ai = 0; ai < 2; ++ai)
#pragma unroll
            for (int m = 0; m < 4; ++m) {
                const int e = u.b + ai * 128 + wr * 64 + m * 16 + fr;
                float* kp = KV + ((size_t)u.a * 512 + e) * 256 + c8;
#pragma unroll
                for (int bj = 0; bj < 2; ++bj) { *(GAS f32x4*)(kp + bj * 128) = acc[ai][bj][m][0]; *(GAS f32x4*)(kp + bj * 128 + 4) = acc[ai][bj][m][1]; }
            }
    }
};
struct DecR4 {
    const char* ACAT; const char* BCAT;
    __device__ __forceinline__ void operator()(int u, Unit& o) const {
        const int pn2 = u & 1, pm2 = (u >> 1) & 1, cc = (u >> 2) & 7, bh = u >> 5, b = bh >> 2, h = bh & 3;
        const int ti = b * 4096 + cc * 512 + pm2 * 256;
        o.A = ACAT + (((size_t)ti * 4 + h) * 1024) * 2; o.B = BCAT + (((size_t)(bh * 8 + cc) * 512 + pn2 * 256) * 1024) * 2;
        o.kind = 0; o.a = h * 512 + pn2 * 256; o.b = ti; o.c = 0;
    }
};
struct EpiR4 {
    bf16_t* RET;
    __device__ __forceinline__ void operator()(const f32x4 (&acc)[2][2][4][2], const Unit& u, int wr, int wc, int fr, int fq) const {
        const int c8 = wc * 32 + fq * 8;
#pragma unroll
        for (int ai = 0; ai < 2; ++ai)
#pragma unroll
            for (int m = 0; m < 4; ++m) {
                const int t = u.b + ai * 128 + wr * 64 + m * 16 + fr;
                bf16_t* rp = RET + (size_t)t * 2048 + u.a + c8;
#pragma unroll
                for (int bj = 0; bj < 2; ++bj) *(GAS u32x4*)(rp + bj * 128) = pack8(acc[ai][bj][m][0], acc[ai][bj][m][1]);
            }
    }
};
struct DecDense {
    const char* A; const char* B; int lda2, ldb2;
    __device__ __forceinline__ void operator()(int u, Unit& o) const {
        const int pn = u >> 6, pm = u & 63;
        o.A = A + (size_t)pm * 256 * lda2; o.B = B + (size_t)pn * 256 * ldb2; o.kind = 0; o.a = pn * 256; o.b = pm * 256; o.c = 0;
    }
};
template <int MODE> struct EpiMerge {
    bf16_t* MG; const bf16_t* Gt;
    __device__ __forceinline__ void operator()(const f32x4 (&acc)[2][2][4][2], const Unit& u, int wr, int wc, int fr, int fq) const {
        const int c8 = wc * 32 + fq * 8;
#pragma unroll
        for (int ai = 0; ai < 2; ++ai)
#pragma unroll
            for (int m = 0; m < 4; ++m) {
                const int t = u.b + ai * 128 + wr * 64 + m * 16 + fr;
#pragma unroll
                for (int bj = 0; bj < 2; ++bj) {
                    const int c = u.a + bj * 128 + c8;
                    const u32x4 g = *(const GAS u32x4*)(Gt + (size_t)t * 2048 + MODE * 1024 + c);
                    f32x4 v0 = acc[ai][bj][m][0], v1 = acc[ai][bj][m][1];
                    v0[0] *= bf_lo(g.x); v0[1] *= bf_hi(g.x); v0[2] *= bf_lo(g.y); v0[3] *= bf_hi(g.y);
                    v1[0] *= bf_lo(g.z); v1[1] *= bf_hi(g.z); v1[2] *= bf_lo(g.w); v1[3] *= bf_hi(g.w);
                    bf16_t* mp = MG + (size_t)t * 1024 + c;
                    if (MODE == 1) { const u32x4 o = *(const GAS u32x4*)mp;
                        v0[0] += bf_lo(o.x); v0[1] += bf_hi(o.x); v0[2] += bf_lo(o.y); v0[3] += bf_hi(o.y);
                        v1[0] += bf_lo(o.z); v1[1] += bf_hi(o.z); v1[2] += bf_lo(o.w); v1[3] += bf_hi(o.w); }
                    *(GAS u32x4*)mp = pack8(v0, v1);
                }
            }
    }
};
struct EpiPre {
    float* PRE; const float* xin;
    __device__ __forceinline__ void operator()(const f32x4 (&acc)[2][2][4][2], const Unit& u, int wr, int wc, int fr, int fq) const {
        const int c8 = wc * 32 + fq * 8;
#pragma unroll
        for (int ai = 0; ai < 2; ++ai)
#pragma unroll
            for (int m = 0; m < 4; ++m) {
                const int t = u.b + ai * 128 + wr * 64 + m * 16 + fr;
#pragma unroll
                for (int bj = 0; bj < 2; ++bj) {
                    const size_t o = (size_t)t * 1024 + u.a + bj * 128 + c8;
                    const f32x4 x0 = *(const GAS f32x4*)(xin + o), x1 = *(const GAS f32x4*)(xin + o + 4);
                    *(GAS f32x4*)(PRE + o) = x0 * ALPHA + acc[ai][bj][m][0]; *(GAS f32x4*)(PRE + o + 4) = x1 * ALPHA + acc[ai][bj][m][1];
                }
            }
    }
};
struct DecMoe {
    const char* A; const char* W; int lda2, wexp2, ldb2; const LAS int* tile_e;
    __device__ __forceinline__ void operator()(int u, Unit& o) const {
        const int a = u >> 2, pn = u & 3, e = tile_e[a];
        o.A = A + (size_t)a * 256 * lda2; o.B = W + (size_t)e * wexp2 + (size_t)pn * 256 * ldb2; o.kind = 0; o.a = pn; o.b = a * 256; o.c = 0;
    }
};
struct EpiUp {
    bf16_t* H;
    __device__ __forceinline__ void operator()(const f32x4 (&acc)[2][2][4][2], const Unit& u, int wr, int wc, int fr, int fq) const {
        const int c8 = wc * 32 + fq * 8;
#pragma unroll
        for (int ai = 0; ai < 2; ++ai)
#pragma unroll
            for (int m = 0; m < 4; ++m) {
                const int r = u.b + ai * 128 + wr * 64 + m * 16 + fr;
                f32x4 g0 = acc[ai][0][m][0], g1 = acc[ai][0][m][1]; const f32x4 u0 = acc[ai][1][m][0], u1 = acc[ai][1][m][1];
#pragma unroll
                for (int i = 0; i < 4; ++i) { g0[i] = g0[i] * sigmoid_f(g0[i]) * u0[i]; g1[i] = g1[i] * sigmoid_f(g1[i]) * u1[i]; }
                *(GAS u32x4*)(H + (size_t)r * 512 + u.a * 128 + c8) = pack8(g0, g1);
            }
    }
};
struct EpiDown {
    bf16_t* Y;
    __device__ __forceinline__ void operator()(const f32x4 (&acc)[2][2][4][2], const Unit& u, int wr, int wc, int fr, int fq) const {
        const int c8 = wc * 32 + fq * 8;
#pragma unroll
        for (int ai = 0; ai < 2; ++ai)
#pragma unroll
            for (int m = 0; m < 4; ++m) {
                const int r = u.b + ai * 128 + wr * 64 + m * 16 + fr;
                bf16_t* yp = Y + (size_t)r * 1024 + u.a * 256 + c8;
#pragma unroll
                for (int bj = 0; bj < 2; ++bj) *(GAS u32x4*)(yp + bj * 128) = pack8(acc[ai][bj][m][0], acc[ai][bj][m][1]);
            }
    }
};

__device__ __forceinline__ void tr_item(const float* W, int ldw, bf16_t* WT, int ldwt, int k0, int n0, int drow0, LAS float* scr, int lane) {
#pragma unroll 8
    for (int i = 0; i < 32; ++i) { const int kk = 2 * i + (lane >> 5); scr[kk * 33 + (lane & 31)] = ((const GAS float*)W)[(size_t)(k0 + kk) * ldw + n0 + (lane & 31)]; }
    LDS_WAIT();
    const int c = lane & 7;
#pragma unroll
    for (int j = 0; j < 4; ++j) { const int n = (lane >> 3) + 8 * j; const LAS float* s = scr + (8 * c) * 33 + n;
        u32x4 o; o.x = cvt_pk_bf16(s[0 * 33], s[1 * 33]); o.y = cvt_pk_bf16(s[2 * 33], s[3 * 33]); o.z = cvt_pk_bf16(s[4 * 33], s[5 * 33]); o.w = cvt_pk_bf16(s[6 * 33], s[7 * 33]);
        *(GAS u32x4*)(WT + (size_t)(drow0 + n) * ldwt + k0 + 8 * c) = o; }
    LDS_WAIT();
}
struct Params {
    const float* x; const float* w_in; const float* decay; const float* w_ret_o; const float* rpb; const float* w_na_o; const float* w_out;
    const float* ln_mix_g; const float* ln_mix_b; const float* router_w; const float* router_bias;
    const float* w_gate; const float* w_up; const float* w_down; const float* ln_ffn_g; const float* ln_ffn_b;
    float* out; unsigned char* ws; int ph_lo, ph_hi;
};
__device__ __forceinline__ Params load_params() {
    typedef __attribute__((address_space(4))) const Params CP;
    CP* pk = (CP*)__builtin_amdgcn_kernarg_segment_ptr();
    asm volatile("" : "+s"(pk));
    Params r;
    r.x = pk->x; r.w_in = pk->w_in; r.decay = pk->decay; r.w_ret_o = pk->w_ret_o; r.rpb = pk->rpb; r.w_na_o = pk->w_na_o; r.w_out = pk->w_out;
    r.ln_mix_g = pk->ln_mix_g; r.ln_mix_b = pk->ln_mix_b; r.router_w = pk->router_w; r.router_bias = pk->router_bias;
    r.w_gate = pk->w_gate; r.w_up = pk->w_up; r.w_down = pk->w_down; r.ln_ffn_g = pk->ln_ffn_g; r.ln_ffn_b = pk->ln_ffn_b;
    r.out = pk->out; r.ws = pk->ws; r.ph_lo = pk->ph_lo; r.ph_hi = pk->ph_hi;
    return r;
}
__device__ __forceinline__ void convert_layer(const Params& P, int l, LAS unsigned char* lds, int gw, int NGW, int wave, int lane) {
    LAS float* scr = (LAS float*)(lds + wave * 16384);
    unsigned char* ws = P.ws;
    constexpr int I0 = 16 * 352, I1 = 32 * 32, I2 = 16 * 32, I3 = 16 * 32, I4 = 32 * 256, I5 = 32 * 256, I6 = 32 * 256;
    constexpr int NIT = I0 + I1 + I2 + I3 + I4 + I5 + I6;
    for (int it = gw; it < NIT; it += NGW) {
        int r = it;
        if (r < I0) { const int kb = r / 352, nb = r % 352; tr_item(P.w_in + (size_t)l * 1024 * DIN, DIN, (bf16_t*)(ws + WS_WIN), 1024, kb * 64, nb * 32, nb * 32, scr, lane); continue; } r -= I0;
        if (r < I1) { const int kb = r >> 5, nb = r & 31; tr_item(P.w_ret_o + (size_t)l * 2048 * 1024, 1024, (bf16_t*)(ws + WS_WRET), 2048, kb * 64, nb * 32, nb * 32, scr, lane); continue; } r -= I1;
        if (r < I2) { const int kb = r >> 5, nb = r & 31; tr_item(P.w_na_o + (size_t)l * 1024 * 1024, 1024, (bf16_t*)(ws + WS_WNA), 1024, kb * 64, nb * 32, nb * 32, scr, lane); continue; } r -= I2;
        if (r < I3) { const int kb = r >> 5, nb = r & 31; tr_item(P.w_out + (size_t)l * 1024 * 1024, 1024, (bf16_t*)(ws + WS_WOUT), 1024, kb * 64, nb * 32, nb * 32, scr, lane); continue; } r -= I3;
        if (r < I4 + I5) { const int up = r >= I4 ? 1 : 0; if (up) r -= I4; const int e = r >> 8, q = r & 255, kb = q >> 4, nb = q & 15, n0 = nb * 32;
            const float* src = (up ? P.w_up : P.w_gate) + ((size_t)l * NE + e) * 1024 * 512;
            tr_item(src, 512, (bf16_t*)(ws + WS_WGU), 1024, kb * 64, n0, e * 1024 + (n0 >> 7) * 256 + up * 128 + (n0 & 127), scr, lane); continue; } r -= I4 + I5;
        { const int e = r >> 8, q = r & 255, kb = q >> 5, nb = q & 31;
          tr_item(P.w_down + ((size_t)l * NE + e) * 512 * 1024, 1024, (bf16_t*)(ws + WS_WD), 512, kb * 64, nb * 32, e * 1024 + nb * 32, scr, lane); }
    }
}
__device__ __forceinline__ void sincos_d(double a, float& s, float& c) {
    const double k = rint(a * 0.63661977236758134308);
    double y = fma(-k, 1.5707963267948966192, a); y = fma(-k, 6.123233995736766036e-17, y);
    const double y2 = y * y;
    double sp = -1.0 / 1307674368000.0; sp = fma(sp, y2, 1.0 / 6227020800.0); sp = fma(sp, y2, -1.0 / 39916800.0); sp = fma(sp, y2, 1.0 / 362880.0); sp = fma(sp, y2, -1.0 / 5040.0); sp = fma(sp, y2, 1.0 / 120.0); sp = fma(sp, y2, -1.0 / 6.0); sp = fma(sp * y2, y, y);
    double cp = 1.0 / 20922789888000.0; cp = fma(cp, y2, -1.0 / 87178291200.0); cp = fma(cp, y2, 1.0 / 479001600.0); cp = fma(cp, y2, -1.0 / 3628800.0); cp = fma(cp, y2, 1.0 / 40320.0); cp = fma(cp, y2, -1.0 / 720.0); cp = fma(cp, y2, 1.0 / 24.0); cp = fma(cp, y2, -0.5); cp = fma(cp, y2, 1.0);
    const int q = (int)((long long)k & 3);
    const double sv = (q == 0) ? sp : (q == 1) ? cp : (q == 2) ? -sp : -cp;
    const double cv = (q == 0) ? cp : (q == 1) ? -sp : (q == 2) ? -cp : sp;
    s = (float)sv; c = (float)cv;
}
__device__ __forceinline__ void phase_init(const Params& P, LAS unsigned char* lds, int gw, int NGW, int wave, int lane) {
    unsigned char* ws = P.ws;
    float* cosN = (float*)(ws + WS_TAB); float* sinN = cosN + 4096 * 128; float* cosT = sinN + 4096 * 128; float* sinT = cosT + 4096 * 128;
    const int gtid = gw * 64 + lane, NT_ = NGW * 64;
    for (int i = gtid; i < 4096 * 128; i += NT_) {
        const int pos = i >> 7, j = i & 127;
        const double freq = exp(-(double)j * (9.210340371976184 / 128.0));
        float s, c; sincos_d((double)pos * freq, s, c);
        cosN[i] = c; sinN[i] = s; cosT[(size_t)j * 4096 + pos] = c; sinT[(size_t)j * 4096 + pos] = s;
    }
    bf16_t* wrt = (bf16_t*)(ws + WS_WRT);
    for (int i = gtid; i < 32 * 1024; i += NT_) {
        const int e = i >> 10, d = i & 1023; const float w = ((const GAS float*)P.router_w)[d * 32 + e];
        const unsigned h = cvt_pk_bf16(w, 0.f) & 0xffffu; const unsigned lo = cvt_pk_bf16(w - bf_lo(h), 0.f) & 0xffffu;
        wrt[i] = (bf16_t)h; wrt[32 * 1024 + i] = (bf16_t)lo;
    }
    bf16_t* xb = (bf16_t*)(ws + WS_XB);
    for (int i = gtid; i < T * D / 8; i += NT_) {
        const f32x4 a = *(const GAS f32x4*)(P.x + (size_t)i * 8), b = *(const GAS f32x4*)(P.x + (size_t)i * 8 + 4);
        *(GAS u32x4*)(xb + (size_t)i * 8) = pack8(a, b);
    }
    convert_layer(P, 0, lds, gw, NGW, wave, lane);
}
__device__ __forceinline__ void phase_prefix(const Params& P, int l, int gw, int NGW, int lane) {
    const float* KV = (const float*)(P.ws + WS_KV); bf16_t* BCAT = (bf16_t*)(P.ws + WS_BCAT);
    const float* decay = P.decay + l * 8;
    const int gtid = gw * 64 + lane, NT_ = NGW * 64;
    for (int idx = gtid; idx < 16 * 2 * 512 * 32; idx += NT_) {
        const int dg = idx & 31, e = (idx >> 5) & 511, dir = (idx >> 14) & 1, bh = idx >> 15, h = bh & 3;
        const float cd = fast_exp2(log2_sigmoid(decay[dir * 4 + h]) * 512.0f);
        f32x4 s0 = {0.f, 0.f, 0.f, 0.f}, s1 = {0.f, 0.f, 0.f, 0.f};
        for (int q = 0; q < 8; ++q) {
            const int cc = dir ? 7 - q : q;
            *(GAS u32x4*)(BCAT + ((size_t)(bh * 8 + cc) * 512 + e) * 1024 + 512 + dir * 256 + dg * 8) = pack8(s0, s1);
            if (q < 7) { const float* kp = KV + ((size_t)((bh * 8 + cc) * 2 + dir) * 512 + e) * 256 + dg * 8;
                s0 = s0 * cd + *(const GAS f32x4*)kp; s1 = s1 * cd + *(const GAS f32x4*)(kp + 4); }
        }
    }
}
__device__ __forceinline__ void phase_headnorm(const Params& P, int gw, int NGW, int lane) {
    const bf16_t* RET = (const bf16_t*)(P.ws + WS_KV); const bf16_t* SG = (const bf16_t*)(P.ws + WS_SG); bf16_t* AR = (bf16_t*)(P.ws + WS_KDT);
    for (int it = gw; it < T * 4; it += NGW) {
        const size_t off = (size_t)it * 512 + lane * 8;
        const u32x4 r = *(const GAS u32x4*)(RET + off), g = *(const GAS u32x4*)(SG + off);
        float v[8] = {bf_lo(r.x), bf_hi(r.x), bf_lo(r.y), bf_hi(r.y), bf_lo(r.z), bf_hi(r.z), bf_lo(r.w), bf_hi(r.w)};
        float s = 0.f;
#pragma unroll
        for (int i = 0; i < 8; ++i) s += v[i];
        const float mean = wave_sum(s) * (1.0f / 512.0f);
        float q = 0.f;
#pragma unroll
        for (int i = 0; i < 8; ++i) { v[i] -= mean; q += v[i] * v[i]; }
        const float rstd = 1.0f / sqrtf(wave_sum(q) * (1.0f / 512.0f) + 1e-5f);
        const float gg[8] = {bf_lo(g.x), bf_hi(g.x), bf_lo(g.y), bf_hi(g.y), bf_lo(g.z), bf_hi(g.z), bf_lo(g.w), bf_hi(g.w)};
        u32x4 o; o.x = cvt_pk_bf16(v[0] * rstd * gg[0], v[1] * rstd * gg[1]); o.y = cvt_pk_bf16(v[2] * rstd * gg[2], v[3] * rstd * gg[3]);
        o.z = cvt_pk_bf16(v[4] * rstd * gg[4], v[5] * rstd * gg[5]); o.w = cvt_pk_bf16(v[6] * rstd * gg[6], v[7] * rstd * gg[7]);
        *(GAS u32x4*)(AR + off) = o;
    }
}
__device__ __forceinline__ void phase_na(const Params& P, int l, int gw, int NGW, int lane) {
    const bf16_t* QN = (const bf16_t*)(P.ws + WS_QN); const bf16_t* KN = (const bf16_t*)(P.ws + WS_KN); const bf16_t* VNT = (const bf16_t*)(P.ws + WS_VNT);
    bf16_t* NAO = (bf16_t*)(P.ws + WS_NAO);
    const float* rpb = P.rpb + (size_t)l * 16 * 15 * 31;
    const int fr = lane & 15, fq = lane >> 4;
    for (int id = gw; id < 16384; id += NGW) {
        const int cb = id & 3, r = (id >> 2) & 63, h = (id >> 8) & 15, b = id >> 12;
        const int rs = min(max(r - 4, 0), 56), c0 = cb * 16, cs = min(max(c0 - 8, 0), 32);
        const int c = c0 + fr, cst = min(max(c - 8, 0), 48);
        const size_t tq = (size_t)b * 4096 + r * 64 + c;
        const bf16x8 yq0 = *(const GAS bf16x8*)(QN + tq * 1024 + h * 64 + 8 * fq), yq1 = *(const GAS bf16x8*)(QN + tq * 1024 + h * 64 + 32 + 8 * fq);
        f32x4 S[16];
#pragma unroll
        for (int kt = 0; kt < 16; ++kt) {
            const int kr = rs + (kt >> 1), kcb = cs + (kt & 1) * 16;
            const size_t tk = (size_t)b * 4096 + kr * 64 + kcb + fr;
            const bf16x8 xk0 = *(const GAS bf16x8*)(KN + tk * 1024 + h * 64 + 8 * fq), xk1 = *(const GAS bf16x8*)(KN + tk * 1024 + h * 64 + 32 + 8 * fq);
            f32x4 z = {0.f, 0.f, 0.f, 0.f};
            z = __builtin_amdgcn_mfma_f32_16x16x32_bf16(xk0, yq0, z, 0, 0, 0);
            z = __builtin_amdgcn_mfma_f32_16x16x32_bf16(xk1, yq1, z, 0, 0, 0);
            const float* bp = rpb + (h * 15 + (kr - r + 7)) * 31;
#pragma unroll
            for (int j = 0; j < 4; ++j) {
                const int kc = kcb + 4 * fq + j; const bool valid = (kc >= cst) && (kc < cst + 16);
                const int co = min(max(kc - c + 15, 0), 30);
                const float bias = ((const GAS float*)bp)[co];
                z[j] = valid ? z[j] + bias : -INFINITY;
            }
            S[kt] = z;
        }
        float mx = -INFINITY;
#pragma unroll
        for (int kt = 0; kt < 16; ++kt)
#pragma unroll
            for (int j = 0; j < 4; ++j) mx = fmaxf(mx, S[kt][j]);
        mx = fmaxf(mx, __shfl_xor(mx, 16)); mx = fmaxf(mx, __shfl_xor(mx, 32));
        float sum = 0.f;
#pragma unroll
        for (int kt = 0; kt < 16; ++kt)
#pragma unroll
            for (int j = 0; j < 4; ++j) { const float p = fast_exp2((S[kt][j] - mx) * LOG2E); S[kt][j] = p; sum += p; }
        sum += __shfl_xor(sum, 16); sum += __shfl_xor(sum, 32);
        f32x4 O[4];
#pragma unroll
        for (int ht = 0; ht < 4; ++ht) O[ht] = (f32x4){0.f, 0.f, 0.f, 0.f};
#pragma unroll
        for (int p = 0; p < 8; ++p) {
            const u32x4 yw = pack8(S[2 * p], S[2 * p + 1]);
            const bf16x8 yp = __builtin_bit_cast(bf16x8, yw);
            const size_t sk = (size_t)(rs + p) * 64 + cs + 4 * fq;
#pragma unroll
            for (int ht = 0; ht < 4; ++ht) {
                const bf16_t* vp = VNT + ((size_t)b * 1024 + h * 64 + ht * 16 + fr) * 4096 + sk;
                const u32x2 lo = *(const GAS u32x2*)vp, hi = *(const GAS u32x2*)(vp + 16);
                const u32x4 xw = {lo.x, lo.y, hi.x, hi.y};
                O[ht] = __builtin_amdgcn_mfma_f32_16x16x32_bf16(__builtin_bit_cast(bf16x8, xw), yp, O[ht], 0, 0, 0);
            }
        }
        const float inv = 1.0f / sum;
#pragma unroll
        for (int ht = 0; ht < 4; ++ht) *(GAS u32x2*)(NAO + tq * 1024 + h * 64 + ht * 16 + 4 * fq) = pack4(O[ht] * inv);
    }
}
constexpr int LM_BIAS = 4096;
__device__ __forceinline__ void phase_na2(const Params& P, int l, LAS unsigned char* lds, int tid, int wave, int lane) {
    const bf16_t* QN = (const bf16_t*)(P.ws + WS_QN); const bf16_t* KN = (const bf16_t*)(P.ws + WS_KN); const bf16_t* VNT = (const bf16_t*)(P.ws + WS_VNT);
    bf16_t* NAO = (bf16_t*)(P.ws + WS_NAO);
    const float* rpb = P.rpb + (size_t)l * 16 * 15 * 31;
    LAS unsigned char* Ks = lds; LAS unsigned char* Vs = lds + 65536;
    LAS float* bias_s = (LAS float*)(lds + LDS_MISC + LM_BIAS);
    const int fr = lane & 15, fq = lane >> 4;
    const int prow = tid >> 3, pc = (tid & 7) ^ ((prow >> 1) & 7);
#define NA_BAR() do { asm volatile("s_waitcnt lgkmcnt(0)" ::: "memory"); __builtin_amdgcn_s_barrier(); asm volatile("" ::: "memory"); } while (0)
#define NA_LOAD_K(kr) __builtin_amdgcn_global_load_lds((const unsigned*)(kbase + ((size_t)((kr) * 64 + prow)) * 2048 + pc * 16), (LAS unsigned*)(Ks + ((kr) & 7) * 8192 + wave * 1024), 16, 0, 0)
#define NA_LOAD_V(kr) __builtin_amdgcn_global_load_lds((const unsigned*)(vbase + (size_t)prow * 8192 + (kr) * 128 + pc * 16), (LAS unsigned*)(Vs + ((kr) & 7) * 8192 + wave * 1024), 16, 0, 0)
    for (int bu = launder_si((int)blockIdx.x); bu < 256; bu += gridDim.x) {
        const int sg = bu & 3, h = (bu >> 2) & 15, b = bu >> 6;
        const char* kbase = (const char*)(KN + (size_t)b * 4096 * 1024 + h * 64);
        const char* vbase = (const char*)(VNT + ((size_t)b * 1024 + h * 64) * 4096);
        asm volatile("s_waitcnt vmcnt(0)" ::: "memory"); NA_BAR();
        for (int i = tid; i < 465; i += 512) bias_s[i] = ((const GAS float*)rpb)[h * 465 + i];
        const int r0 = sg * 16, rs0 = min(max(r0 - 4, 0), 56);
#pragma unroll
        for (int q = 0; q < 8; ++q) { NA_LOAD_K(rs0 + q); NA_LOAD_V(rs0 + q); }
        const int cb = wave & 3, c0 = cb * 16, cs = min(max(c0 - 8, 0), 32), c = c0 + fr, cst = min(max(c - 8, 0), 48);
        bf16x8 yq0, yq1;
        { const size_t tq = (size_t)b * 4096 + r0 * 64 + c; yq0 = *(const GAS bf16x8*)(QN + tq * 1024 + h * 64 + 8 * fq); yq1 = *(const GAS bf16x8*)(QN + tq * 1024 + h * 64 + 32 + 8 * fq); }
#pragma nounroll
        for (int r = r0; r < r0 + 16; ++r) {
            const int rs = min(max(r - 4, 0), 56), rsn = min(max(r - 3, 0), 56);
            const bool mv = (r + 1 < r0 + 16) && (rsn != rs);
            asm volatile("s_waitcnt vmcnt(0)" ::: "memory"); NA_BAR();
            const bf16x8 q0 = yq0, q1 = yq1;
            const size_t tq = (size_t)b * 4096 + r * 64 + c;
            if (r + 1 < r0 + 16) { const size_t tn = tq + 64; yq0 = *(const GAS bf16x8*)(QN + tn * 1024 + h * 64 + 8 * fq); yq1 = *(const GAS bf16x8*)(QN + tn * 1024 + h * 64 + 32 + 8 * fq); }
            f32x4 S[16];
            if (wave < 4) {
#pragma unroll
                for (int kt = 0; kt < 16; ++kt) {
                    const int kr = rs + (kt >> 1), kcb = cs + (kt & 1) * 16, key = kcb + fr;
                    const LAS unsigned char* kp = Ks + (kr & 7) * 8192 + key * 128; const int sw = (key >> 1) & 7;
                    const bf16x8 xk0 = *(const LAS bf16x8*)(kp + ((fq ^ sw) << 4)), xk1 = *(const LAS bf16x8*)(kp + (((4 + fq) ^ sw) << 4));
                    f32x4 z = {0.f, 0.f, 0.f, 0.f};
                    z = __builtin_amdgcn_mfma_f32_16x16x32_bf16(xk0, q0, z, 0, 0, 0);
                    z = __builtin_amdgcn_mfma_f32_16x16x32_bf16(xk1, q1, z, 0, 0, 0);
                    const LAS float* bp = bias_s + (kr - r + 7) * 31;
#pragma unroll
                    for (int j = 0; j < 4; ++j) {
                        const int kc = kcb + 4 * fq + j; const bool valid = (kc >= cst) && (kc < cst + 16);
                        const int co = min(max(kc - c + 15, 0), 30);
                        z[j] = valid ? z[j] + bp[co] : -INFINITY;
                    }
                    S[kt] = z;
                }
            }
            NA_BAR();
            if (mv) NA_LOAD_K(rs + 8);
            f32x4 O[4]; float inv = 0.f;
            if (wave < 4) {
                float mx = -INFINITY;
#pragma unroll
                for (int kt = 0; kt < 16; ++kt)
#pragma unroll
                    for (int j = 0; j < 4; ++j) mx = fmaxf(mx, S[kt][j]);
                mx = fmaxf(mx, __shfl_xor(mx, 16)); mx = fmaxf(mx, __shfl_xor(mx, 32));
                float sum = 0.f;
#pragma unroll
                for (int kt = 0; kt < 16; ++kt)
#pragma unroll
                    for (int j = 0; j < 4; ++j) { const float p = fast_exp2((S[kt][j] - mx) * LOG2E); S[kt][j] = p; sum += p; }
                sum += __shfl_xor(sum, 16); sum += __shfl_xor(sum, 32);
                inv = 1.0f / sum;
#pragma unroll
                for (int ht = 0; ht < 4; ++ht) O[ht] = (f32x4){0.f, 0.f, 0.f, 0.f};
            }
#pragma unroll
            for (int p = 0; p < 8; ++p) {
                if (wave < 4) {
                    const bf16x8 yp = __builtin_bit_cast(bf16x8, pack8(S[2 * p], S[2 * p + 1]));
                    const LAS unsigned char* vrow = Vs + ((rs + p) & 7) * 8192;
#pragma unroll
                    for (int ht = 0; ht < 4; ++ht) {
                        const int ch = ht * 16 + fr, sw = (ch >> 1) & 7, pc0 = (cs >> 3) + (fq >> 1);
                        const LAS unsigned char* vp = vrow + ch * 128 + (fq & 1) * 8;
                        const u32x2 lo = *(const LAS u32x2*)(vp + ((pc0 ^ sw) << 4)), hi = *(const LAS u32x2*)(vp + (((pc0 + 2) ^ sw) << 4));
                        const u32x4 xw = {lo.x, lo.y, hi.x, hi.y};
                        O[ht] = __builtin_amdgcn_mfma_f32_16x16x32_bf16(__builtin_bit_cast(bf16x8, xw), yp, O[ht], 0, 0, 0);
                    }
                }
                if (p == 0) { NA_BAR(); if (mv) NA_LOAD_V(rs + 8); }
            }
            if (wave < 4) {
#pragma unroll
                for (int ht = 0; ht < 4; ++ht) *(GAS u32x2*)(NAO + tq * 1024 + h * 64 + ht * 16 + 4 * fq) = pack4(O[ht] * inv);
            }
        }
    }
    asm volatile("s_waitcnt vmcnt(0)" ::: "memory"); NA_BAR();
#undef NA_BAR
#undef NA_LOAD_K
#undef NA_LOAD_V
}
__device__ __forceinline__ void ln_row(f32x4 (&v)[4], const f32x4 (&g)[4], const f32x4 (&bb)[4]) {
    float s = 0.f;
#pragma unroll
    for (int j = 0; j < 4; ++j) s += (v[j][0] + v[j][1]) + (v[j][2] + v[j][3]);
    const float mean = wave_sum(s) * (1.0f / 1024.0f);
    float q = 0.f;
#pragma unroll
    for (int j = 0; j < 4; ++j) { v[j] = v[j] - mean; q += (v[j][0] * v[j][0] + v[j][1] * v[j][1]) + (v[j][2] * v[j][2] + v[j][3] * v[j][3]); }
    const float rstd = 1.0f / sqrtf(wave_sum(q) * (1.0f / 1024.0f) + 1e-5f);
#pragma unroll
    for (int j = 0; j < 4; ++j) v[j] = v[j] * rstd * g[j] + bb[j];
}
__device__ __forceinline__ void phase_ln_router(const Params& P, int l, LAS unsigned char* lds, int wave, int lane) {
    unsigned char* ws = P.ws;
    const float* PRE = (const float*)(ws + WS_ACAT); float* X1 = (float*)(ws + WS_ACAT + 64 * MiB); bf16_t* X1B = (bf16_t*)(ws + WS_K);
    const bf16_t* WRT = (const bf16_t*)(ws + WS_WRT);
    int* tok_e = (int*)(ws + WS_TOK); int* tok_rank = tok_e + T * 2; float* tok_w = (float*)(tok_rank + T * 2);
    unsigned* cnt = (unsigned*)(ws + WS_CTL) + CW_CNT + l * 64;
    LAS int* hist = (LAS int*)(lds + LDS_MISC + LM_HIST); LAS int* basee = (LAS int*)(lds + LDS_MISC + LM_BASE); LAS int* rowi = (LAS int*)(lds + LDS_MISC + LM_ROW);
    const int tid = launder_v((int)threadIdx.x);
    const int fr = lane & 15, fq = lane >> 4;
    f32x4 g[4], bb[4];
#pragma unroll
    for (int j = 0; j < 4; ++j) { g[j] = *(const GAS f32x4*)(P.ln_mix_g + l * 1024 + 4 * lane + 256 * j); bb[j] = *(const GAS f32x4*)(P.ln_mix_b + l * 1024 + 4 * lane + 256 * j); }
    for (int chunk = launder_si((int)blockIdx.x); chunk < T / 64; chunk += gridDim.x) {
        if (tid < 32) hist[tid] = 0;
#pragma nounroll
        for (int rr = 0; rr < 8; ++rr) {
            const int ta = chunk * 64 + wave * 8 + rr;
            f32x4 va[4];
#pragma unroll
            for (int j = 0; j < 4; ++j) va[j] = *(const GAS f32x4*)(PRE + (size_t)ta * 1024 + 4 * lane + 256 * j);
            ln_row(va, g, bb);
#pragma unroll
            for (int j = 0; j < 4; ++j) { *(GAS f32x4*)(X1 + (size_t)ta * 1024 + 4 * lane + 256 * j) = va[j]; *(GAS u32x2*)(X1B + (size_t)ta * 1024 + 4 * lane + 256 * j) = pack4(va[j]); }
        }
        VM_WAIT();
        __syncthreads();
        if (wave < 4) {
            const int t0 = chunk * 64 + wave * 16;
            f32x4 acc0 = {0.f, 0.f, 0.f, 0.f}, acc1 = {0.f, 0.f, 0.f, 0.f};
            const float* yp = X1 + (size_t)(t0 + fr) * 1024 + 8 * fq;
            const bf16_t* wp = WRT + (size_t)fr * 1024 + 8 * fq;
#pragma unroll 4
            for (int s = 0; s < 32; ++s) {
                const f32x4 ya = *(const GAS f32x4*)(yp + 32 * s), yb = *(const GAS f32x4*)(yp + 32 * s + 4);
                const bf16x8 w0h = *(const GAS bf16x8*)(wp + 32 * s), w1h = *(const GAS bf16x8*)(wp + 16 * 1024 + 32 * s);
                const bf16x8 w0l = *(const GAS bf16x8*)(wp + 32 * 1024 + 32 * s), w1l = *(const GAS bf16x8*)(wp + 48 * 1024 + 32 * s);
                u32x4 yh; yh.x = cvt_pk_bf16(ya[0], ya[1]); yh.y = cvt_pk_bf16(ya[2], ya[3]); yh.z = cvt_pk_bf16(yb[0], yb[1]); yh.w = cvt_pk_bf16(yb[2], yb[3]);
                u32x4 yl; yl.x = cvt_pk_bf16(ya[0] - bf_lo(yh.x), ya[1] - bf_hi(yh.x)); yl.y = cvt_pk_bf16(ya[2] - bf_lo(yh.y), ya[3] - bf_hi(yh.y));
                yl.z = cvt_pk_bf16(yb[0] - bf_lo(yh.z), yb[1] - bf_hi(yh.z)); yl.w = cvt_pk_bf16(yb[2] - bf_lo(yh.w), yb[3] - bf_hi(yh.w));
                const bf16x8 yhv = __builtin_bit_cast(bf16x8, yh), ylv = __builtin_bit_cast(bf16x8, yl);
                acc0 = __builtin_amdgcn_mfma_f32_16x16x32_bf16(w0h, yhv, acc0, 0, 0, 0); acc1 = __builtin_amdgcn_mfma_f32_16x16x32_bf16(w1h, yhv, acc1, 0, 0, 0);
                acc0 = __builtin_amdgcn_mfma_f32_16x16x32_bf16(w0h, ylv, acc0, 0, 0, 0); acc1 = __builtin_amdgcn_mfma_f32_16x16x32_bf16(w1h, ylv, acc1, 0, 0, 0);
                acc0 = __builtin_amdgcn_mfma_f32_16x16x32_bf16(w0l, yhv, acc0, 0, 0, 0); acc1 = __builtin_amdgcn_mfma_f32_16x16x32_bf16(w1l, yhv, acc1, 0, 0, 0);
            }
            const f32x4 rb0 = *(const GAS f32x4*)(P.router_bias + 4 * fq), rb1 = *(const GAS f32x4*)(P.router_bias + 16 + 4 * fq);
            f32x4 sc0, sc1, se0, se1;
#pragma unroll
            for (int j = 0; j < 4; ++j) { sc0[j] = 1.0f / (1.0f + expf(-acc0[j])); sc1[j] = 1.0f / (1.0f + expf(-acc1[j])); se0[j] = sc0[j] + rb0[j]; se1[j] = sc1[j] + rb1[j]; }
            float gs0, gs1;
            { const float a = fmaxf(se0[0], se0[1]), b2 = fminf(se0[0], se0[1]), c = fmaxf(se0[2], se0[3]), d2 = fminf(se0[2], se0[3]); gs0 = fmaxf(a, c) + fmaxf(fminf(a, c), fmaxf(b2, d2)); }
            { const float a = fmaxf(se1[0], se1[1]), b2 = fminf(se1[0], se1[1]), c = fmaxf(se1[2], se1[3]), d2 = fminf(se1[2], se1[3]); gs1 = fmaxf(a, c) + fmaxf(fminf(a, c), fmaxf(b2, d2)); }
            float bs = gs0; int bg = fq;
            if (gs1 > gs0) { bs = gs1; bg = 4 + fq; }
#pragma unroll
            for (int o = 16; o < 64; o <<= 1) { const float os = __shfl_xor(bs, o); const int og = __shfl_xor(bg, o); if (os > bs || (os == bs && og < bg)) { bs = os; bg = og; } }
            if ((bg & 3) == fq) {
                const bool hi = bg >= 4;
                const float u0 = hi ? se1[0] : se0[0], u1 = hi ? se1[1] : se0[1], u2 = hi ? se1[2] : se0[2], u3 = hi ? se1[3] : se0[3];
                const float p0 = hi ? sc1[0] : sc0[0], p1 = hi ? sc1[1] : sc0[1], p2 = hi ? sc1[2] : sc0[2], p3 = hi ? sc1[3] : sc0[3];
                int i1 = 0; float t1 = u0;
                if (u1 > t1) { t1 = u1; i1 = 1; } if (u2 > t1) { t1 = u2; i1 = 2; } if (u3 > t1) { t1 = u3; i1 = 3; }
                int i2 = -1; float t2 = -INFINITY;
                if (i1 != 0 && u0 > t2) { t2 = u0; i2 = 0; } if (i1 != 1 && u1 > t2) { t2 = u1; i2 = 1; } if (i1 != 2 && u2 > t2) { t2 = u2; i2 = 2; } if (i1 != 3 && u3 > t2) { t2 = u3; i2 = 3; }
                if (i2 < 0) i2 = (i1 + 1) & 3;
                const float s1 = i1 == 0 ? p0 : i1 == 1 ? p1 : i1 == 2 ? p2 : p3, s2 = i2 == 0 ? p0 : i2 == 1 ? p1 : i2 == 2 ? p2 : p3, inv = 1.0f / (s1 + s2);
                const int e1 = 4 * bg + i1, e2 = 4 * bg + i2;
                const int r1 = __hip_atomic_fetch_add(hist + e1, 1, __ATOMIC_RELAXED, __HIP_MEMORY_SCOPE_WORKGROUP);
                const int r2 = __hip_atomic_fetch_add(hist + e2, 1, __ATOMIC_RELAXED, __HIP_MEMORY_SCOPE_WORKGROUP);
                const int q = wave * 16 + fr;
                rowi[q] = e1; rowi[64 + q] = e2; rowi[128 + q] = r1; rowi[192 + q] = r2; rowi[256 + q] = __float_as_int(s1 * inv); rowi[320 + q] = __float_as_int(s2 * inv);
            }
        }
        __syncthreads();
        if (tid < 32) basee[tid] = (int)__hip_atomic_fetch_add(cnt + tid, (unsigned)hist[tid], __ATOMIC_RELAXED, __HIP_MEMORY_SCOPE_AGENT);
        __syncthreads();
        if (tid < 64) {
            const int t = chunk * 64 + tid, e1 = rowi[tid], e2 = rowi[64 + tid];
            tok_e[2 * t] = e1; tok_e[2 * t + 1] = e2;
            tok_rank[2 * t] = basee[e1] + rowi[128 + tid]; tok_rank[2 * t + 1] = basee[e2] + rowi[192 + tid];
            tok_w[2 * t] = __int_as_float(rowi[256 + tid]); tok_w[2 * t + 1] = __int_as_float(rowi[320 + tid]);
        }
        __syncthreads();
    }
}
__device__ __forceinline__ void build_tiles(const Params& P, int l, LAS unsigned char* lds) {
    const unsigned* cnt = (const unsigned*)(P.ws + WS_CTL) + CW_CNT + l * 64;
    LAS int* tstart = (LAS int*)(lds + LDS_MISC + LM_TSTART); LAS int* tile_e = (LAS int*)(lds + LDS_MISC + LM_TILEE); LAS int* ntp = (LAS int*)(lds + LDS_MISC + LM_NT);
    __syncthreads();
    if (launder_v((int)threadIdx.x) == 0) {
        int a = 0;
#pragma nounroll
        for (int e = 0; e < 32; ++e) { const int c = (int)__hip_atomic_load(cnt + e, __ATOMIC_RELAXED, __HIP_MEMORY_SCOPE_AGENT); const int n = (c + 255) >> 8; tstart[e] = a;
            for (int q = 0; q < n; ++q) { if (a + q < 192) tile_e[a + q] = e; } a += n; }
        tstart[32] = a; ntp[0] = a < 160 ? a : 160;
    }
    __syncthreads();
}
__device__ __forceinline__ void phase_gather(const Params& P, int l, LAS unsigned char* lds, int gw, int NGW, int lane) {
    unsigned char* ws = P.ws;
    const bf16_t* X1B = (const bf16_t*)(ws + WS_K); bf16_t* XG = (bf16_t*)(ws + WS_KV);
    const int* tok_e = (const int*)(ws + WS_TOK); const int* tok_rank = tok_e + T * 2; int* tok_dest = (int*)(ws + WS_TOK) + T * 6;
    build_tiles(P, l, lds);
    const LAS int* tstart = (const LAS int*)(lds + LDS_MISC + LM_TSTART);
    for (int pr = gw; pr < T * 2; pr += NGW) {
        const int e = tok_e[pr], dest = tstart[e] * 256 + tok_rank[pr];
        if (lane == 0) tok_dest[pr] = dest;
        const GAS u32x4* src = (const GAS u32x4*)(X1B + (size_t)(pr >> 1) * 1024); GAS u32x4* dst = (GAS u32x4*)(XG + (size_t)dest * 1024);
        dst[lane] = src[lane]; dst[lane + 64] = src[lane + 64];
    }
}
__device__ __forceinline__ void phase_combine(const Params& P, int l, int gw, int NGW, int lane) {
    unsigned char* ws = P.ws;
    const float* X1 = (const float*)(ws + WS_ACAT + 64 * MiB); const bf16_t* Y = (const bf16_t*)(ws + WS_BCAT + 40 * MiB);
    const float* tok_w = (const float*)(ws + WS_TOK) + T * 4; const int* tok_dest = (const int*)(ws + WS_TOK) + T * 6;
    bf16_t* xb = (bf16_t*)(ws + WS_XB);
    f32x4 g[4], bb[4];
#pragma unroll
    for (int j = 0; j < 4; ++j) { g[j] = *(const GAS f32x4*)(P.ln_ffn_g + l * 1024 + 4 * lane + 256 * j); bb[j] = *(const GAS f32x4*)(P.ln_ffn_b + l * 1024 + 4 * lane + 256 * j); }
    for (int t = gw; t < T; t += NGW) {
        const int d0 = tok_dest[2 * t], d1 = tok_dest[2 * t + 1]; const float w0 = tok_w[2 * t], w1 = tok_w[2 * t + 1];
        f32x4 v[4];
#pragma unroll
        for (int j = 0; j < 4; ++j) {
            const f32x4 x1 = *(const GAS f32x4*)(X1 + (size_t)t * 1024 + 4 * lane + 256 * j);
            const u32x2 y0 = *(const GAS u32x2*)(Y + (size_t)d0 * 1024 + 4 * lane + 256 * j), y1 = *(const GAS u32x2*)(Y + (size_t)d1 * 1024 + 4 * lane + 256 * j);
            v[j][0] = x1[0] * ALPHA + w0 * bf_lo(y0.x) + w1 * bf_lo(y1.x); v[j][1] = x1[1] * ALPHA + w0 * bf_hi(y0.x) + w1 * bf_hi(y1.x);
            v[j][2] = x1[2] * ALPHA + w0 * bf_lo(y0.y) + w1 * bf_lo(y1.y); v[j][3] = x1[3] * ALPHA + w0 * bf_hi(y0.y) + w1 * bf_hi(y1.y);
        }
        ln_row(v, g, bb);
#pragma unroll
        for (int j = 0; j < 4; ++j) { *(GAS f32x4*)(P.out + (size_t)t * 1024 + 4 * lane + 256 * j) = v[j]; *(GAS u32x2*)(xb + (size_t)t * 1024 + 4 * lane + 256 * j) = pack4(v[j]); }
    }
}

__global__ void __launch_bounds__(512, 2) fwd_kernel(Params P) {
    extern __shared__ __attribute__((aligned(16))) unsigned char lds_raw[];
    LAS unsigned char* lds = (LAS unsigned char*)lds_raw;
    const int NGW = gridDim.x * 8;
    for (int u = threadIdx.x; u < (LDS_BYTES - LDS_MISC) / 4; u += 512) ((LAS unsigned*)(lds + LDS_MISC))[u] = 0u;
#define PHASE_CTX() const Params PP = load_params(); unsigned char* ws = PP.ws; const int tid = launder_v((int)threadIdx.x), lane = tid & 63, wave = __builtin_amdgcn_readfirstlane(tid >> 6), gw = launder_si((int)blockIdx.x) * 8 + wave; (void)ws; (void)lane; (void)gw
    __syncthreads();
#if MK_ONE_LAUNCH
    XcdBarrier bar = xcd_barrier_post((unsigned*)(P.ws + WS_CTL) + CW_BAR, (volatile LAS unsigned*)(lds + LDS_MISC + LM_BAR));
#define GRID_BAR() xcd_barrier(bar)
#else
#define GRID_BAR() do { } while (0)
#endif
    const int lo = P.ph_lo, hi = P.ph_hi;
#define IN(k) (lo <= (k) && (k) < hi)
#define SEAM(k) do { if (IN(k) && IN((k) + 1)) GRID_BAR(); } while (0)
#ifndef PROBE_MASK
#define PROBE_MASK 0
#endif
#define REP(b) for (int rep_ = 0; rep_ < (((PROBE_MASK) >> (b)) & 1) + 1; ++rep_)

    if (IN(0)) { PHASE_CTX(); phase_init(PP, lds, gw, NGW, wave, lane); SEAM(0); }

    for (int l = 0; l < DEPTH; ++l) {
        const int pb = 1 + l * 12;
        if (IN(pb + 0)) { PHASE_CTX(); const float* decay = PP.decay + l * 8; (void)decay;
            DecInProj dec{(const char*)(ws + WS_XB), (const char*)(ws + WS_WIN)};
            EpiInProj E{ws, decay};
            REP(0) pg::gemm_phase<1 + PROBE_EPI2>(lds, 1024, 1024, 1024, 3072, dec, E);
            SEAM(pb + 0);
        }
        if (IN(pb + 1)) { PHASE_CTX(); const float* decay = PP.decay + l * 8; (void)decay;
            { DecR1 dec{(const char*)(ws + WS_Q), (const char*)(ws + WS_K)}; EpiR1 E{(bf16_t*)(ws + WS_ACAT), decay};
              REP(1) pg::gemm_phase(lds, 256, 1024, 1024, 512, dec, E); }
            { DecR2 dec{(const char*)(ws + WS_BCAT), (const char*)(ws + WS_KDT)}; EpiR2 E{(float*)(ws + WS_KV)};
              REP(2) pg::gemm_phase(lds, 512, 1024, 512, 448, dec, E); }
            REP(3) phase_na2(PP, l, lds, tid, wave, lane);
            SEAM(pb + 1);
        }
        if (IN(pb + 2)) { PHASE_CTX(); const float* decay = PP.decay + l * 8; (void)decay; REP(4) phase_prefix(PP, l, gw, NGW, lane); SEAM(pb + 2); }
        if (IN(pb + 3)) { PHASE_CTX(); const float* decay = PP.decay + l * 8; (void)decay;
            DecR4 dec{(const char*)(ws + WS_ACAT), (const char*)(ws + WS_BCAT)}; EpiR4 E{(bf16_t*)(ws + WS_KV)};
            REP(5) pg::gemm_phase(lds, 1024, 4096, 1024, 512, dec, E);
            SEAM(pb + 3);
        }
        if (IN(pb + 4)) { PHASE_CTX(); const float* decay = PP.decay + l * 8; (void)decay; REP(6) phase_headnorm(PP, gw, NGW, lane); SEAM(pb + 4); }
        if (IN(pb + 5)) { PHASE_CTX(); const float* decay = PP.decay + l * 8; (void)decay;
            REP(7) {
            { DecDense dec{(const char*)(ws + WS_KDT), (const char*)(ws + WS_WRET), 2048 * 2, 2048 * 2}; EpiMerge<0> E{(bf16_t*)(ws + WS_Q), (const bf16_t*)(ws + WS_G)};
              pg::gemm_phase(lds, 2048, 2048, 2048, 256, dec, E); }
            { DecDense dec{(const char*)(ws + WS_NAO), (const char*)(ws + WS_WNA), 1024 * 2, 1024 * 2}; EpiMerge<1> E{(bf16_t*)(ws + WS_Q), (const bf16_t*)(ws + WS_G)};
              pg::gemm_phase(lds, 1024, 1024, 1024, 256, dec, E); }
            }
            SEAM(pb + 5);
        }
        if (IN(pb + 6)) { PHASE_CTX(); const float* decay = PP.decay + l * 8; (void)decay;
            DecDense dec{(const char*)(ws + WS_Q), (const char*)(ws + WS_WOUT), 1024 * 2, 1024 * 2}; EpiPre E{(float*)(ws + WS_ACAT), l == 0 ? PP.x : (const float*)PP.out};
            REP(8) pg::gemm_phase(lds, 1024, 1024, 1024, 256, dec, E);
            SEAM(pb + 6);
        }
        if (IN(pb + 7)) { PHASE_CTX(); const float* decay = PP.decay + l * 8; (void)decay; phase_ln_router(PP, l, lds, wave, lane); SEAM(pb + 7); }
        if (IN(pb + 8)) { PHASE_CTX(); const float* decay = PP.decay + l * 8; (void)decay; REP(9) phase_gather(PP, l, lds, gw, NGW, lane); SEAM(pb + 8); }
        if (IN(pb + 9)) { PHASE_CTX(); const float* decay = PP.decay + l * 8; (void)decay;
            build_tiles(PP, l, lds);
            const int nt = *(const LAS int*)(lds + LDS_MISC + LM_NT);
            DecMoe dec{(const char*)(ws + WS_KV), (const char*)(ws + WS_WGU), 1024 * 2, 1024 * 1024 * 2, 1024 * 2, (const LAS int*)(lds + LDS_MISC + LM_TILEE)}; EpiUp E{(bf16_t*)(ws + WS_BCAT)};
            REP(10) pg::gemm_phase(lds, 1024, 1024, 1024, nt * 4, dec, E);
            SEAM(pb + 9);
        }
        if (IN(pb + 10)) { PHASE_CTX(); const float* decay = PP.decay + l * 8; (void)decay;
            build_tiles(PP, l, lds);
            const int nt = *(const LAS int*)(lds + LDS_MISC + LM_NT);
            DecMoe dec{(const char*)(ws + WS_BCAT), (const char*)(ws + WS_WD), 512 * 2, 1024 * 512 * 2, 512 * 2, (const LAS int*)(lds + LDS_MISC + LM_TILEE)}; EpiDown E{(bf16_t*)(ws + WS_BCAT + 40 * MiB)};
            REP(11) pg::gemm_phase(lds, 512, 512, 512, nt * 4, dec, E);
            SEAM(pb + 10);
        }
        if (IN(pb + 11)) { PHASE_CTX(); const float* decay = PP.decay + l * 8; (void)decay;
            REP(12) phase_combine(PP, l, gw, NGW, lane);
            REP(13) if (l + 1 < DEPTH) convert_layer(PP, l + 1, lds, gw, NGW, wave, lane);
            SEAM(pb + 11);
        }
    }
#undef IN
#undef SEAM
}

extern "C" void kernel_launch(void* const* d_in, const int* in_sizes, int n_in, void* d_out, int out_size, void* d_ws, size_t ws_size, hipStream_t stream) {
    static int grid = 0;
    if (grid == 0) {
        if (n_in != 16 || in_sizes[0] != T * D || out_size != T * D || ws_size < WS_END) {
            fprintf(stderr, "kernel_launch: unexpected shapes / workspace (n_in %d, in0 %d, out %d, ws %zu < %zu); nothing launched\n", n_in, n_in > 0 ? in_sizes[0] : -1, out_size, ws_size, (size_t)WS_END); grid = -1; return; }
        int dev = 0, cus = 0, per_cu = 0;
        if (hipGetDevice(&dev) != hipSuccess || hipDeviceGetAttribute(&cus, hipDeviceAttributeMultiprocessorCount, dev) != hipSuccess) { grid = -1; return; }
        if (hipFuncSetAttribute((const void*)fwd_kernel, hipFuncAttributeMaxDynamicSharedMemorySize, LDS_BYTES) != hipSuccess) { fprintf(stderr, "kernel_launch: hipFuncSetAttribute failed\n"); grid = -1; return; }
        if (hipOccupancyMaxActiveBlocksPerMultiprocessor(&per_cu, (const void*)fwd_kernel, 512, LDS_BYTES) != hipSuccess || per_cu < 1)
            fprintf(stderr, "kernel_launch: occupancy query reports %d workgroups per CU\n", per_cu);
        (void)hipGetLastError();
        grid = cus;
    }
    if (grid < 0) return;
    if (hipMemsetAsync((char*)d_ws + WS_CTL, 0, CTL_ZERO_BYTES, stream) != hipSuccess) return;
    Params p{};
    p.x = (const float*)d_in[0]; p.w_in = (const float*)d_in[1]; p.decay = (const float*)d_in[2]; p.w_ret_o = (const float*)d_in[3]; p.rpb = (const float*)d_in[4];
    p.w_na_o = (const float*)d_in[5]; p.w_out = (const float*)d_in[6]; p.ln_mix_g = (const float*)d_in[7]; p.ln_mix_b = (const float*)d_in[8];
    p.router_w = (const float*)d_in[9]; p.router_bias = (const float*)d_in[10]; p.w_gate = (const float*)d_in[11]; p.w_up = (const float*)d_in[12]; p.w_down = (const float*)d_in[13];
    p.ln_ffn_g = (const float*)d_in[14]; p.ln_ffn_b = (const float*)d_in[15];
    p.out = (float*)d_out; p.ws = (unsigned char*)d_ws;
#if MK_ONE_LAUNCH
    p.ph_lo = 0; p.ph_hi = NPH;
    hipLaunchKernelGGL(fwd_kernel, dim3(grid), dim3(512), LDS_BYTES, stream, p);
#else
    for (int ph = 0; ph < NPH; ++ph) { p.ph_lo = ph; p.ph_hi = ph + 1; hipLaunchKernelGGL(fwd_kernel, dim3(grid), dim3(512), LDS_BYTES, stream, p); }
#endif
}
```

```cpp
#include <hip/hip_runtime.h>
#include <cstdio>
#include <cstdint>

#ifndef PROBE_EPI2
#define PROBE_EPI2 0
#endif
#ifndef MK_ONE_LAUNCH
#define MK_ONE_LAUNCH 1
#endif

#define LAS __attribute__((address_space(3)))
#define GAS __attribute__((address_space(1)))
typedef unsigned short bf16_t;
typedef short bf16x8 __attribute__((ext_vector_type(8)));
typedef float f32x4 __attribute__((ext_vector_type(4)));
typedef float f32x2 __attribute__((ext_vector_type(2)));
typedef unsigned u32x4 __attribute__((ext_vector_type(4)));
typedef unsigned u32x2 __attribute__((ext_vector_type(2)));

constexpr int D = 1024, BATCH = 4, SEQ = 4096, T = BATCH * SEQ, DEPTH = 4;
constexpr int DIN = 11264;
constexpr int NE = 32;
constexpr int NPH = 1 + DEPTH * 12;
constexpr float ALPHA = 1.681792830507429f;
constexpr float LOG2E = 1.4426950408889634f;

constexpr size_t MiB = 1u << 20;
constexpr size_t WS_CTL = 0, CTL_ZERO_BYTES = 1 * MiB;
constexpr size_t WS_TAB = 2 * MiB;
constexpr size_t WS_TOK = 10 * MiB;
constexpr size_t WS_WRT = 11 * MiB;
constexpr size_t WS_WIN = 12 * MiB;
constexpr size_t WS_WRET = 34 * MiB;
constexpr size_t WS_WNA = 38 * MiB;
constexpr size_t WS_WOUT = 40 * MiB;
constexpr size_t WS_WGU = 42 * MiB;
constexpr size_t WS_WD = 106 * MiB;
constexpr size_t WS_XB = 138 * MiB;
constexpr size_t WS_Q = 170 * MiB;
constexpr size_t WS_K = 202 * MiB;
constexpr size_t WS_ACAT = 234 * MiB;
constexpr size_t WS_BCAT = 362 * MiB;
constexpr size_t WS_KDT = 490 * MiB;
constexpr size_t WS_KV = 554 * MiB;
constexpr size_t WS_SG = 682 * MiB;
constexpr size_t WS_QN = 746 * MiB;
constexpr size_t WS_KN = 778 * MiB;
constexpr size_t WS_VNT = 810 * MiB;
constexpr size_t WS_G = 842 * MiB;
constexpr size_t WS_NAO = 906 * MiB;
constexpr size_t WS_END = 938 * MiB;
constexpr int CW_BAR = 4096;
constexpr int CW_CNT = 16384;

constexpr int LDS_STAGE = 131072;
constexpr int LDS_MISC = 131072;
constexpr int LM_BAR = 0;
constexpr int LM_HIST = 64;
constexpr int LM_BASE = 192;
constexpr int LM_ROW = 512;
constexpr int LM_NT = 2048;
constexpr int LM_TSTART = 2112;
constexpr int LM_TILEE = 2304;
constexpr int LDS_BYTES = 147456;

#define LDS_WAIT() asm volatile("s_waitcnt lgkmcnt(0)" ::: "memory")
#define VM_WAIT() asm volatile("s_waitcnt vmcnt(0)" ::: "memory")
__device__ __forceinline__ unsigned cvt_pk_bf16(float lo, float hi) { unsigned r; asm("v_cvt_pk_bf16_f32 %0, %1, %2" : "=v"(r) : "v"(lo), "v"(hi)); return r; }
__device__ __forceinline__ u32x4 pack8(const f32x4 a, const f32x4 b) { u32x4 w; w.x = cvt_pk_bf16(a[0], a[1]); w.y = cvt_pk_bf16(a[2], a[3]); w.z = cvt_pk_bf16(b[0], b[1]); w.w = cvt_pk_bf16(b[2], b[3]); return w; }
__device__ __forceinline__ u32x2 pack4(const f32x4 a) { u32x2 w; w.x = cvt_pk_bf16(a[0], a[1]); w.y = cvt_pk_bf16(a[2], a[3]); return w; }
__device__ __forceinline__ float bf_lo(unsigned u) { return __uint_as_float(u << 16); }
__device__ __forceinline__ float bf_hi(unsigned u) { return __uint_as_float(u & 0xffff0000u); }
__device__ __forceinline__ float wave_sum(float v) {
#pragma unroll
    for (int o = 1; o < 64; o <<= 1) v += __shfl_xor(v, o);
    return v;
}
template <class Tp> __device__ __forceinline__ Tp* launder_s(Tp* p) { asm volatile("" : "+s"(p)); return p; }
__device__ __forceinline__ int launder_v(int v) { asm volatile("" : "+v"(v)); return v; }
__device__ __forceinline__ int launder_si(int v) { asm volatile("" : "+s"(v)); return v; }
__device__ __forceinline__ float fast_exp2(float x) { return __builtin_amdgcn_exp2f(x); }
__device__ __forceinline__ float fast_rcp(float x) { return __builtin_amdgcn_rcpf(x); }
__device__ __forceinline__ float sigmoid_f(float v) { return fast_rcp(1.0f + fast_exp2(-v * LOG2E)); }
__device__ __forceinline__ float log2_sigmoid(float x) { return -log1pf(expf(-x)) * LOG2E; }

#define XB_TMO      128
#define XB_XCNT(j)  (256  + 64 * (j))
#define XB_XSUB(j)  (1280 + 64 * (j))
#define XB_XGEN(j)  (2304 + 64 * (j))
#define XB_TOP      3328
#define XB_TOPGEN   3392
#define XCD_BAR_WORDS 3456
#define XB_SPIN_CAP (1u << 18)

__device__ __forceinline__ unsigned xb_ld(unsigned* p)              { return __hip_atomic_load(p, __ATOMIC_RELAXED, __HIP_MEMORY_SCOPE_AGENT); }
__device__ __forceinline__ unsigned xb_add(unsigned* p, unsigned v) { return __hip_atomic_fetch_add(p, v, __ATOMIC_RELAXED, __HIP_MEMORY_SCOPE_AGENT); }
__device__ __forceinline__ unsigned xb_xcc_id() { return (unsigned)__builtin_amdgcn_s_getreg((3 << 11) | 20) & 0xFu; }
#define XB_SPIN(cond, bar) do { unsigned _sp = 0; while (cond) { __builtin_amdgcn_s_sleep(1); \
    if ((++_sp & 255u) == 0u) { if (xb_ld(&(bar)[XB_TMO])) break; if (_sp > XB_SPIN_CAP) { atomicAdd(&(bar)[XB_TMO], 1u); break; } } } } while (0)

struct XcdBarrier {
    unsigned* bar; unsigned x;
    volatile LAS unsigned* st;
};
__device__ __forceinline__ XcdBarrier xcd_barrier_post(unsigned* bar, volatile LAS unsigned* st) {
    XcdBarrier b; b.bar = bar; b.x = xb_xcc_id(); b.st = st;
    if (threadIdx.x == 0) (void)xb_add(&bar[XB_XCNT(b.x)], 1u);
    return b;
}
__device__ __forceinline__ void xcd_barrier_complete(unsigned* bar, unsigned x, unsigned& nloc, unsigned& nx) {
    const unsigned G = gridDim.x * gridDim.y * gridDim.z;
    unsigned sum, cnt, mine, sp = 0u;
    for (;;) {
        sum = 0u; cnt = 0u; mine = 0u;
#pragma unroll
        for (unsigned j = 0; j < 16; ++j) { const unsigned c = xb_ld(&bar[XB_XCNT(j)]); sum += c; cnt += (c > 0u) ? 1u : 0u; mine = (j == x) ? c : mine; }
        if (sum == G) break;
        __builtin_amdgcn_s_sleep(1);
        if ((++sp & 255u) == 0u) { if (xb_ld(&bar[XB_TMO])) break; if (sp > XB_SPIN_CAP) { atomicAdd(&bar[XB_TMO], 1u); break; } }
    }
    nloc = mine > 0u ? mine : 1u; nx = cnt > 0u ? cnt : 1u;
}
__device__ __forceinline__ void xcd_barrier(const XcdBarrier& b) {
    asm volatile("s_waitcnt vmcnt(0)" ::: "memory");
    __syncthreads();
    if (threadIdx.x == 0) {
        unsigned* bar = b.bar;
        __builtin_amdgcn_s_waitcnt(0);
        unsigned nloc = b.st[0], nx = b.st[1];
        if (nloc == 0u) { xcd_barrier_complete(bar, b.x, nloc, nx); b.st[0] = nloc; b.st[1] = nx; }
        const unsigned old = xb_add(&bar[XB_XSUB(b.x)], 1u);
        const unsigned gen = old / nloc;
        if (old + 1u == (gen + 1u) * nloc) {
            __builtin_amdgcn_fence(__ATOMIC_RELEASE, "agent");
            asm volatile("s_waitcnt vmcnt(0)" ::: "memory");
            const unsigned og = xb_add(&bar[XB_TOP], 1u);
            const unsigned tg = og / nx;
            if (og + 1u == (tg + 1u) * nx) xb_add(&bar[XB_TOPGEN], 1u);
            else XB_SPIN(xb_ld(&bar[XB_TOPGEN]) == tg, bar);
            __builtin_amdgcn_fence(__ATOMIC_ACQUIRE, "agent");
            xb_add(&bar[XB_XGEN(b.x)], 1u);
            asm volatile("s_waitcnt vmcnt(0)" ::: "memory");
        } else {
            XB_SPIN(xb_ld(&bar[XB_XGEN(b.x)]) == gen, bar);
            __builtin_amdgcn_fence(__ATOMIC_ACQUIRE, "agent");
            asm volatile("s_waitcnt vmcnt(0)" ::: "memory");
        }
    }
    __syncthreads();
}

namespace pg {
constexpr int BM = 256, BK = 64, HALF = 128, HTB = HALF * BK * 2, STAGE_BYTES = 8 * HTB;
__device__ __forceinline__ int lds_byte(int r, int c) { const int st = (r >> 4) * 2 + (c >> 5), rr = r & 15, cc = c & 31, ob = rr * 64 + cc * 2; return st * 1024 + (ob ^ (((ob >> 9) & 1) << 5)); }
__device__ __forceinline__ void stage_rc(int b, int& R, int& C) { const int st = b / 1024, sb = b % 1024, swz = sb ^ (((sb >> 9) & 1) << 5); R = (st >> 1) * 16 + swz / 64; C = (st & 1) * 32 + (swz % 64) / 2; }
__device__ __forceinline__ int perm32(int rho) { const int n = rho >> 4, i = rho & 15; return 8 * (i >> 2) + 4 * n + (i & 3); }

struct Unit { const char* A; const char* B; int kind, a, b, c; };

template <int EPI_REP = 1, bool CHAIN = false, class Epi, class Dec>
__device__ __forceinline__ void gemm_phase(LAS unsigned char* lds, const int K, const int lda, const int ldb, const int nunits, const Dec& dec, const Epi& E, const int vG, const int vbid) {
    const int tid = launder_v((int)threadIdx.x), wid = __builtin_amdgcn_readfirstlane(tid >> 6), lane = tid & 63, wr = wid >> 2, wc = wid & 3, fr = lane & 15, fq = lane >> 4;
    const int nt = K / BK;
    const int G = launder_si(vG); int uidx = launder_si(vbid);
    if (uidx < 0 || uidx >= nunits) return;
    unsigned voffA[2], voffB[2];
#pragma unroll
    for (int i = 0; i < 2; ++i) { int R, C; stage_rc(tid * 16 + i * 8192, R, C); const int Rb = (R & ~31) + perm32(R & 31);
        voffA[i] = (unsigned)(R * lda + C) * 2u; voffB[i] = (unsigned)(Rb * ldb + C) * 2u; }
    const size_t kstep = (size_t)(BK * 2);
    const size_t hstepA = (size_t)HALF * lda * 2, hstepB = (size_t)HALF * ldb * 2;
    const unsigned ldsw = (unsigned)wid * 1024u;
    const int aoff = lds_byte(wr * 64 + fr, fq * 8), boff = lds_byte(wc * 32 + fr, fq * 8);
#define PG_SA(b, h) (((b) * 2 + (h)) * HTB)
#define PG_SB(b, h) ((4 + (b) * 2 + (h)) * HTB)
#define PG_STAGE(bufoff, gbase, voff) do { _Pragma("unroll") for (int _i = 0; _i < 2; ++_i) \
        __builtin_amdgcn_global_load_lds((const unsigned*)((const char*)(gbase) + (voff)[_i]), (LAS unsigned*)(lds + (bufoff) + ldsw + _i * 8192), 16, 0, 0); } while (0)
#define PG_LDA(dst, b, h) do { _Pragma("unroll") for (int m = 0; m < 4; ++m) _Pragma("unroll") for (int k = 0; k < 2; ++k) dst[m][k] = *(const LAS bf16x8*)(lds + PG_SA(b, h) + aoff + m * 2048 + k * 1024); } while (0)
#define PG_LDB(dst, b, h) do { _Pragma("unroll") for (int n = 0; n < 2; ++n) _Pragma("unroll") for (int k = 0; k < 2; ++k) dst[n][k] = *(const LAS bf16x8*)(lds + PG_SB(b, h) + boff + n * 2048 + k * 1024); } while (0)
#define PG_MMA(ai, bj, At, Bt) do { __builtin_amdgcn_s_setprio(1); _Pragma("unroll") for (int m = 0; m < 4; ++m) _Pragma("unroll") for (int n = 0; n < 2; ++n) _Pragma("unroll") for (int k = 0; k < 2; ++k) \
        acc[ai][bj][m][n] = __builtin_amdgcn_mfma_f32_16x16x32_bf16(Bt[n][k], At[m][k], acc[ai][bj][m][n], 0, 0, 0); __builtin_amdgcn_s_setprio(0); } while (0)
#define PG_WAIT_V(n) asm volatile("s_waitcnt vmcnt(" #n ")" ::: "memory")
#define PG_WAIT_L(n) asm volatile("s_waitcnt lgkmcnt(" #n ")" ::: "memory")
#define PG_BAR __builtin_amdgcn_s_barrier()
#define PG_SCHED __builtin_amdgcn_sched_barrier(0)
    Unit cur, nxt;
    dec(uidx, cur);
    f32x4 acc[2][2][4][2];
#pragma unroll
    for (int a = 0; a < 2; ++a)
#pragma unroll
        for (int b = 0; b < 2; ++b)
#pragma unroll
            for (int m = 0; m < 4; ++m)
#pragma unroll
                for (int n = 0; n < 2; ++n) acc[a][b][m][n] = (f32x4){0.f, 0.f, 0.f, 0.f};
    bf16x8 At[4][2], B0[2][2], B1[2][2];
    const char* cA = cur.A; const char* cB = cur.B;
    PG_STAGE(PG_SB(0, 0), cB, voffB); PG_STAGE(PG_SB(0, 1), cB + hstepB, voffB); PG_STAGE(PG_SA(0, 0), cA, voffA); PG_STAGE(PG_SA(0, 1), cA + hstepA, voffA);
    if (wr == 1) PG_BAR;
    PG_WAIT_V(2); PG_BAR;
    PG_STAGE(PG_SB(1, 0), cB + kstep, voffB); PG_STAGE(PG_SA(1, 0), cA + kstep, voffA); PG_STAGE(PG_SB(1, 1), cB + hstepB + kstep, voffB);
    PG_WAIT_V(6); PG_BAR;
    for (;;) {
        const bool has_next = (uidx + G < nunits);
        if (has_next) dec(uidx + G, nxt);
        const char* nA = has_next ? nxt.A : cA; const char* nB = has_next ? nxt.B : cB;
#pragma nounroll
        for (int t = 0; t < nt; t += 2) {
            const bool last = (t == nt - 2);
            const char* a1 = cA + (size_t)(t + 1) * kstep;
            const char* a2 = last ? nA : cA + (size_t)(t + 2) * kstep; const char* b2 = last ? nB : cB + (size_t)(t + 2) * kstep;
            const char* a3 = a2 + kstep; const char* b3 = b2 + kstep;
            PG_LDB(B0, 0, 0); PG_LDB(B1, 0, 1); PG_SCHED; PG_LDA(At, 0, 0); PG_STAGE(PG_SA(1, 1), a1 + hstepA, voffA);
            PG_WAIT_V(8); PG_WAIT_L(0); PG_BAR; PG_MMA(0, 0, At, B0); PG_MMA(0, 1, At, B1); PG_BAR; PG_SCHED;
            PG_LDA(At, 0, 1); PG_STAGE(PG_SB(0, 0), b2, voffB); PG_STAGE(PG_SB(0, 1), b2 + hstepB, voffB); PG_STAGE(PG_SA(0, 0), a2, voffA);
            PG_WAIT_V(8); PG_WAIT_L(0); PG_BAR; PG_MMA(1, 0, At, B0); PG_MMA(1, 1, At, B1); PG_BAR; PG_SCHED;
            PG_LDB(B0, 1, 0); PG_LDB(B1, 1, 1); PG_SCHED; PG_LDA(At, 1, 0); PG_STAGE(PG_SA(0, 1), a2 + hstepA, voffA);
            PG_WAIT_V(8); PG_WAIT_L(0); PG_BAR; PG_MMA(0, 0, At, B0); PG_MMA(0, 1, At, B1); PG_BAR; PG_SCHED;
            PG_LDA(At, 1, 1); PG_STAGE(PG_SB(1, 0), b3, voffB); PG_STAGE(PG_SB(1, 1), b3 + hstepB, voffB); PG_STAGE(PG_SA(1, 0), a3, voffA);
            PG_WAIT_V(8); PG_WAIT_L(0); PG_BAR; PG_MMA(1, 0, At, B0); PG_MMA(1, 1, At, B1); PG_BAR; PG_SCHED;
        }
        if (wr == 0) PG_BAR;
        E(acc, cur, wr, wc, fr, fq);
        if constexpr (EPI_REP > 1) E(acc, cur, wr, wc, fr, fq);
        if (!has_next) break;
        if constexpr (CHAIN) E.carry(acc, nxt);
        else {
#pragma unroll
        for (int a = 0; a < 2; ++a)
#pragma unroll
            for (int b = 0; b < 2; ++b)
#pragma unroll
                for (int m = 0; m < 4; ++m)
#pragma unroll
                    for (int n = 0; n < 2; ++n) acc[a][b][m][n] = (f32x4){0.f, 0.f, 0.f, 0.f};
        }
        cur = nxt; cA = nA; cB = nB; uidx += G;
        if (wr == 1) PG_BAR;
    }
    PG_WAIT_V(0);
    PG_BAR;
#undef PG_SA
#undef PG_SB
#undef PG_STAGE
#undef PG_LDA
#undef PG_LDB
#undef PG_MMA
#undef PG_WAIT_V
#undef PG_WAIT_L
#undef PG_BAR
#undef PG_SCHED
}
}
using pg::Unit;

enum { KQ = 0, KK = 1, KPL_SILU = 2, KPL_SCALE = 3, KPL_SIG = 4, KKT = 5, KVT = 6, KVNT = 7 };

struct DecInProj {
    const char* xb; const char* WinT;
    __device__ __forceinline__ void operator()(int u, Unit& o) const {
        if (u < 2048) {
            const int g = u >> 8, r = u & 255, x = r & 7, idx = r >> 3, pm = g * 8 + (idx & 7), j = ((x + g) & 7) * 4 + (idx >> 3);
            const int wt = j < 8 ? j : (j < 24 ? j + 8 : j + 12);
            o.A = xb + (size_t)pm * (256 * 1024 * 2); o.B = WinT + (size_t)wt * (256 * 1024 * 2); o.b = pm * 256; o.c = 0;
            if (wt < 4) { o.kind = KQ; o.a = wt; }
            else if (wt < 8) { o.kind = KK; o.a = wt - 4; }
            else if (wt < 24) { o.kind = KPL_SILU; o.a = (wt - 16) * 256; }
            else if (wt < 28) { o.kind = KPL_SCALE; o.a = (wt - 24) * 256; o.c = 0; }
            else if (wt < 32) { o.kind = KPL_SCALE; o.a = (wt - 28) * 256; o.c = 1; }
            else { o.kind = KPL_SIG; o.a = (wt - 36) * 256; }
        } else {
            const int v = u - 2048, g = v >> 8, r = v & 255, x = r & 7, idx = r >> 3, ci = ((x + g) & 3) * 4 + (idx >> 3), tt = (x >> 2) * 32 + g * 8 + (idx & 7);
            int ct;
            if (ci < 4) { ct = 4 + ci; o.kind = KKT; o.a = ci; o.c = 0; }
            else if (ci < 12) { ct = 8 + (ci - 4); o.kind = KVT; o.a = (ci - 4) >> 1; o.c = (ci - 4) & 1; }
            else { ct = 32 + (ci - 12); o.kind = KVNT; o.a = ci - 12; o.c = 0; }
            o.A = WinT + (size_t)ct * (256 * 1024 * 2); o.B = xb + (size_t)tt * (256 * 1024 * 2); o.b = tt * 256;
        }
    }
};
struct EpiInProj {
    unsigned char* ws_;
    const float* decay;
    __device__ __forceinline__ void operator()(const f32x4 (&acc)[2][2][4][2], const Unit& u, int wr, int wc, int fr, int fq) const {
        unsigned char* w = launder_s(ws_);
        bf16_t* const Q = (bf16_t*)(w + WS_Q); bf16_t* const Kb = (bf16_t*)(w + WS_K); bf16_t* const ACAT = (bf16_t*)(w + WS_ACAT); bf16_t* const BCAT = (bf16_t*)(w + WS_BCAT);
        bf16_t* const KDT = (bf16_t*)(w + WS_KDT); bf16_t* const SG = (bf16_t*)(w + WS_SG); bf16_t* const QN = (bf16_t*)(w + WS_QN); bf16_t* const KN = (bf16_t*)(w + WS_KN);
        bf16_t* const VNT = (bf16_t*)(w + WS_VNT); bf16_t* const Gt = (bf16_t*)(w + WS_G);
        const float* const cosN = (const float*)(w + WS_TAB); const float* const sinN = cosN + 4096 * 128; const float* const cosT = sinN + 4096 * 128; const float* const sinT = cosT + 4096 * 128;
        const int kind = u.kind, c8 = wc * 32 + fq * 8;
        if (kind == KQ || kind == KK) {
            const int h = u.a, t0 = u.b;
            float lf = 0.f, lb = 0.f;
            if (kind == KQ) { lf = log2_sigmoid(decay[h]); lb = log2_sigmoid(decay[4 + h]); }
#pragma unroll
            for (int ai = 0; ai < 2; ++ai)
#pragma unroll
                for (int m = 0; m < 4; ++m) {
                    const int t = t0 + ai * 128 + wr * 64 + m * 16 + fr, pos = t & 4095;
                    const float* cp = cosN + (size_t)pos * 128 + c8; const float* sp = sinN + (size_t)pos * 128 + c8;
                    const f32x4 c0 = *(const GAS f32x4*)cp, c1 = *(const GAS f32x4*)(cp + 4), s0 = *(const GAS f32x4*)sp, s1 = *(const GAS f32x4*)(sp + 4);
                    const f32x4 x1a = acc[ai][0][m][0], x1b = acc[ai][0][m][1], x2a = acc[ai][1][m][0], x2b = acc[ai][1][m][1];
                    f32x4 q1a = x1a * c0 - x2a * s0, q1b = x1b * c1 - x2b * s1, q2a = x1a * s0 + x2a * c0, q2b = x1b * s1 + x2b * c1;
                    if (kind == KQ) {
                        bf16_t* qp = Q + (size_t)t * 1024 + h * 256 + c8;
                        *(GAS u32x4*)qp = pack8(q1a, q1b); *(GAS u32x4*)(qp + 128) = pack8(q2a, q2b);
                        const int p = t & 511; const float df = fast_exp2(lf * (float)(p + 1)), db = fast_exp2(lb * (float)(512 - p));
                        bf16_t* ap = ACAT + ((size_t)t * 4 + h) * 1024 + 512 + c8;
                        *(GAS u32x4*)ap = pack8(q1a * df, q1b * df); *(GAS u32x4*)(ap + 128) = pack8(q2a * df, q2b * df);
                        *(GAS u32x4*)(ap + 256) = pack8(q1a * db, q1b * db); *(GAS u32x4*)(ap + 384) = pack8(q2a * db, q2b * db);
                    } else {
                        bf16_t* kp = Kb + (size_t)t * 1024 + h * 256 + c8;
                        *(GAS u32x4*)kp = pack8(q1a * 0.0625f, q1b * 0.0625f); *(GAS u32x4*)(kp + 128) = pack8(q2a * 0.0625f, q2b * 0.0625f);
                    }
                    __builtin_amdgcn_sched_barrier(0);
                }
        } else if (kind == KPL_SILU || kind == KPL_SCALE || kind == KPL_SIG) {
            const int t0 = u.b;
            bf16_t* dst; int ld; float sc = 1.f;
            if (kind == KPL_SILU) { dst = SG; ld = 2048; }
            else if (kind == KPL_SIG) { dst = Gt; ld = 2048; }
            else { ld = 1024; if (u.c == 0) { dst = QN; sc = 0.125f; } else { dst = KN; } }
            dst += u.a + c8;
#pragma unroll
            for (int ai = 0; ai < 2; ++ai)
#pragma unroll
                for (int m = 0; m < 4; ++m) {
                    const int t = t0 + ai * 128 + wr * 64 + m * 16 + fr;
#pragma unroll
                    for (int bj = 0; bj < 2; ++bj) {
                        f32x4 v0 = acc[ai][bj][m][0], v1 = acc[ai][bj][m][1];
                        if (kind == KPL_SCALE) { v0 = v0 * sc; v1 = v1 * sc; }
                        else {
#pragma unroll
                            for (int i = 0; i < 4; ++i) { const float g0 = sigmoid_f(v0[i]), g1 = sigmoid_f(v1[i]); v0[i] = (kind == KPL_SILU) ? v0[i] * g0 : g0; v1[i] = (kind == KPL_SILU) ? v1[i] * g1 : g1; }
                        }
                        *(GAS u32x4*)(dst + (size_t)t * ld + bj * 128) = pack8(v0, v1);
                    }
                }
        } else {
            const int t0 = u.b, bb = t0 >> 12, s0 = t0 & 4095, cc = s0 >> 9, j0 = s0 & 511;
            if (kind == KKT) {
                const int h = u.a;
                const float lf = log2_sigmoid(decay[h]), lb = log2_sigmoid(decay[4 + h]);
#pragma unroll
                for (int bj = 0; bj < 2; ++bj) {
                    const int col8 = bj * 128 + c8, s = s0 + col8, j = j0 + col8;
                    f32x4 df0, df1, db0, db1;
#pragma unroll
                    for (int i = 0; i < 4; ++i) { df0[i] = 0.0625f * fast_exp2(lf * (float)(511 - (j + i))); df1[i] = 0.0625f * fast_exp2(lf * (float)(511 - (j + 4 + i)));
                                                  db0[i] = 0.0625f * fast_exp2(lb * (float)(j + i)); db1[i] = 0.0625f * fast_exp2(lb * (float)(j + 4 + i)); }
#pragma unroll
                    for (int m = 0; m < 4; ++m) {
                        const int dl = wr * 64 + m * 16 + fr;
                        const float* cp = cosT + (size_t)dl * 4096 + s; const float* sp = sinT + (size_t)dl * 4096 + s;
                        const f32x4 c0 = *(const GAS f32x4*)cp, c1 = *(const GAS f32x4*)(cp + 4), sn0 = *(const GAS f32x4*)sp, sn1 = *(const GAS f32x4*)(sp + 4);
                        const f32x4 x1a = acc[0][bj][m][0], x1b = acc[0][bj][m][1], x2a = acc[1][bj][m][0], x2b = acc[1][bj][m][1];
                        const f32x4 k1a = x1a * c0 - x2a * sn0, k1b = x1b * c1 - x2b * sn1, k2a = x1a * sn0 + x2a * c0, k2b = x1b * sn1 + x2b * c1;
                        bf16_t* kp = KDT + ((((size_t)(bb * 4 + h) * 8 + cc) * 2) * 256 + dl) * 512 + j;
                        *(GAS u32x4*)kp = pack8(k1a * df0, k1b * df1); *(GAS u32x4*)(kp + 128 * 512) = pack8(k2a * df0, k2b * df1);
                        *(GAS u32x4*)(kp + 256 * 512) = pack8(k1a * db0, k1b * db1); *(GAS u32x4*)(kp + 384 * 512) = pack8(k2a * db0, k2b * db1);
                        __builtin_amdgcn_sched_barrier(0);
                    }
                }
            } else if (kind == KVT) {
                const int h = u.a;
#pragma unroll
                for (int ai = 0; ai < 2; ++ai)
#pragma unroll
                    for (int m = 0; m < 4; ++m) {
                        const int e = u.c * 256 + ai * 128 + wr * 64 + m * 16 + fr;
                        bf16_t* vp = BCAT + (((size_t)(bb * 4 + h) * 8 + cc) * 512 + e) * 1024 + j0 + c8;
#pragma unroll
                        for (int bj = 0; bj < 2; ++bj) *(GAS u32x4*)(vp + bj * 128) = pack8(acc[ai][bj][m][0], acc[ai][bj][m][1]);
                    }
            } else {
#pragma unroll
                for (int ai = 0; ai < 2; ++ai)
#pragma unroll
                    for (int m = 0; m < 4; ++m) {
                        const int ch = u.a * 256 + ai * 128 + wr * 64 + m * 16 + fr;
                        bf16_t* vp = VNT + ((size_t)bb * 1024 + ch) * 4096 + s0 + c8;
#pragma unroll
                        for (int bj = 0; bj < 2; ++bj) *(GAS u32x4*)(vp + bj * 128) = pack8(acc[ai][bj][m][0], acc[ai][bj][m][1]);
                    }
            }
        }
    }
};

struct DecR1 {
    const char* Q; const char* Kb;
    __device__ __forceinline__ void operator()(int u, Unit& o) const {
        const int pn2 = u & 1, pm2 = (u >> 1) & 1, cc = (u >> 2) & 7, bh = u >> 5, b = bh >> 2, h = bh & 3;
        const int ti = b * 4096 + cc * 512 + pm2 * 256, tj = b * 4096 + cc * 512 + pn2 * 256;
        o.A = Q + ((size_t)ti * 1024 + h * 256) * 2; o.B = Kb + ((size_t)tj * 1024 + h * 256) * 2;
        o.kind = 0; o.a = h; o.b = ti; o.c = pm2 * 2 + pn2;
    }
};
struct EpiR1 {
    bf16_t* ACAT; const float* decay;
    __device__ __forceinline__ void operator()(const f32x4 (&acc)[2][2][4][2], const Unit& u, int wr, int wc, int fr, int fq) const {
        const int h = u.a, ti0 = u.b, i0 = (u.c >> 1) * 256, j0 = (u.c & 1) * 256, c8 = wc * 32 + fq * 8;
        const float lf = log2_sigmoid(decay[h]), lb = log2_sigmoid(decay[4 + h]);
#pragma unroll
        for (int ai = 0; ai < 2; ++ai)
#pragma unroll
            for (int m = 0; m < 4; ++m) {
                const int r = ai * 128 + wr * 64 + m * 16 + fr, i = i0 + r;
                bf16_t* ap = ACAT + ((size_t)(ti0 + r) * 4 + h) * 1024 + j0 + c8;
#pragma unroll
                for (int bj = 0; bj < 2; ++bj) {
                    f32x4 v0 = acc[ai][bj][m][0], v1 = acc[ai][bj][m][1];
                    const int jb = j0 + bj * 128 + c8;
#pragma unroll
                    for (int q = 0; q < 4; ++q) {
                        const int d0 = i - (jb + q), d1 = i - (jb + 4 + q);
                        v0[q] *= fast_exp2(d0 >= 0 ? lf * (float)d0 : lb * (float)(-d0));
                        v1[q] *= fast_exp2(d1 >= 0 ? lf * (float)d1 : lb * (float)(-d1));
                    }
                    *(GAS u32x4*)(ap + bj * 128) = pack8(v0, v1);
                }
                __builtin_amdgcn_sched_barrier(0);
            }
    }
};
struct DecR2c {
    const char* BCAT; const char* KDT;
    __device__ __forceinline__ void operator()(int u, Unit& o) const {
        const int ch = u & 63, i = u >> 6, pm2 = ch & 1, dir = (ch >> 1) & 1, bh = ch >> 2;
        const int cs = dir ? 7 - i : i, ct = dir ? 6 - i : i + 1;
        o.A = BCAT + (((size_t)(bh * 8 + cs) * 512 + pm2 * 256) * 1024) * 2;
        o.B = KDT + ((((size_t)(bh * 8 + cs) * 2 + dir) * 256) * 512) * 2;
        o.kind = i; o.a = (bh * 8 + ct) * 512 + pm2 * 256; o.b = dir; o.c = dir * 4 + (bh & 3);
    }
};
struct EpiR2c {
    bf16_t* BCAT; const float* decay;
    __device__ __forceinline__ void carry(f32x4 (&acc)[2][2][4][2], const Unit& nx) const {
        const float cd = fast_exp2(log2_sigmoid(decay[nx.c]) * 512.0f);
#pragma unroll
        for (int a = 0; a < 2; ++a)
#pragma unroll
            for (int b = 0; b < 2; ++b)
#pragma unroll
                for (int m = 0; m < 4; ++m)
#pragma unroll
                    for (int n = 0; n < 2; ++n) acc[a][b][m][n] = acc[a][b][m][n] * cd;
    }
    __device__ __forceinline__ void operator()(const f32x4 (&acc)[2][2][4][2], const Unit& u, int wr, int wc, int fr, int fq) const {
        const int c8 = wc * 32 + fq * 8, dir = u.b;
#pragma unroll
        for (int ai = 0; ai < 2; ++ai)
#pragma unroll
            for (int m = 0; m < 4; ++m) {
                const int row = ai * 128 + wr * 64 + m * 16 + fr;
                bf16_t* sp = BCAT + ((size_t)u.a + row) * 1024 + 512 + dir * 256 + c8;
#pragma unroll
                for (int bj = 0; bj < 2; ++bj) *(GAS u32x4*)(sp + bj * 128) = pack8(acc[ai][bj][m][0], acc[ai][bj][m][1]);
                if (u.kind == 0) {
                    bf16_t* zp = dir ? sp + (size_t)512 * 1024 : sp - (size_t)512 * 1024;
                    const u32x4 z = {0u, 0u, 0u, 0u};
#pragma unroll
                    for (int bj = 0; bj < 2; ++bj) *(GAS u32x4*)(zp + bj * 128) = z;
                }
            }
    }
};
struct DecR4 {
    const char* ACAT; const char* BCAT;
    __device__ __forceinline__ void operator()(int u, Unit& o) const {
        const int pn2 = u & 1, pm2 = (u >> 1) & 1, cc = (u >> 2) & 7, bh = u >> 5, b = bh >> 2, h = bh & 3;
        const int ti = b * 4096 + cc * 512 + pm2 * 256;
        o.A = ACAT + (((size_t)ti * 4 + h) * 1024) * 2; o.B = BCAT + (((size_t)(bh * 8 + cc) * 512 + pn2 * 256) * 1024) * 2;
        o.kind = 0; o.a = h * 512 + pn2 * 256; o.b = ti; o.c = 0;
    }
};
struct EpiR4 {
    bf16_t* RET;
    __device__ __forceinline__ void operator()(const f32x4 (&acc)[2][2][4][2], const Unit& u, int wr, int wc, int fr, int fq) const {
        const int c8 = wc * 32 + fq * 8;
#pragma unroll
        for (int ai = 0; ai < 2; ++ai)
#pragma unroll
            for (int m = 0; m < 4; ++m) {
                const int t = u.b + ai * 128 + wr * 64 + m * 16 + fr;
                bf16_t* rp = RET + (size_t)t * 2048 + u.a + c8;
#pragma unroll
                for (int bj = 0; bj < 2; ++bj) *(GAS u32x4*)(rp + bj * 128) = pack8(acc[ai][bj][m][0], acc[ai][bj][m][1]);
            }
    }
};
struct DecDense {
    const char* A; const char* B; int lda2, ldb2;
    __device__ __forceinline__ void operator()(int u, Unit& o) const {
        const int pn = u >> 6, pm = u & 63;
        o.A = A + (size_t)pm * 256 * lda2; o.B = B + (size_t)pn * 256 * ldb2; o.kind = 0; o.a = pn * 256; o.b = pm * 256; o.c = 0;
    }
};
template <int MODE> struct EpiMerge {
    bf16_t* MG; const bf16_t* Gt;
    __device__ __forceinline__ void operator()(const f32x4 (&acc)[2][2][4][2], const Unit& u, int wr, int wc, int fr, int fq) const {
        const int c8 = wc * 32 + fq * 8;
#pragma unroll
        for (int ai = 0; ai < 2; ++ai)
#pragma unroll
            for (int m = 0; m < 4; ++m) {
                const int t = u.b + ai * 128 + wr * 64 + m * 16 + fr;
#pragma unroll
                for (int bj = 0; bj < 2; ++bj) {
                    const int c = u.a + bj * 128 + c8;
                    const u32x4 g = *(const GAS u32x4*)(Gt + (size_t)t * 2048 + MODE * 1024 + c);
                    f32x4 v0 = acc[ai][bj][m][0], v1 = acc[ai][bj][m][1];
                    v0[0] *= bf_lo(g.x); v0[1] *= bf_hi(g.x); v0[2] *= bf_lo(g.y); v0[3] *= bf_hi(g.y);
                    v1[0] *= bf_lo(g.z); v1[1] *= bf_hi(g.z); v1[2] *= bf_lo(g.w); v1[3] *= bf_hi(g.w);
                    bf16_t* mp = MG + (size_t)t * 1024 + c;
                    if (MODE == 1) { const u32x4 o = *(const GAS u32x4*)mp;
                        v0[0] += bf_lo(o.x); v0[1] += bf_hi(o.x); v0[2] += bf_lo(o.y); v0[3] += bf_hi(o.y);
                        v1[0] += bf_lo(o.z); v1[1] += bf_hi(o.z); v1[2] += bf_lo(o.w); v1[3] += bf_hi(o.w); }
                    *(GAS u32x4*)mp = pack8(v0, v1);
                }
            }
    }
};
struct EpiPre {
    float* PRE; const float* xin;
    __device__ __forceinline__ void operator()(const f32x4 (&acc)[2][2][4][2], const Unit& u, int wr, int wc, int fr, int fq) const {
        const int c8 = wc * 32 + fq * 8;
#pragma unroll
        for (int ai = 0; ai < 2; ++ai)
#pragma unroll
            for (int m = 0; m < 4; ++m) {
                const int t = u.b + ai * 128 + wr * 64 + m * 16 + fr;
#pragma unroll
                for (int bj = 0; bj < 2; ++bj) {
                    const size_t o = (size_t)t * 1024 + u.a + bj * 128 + c8;
                    const f32x4 x0 = *(const GAS f32x4*)(xin + o), x1 = *(const GAS f32x4*)(xin + o + 4);
                    *(GAS f32x4*)(PRE + o) = x0 * ALPHA + acc[ai][bj][m][0]; *(GAS f32x4*)(PRE + o + 4) = x1 * ALPHA + acc[ai][bj][m][1];
                }
            }
    }
};
struct DecMoe {
    const char* A; const char* W; int lda2, wexp2, ldb2; const LAS int* tile_e;
    __device__ __forceinline__ void operator()(int u, Unit& o) const {
        const int a = u >> 2, pn = u & 3, e = tile_e[a];
        o.A = A + (size_t)a * 256 * lda2; o.B = W + (size_t)e * wexp2 + (size_t)pn * 256 * ldb2; o.kind = 0; o.a = pn; o.b = a * 256; o.c = 0;
    }
};
struct EpiUp {
    bf16_t* H;
    __device__ __forceinline__ void operator()(const f32x4 (&acc)[2][2][4][2], const Unit& u, int wr, int wc, int fr, int fq) const {
        const int c8 = wc * 32 + fq * 8;
#pragma unroll
        for (int ai = 0; ai < 2; ++ai)
#pragma unroll
            for (int m = 0; m < 4; ++m) {
                const int r = u.b + ai * 128 + wr * 64 + m * 16 + fr;
                f32x4 g0 = acc[ai][0][m][0], g1 = acc[ai][0][m][1]; const f32x4 u0 = acc[ai][1][m][0], u1 = acc[ai][1][m][1];
#pragma unroll
                for (int i = 0; i < 4; ++i) { g0[i] = g0[i] * sigmoid_f(g0[i]) * u0[i]; g1[i] = g1[i] * sigmoid_f(g1[i]) * u1[i]; }
                *(GAS u32x4*)(H + (size_t)r * 512 + u.a * 128 + c8) = pack8(g0, g1);
            }
    }
};
struct EpiDown {
    bf16_t* Y;
    __device__ __forceinline__ void operator()(const f32x4 (&acc)[2][2][4][2], const Unit& u, int wr, int wc, int fr, int fq) const {
        const int c8 = wc * 32 + fq * 8;
#pragma unroll
        for (int ai = 0; ai < 2; ++ai)
#pragma unroll
            for (int m = 0; m < 4; ++m) {
                const int r = u.b + ai * 128 + wr * 64 + m * 16 + fr;
                bf16_t* yp = Y + (size_t)r * 1024 + u.a * 256 + c8;
#pragma unroll
                for (int bj = 0; bj < 2; ++bj) *(GAS u32x4*)(yp + bj * 128) = pack8(acc[ai][bj][m][0], acc[ai][bj][m][1]);
            }
    }
};

__device__ __forceinline__ void tr_item(const float* W, int ldw, bf16_t* WT, int ldwt, int k0, int n0, int drow0, LAS float* scr, int lane) {
#pragma unroll 8
    for (int i = 0; i < 32; ++i) { const int kk = 2 * i + (lane >> 5); scr[kk * 33 + (lane & 31)] = ((const GAS float*)W)[(size_t)(k0 + kk) * ldw + n0 + (lane & 31)]; }
    LDS_WAIT();
    const int c = lane & 7;
#pragma unroll
    for (int j = 0; j < 4; ++j) { const int n = (lane >> 3) + 8 * j; const LAS float* s = scr + (8 * c) * 33 + n;
        u32x4 o; o.x = cvt_pk_bf16(s[0 * 33], s[1 * 33]); o.y = cvt_pk_bf16(s[2 * 33], s[3 * 33]); o.z = cvt_pk_bf16(s[4 * 33], s[5 * 33]); o.w = cvt_pk_bf16(s[6 * 33], s[7 * 33]);
        *(GAS u32x4*)(WT + (size_t)(drow0 + n) * ldwt + k0 + 8 * c) = o; }
    LDS_WAIT();
}
struct Params {
    const float* x; const float* w_in; const float* decay; const float* w_ret_o; const float* rpb; const float* w_na_o; const float* w_out;
    const float* ln_mix_g; const float* ln_mix_b; const float* router_w; const float* router_bias;
    const float* w_gate; const float* w_up; const float* w_down; const float* ln_ffn_g; const float* ln_ffn_b;
    float* out; unsigned char* ws; int ph_lo, ph_hi;
};
__device__ __forceinline__ Params load_params() {
    typedef __attribute__((address_space(4))) const Params CP;
    CP* pk = (CP*)__builtin_amdgcn_kernarg_segment_ptr();
    asm volatile("" : "+s"(pk));
    Params r;
    r.x = pk->x; r.w_in = pk->w_in; r.decay = pk->decay; r.w_ret_o = pk->w_ret_o; r.rpb = pk->rpb; r.w_na_o = pk->w_na_o; r.w_out = pk->w_out;
    r.ln_mix_g = pk->ln_mix_g; r.ln_mix_b = pk->ln_mix_b; r.router_w = pk->router_w; r.router_bias = pk->router_bias;
    r.w_gate = pk->w_gate; r.w_up = pk->w_up; r.w_down = pk->w_down; r.ln_ffn_g = pk->ln_ffn_g; r.ln_ffn_b = pk->ln_ffn_b;
    r.out = pk->out; r.ws = pk->ws; r.ph_lo = pk->ph_lo; r.ph_hi = pk->ph_hi;
    return r;
}
__device__ __forceinline__ void convert_layer(const Params& P, int l, LAS unsigned char* lds, int gw, int NGW, int wave, int lane) {
    LAS float* scr = (LAS float*)(lds + wave * 16384);
    unsigned char* ws = P.ws;
    constexpr int I0 = 16 * 352, I1 = 32 * 32, I2 = 16 * 32, I3 = 16 * 32, I4 = 32 * 256, I5 = 32 * 256, I6 = 32 * 256;
    constexpr int NIT = I0 + I1 + I2 + I3 + I4 + I5 + I6;
    for (int it = gw; it < NIT; it += NGW) {
        int r = it;
        if (r < I0) { const int kb = r / 352, nb = r % 352; tr_item(P.w_in + (size_t)l * 1024 * DIN, DIN, (bf16_t*)(ws + WS_WIN), 1024, kb * 64, nb * 32, nb * 32, scr, lane); continue; } r -= I0;
        if (r < I1) { const int kb = r >> 5, nb = r & 31; tr_item(P.w_ret_o + (size_t)l * 2048 * 1024, 1024, (bf16_t*)(ws + WS_WRET), 2048, kb * 64, nb * 32, nb * 32, scr, lane); continue; } r -= I1;
        if (r < I2) { const int kb = r >> 5, nb = r & 31; tr_item(P.w_na_o + (size_t)l * 1024 * 1024, 1024, (bf16_t*)(ws + WS_WNA), 1024, kb * 64, nb * 32, nb * 32, scr, lane); continue; } r -= I2;
        if (r < I3) { const int kb = r >> 5, nb = r & 31; tr_item(P.w_out + (size_t)l * 1024 * 1024, 1024, (bf16_t*)(ws + WS_WOUT), 1024, kb * 64, nb * 32, nb * 32, scr, lane); continue; } r -= I3;
        if (r < I4 + I5) { const int up = r >= I4 ? 1 : 0; if (up) r -= I4; const int e = r >> 8, q = r & 255, kb = q >> 4, nb = q & 15, n0 = nb * 32;
            const float* src = (up ? P.w_up : P.w_gate) + ((size_t)l * NE + e) * 1024 * 512;
            tr_item(src, 512, (bf16_t*)(ws + WS_WGU), 1024, kb * 64, n0, e * 1024 + (n0 >> 7) * 256 + up * 128 + (n0 & 127), scr, lane); continue; } r -= I4 + I5;
        { const int e = r >> 8, q = r & 255, kb = q >> 5, nb = q & 31;
          tr_item(P.w_down + ((size_t)l * NE + e) * 512 * 1024, 1024, (bf16_t*)(ws + WS_WD), 512, kb * 64, nb * 32, e * 1024 + nb * 32, scr, lane); }
    }
}
__device__ __forceinline__ void sincos_d(double a, float& s, float& c) {
    const double k = rint(a * 0.63661977236758134308);
    double y = fma(-k, 1.5707963267948966192, a); y = fma(-k, 6.123233995736766036e-17, y);
    const double y2 = y * y;
    double sp = -1.0 / 1307674368000.0; sp = fma(sp, y2, 1.0 / 6227020800.0); sp = fma(sp, y2, -1.0 / 39916800.0); sp = fma(sp, y2, 1.0 / 362880.0); sp = fma(sp, y2, -1.0 / 5040.0); sp = fma(sp, y2, 1.0 / 120.0); sp = fma(sp, y2, -1.0 / 6.0); sp = fma(sp * y2, y, y);
    double cp = 1.0 / 20922789888000.0; cp = fma(cp, y2, -1.0 / 87178291200.0); cp = fma(cp, y2, 1.0 / 479001600.0); cp = fma(cp, y2, -1.0 / 3628800.0); cp = fma(cp, y2, 1.0 / 40320.0); cp = fma(cp, y2, -1.0 / 720.0); cp = fma(cp, y2, 1.0 / 24.0); cp = fma(cp, y2, -0.5); cp = fma(cp, y2, 1.0);
    const int q = (int)((long long)k & 3);
    const double sv = (q == 0) ? sp : (q == 1) ? cp : (q == 2) ? -sp : -cp;
    const double cv = (q == 0) ? cp : (q == 1) ? -sp : (q == 2) ? -cp : sp;
    s = (float)sv; c = (float)cv;
}
__device__ __forceinline__ void phase_init(const Params& P, LAS unsigned char* lds, int gw, int NGW, int wave, int lane) {
    unsigned char* ws = P.ws;
    float* cosN = (float*)(ws + WS_TAB); float* sinN = cosN + 4096 * 128; float* cosT = sinN + 4096 * 128; float* sinT = cosT + 4096 * 128;
    const int gtid = gw * 64 + lane, NT_ = NGW * 64;
    for (int i = gtid; i < 4096 * 128; i += NT_) {
        const int pos = i >> 7, j = i & 127;
        const double freq = exp(-(double)j * (9.210340371976184 / 128.0));
        float s, c; sincos_d((double)pos * freq, s, c);
        cosN[i] = c; sinN[i] = s; cosT[(size_t)j * 4096 + pos] = c; sinT[(size_t)j * 4096 + pos] = s;
    }
    bf16_t* wrt = (bf16_t*)(ws + WS_WRT);
    for (int i = gtid; i < 32 * 1024; i += NT_) {
        const int e = i >> 10, d = i & 1023; const float w = ((const GAS float*)P.router_w)[d * 32 + e];
        const unsigned h = cvt_pk_bf16(w, 0.f) & 0xffffu; const unsigned lo = cvt_pk_bf16(w - bf_lo(h), 0.f) & 0xffffu;
        wrt[i] = (bf16_t)h; wrt[32 * 1024 + i] = (bf16_t)lo;
    }
    bf16_t* xb = (bf16_t*)(ws + WS_XB);
    for (int i = gtid; i < T * D / 8; i += NT_) {
        const f32x4 a = *(const GAS f32x4*)(P.x + (size_t)i * 8), b = *(const GAS f32x4*)(P.x + (size_t)i * 8 + 4);
        *(GAS u32x4*)(xb + (size_t)i * 8) = pack8(a, b);
    }
    convert_layer(P, 0, lds, gw, NGW, wave, lane);
}
__device__ __forceinline__ void phase_prefix(const Params& P, int l, int gw, int NGW, int lane) {
    const float* KV = (const float*)(P.ws + WS_KV); bf16_t* BCAT = (bf16_t*)(P.ws + WS_BCAT);
    const float* decay = P.decay + l * 8;
    const int gtid = gw * 64 + lane, NT_ = NGW * 64;
    for (int idx = gtid; idx < 16 * 2 * 512 * 32; idx += NT_) {
        const int dg = idx & 31, e = (idx >> 5) & 511, dir = (idx >> 14) & 1, bh = idx >> 15, h = bh & 3;
        const float cd = fast_exp2(log2_sigmoid(decay[dir * 4 + h]) * 512.0f);
        f32x4 s0 = {0.f, 0.f, 0.f, 0.f}, s1 = {0.f, 0.f, 0.f, 0.f};
        for (int q = 0; q < 8; ++q) {
            const int cc = dir ? 7 - q : q;
            *(GAS u32x4*)(BCAT + ((size_t)(bh * 8 + cc) * 512 + e) * 1024 + 512 + dir * 256 + dg * 8) = pack8(s0, s1);
            if (q < 7) { const float* kp = KV + ((size_t)((bh * 8 + cc) * 2 + dir) * 512 + e) * 256 + dg * 8;
                s0 = s0 * cd + *(const GAS f32x4*)kp; s1 = s1 * cd + *(const GAS f32x4*)(kp + 4); }
        }
    }
}
__device__ __forceinline__ void phase_headnorm(const Params& P, int gw, int NGW, int lane) {
    const bf16_t* RET = (const bf16_t*)(P.ws + WS_KV); const bf16_t* SG = (const bf16_t*)(P.ws + WS_SG); bf16_t* AR = (bf16_t*)(P.ws + WS_KDT);
    for (int it = gw; it < T * 4; it += NGW) {
        const size_t off = (size_t)it * 512 + lane * 8;
        const u32x4 r = *(const GAS u32x4*)(RET + off), g = *(const GAS u32x4*)(SG + off);
        float v[8] = {bf_lo(r.x), bf_hi(r.x), bf_lo(r.y), bf_hi(r.y), bf_lo(r.z), bf_hi(r.z), bf_lo(r.w), bf_hi(r.w)};
        float s = 0.f;
#pragma unroll
        for (int i = 0; i < 8; ++i) s += v[i];
        const float mean = wave_sum(s) * (1.0f / 512.0f);
        float q = 0.f;
#pragma unroll
        for (int i = 0; i < 8; ++i) { v[i] -= mean; q += v[i] * v[i]; }
        const float rstd = 1.0f / sqrtf(wave_sum(q) * (1.0f / 512.0f) + 1e-5f);
        const float gg[8] = {bf_lo(g.x), bf_hi(g.x), bf_lo(g.y), bf_hi(g.y), bf_lo(g.z), bf_hi(g.z), bf_lo(g.w), bf_hi(g.w)};
        u32x4 o; o.x = cvt_pk_bf16(v[0] * rstd * gg[0], v[1] * rstd * gg[1]); o.y = cvt_pk_bf16(v[2] * rstd * gg[2], v[3] * rstd * gg[3]);
        o.z = cvt_pk_bf16(v[4] * rstd * gg[4], v[5] * rstd * gg[5]); o.w = cvt_pk_bf16(v[6] * rstd * gg[6], v[7] * rstd * gg[7]);
        *(GAS u32x4*)(AR + off) = o;
    }
}
__device__ __forceinline__ void phase_na(const Params& P, int l, int gw, int NGW, int lane) {
    const bf16_t* QN = (const bf16_t*)(P.ws + WS_QN); const bf16_t* KN = (const bf16_t*)(P.ws + WS_KN); const bf16_t* VNT = (const bf16_t*)(P.ws + WS_VNT);
    bf16_t* NAO = (bf16_t*)(P.ws + WS_NAO);
    const float* rpb = P.rpb + (size_t)l * 16 * 15 * 31;
    const int fr = lane & 15, fq = lane >> 4;
    for (int id = gw; id < 16384; id += NGW) {
        const int cb = id & 3, r = (id >> 2) & 63, h = (id >> 8) & 15, b = id >> 12;
        const int rs = min(max(r - 4, 0), 56), c0 = cb * 16, cs = min(max(c0 - 8, 0), 32);
        const int c = c0 + fr, cst = min(max(c - 8, 0), 48);
        const size_t tq = (size_t)b * 4096 + r * 64 + c;
        const bf16x8 yq0 = *(const GAS bf16x8*)(QN + tq * 1024 + h * 64 + 8 * fq), yq1 = *(const GAS bf16x8*)(QN + tq * 1024 + h * 64 + 32 + 8 * fq);
        f32x4 S[16];
#pragma unroll
        for (int kt = 0; kt < 16; ++kt) {
            const int kr = rs + (kt >> 1), kcb = cs + (kt & 1) * 16;
            const size_t tk = (size_t)b * 4096 + kr * 64 + kcb + fr;
            const bf16x8 xk0 = *(const GAS bf16x8*)(KN + tk * 1024 + h * 64 + 8 * fq), xk1 = *(const GAS bf16x8*)(KN + tk * 1024 + h * 64 + 32 + 8 * fq);
            f32x4 z = {0.f, 0.f, 0.f, 0.f};
            z = __builtin_amdgcn_mfma_f32_16x16x32_bf16(xk0, yq0, z, 0, 0, 0);
            z = __builtin_amdgcn_mfma_f32_16x16x32_bf16(xk1, yq1, z, 0, 0, 0);
            const float* bp = rpb + (h * 15 + (kr - r + 7)) * 31;
#pragma unroll
            for (int j = 0; j < 4; ++j) {
                const int kc = kcb + 4 * fq + j; const bool valid = (kc >= cst) && (kc < cst + 16);
                const int co = min(max(kc - c + 15, 0), 30);
                const float bias = ((const GAS float*)bp)[co];
                z[j] = valid ? z[j] + bias : -INFINITY;
            }
            S[kt] = z;
        }
        float mx = -INFINITY;
#pragma unroll
        for (int kt = 0; kt < 16; ++kt)
#pragma unroll
            for (int j = 0; j < 4; ++j) mx = fmaxf(mx, S[kt][j]);
        mx = fmaxf(mx, __shfl_xor(mx, 16)); mx = fmaxf(mx, __shfl_xor(mx, 32));
        float sum = 0.f;
#pragma unroll
        for (int kt = 0; kt < 16; ++kt)
#pragma unroll
            for (int j = 0; j < 4; ++j) { const float p = fast_exp2((S[kt][j] - mx) * LOG2E); S[kt][j] = p; sum += p; }
        sum += __shfl_xor(sum, 16); sum += __shfl_xor(sum, 32);
        f32x4 O[4];
#pragma unroll
        for (int ht = 0; ht < 4; ++ht) O[ht] = (f32x4){0.f, 0.f, 0.f, 0.f};
#pragma unroll
        for (int p = 0; p < 8; ++p) {
            const u32x4 yw = pack8(S[2 * p], S[2 * p + 1]);
            const bf16x8 yp = __builtin_bit_cast(bf16x8, yw);
            const size_t sk = (size_t)(rs + p) * 64 + cs + 4 * fq;
#pragma unroll
            for (int ht = 0; ht < 4; ++ht) {
                const bf16_t* vp = VNT + ((size_t)b * 1024 + h * 64 + ht * 16 + fr) * 4096 + sk;
                const u32x2 lo = *(const GAS u32x2*)vp, hi = *(const GAS u32x2*)(vp + 16);
                const u32x4 xw = {lo.x, lo.y, hi.x, hi.y};
                O[ht] = __builtin_amdgcn_mfma_f32_16x16x32_bf16(__builtin_bit_cast(bf16x8, xw), yp, O[ht], 0, 0, 0);
            }
        }
        const float inv = 1.0f / sum;
#pragma unroll
        for (int ht = 0; ht < 4; ++ht) *(GAS u32x2*)(NAO + tq * 1024 + h * 64 + ht * 16 + 4 * fq) = pack4(O[ht] * inv);
    }
}
constexpr int LM_BIAS = 4096;
__device__ __forceinline__ void phase_na2(const Params& P, int l, LAS unsigned char* lds, int tid, int wave, int lane, int vG, int vbid) {
    const bf16_t* QN = (const bf16_t*)(P.ws + WS_QN); const bf16_t* KN = (const bf16_t*)(P.ws + WS_KN); const bf16_t* VNT = (const bf16_t*)(P.ws + WS_VNT);
    bf16_t* NAO = (bf16_t*)(P.ws + WS_NAO);
    const float* rpb = P.rpb + (size_t)l * 16 * 15 * 31;
    LAS unsigned char* Ks = lds; LAS unsigned char* Vs = lds + 65536;
    LAS float* bias_s = (LAS float*)(lds + LDS_MISC + LM_BIAS);
    const int fr = lane & 15, fq = lane >> 4;
    const int prow = tid >> 3, pc = (tid & 7) ^ ((prow >> 1) & 7);
#define NA_BAR() do { asm volatile("s_waitcnt lgkmcnt(0)" ::: "memory"); __builtin_amdgcn_s_barrier(); asm volatile("" ::: "memory"); } while (0)
#define NA_LOAD_K(kr) __builtin_amdgcn_global_load_lds((const unsigned*)(kbase + ((size_t)((kr) * 64 + prow)) * 2048 + pc * 16), (LAS unsigned*)(Ks + ((kr) & 7) * 8192 + wave * 1024), 16, 0, 0)
#define NA_LOAD_V(kr) __builtin_amdgcn_global_load_lds((const unsigned*)(vbase + (size_t)prow * 8192 + (kr) * 128 + pc * 16), (LAS unsigned*)(Vs + ((kr) & 7) * 8192 + wave * 1024), 16, 0, 0)
    for (int bu = launder_si(vbid); bu < 256; bu += vG) {
        const int sg = bu & 3, h = (bu >> 2) & 15, b = bu >> 6;
        const char* kbase = (const char*)(KN + (size_t)b * 4096 * 1024 + h * 64);
        const char* vbase = (const char*)(VNT + ((size_t)b * 1024 + h * 64) * 4096);
        asm volatile("s_waitcnt vmcnt(0)" ::: "memory"); NA_BAR();
        for (int i = tid; i < 465; i += 512) bias_s[i] = ((const GAS float*)rpb)[h * 465 + i];
        const int r0 = sg * 16, rs0 = min(max(r0 - 4, 0), 56);
#pragma unroll
        for (int q = 0; q < 8; ++q) { NA_LOAD_K(rs0 + q); NA_LOAD_V(rs0 + q); }
        const int cb = wave & 3, c0 = cb * 16, cs = min(max(c0 - 8, 0), 32), c = c0 + fr, cst = min(max(c - 8, 0), 48);
        bf16x8 yq0, yq1;
        { const size_t tq = (size_t)b * 4096 + r0 * 64 + c; yq0 = *(const GAS bf16x8*)(QN + tq * 1024 + h * 64 + 8 * fq); yq1 = *(const GAS bf16x8*)(QN + tq * 1024 + h * 64 + 32 + 8 * fq); }
#pragma nounroll
        for (int r = r0; r < r0 + 16; ++r) {
            const int rs = min(max(r - 4, 0), 56), rsn = min(max(r - 3, 0), 56);
            const bool mv = (r + 1 < r0 + 16) && (rsn != rs);
            asm volatile("s_waitcnt vmcnt(0)" ::: "memory"); NA_BAR();
            const bf16x8 q0 = yq0, q1 = yq1;
            const size_t tq = (size_t)b * 4096 + r * 64 + c;
            if (r + 1 < r0 + 16) { const size_t tn = tq + 64; yq0 = *(const GAS bf16x8*)(QN + tn * 1024 + h * 64 + 8 * fq); yq1 = *(const GAS bf16x8*)(QN + tn * 1024 + h * 64 + 32 + 8 * fq); }
            f32x4 S[16];
            if (wave < 4) {
#pragma unroll
                for (int kt = 0; kt < 16; ++kt) {
                    const int kr = rs + (kt >> 1), kcb = cs + (kt & 1) * 16, key = kcb + fr;
                    const LAS unsigned char* kp = Ks + (kr & 7) * 8192 + key * 128; const int sw = (key >> 1) & 7;
                    const bf16x8 xk0 = *(const LAS bf16x8*)(kp + ((fq ^ sw) << 4)), xk1 = *(const LAS bf16x8*)(kp + (((4 + fq) ^ sw) << 4));
                    f32x4 z = {0.f, 0.f, 0.f, 0.f};
                    z = __builtin_amdgcn_mfma_f32_16x16x32_bf16(xk0, q0, z, 0, 0, 0);
                    z = __builtin_amdgcn_mfma_f32_16x16x32_bf16(xk1, q1, z, 0, 0, 0);
                    const LAS float* bp = bias_s + (kr - r + 7) * 31;
#pragma unroll
                    for (int j = 0; j < 4; ++j) {
                        const int kc = kcb + 4 * fq + j; const bool valid = (kc >= cst) && (kc < cst + 16);
                        const int co = min(max(kc - c + 15, 0), 30);
                        z[j] = valid ? z[j] + bp[co] : -INFINITY;
                    }
                    S[kt] = z;
                }
            }
            NA_BAR();
            if (mv) NA_LOAD_K(rs + 8);
            f32x4 O[4]; float inv = 0.f;
            if (wave < 4) {
                float mx = -INFINITY;
#pragma unroll
                for (int kt = 0; kt < 16; ++kt)
#pragma unroll
                    for (int j = 0; j < 4; ++j) mx = fmaxf(mx, S[kt][j]);
                mx = fmaxf(mx, __shfl_xor(mx, 16)); mx = fmaxf(mx, __shfl_xor(mx, 32));
                float sum = 0.f;
#pragma unroll
                for (int kt = 0; kt < 16; ++kt)
#pragma unroll
                    for (int j = 0; j < 4; ++j) { const float p = fast_exp2((S[kt][j] - mx) * LOG2E); S[kt][j] = p; sum += p; }
                sum += __shfl_xor(sum, 16); sum += __shfl_xor(sum, 32);
                inv = 1.0f / sum;
#pragma unroll
                for (int ht = 0; ht < 4; ++ht) O[ht] = (f32x4){0.f, 0.f, 0.f, 0.f};
            }
#pragma unroll
            for (int p = 0; p < 8; ++p) {
                if (wave < 4) {
                    const bf16x8 yp = __builtin_bit_cast(bf16x8, pack8(S[2 * p], S[2 * p + 1]));
                    const LAS unsigned char* vrow = Vs + ((rs + p) & 7) * 8192;
#pragma unroll
                    for (int ht = 0; ht < 4; ++ht) {
                        const int ch = ht * 16 + fr, sw = (ch >> 1) & 7, pc0 = (cs >> 3) + (fq >> 1);
                        const LAS unsigned char* vp = vrow + ch * 128 + (fq & 1) * 8;
                        const u32x2 lo = *(const LAS u32x2*)(vp + ((pc0 ^ sw) << 4)), hi = *(const LAS u32x2*)(vp + (((pc0 + 2) ^ sw) << 4));
                        const u32x4 xw = {lo.x, lo.y, hi.x, hi.y};
                        O[ht] = __builtin_amdgcn_mfma_f32_16x16x32_bf16(__builtin_bit_cast(bf16x8, xw), yp, O[ht], 0, 0, 0);
                    }
                }
                if (p == 0) { NA_BAR(); if (mv) NA_LOAD_V(rs + 8); }
            }
            if (wave < 4) {
#pragma unroll
                for (int ht = 0; ht < 4; ++ht) *(GAS u32x2*)(NAO + tq * 1024 + h * 64 + ht * 16 + 4 * fq) = pack4(O[ht] * inv);
            }
        }
    }
    asm volatile("s_waitcnt vmcnt(0)" ::: "memory"); NA_BAR();
#undef NA_BAR
#undef NA_LOAD_K
#undef NA_LOAD_V
}
__device__ __forceinline__ void ln_row(f32x4 (&v)[4], const f32x4 (&g)[4], const f32x4 (&bb)[4]) {
    float s = 0.f;
#pragma unroll
    for (int j = 0; j < 4; ++j) s += (v[j][0] + v[j][1]) + (v[j][2] + v[j][3]);
    const float mean = wave_sum(s) * (1.0f / 1024.0f);
    float q = 0.f;
#pragma unroll
    for (int j = 0; j < 4; ++j) { v[j] = v[j] - mean; q += (v[j][0] * v[j][0] + v[j][1] * v[j][1]) + (v[j][2] * v[j][2] + v[j][3] * v[j][3]); }
    const float rstd = 1.0f / sqrtf(wave_sum(q) * (1.0f / 1024.0f) + 1e-5f);
#pragma unroll
    for (int j = 0; j < 4; ++j) v[j] = v[j] * rstd * g[j] + bb[j];
}
__device__ __forceinline__ void phase_ln_router(const Params& P, int l, LAS unsigned char* lds, int wave, int lane) {
    unsigned char* ws = P.ws;
    const float* PRE = (const float*)(ws + WS_ACAT); float* X1 = (float*)(ws + WS_ACAT + 64 * MiB); bf16_t* X1B = (bf16_t*)(ws + WS_K);
    const bf16_t* WRT = (const bf16_t*)(ws + WS_WRT);
    int* tok_e = (int*)(ws + WS_TOK); int* tok_rank = tok_e + T * 2; float* tok_w = (float*)(tok_rank + T * 2);
    unsigned* cnt = (unsigned*)(ws + WS_CTL) + CW_CNT + l * 64;
    LAS int* hist = (LAS int*)(lds + LDS_MISC + LM_HIST); LAS int* basee = (LAS int*)(lds + LDS_MISC + LM_BASE); LAS int* rowi = (LAS int*)(lds + LDS_MISC + LM_ROW);
    const int tid = launder_v((int)threadIdx.x);
    const int fr = lane & 15, fq = lane >> 4;
    f32x4 g[4], bb[4];
#pragma unroll
    for (int j = 0; j < 4; ++j) { g[j] = *(const GAS f32x4*)(P.ln_mix_g + l * 1024 + 4 * lane + 256 * j); bb[j] = *(const GAS f32x4*)(P.ln_mix_b + l * 1024 + 4 * lane + 256 * j); }
    for (int chunk = launder_si((int)blockIdx.x); chunk < T / 64; chunk += gridDim.x) {
        if (tid < 32) hist[tid] = 0;
#pragma nounroll
        for (int rr = 0; rr < 8; ++rr) {
            const int ta = chunk * 64 + wave * 8 + rr;
            f32x4 va[4];
#pragma unroll
            for (int j = 0; j < 4; ++j) va[j] = *(const GAS f32x4*)(PRE + (size_t)ta * 1024 + 4 * lane + 256 * j);
            ln_row(va, g, bb);
#pragma unroll
            for (int j = 0; j < 4; ++j) { *(GAS f32x4*)(X1 + (size_t)ta * 1024 + 4 * lane + 256 * j) = va[j]; *(GAS u32x2*)(X1B + (size_t)ta * 1024 + 4 * lane + 256 * j) = pack4(va[j]); }
        }
        VM_WAIT();
        __syncthreads();
        if (wave < 4) {
            const int t0 = chunk * 64 + wave * 16;
            f32x4 acc0 = {0.f, 0.f, 0.f, 0.f}, acc1 = {0.f, 0.f, 0.f, 0.f};
            const float* yp = X1 + (size_t)(t0 + fr) * 1024 + 8 * fq;
            const bf16_t* wp = WRT + (size_t)fr * 1024 + 8 * fq;
#pragma unroll 4
            for (int s = 0; s < 32; ++s) {
                const f32x4 ya = *(const GAS f32x4*)(yp + 32 * s), yb = *(const GAS f32x4*)(yp + 32 * s + 4);
                const bf16x8 w0h = *(const GAS bf16x8*)(wp + 32 * s), w1h = *(const GAS bf16x8*)(wp + 16 * 1024 + 32 * s);
                const bf16x8 w0l = *(const GAS bf16x8*)(wp + 32 * 1024 + 32 * s), w1l = *(const GAS bf16x8*)(wp + 48 * 1024 + 32 * s);
                u32x4 yh; yh.x = cvt_pk_bf16(ya[0], ya[1]); yh.y = cvt_pk_bf16(ya[2], ya[3]); yh.z = cvt_pk_bf16(yb[0], yb[1]); yh.w = cvt_pk_bf16(yb[2], yb[3]);
                u32x4 yl; yl.x = cvt_pk_bf16(ya[0] - bf_lo(yh.x), ya[1] - bf_hi(yh.x)); yl.y = cvt_pk_bf16(ya[2] - bf_lo(yh.y), ya[3] - bf_hi(yh.y));
                yl.z = cvt_pk_bf16(yb[0] - bf_lo(yh.z), yb[1] - bf_hi(yh.z)); yl.w = cvt_pk_bf16(yb[2] - bf_lo(yh.w), yb[3] - bf_hi(yh.w));
                const bf16x8 yhv = __builtin_bit_cast(bf16x8, yh), ylv = __builtin_bit_cast(bf16x8, yl);
                acc0 = __builtin_amdgcn_mfma_f32_16x16x32_bf16(w0h, yhv, acc0, 0, 0, 0); acc1 = __builtin_amdgcn_mfma_f32_16x16x32_bf16(w1h, yhv, acc1, 0, 0, 0);
                acc0 = __builtin_amdgcn_mfma_f32_16x16x32_bf16(w0h, ylv, acc0, 0, 0, 0); acc1 = __builtin_amdgcn_mfma_f32_16x16x32_bf16(w1h, ylv, acc1, 0, 0, 0);
                acc0 = __builtin_amdgcn_mfma_f32_16x16x32_bf16(w0l, yhv, acc0, 0, 0, 0); acc1 = __builtin_amdgcn_mfma_f32_16x16x32_bf16(w1l, yhv, acc1, 0, 0, 0);
            }
            const f32x4 rb0 = *(const GAS f32x4*)(P.router_bias + 4 * fq), rb1 = *(const GAS f32x4*)(P.router_bias + 16 + 4 * fq);
            f32x4 sc0, sc1, se0, se1;
#pragma unroll
            for (int j = 0; j < 4; ++j) { sc0[j] = 1.0f / (1.0f + expf(-acc0[j])); sc1[j] = 1.0f / (1.0f + expf(-acc1[j])); se0[j] = sc0[j] + rb0[j]; se1[j] = sc1[j] + rb1[j]; }
            float gs0, gs1;
            { const float a = fmaxf(se0[0], se0[1]), b2 = fminf(se0[0], se0[1]), c = fmaxf(se0[2], se0[3]), d2 = fminf(se0[2], se0[3]); gs0 = fmaxf(a, c) + fmaxf(fminf(a, c), fmaxf(b2, d2)); }
            { const float a = fmaxf(se1[0], se1[1]), b2 = fminf(se1[0], se1[1]), c = fmaxf(se1[2], se1[3]), d2 = fminf(se1[2], se1[3]); gs1 = fmaxf(a, c) + fmaxf(fminf(a, c), fmaxf(b2, d2)); }
            float bs = gs0; int bg = fq;
            if (gs1 > gs0) { bs = gs1; bg = 4 + fq; }
#pragma unroll
            for (int o = 16; o < 64; o <<= 1) { const float os = __shfl_xor(bs, o); const int og = __shfl_xor(bg, o); if (os > bs || (os == bs && og < bg)) { bs = os; bg = og; } }
            if ((bg & 3) == fq) {
                const bool hi = bg >= 4;
                const float u0 = hi ? se1[0] : se0[0], u1 = hi ? se1[1] : se0[1], u2 = hi ? se1[2] : se0[2], u3 = hi ? se1[3] : se0[3];
                const float p0 = hi ? sc1[0] : sc0[0], p1 = hi ? sc1[1] : sc0[1], p2 = hi ? sc1[2] : sc0[2], p3 = hi ? sc1[3] : sc0[3];
                int i1 = 0; float t1 = u0;
                if (u1 > t1) { t1 = u1; i1 = 1; } if (u2 > t1) { t1 = u2; i1 = 2; } if (u3 > t1) { t1 = u3; i1 = 3; }
                int i2 = -1; float t2 = -INFINITY;
                if (i1 != 0 && u0 > t2) { t2 = u0; i2 = 0; } if (i1 != 1 && u1 > t2) { t2 = u1; i2 = 1; } if (i1 != 2 && u2 > t2) { t2 = u2; i2 = 2; } if (i1 != 3 && u3 > t2) { t2 = u3; i2 = 3; }
                if (i2 < 0) i2 = (i1 + 1) & 3;
                const float s1 = i1 == 0 ? p0 : i1 == 1 ? p1 : i1 == 2 ? p2 : p3, s2 = i2 == 0 ? p0 : i2 == 1 ? p1 : i2 == 2 ? p2 : p3, inv = 1.0f / (s1 + s2);
                const int e1 = 4 * bg + i1, e2 = 4 * bg + i2;
                const int r1 = __hip_atomic_fetch_add(hist + e1, 1, __ATOMIC_RELAXED, __HIP_MEMORY_SCOPE_WORKGROUP);
                const int r2 = __hip_atomic_fetch_add(hist + e2, 1, __ATOMIC_RELAXED, __HIP_MEMORY_SCOPE_WORKGROUP);
                const int q = wave * 16 + fr;
                rowi[q] = e1; rowi[64 + q] = e2; rowi[128 + q] = r1; rowi[192 + q] = r2; rowi[256 + q] = __float_as_int(s1 * inv); rowi[320 + q] = __float_as_int(s2 * inv);
            }
        }
        __syncthreads();
        if (tid < 32) basee[tid] = (int)__hip_atomic_fetch_add(cnt + tid, (unsigned)hist[tid], __ATOMIC_RELAXED, __HIP_MEMORY_SCOPE_AGENT);
        __syncthreads();
        if (tid < 64) {
            const int t = chunk * 64 + tid, e1 = rowi[tid], e2 = rowi[64 + tid];
            tok_e[2 * t] = e1; tok_e[2 * t + 1] = e2;
            tok_rank[2 * t] = basee[e1] + rowi[128 + tid]; tok_rank[2 * t + 1] = basee[e2] + rowi[192 + tid];
            tok_w[2 * t] = __int_as_float(rowi[256 + tid]); tok_w[2 * t + 1] = __int_as_float(rowi[320 + tid]);
        }
        __syncthreads();
    }
}
__device__ __forceinline__ void build_tiles(const Params& P, int l, LAS unsigned char* lds) {
    const unsigned* cnt = (const unsigned*)(P.ws + WS_CTL) + CW_CNT + l * 64;
    LAS int* tstart = (LAS int*)(lds + LDS_MISC + LM_TSTART); LAS int* tile_e = (LAS int*)(lds + LDS_MISC + LM_TILEE); LAS int* ntp = (LAS int*)(lds + LDS_MISC + LM_NT);
    __syncthreads();
    if (launder_v((int)threadIdx.x) == 0) {
        int a = 0;
#pragma nounroll
        for (int e = 0; e < 32; ++e) { const int c = (int)__hip_atomic_load(cnt + e, __ATOMIC_RELAXED, __HIP_MEMORY_SCOPE_AGENT); const int n = (c + 255) >> 8; tstart[e] = a;
            for (int q = 0; q < n; ++q) { if (a + q < 192) tile_e[a + q] = e; } a += n; }
        tstart[32] = a; ntp[0] = a < 160 ? a : 160;
    }
    __syncthreads();
}
__device__ __forceinline__ void phase_gather(const Params& P, int l, LAS unsigned char* lds, int gw, int NGW, int lane) {
    unsigned char* ws = P.ws;
    const bf16_t* X1B = (const bf16_t*)(ws + WS_K); bf16_t* XG = (bf16_t*)(ws + WS_KV);
    const int* tok_e = (const int*)(ws + WS_TOK); const int* tok_rank = tok_e + T * 2; int* tok_dest = (int*)(ws + WS_TOK) + T * 6;
    build_tiles(P, l, lds);
    const LAS int* tstart = (const LAS int*)(lds + LDS_MISC + LM_TSTART);
    for (int pr = gw; pr < T * 2; pr += NGW) {
        const int e = tok_e[pr], dest = tstart[e] * 256 + tok_rank[pr];
        if (lane == 0) tok_dest[pr] = dest;
        const GAS u32x4* src = (const GAS u32x4*)(X1B + (size_t)(pr >> 1) * 1024); GAS u32x4* dst = (GAS u32x4*)(XG + (size_t)dest * 1024);
        dst[lane] = src[lane]; dst[lane + 64] = src[lane + 64];
    }
}
__device__ __forceinline__ void phase_combine(const Params& P, int l, int gw, int NGW, int lane) {
    unsigned char* ws = P.ws;
    const float* X1 = (const float*)(ws + WS_ACAT + 64 * MiB); const bf16_t* Y = (const bf16_t*)(ws + WS_BCAT + 40 * MiB);
    const float* tok_w = (const float*)(ws + WS_TOK) + T * 4; const int* tok_dest = (const int*)(ws + WS_TOK) + T * 6;
    bf16_t* xb = (bf16_t*)(ws + WS_XB);
    f32x4 g[4], bb[4];
#pragma unroll
    for (int j = 0; j < 4; ++j) { g[j] = *(const GAS f32x4*)(P.ln_ffn_g + l * 1024 + 4 * lane + 256 * j); bb[j] = *(const GAS f32x4*)(P.ln_ffn_b + l * 1024 + 4 * lane + 256 * j); }
    for (int t = gw; t < T; t += NGW) {
        const int d0 = tok_dest[2 * t], d1 = tok_dest[2 * t + 1]; const float w0 = tok_w[2 * t], w1 = tok_w[2 * t + 1];
        f32x4 v[4];
#pragma unroll
        for (int j = 0; j < 4; ++j) {
            const f32x4 x1 = *(const GAS f32x4*)(X1 + (size_t)t * 1024 + 4 * lane + 256 * j);
            const u32x2 y0 = *(const GAS u32x2*)(Y + (size_t)d0 * 1024 + 4 * lane + 256 * j), y1 = *(const GAS u32x2*)(Y + (size_t)d1 * 1024 + 4 * lane + 256 * j);
            v[j][0] = x1[0] * ALPHA + w0 * bf_lo(y0.x) + w1 * bf_lo(y1.x); v[j][1] = x1[1] * ALPHA + w0 * bf_hi(y0.x) + w1 * bf_hi(y1.x);
            v[j][2] = x1[2] * ALPHA + w0 * bf_lo(y0.y) + w1 * bf_lo(y1.y); v[j][3] = x1[3] * ALPHA + w0 * bf_hi(y0.y) + w1 * bf_hi(y1.y);
        }
        ln_row(v, g, bb);
#pragma unroll
        for (int j = 0; j < 4; ++j) { *(GAS f32x4*)(P.out + (size_t)t * 1024 + 4 * lane + 256 * j) = v[j]; *(GAS u32x2*)(xb + (size_t)t * 1024 + 4 * lane + 256 * j) = pack4(v[j]); }
    }
}

__global__ void __launch_bounds__(512, 2) fwd_kernel(Params P) {
    extern __shared__ __attribute__((aligned(16))) unsigned char lds_raw[];
    LAS unsigned char* lds = (LAS unsigned char*)lds_raw;
    const int NGW = gridDim.x * 8;
    for (int u = threadIdx.x; u < (LDS_BYTES - LDS_MISC) / 4; u += 512) ((LAS unsigned*)(lds + LDS_MISC))[u] = 0u;
#define PHASE_CTX() const Params PP = load_params(); unsigned char* ws = PP.ws; const int tid = launder_v((int)threadIdx.x), lane = tid & 63, wave = __builtin_amdgcn_readfirstlane(tid >> 6), gw = launder_si((int)blockIdx.x) * 8 + wave; (void)ws; (void)lane; (void)gw
    __syncthreads();
#if MK_ONE_LAUNCH
    XcdBarrier bar = xcd_barrier_post((unsigned*)(P.ws + WS_CTL) + CW_BAR, (volatile LAS unsigned*)(lds + LDS_MISC + LM_BAR));
#define GRID_BAR() xcd_barrier(bar)
#else
#define GRID_BAR() do { } while (0)
#endif
    const int lo = P.ph_lo, hi = P.ph_hi;
#define IN(k) (lo <= (k) && (k) < hi)
#define SEAM(k) do { if (IN(k) && IN((k) + 1)) GRID_BAR(); } while (0)
#ifndef PROBE_MASK
#define PROBE_MASK 0
#endif
#define REP(b) for (int rep_ = 0; rep_ < (((PROBE_MASK) >> (b)) & 1) + 1; ++rep_)

    if (IN(0)) { PHASE_CTX(); phase_init(PP, lds, gw, NGW, wave, lane); SEAM(0); }

    for (int l = 0; l < DEPTH; ++l) {
        const int pb = 1 + l * 12;
        if (IN(pb + 0)) { PHASE_CTX(); const float* decay = PP.decay + l * 8; (void)decay;
            DecInProj dec{(const char*)(ws + WS_XB), (const char*)(ws + WS_WIN)};
            EpiInProj E{ws, decay};
            REP(0) pg::gemm_phase<1 + PROBE_EPI2>(lds, 1024, 1024, 1024, 3072, dec, E, (int)gridDim.x, (int)blockIdx.x);
            SEAM(pb + 0);
        }
        if (IN(pb + 1)) { PHASE_CTX(); const float* decay = PP.decay + l * 8; (void)decay;
            const int bid = launder_si((int)blockIdx.x);
            if (bid < 64) {
                DecR2c dec{(const char*)(ws + WS_BCAT), (const char*)(ws + WS_KDT)}; EpiR2c E{(bf16_t*)(ws + WS_BCAT), decay};
                REP(2) pg::gemm_phase<1, true>(lds, 512, 1024, 512, 448, dec, E, 64, bid);
            } else {
                if (bid >= 128) { DecR1 dec{(const char*)(ws + WS_Q), (const char*)(ws + WS_K)}; EpiR1 E{(bf16_t*)(ws + WS_ACAT), decay};
                  REP(1) pg::gemm_phase(lds, 256, 1024, 1024, 512, dec, E, 128, bid - 128); }
                REP(3) phase_na2(PP, l, lds, tid, wave, lane, 192, bid - 64);
            }
            SEAM(pb + 1);
        }
        if (IN(pb + 3)) { PHASE_CTX(); const float* decay = PP.decay + l * 8; (void)decay;
            DecR4 dec{(const char*)(ws + WS_ACAT), (const char*)(ws + WS_BCAT)}; EpiR4 E{(bf16_t*)(ws + WS_KV)};
            REP(5) pg::gemm_phase(lds, 1024, 4096, 1024, 512, dec, E, (int)gridDim.x, (int)blockIdx.x);
            SEAM(pb + 3);
        }
        if (IN(pb + 4)) { PHASE_CTX(); const float* decay = PP.decay + l * 8; (void)decay; REP(6) phase_headnorm(PP, gw, NGW, lane); SEAM(pb + 4); }
        if (IN(pb + 5)) { PHASE_CTX(); const float* decay = PP.decay + l * 8; (void)decay;
            REP(7) {
            { DecDense dec{(const char*)(ws + WS_KDT), (const char*)(ws + WS_WRET), 2048 * 2, 2048 * 2}; EpiMerge<0> E{(bf16_t*)(ws + WS_Q), (const bf16_t*)(ws + WS_G)};
              pg::gemm_phase(lds, 2048, 2048, 2048, 256, dec, E, (int)gridDim.x, (int)blockIdx.x); }
            { DecDense dec{(const char*)(ws + WS_NAO), (const char*)(ws + WS_WNA), 1024 * 2, 1024 * 2}; EpiMerge<1> E{(bf16_t*)(ws + WS_Q), (const bf16_t*)(ws + WS_G)};
              pg::gemm_phase(lds, 1024, 1024, 1024, 256, dec, E, (int)gridDim.x, (int)blockIdx.x); }
            }
            SEAM(pb + 5);
        }
        if (IN(pb + 6)) { PHASE_CTX(); const float* decay = PP.decay + l * 8; (void)decay;
            DecDense dec{(const char*)(ws + WS_Q), (const char*)(ws + WS_WOUT), 1024 * 2, 1024 * 2}; EpiPre E{(float*)(ws + WS_ACAT), l == 0 ? PP.x : (const float*)PP.out};
            REP(8) pg::gemm_phase(lds, 1024, 1024, 1024, 256, dec, E, (int)gridDim.x, (int)blockIdx.x);
            SEAM(pb + 6);
        }
        if (IN(pb + 7)) { PHASE_CTX(); const float* decay = PP.decay + l * 8; (void)decay; phase_ln_router(PP, l, lds, wave, lane); SEAM(pb + 7); }
        if (IN(pb + 8)) { PHASE_CTX(); const float* decay = PP.decay + l * 8; (void)decay; REP(9) phase_gather(PP, l, lds, gw, NGW, lane); SEAM(pb + 8); }
        if (IN(pb + 9)) { PHASE_CTX(); const float* decay = PP.decay + l * 8; (void)decay;
            build_tiles(PP, l, lds);
            const int nt = *(const LAS int*)(lds + LDS_MISC + LM_NT);
            DecMoe dec{(const char*)(ws + WS_KV), (const char*)(ws + WS_WGU), 1024 * 2, 1024 * 1024 * 2, 1024 * 2, (const LAS int*)(lds + LDS_MISC + LM_TILEE)}; EpiUp E{(bf16_t*)(ws + WS_BCAT)};
            REP(10) pg::gemm_phase(lds, 1024, 1024, 1024, nt * 4, dec, E, (int)gridDim.x, (int)blockIdx.x);
            SEAM(pb + 9);
        }
        if (IN(pb + 10)) { PHASE_CTX(); const float* decay = PP.decay + l * 8; (void)decay;
            build_tiles(PP, l, lds);
            const int nt = *(const LAS int*)(lds + LDS_MISC + LM_NT);
            DecMoe dec{(const char*)(ws + WS_BCAT), (const char*)(ws + WS_WD), 512 * 2, 1024 * 512 * 2, 512 * 2, (const LAS int*)(lds + LDS_MISC + LM_TILEE)}; EpiDown E{(bf16_t*)(ws + WS_BCAT + 40 * MiB)};
            REP(11) pg::gemm_phase(lds, 512, 512, 512, nt * 4, dec, E, (int)gridDim.x, (int)blockIdx.x);
            SEAM(pb + 10);
        }
        if (IN(pb + 11)) { PHASE_CTX(); const float* decay = PP.decay + l * 8; (void)decay;
            REP(12) phase_combine(PP, l, gw, NGW, lane);
            REP(13) if (l + 1 < DEPTH) convert_layer(PP, l + 1, lds, gw, NGW, wave, lane);
            SEAM(pb + 11);
        }
    }
#undef IN
#undef SEAM
}

extern "C" void kernel_launch(void* const* d_in, const int* in_sizes, int n_in, void* d_out, int out_size, void* d_ws, size_t ws_size, hipStream_t stream) {
    static int grid = 0;
    if (grid == 0) {
        if (n_in != 16 || in_sizes[0] != T * D || out_size != T * D || ws_size < WS_END) {
            fprintf(stderr, "kernel_launch: unexpected shapes / workspace (n_in %d, in0 %d, out %d, ws %zu < %zu); nothing launched\n", n_in, n_in > 0 ? in_sizes[0] : -1, out_size, ws_size, (size_t)WS_END); grid = -1; return; }
        int dev = 0, cus = 0, per_cu = 0;
        if (hipGetDevice(&dev) != hipSuccess || hipDeviceGetAttribute(&cus, hipDeviceAttributeMultiprocessorCount, dev) != hipSuccess) { grid = -1; return; }
        if (hipFuncSetAttribute((const void*)fwd_kernel, hipFuncAttributeMaxDynamicSharedMemorySize, LDS_BYTES) != hipSuccess) { fprintf(stderr, "kernel_launch: hipFuncSetAttribute failed\n"); grid = -1; return; }
        if (hipOccupancyMaxActiveBlocksPerMultiprocessor(&per_cu, (const void*)fwd_kernel, 512, LDS_BYTES) != hipSuccess || per_cu < 1)
            fprintf(stderr, "kernel_launch: occupancy query reports %d workgroups per CU\n", per_cu);
        (void)hipGetLastError();
        grid = cus;
    }
    if (grid < 0) return;
    if (hipMemsetAsync((char*)d_ws + WS_CTL, 0, CTL_ZERO_BYTES, stream) != hipSuccess) return;
    Params p{};
    p.x = (const float*)d_in[0]; p.w_in = (const float*)d_in[1]; p.decay = (const float*)d_in[2]; p.w_ret_o = (const float*)d_in[3]; p.rpb = (const float*)d_in[4];
    p.w_na_o = (const float*)d_in[5]; p.w_out = (const float*)d_in[6]; p.ln_mix_g = (const float*)d_in[7]; p.ln_mix_b = (const float*)d_in[8];
    p.router_w = (const float*)d_in[9]; p.router_bias = (const float*)d_in[10]; p.w_gate = (const float*)d_in[11]; p.w_up = (const float*)d_in[12]; p.w_down = (const float*)d_in[13];
    p.ln_ffn_g = (const float*)d_in[14]; p.ln_ffn_b = (const float*)d_in[15];
    p.out = (float*)d_out; p.ws = (unsigned char*)d_ws;
#if MK_ONE_LAUNCH
    p.ph_lo = 0; p.ph_hi = NPH;
    hipLaunchKernelGGL(fwd_kernel, dim3(grid), dim3(512), LDS_BYTES, stream, p);
#else
    for (int ph = 0; ph < NPH; ++ph) { p.ph_lo = ph; p.ph_hi = ph + 1; hipLaunchKernelGGL(fwd_kernel, dim3(grid), dim3(512), LDS_BYTES, stream, p); }
#endif
}
```

```cpp
#include <hip/hip_runtime.h>
#include <cstdio>
#include <cstdint>

#ifndef STAGGER_TICKS
#define STAGGER_TICKS 0
#endif
#ifndef PROBE_K2
#define PROBE_K2 0
#endif
#ifndef PROBE_EPI6
#define PROBE_EPI6 0
#endif
#ifndef PROBE_EPIKIND
#define PROBE_EPIKIND -1
#endif
#ifndef PROBE_EPI2
#define PROBE_EPI2 0
#endif
#ifndef DEFER_SILU
#define DEFER_SILU 1
#endif
#ifndef MK_ONE_LAUNCH
#define MK_ONE_LAUNCH 1
#endif

#define LAS __attribute__((address_space(3)))
#define GAS __attribute__((address_space(1)))
typedef unsigned short bf16_t;
typedef short bf16x8 __attribute__((ext_vector_type(8)));
typedef float f32x4 __attribute__((ext_vector_type(4)));
typedef float f32x2 __attribute__((ext_vector_type(2)));
typedef unsigned u32x4 __attribute__((ext_vector_type(4)));
typedef unsigned u32x2 __attribute__((ext_vector_type(2)));

constexpr int D = 1024, BATCH = 4, SEQ = 4096, T = BATCH * SEQ, DEPTH = 4;
constexpr int DIN = 11264;
constexpr int NE = 32;
constexpr int NPH = 1 + DEPTH * 12;
constexpr float ALPHA = 1.681792830507429f;
constexpr float LOG2E = 1.4426950408889634f;

constexpr size_t MiB = 1u << 20;
constexpr size_t WS_CTL = 0, CTL_ZERO_BYTES = 1 * MiB;
constexpr size_t WS_SRC = 10 * MiB + 640 * 1024;
constexpr size_t WS_TAB = 2 * MiB;
constexpr size_t WS_TOK = 10 * MiB;
constexpr size_t WS_HT = 10 * MiB + 512 * 1024;
constexpr size_t WS_WRT = 11 * MiB;
constexpr size_t WS_RGC = 11 * MiB + 512 * 1024;
constexpr size_t WS_W0 = 12 * MiB;
constexpr size_t WO_WIN = 0;
constexpr size_t WO_WRET = 22 * MiB;
constexpr size_t WO_WNA = 26 * MiB;
constexpr size_t WO_WOUT = 28 * MiB;
constexpr size_t WO_WGU = 30 * MiB;
constexpr size_t WO_WD = 94 * MiB;
constexpr size_t WS_XB = 138 * MiB;
constexpr size_t WS_Q = 170 * MiB;
constexpr size_t WS_K = 202 * MiB;
constexpr size_t WS_ACAT = 234 * MiB;
constexpr size_t WS_BCAT = 362 * MiB;
constexpr size_t WS_KDT = 490 * MiB;
constexpr size_t WS_KV = 554 * MiB;
constexpr size_t WS_SG = 634 * MiB;
constexpr size_t WS_QN = 698 * MiB;
constexpr size_t WS_KN = 730 * MiB;
constexpr size_t WS_VNT = 762 * MiB;
constexpr size_t WS_G = 794 * MiB;
constexpr size_t WS_NAO = 858 * MiB;
constexpr size_t WS_W1 = 890 * MiB;
constexpr size_t WS_END = 1016 * MiB;
__host__ __device__ __forceinline__ constexpr size_t ws_wset(int l) { return (l & 1) ? WS_W1 : WS_W0; }
constexpr int CW_BAR = 4096;
constexpr int CW_CNT = 16384;

constexpr int LDS_STAGE = 131072;
constexpr int LDS_MISC = 147456;
constexpr int LM_BAR = 0;
constexpr int LM_HIST = 64;
constexpr int LM_BASE = 192;
constexpr int LM_ROW = 512;
constexpr int LM_NT = 2048;
constexpr int LM_TSTART = 2112;
constexpr int LM_TILEE = 2304;
constexpr int LM_RSTAT = 3072;
constexpr int LDS_BYTES = 163840;

#define LDS_WAIT() asm volatile("s_waitcnt lgkmcnt(0)" ::: "memory")
#define VM_WAIT() asm volatile("s_waitcnt vmcnt(0)" ::: "memory")
__device__ __forceinline__ unsigned cvt_pk_bf16(float lo, float hi) { unsigned r; asm("v_cvt_pk_bf16_f32 %0, %1, %2" : "=v"(r) : "v"(lo), "v"(hi)); return r; }
__device__ __forceinline__ u32x4 pack8(const f32x4 a, const f32x4 b) { u32x4 w; w.x = cvt_pk_bf16(a[0], a[1]); w.y = cvt_pk_bf16(a[2], a[3]); w.z = cvt_pk_bf16(b[0], b[1]); w.w = cvt_pk_bf16(b[2], b[3]); return w; }
__device__ __forceinline__ u32x2 pack4(const f32x4 a) { u32x2 w; w.x = cvt_pk_bf16(a[0], a[1]); w.y = cvt_pk_bf16(a[2], a[3]); return w; }
#ifndef NT_STORES
#define NT_STORES 0
#endif
#if NT_STORES
#define NT16(p, v) __builtin_nontemporal_store((v), (GAS u32x4*)(p))
#else
#define NT16(p, v) (*(GAS u32x4*)(p) = (v))
#endif
__device__ __forceinline__ float bf_lo(unsigned u) { return __uint_as_float(u << 16); }
__device__ __forceinline__ float bf_hi(unsigned u) { return __uint_as_float(u & 0xffff0000u); }
__device__ __forceinline__ float wave_sum(float v) {
#pragma unroll
    for (int o = 1; o < 64; o <<= 1) v += __shfl_xor(v, o);
    return v;
}
template <class Tp> __device__ __forceinline__ Tp* launder_s(Tp* p) { asm volatile("" : "+s"(p)); return p; }
__device__ __forceinline__ int launder_v(int v) { asm volatile("" : "+v"(v)); return v; }
__device__ __forceinline__ int launder_si(int v) { asm volatile("" : "+s"(v)); return v; }
__device__ __forceinline__ float fast_exp2(float x) { return __builtin_amdgcn_exp2f(x); }
__device__ __forceinline__ float fast_rcp(float x) { return __builtin_amdgcn_rcpf(x); }
__device__ __forceinline__ float sigmoid_f(float v) { return fast_rcp(1.0f + fast_exp2(-v * LOG2E)); }
__device__ __forceinline__ float log2_sigmoid(float x) { return -log1pf(expf(-x)) * LOG2E; }

#define XB_TMO      128
#define XB_XCNT(j)  (256  + 64 * (j))
#define XB_XSUB(j)  (1280 + 64 * (j))
#define XB_XGEN(j)  (2304 + 64 * (j))
#define XB_TOP      3328
#define XB_TOPGEN   3392
#define XCD_BAR_WORDS 3456
#define XB_SPIN_CAP (1u << 18)

__device__ __forceinline__ unsigned xb_ld(unsigned* p)              { return __hip_atomic_load(p, __ATOMIC_RELAXED, __HIP_MEMORY_SCOPE_AGENT); }
__device__ __forceinline__ unsigned xb_add(unsigned* p, unsigned v) { return __hip_atomic_fetch_add(p, v, __ATOMIC_RELAXED, __HIP_MEMORY_SCOPE_AGENT); }
__device__ __forceinline__ unsigned xb_xcc_id() { return (unsigned)__builtin_amdgcn_s_getreg((3 << 11) | 20) & 0xFu; }
#define XB_SPIN(cond, bar) do { unsigned _sp = 0; while (cond) { __builtin_amdgcn_s_sleep(1); \
    if ((++_sp & 255u) == 0u) { if (xb_ld(&(bar)[XB_TMO])) break; if (_sp > XB_SPIN_CAP) { atomicAdd(&(bar)[XB_TMO], 1u); break; } } } } while (0)

struct XcdBarrier {
    unsigned* bar; unsigned x;
    volatile LAS unsigned* st;
};
__device__ __forceinline__ XcdBarrier xcd_barrier_post(unsigned* bar, volatile LAS unsigned* st) {
    XcdBarrier b; b.bar = bar; b.x = xb_xcc_id(); b.st = st;
    if (threadIdx.x == 0) (void)xb_add(&bar[XB_XCNT(b.x)], 1u);
    return b;
}
__device__ __forceinline__ void xcd_barrier_complete(unsigned* bar, unsigned x, unsigned& nloc, unsigned& nx) {
    const unsigned G = gridDim.x * gridDim.y * gridDim.z;
    unsigned sum, cnt, mine, sp = 0u;
    for (;;) {
        sum = 0u; cnt = 0u; mine = 0u;
#pragma unroll
        for (unsigned j = 0; j < 16; ++j) { const unsigned c = xb_ld(&bar[XB_XCNT(j)]); sum += c; cnt += (c > 0u) ? 1u : 0u; mine = (j == x) ? c : mine; }
        if (sum == G) break;
        __builtin_amdgcn_s_sleep(1);
        if ((++sp & 255u) == 0u) { if (xb_ld(&bar[XB_TMO])) break; if (sp > XB_SPIN_CAP) { atomicAdd(&bar[XB_TMO], 1u); break; } }
    }
    nloc = mine > 0u ? mine : 1u; nx = cnt > 0u ? cnt : 1u;
}
__device__ __forceinline__ void xcd_barrier(const XcdBarrier& b) {
    asm volatile("s_waitcnt vmcnt(0)" ::: "memory");
    __syncthreads();
    if (threadIdx.x == 0) {
        unsigned* bar = b.bar;
        __builtin_amdgcn_s_waitcnt(0);
        unsigned nloc = b.st[0], nx = b.st[1];
        if (nloc == 0u) { xcd_barrier_complete(bar, b.x, nloc, nx); b.st[0] = nloc; b.st[1] = nx; }
        const unsigned old = xb_add(&bar[XB_XSUB(b.x)], 1u);
        const unsigned gen = old / nloc;
        if (old + 1u == (gen + 1u) * nloc) {
            __builtin_amdgcn_fence(__ATOMIC_RELEASE, "agent");
            asm volatile("s_waitcnt vmcnt(0)" ::: "memory");
            const unsigned og = xb_add(&bar[XB_TOP], 1u);
            const unsigned tg = og / nx;
            if (og + 1u == (tg + 1u) * nx) xb_add(&bar[XB_TOPGEN], 1u);
            else XB_SPIN(xb_ld(&bar[XB_TOPGEN]) == tg, bar);
            __builtin_amdgcn_fence(__ATOMIC_ACQUIRE, "agent");
            xb_add(&bar[XB_XGEN(b.x)], 1u);
            asm volatile("s_waitcnt vmcnt(0)" ::: "memory");
        } else {
            XB_SPIN(xb_ld(&bar[XB_XGEN(b.x)]) == gen, bar);
            __builtin_amdgcn_fence(__ATOMIC_ACQUIRE, "agent");
            asm volatile("s_waitcnt vmcnt(0)" ::: "memory");
        }
    }
    __syncthreads();
}

namespace pg {
constexpr int BM = 256, BK = 64, HALF = 128, HTB = HALF * BK * 2, STAGE_BYTES = 8 * HTB;
__device__ __forceinline__ int lds_byte(int r, int c) { const int st = (r >> 4) * 2 + (c >> 5), rr = r & 15, cc = c & 31, ob = rr * 64 + cc * 2; return st * 1024 + (ob ^ (((ob >> 9) & 1) << 5)); }
__device__ __forceinline__ void stage_rc(int b, int& R, int& C) { const int st = b / 1024, sb = b % 1024, swz = sb ^ (((sb >> 9) & 1) << 5); R = (st >> 1) * 16 + swz / 64; C = (st & 1) * 32 + (swz % 64) / 2; }
__device__ __forceinline__ int perm32(int rho) { const int n = rho >> 4, i = rho & 15; return 8 * (i >> 2) + 4 * n + (i & 3); }

struct Unit { const char* A; const char* B; int kind, a, b, c; };

template <int EPI_REP = 1, bool CHAIN = false, int KREP = 1, bool BLOCKB = false, bool GATHA = false, int EPI_ST = 0, class Epi, class Dec>
__device__ __forceinline__ void gemm_phase(LAS unsigned char* lds, const int K, const int lda, const int ldb, const int nunits, const Dec& dec, const Epi& E, const int vG, const int vbid, const LAS int* gsrc = nullptr) {
    const int tid = launder_v((int)threadIdx.x), wid = __builtin_amdgcn_readfirstlane(tid >> 6), lane = tid & 63, wr = wid >> 2, wc = wid & 3, fr = lane & 15, fq = lane >> 4;
    const int nt1 = K / BK, nt = nt1 * KREP;
    const int G = launder_si(vG); int uidx = launder_si(vbid);
    if (uidx < 0 || uidx >= nunits) return;
    unsigned voffA[2], voffB[2];
#pragma unroll
    for (int i = 0; i < 2; ++i) { int R, C; stage_rc(tid * 16 + i * 8192, R, C); const int Rb = (R & ~31) + perm32(R & 31);
        voffA[i] = (unsigned)(R * lda + C) * 2u; voffB[i] = BLOCKB ? (unsigned)(((Rb >> 4) * 64 + (C >> 3)) * 128 + (Rb & 15) * 8) * 2u : (unsigned)(Rb * ldb + C) * 2u; }
    const size_t kstep = (size_t)(BK * 2), kstepB = BLOCKB ? (size_t)2048 : kstep;
    const size_t hstepA = GATHA ? (size_t)0 : (size_t)HALF * lda * 2, hstepB = BLOCKB ? (size_t)131072 : (size_t)HALF * ldb * 2;
    int gR[2], gC[2]; unsigned vA0[2], vA1[2], nA0[2], nA1[2];
    if constexpr (GATHA) {
#pragma unroll
        for (int i = 0; i < 2; ++i) { stage_rc(tid * 16 + i * 8192, gR[i], gC[i]);
            vA0[i] = ((unsigned)gsrc[gR[i]] * (unsigned)lda + (unsigned)gC[i]) * 2u; vA1[i] = ((unsigned)gsrc[128 + gR[i]] * (unsigned)lda + (unsigned)gC[i]) * 2u; nA0[i] = vA0[i]; nA1[i] = vA1[i]; }
    }
    int uj = 0;
    const unsigned ldsw = (unsigned)wid * 1024u;
    const int aoff = lds_byte(wr * 64 + fr, fq * 8), boff = lds_byte(wc * 32 + fr, fq * 8);
#define PG_SA(b, h) (((b) * 2 + (h)) * HTB)
#define PG_SB(b, h) ((4 + (b) * 2 + (h)) * HTB)
#define PG_STAGE(bufoff, gbase, voff) do { _Pragma("unroll") for (int _i = 0; _i < 2; ++_i) \
        __builtin_amdgcn_global_load_lds((const unsigned*)((const char*)(gbase) + (voff)[_i]), (LAS unsigned*)(lds + (bufoff) + ldsw + _i * 8192), 16, 0, 0); } while (0)
#define PG_STAGE_A0(bufoff, gbase, nx) do { if constexpr (GATHA) { unsigned v_[2] = {(nx) ? nA0[0] : vA0[0], (nx) ? nA0[1] : vA0[1]}; PG_STAGE(bufoff, gbase, v_); } else PG_STAGE(bufoff, gbase, voffA); } while (0)
#define PG_STAGE_A1(bufoff, gbase, nx) do { if constexpr (GATHA) { unsigned v_[2] = {(nx) ? nA1[0] : vA1[0], (nx) ? nA1[1] : vA1[1]}; PG_STAGE(bufoff, gbase, v_); } else PG_STAGE(bufoff, (gbase) + hstepA, voffA); } while (0)
#define PG_LDA(dst, b, h) do { _Pragma("unroll") for (int m = 0; m < 4; ++m) _Pragma("unroll") for (int k = 0; k < 2; ++k) dst[m][k] = *(const LAS bf16x8*)(lds + PG_SA(b, h) + aoff + m * 2048 + k * 1024); } while (0)
#define PG_LDB(dst, b, h) do { _Pragma("unroll") for (int n = 0; n < 2; ++n) _Pragma("unroll") for (int k = 0; k < 2; ++k) dst[n][k] = *(const LAS bf16x8*)(lds + PG_SB(b, h) + boff + n * 2048 + k * 1024); } while (0)
#define PG_MMA(ai, bj, At, Bt) do { __builtin_amdgcn_s_setprio(1); _Pragma("unroll") for (int m = 0; m < 4; ++m) _Pragma("unroll") for (int n = 0; n < 2; ++n) _Pragma("unroll") for (int k = 0; k < 2; ++k) \
        acc[ai][bj][m][n] = __builtin_amdgcn_mfma_f32_16x16x32_bf16(Bt[n][k], At[m][k], acc[ai][bj][m][n], 0, 0, 0); __builtin_amdgcn_s_setprio(0); } while (0)
#define PG_WAIT_V(n) asm volatile("s_waitcnt vmcnt(" #n ")" ::: "memory")
#define PG_WAIT_V8R() do { if (relax) asm volatile("s_waitcnt vmcnt(%0)" :: "n"(8 + EPI_ST) : "memory"); else asm volatile("s_waitcnt vmcnt(8)" ::: "memory"); } while (0)
#define PG_WAIT_L(n) asm volatile("s_waitcnt lgkmcnt(" #n ")" ::: "memory")
#define PG_BAR __builtin_amdgcn_s_barrier()
#define PG_SCHED __builtin_amdgcn_sched_barrier(0)
    Unit cur, nxt;
    dec(uidx, cur);
    f32x4 acc[2][2][4][2];
#pragma unroll
    for (int a = 0; a < 2; ++a)
#pragma unroll
        for (int b = 0; b < 2; ++b)
#pragma unroll
            for (int m = 0; m < 4; ++m)
#pragma unroll
                for (int n = 0; n < 2; ++n) acc[a][b][m][n] = (f32x4){0.f, 0.f, 0.f, 0.f};
    bf16x8 At[4][2], B0[2][2], B1[2][2];
    const char* cA = cur.A; const char* cB = cur.B;
    PG_STAGE(PG_SB(0, 0), cB, voffB); PG_STAGE(PG_SB(0, 1), cB + hstepB, voffB); PG_STAGE_A0(PG_SA(0, 0), cA, false); PG_STAGE_A1(PG_SA(0, 1), cA, false);
    if (wr == 1) PG_BAR;
    PG_WAIT_V(2); PG_BAR;
    PG_STAGE(PG_SB(1, 0), cB + kstepB, voffB); PG_STAGE_A0(PG_SA(1, 0), cA + kstep, false); PG_STAGE(PG_SB(1, 1), cB + hstepB + kstepB, voffB);
    PG_WAIT_V(6); PG_BAR;
    bool after_epi = false;
    for (;;) {
        const bool has_next = (uidx + G < nunits);
        if (has_next) dec(uidx + G, nxt);
        const char* nA = has_next ? nxt.A : cA; const char* nB = has_next ? nxt.B : cB;
        if constexpr (GATHA) { if (has_next) {
#pragma unroll
            for (int i = 0; i < 2; ++i) { nA0[i] = ((unsigned)gsrc[(uj + 1) * 256 + gR[i]] * (unsigned)lda + (unsigned)gC[i]) * 2u; nA1[i] = ((unsigned)gsrc[(uj + 1) * 256 + 128 + gR[i]] * (unsigned)lda + (unsigned)gC[i]) * 2u; } } }
#pragma nounroll
        for (int t = 0; t < nt; t += 2) {
            const bool last = (t == nt - 2);
            const bool relax = EPI_ST > 0 && after_epi && t == 0;
            const int t1 = KREP > 1 ? (t + 1) % nt1 : t + 1, t2 = KREP > 1 ? (t + 2) % nt1 : t + 2;
            const char* a1 = cA + (size_t)t1 * kstep;
            const char* a2 = last ? nA : cA + (size_t)t2 * kstep; const char* b2 = last ? nB : cB + (size_t)t2 * kstepB;
            const char* a3 = a2 + kstep; const char* b3 = b2 + kstepB;
            PG_LDB(B0, 0, 0); PG_LDB(B1, 0, 1); PG_SCHED; PG_LDA(At, 0, 0); PG_STAGE_A1(PG_SA(1, 1), a1, false);
            PG_WAIT_V8R(); PG_WAIT_L(0); PG_BAR; PG_MMA(0, 0, At, B0); PG_MMA(0, 1, At, B1); PG_BAR; PG_SCHED;
            PG_LDA(At, 0, 1); PG_STAGE(PG_SB(0, 0), b2, voffB); PG_STAGE(PG_SB(0, 1), b2 + hstepB, voffB); PG_STAGE_A0(PG_SA(0, 0), a2, last);
            PG_WAIT_V8R(); PG_WAIT_L(0); PG_BAR; PG_MMA(1, 0, At, B0); PG_MMA(1, 1, At, B1); PG_BAR; PG_SCHED;
            PG_LDB(B0, 1, 0); PG_LDB(B1, 1, 1); PG_SCHED; PG_LDA(At, 1, 0); PG_STAGE_A1(PG_SA(0, 1), a2, last);
            PG_WAIT_V(8); PG_WAIT_L(0); PG_BAR; PG_MMA(0, 0, At, B0); PG_MMA(0, 1, At, B1); PG_BAR; PG_SCHED;
            PG_LDA(At, 1, 1); PG_STAGE(PG_SB(1, 0), b3, voffB); PG_STAGE(PG_SB(1, 1), b3 + hstepB, voffB); PG_STAGE_A0(PG_SA(1, 0), a3, last);
            PG_WAIT_V(8); PG_WAIT_L(0); PG_BAR; PG_MMA(1, 0, At, B0); PG_MMA(1, 1, At, B1); PG_BAR; PG_SCHED;
        }
        if (wr == 0) PG_BAR;
        if constexpr (KREP > 1) {
#pragma unroll
            for (int a = 0; a < 2; ++a)
#pragma unroll
                for (int b = 0; b < 2; ++b)
#pragma unroll
                    for (int m = 0; m < 4; ++m)
#pragma unroll
                        for (int n = 0; n < 2; ++n) acc[a][b][m][n] = acc[a][b][m][n] * (1.0f / KREP);
        }
        E(acc, cur, wr, wc, fr, fq);
        if constexpr (EPI_REP > 1) { if (PROBE_EPIKIND < 0 || cur.kind == PROBE_EPIKIND) E(acc, cur, wr, wc, fr, fq); }
        if (!has_next) break;
        if constexpr (CHAIN) E.carry(acc, nxt);
        else {
#pragma unroll
        for (int a = 0; a < 2; ++a)
#pragma unroll
            for (int b = 0; b < 2; ++b)
#pragma unroll
                for (int m = 0; m < 4; ++m)
#pragma unroll
                    for (int n = 0; n < 2; ++n) acc[a][b][m][n] = (f32x4){0.f, 0.f, 0.f, 0.f};
        }
        cur = nxt; cA = nA; cB = nB; uidx += G; after_epi = true;
        if constexpr (GATHA) { vA0[0] = nA0[0]; vA0[1] = nA0[1]; vA1[0] = nA1[0]; vA1[1] = nA1[1]; ++uj; }
        if (wr == 1) PG_BAR;
    }
    PG_WAIT_V(0);
    PG_BAR;
#undef PG_SA
#undef PG_SB
#undef PG_STAGE
#undef PG_LDA
#undef PG_STAGE_A0
#undef PG_STAGE_A1
#undef PG_LDB
#undef PG_MMA
#undef PG_WAIT_V
#undef PG_WAIT_L
#undef PG_WAIT_V8R
#undef PG_BAR
#undef PG_SCHED
}
}
using pg::Unit;

enum { KQ = 0, KK = 1, KPL_SILU = 2, KPL_SCALE = 3, KPL_SIG = 4, KKT = 5, KVT = 6, KVNT = 7 };

struct DecInProj {
    const char* xb; const char* WinT;
    __device__ __forceinline__ void operator()(int u, Unit& o) const {
#if DEFER_SILU
        if (u < 1792) {
            const int g = u >> 8, r = u & 255, x = r & 7, idx = r >> 3, cell = g * 8 + x, pg = cell / 7, jg7 = cell - pg * 7, pm = pg * 8 + (idx & 7), j = (jg7 < 2 ? jg7 : jg7 + 1) * 4 + (idx >> 3);
            const int wt = j < 8 ? j : (j < 24 ? j + 8 : j + 12);
#else
        if (u < 2048) {
            const int g = u >> 8, r = u & 255, x = r & 7, idx = r >> 3, pm = g * 8 + (idx & 7), j = ((x + g) & 7) * 4 + (idx >> 3);
            const int wt = j < 8 ? j : (j < 24 ? j + 8 : j + 12);
#endif
            o.A = xb + (size_t)pm * (256 * 1024 * 2); o.B = WinT + (size_t)wt * (256 * 1024 * 2); o.b = pm * 256; o.c = 0;
            if (wt < 4) { o.kind = KQ; o.a = wt; }
            else if (wt < 8) { o.kind = KK; o.a = wt - 4; }
            else if (wt < 24) { o.kind = KPL_SILU; o.a = (wt - 16) * 256; }
            else if (wt < 28) { o.kind = KPL_SCALE; o.a = (wt - 24) * 256; o.c = 0; }
            else if (wt < 32) { o.kind = KPL_SCALE; o.a = (wt - 28) * 256; o.c = 1; }
            else { o.kind = KPL_SIG; o.a = (wt - 36) * 256; }
        } else {
            const int v = u - (DEFER_SILU ? 1792 : 2048), g = v >> 8, r = v & 255, x = r & 7, idx = r >> 3, ci = 4 * g + (idx >> 3), tt = x * 8 + (idx & 7);
            int ct;
            if (ci < 8) { ct = 8 + ci; o.kind = KVT; o.a = ci >> 1; o.c = ci & 1; }
            else { ct = 32 + (ci - 8); o.kind = KVNT; o.a = ci - 8; o.c = 0; }
            o.A = WinT + (size_t)ct * (256 * 1024 * 2); o.B = xb + (size_t)tt * (256 * 1024 * 2); o.b = tt * 256;
        }
    }
};
struct DecInProjD {
    const char* xb; const char* WinT; int mode;
    __device__ __forceinline__ void operator()(int u, Unit& o) const {
        int pm, t4;
        if (mode == 0) { const int x = u & 7, i = u >> 3; pm = x * 4 + (i & 3); t4 = i >> 2; }
        else { const int k = u >> 6, r = u & 63, x = r & 7, i = r >> 3; pm = 32 + x * 4 + (i & 3); t4 = (i >> 2) * 2 + k; }
        o.A = xb + (size_t)pm * (256 * 1024 * 2); o.B = WinT + (size_t)(16 + t4) * (256 * 1024 * 2); o.b = pm * 256; o.c = 0; o.kind = KPL_SILU; o.a = t4 * 256;
    }
};
struct EpiInProj {
    unsigned char* ws_;
    const float* decay;
    __device__ __forceinline__ void operator()(const f32x4 (&acc)[2][2][4][2], const Unit& u, int wr, int wc, int fr, int fq) const {
        unsigned char* w = launder_s(ws_);
        bf16_t* const Q = (bf16_t*)(w + WS_Q); bf16_t* const Kb = (bf16_t*)(w + WS_K); bf16_t* const ACAT = (bf16_t*)(w + WS_ACAT); bf16_t* const BCAT = (bf16_t*)(w + WS_BCAT);
        bf16_t* const KDT = (bf16_t*)(w + WS_KDT); bf16_t* const SG = (bf16_t*)(w + WS_SG); bf16_t* const QN = (bf16_t*)(w + WS_QN); bf16_t* const KN = (bf16_t*)(w + WS_KN);
        bf16_t* const VNT = (bf16_t*)(w + WS_VNT); bf16_t* const Gt = (bf16_t*)(w + WS_G);
        const float* const frq = (const float*)(w + WS_TAB);
        const int kind = u.kind, c8 = wc * 32 + fq * 8;
        if (kind == KQ || kind == KK) {
            const int h = u.a, t0 = u.b;
            float lf = 0.f, lb = 0.f;
            lf = log2_sigmoid(decay[h]); lb = log2_sigmoid(decay[4 + h]);
            bf16x8 iy1, iy2;
#pragma unroll
            for (int i = 0; i < 8; ++i) { iy1[i] = (8 * fq + i == fr) ? (short)0x3F80 : (short)0; iy2[i] = (8 * fq + i == 16 + fr) ? (short)0x3F80 : (short)0; }
            const f32x4 fh0 = *(const GAS f32x4*)(frq + c8), fh1 = *(const GAS f32x4*)(frq + c8 + 4), fl0 = *(const GAS f32x4*)(frq + 128 + c8), fl1 = *(const GAS f32x4*)(frq + 128 + c8 + 4);
#pragma unroll
            for (int am = 0; am < 4; ++am) {
                const int ai = am >> 1;
#pragma unroll
                for (int mm = 0; mm < 2; ++mm) {
                    const int m = (am & 1) * 2 + mm;
                    const int t = t0 + ai * 128 + wr * 64 + m * 16 + fr;
                    const float pf = (float)(t & 4095);
                    f32x4 c0, c1, s0, s1;
#pragma unroll
                    for (int i = 0; i < 4; ++i) {
                        const float r0 = fmaf(pf, fl0[i], __builtin_amdgcn_fractf(pf * fh0[i])), r1 = fmaf(pf, fl1[i], __builtin_amdgcn_fractf(pf * fh1[i]));
                        c0[i] = __builtin_amdgcn_cosf(r0); s0[i] = __builtin_amdgcn_sinf(r0); c1[i] = __builtin_amdgcn_cosf(r1); s1[i] = __builtin_amdgcn_sinf(r1);
                    }
                    const f32x4 x1a = acc[ai][0][m][0], x1b = acc[ai][0][m][1], x2a = acc[ai][1][m][0], x2b = acc[ai][1][m][1];
                    f32x4 q1a = x1a * c0 - x2a * s0, q1b = x1b * c1 - x2b * s1, q2a = x1a * s0 + x2a * c0, q2b = x1b * s1 + x2b * c1;
                    if (kind == KQ) {
                        bf16_t* qp = Q + (size_t)t * 1024 + h * 256 + c8;
                        NT16(qp, pack8(q1a, q1b)); NT16((qp + 128), pack8(q2a, q2b));
                        const int p = t & 511; const float df = fast_exp2(lf * (float)(p + 1)), db = fast_exp2(lb * (float)(512 - p));
                        bf16_t* ap = ACAT + ((size_t)t * 4 + h) * 1024 + 512 + c8;
                        NT16(ap, pack8(q1a * df, q1b * df)); NT16((ap + 128), pack8(q2a * df, q2b * df));
                        NT16((ap + 256), pack8(q1a * db, q1b * db)); NT16((ap + 384), pack8(q2a * db, q2b * db));
                    } else {
                        bf16_t* kp = Kb + (size_t)t * 1024 + h * 256 + c8;
                        const u32x4 f0 = pack8(q1a * 0.0625f, q1b * 0.0625f), f1 = pack8(q2a * 0.0625f, q2b * 0.0625f);
                        NT16(kp, f0); NT16((kp + 128), f1);
                        const int tk = t0 + ai * 128 + wr * 64 + m * 16 + 4 * fq, sk = tk & 4095, jk = sk & 511;
                        f32x4 dfv, dbv;
#pragma unroll
                        for (int r = 0; r < 4; ++r) { dfv[r] = fast_exp2(lf * (float)(511 - (jk + r))); dbv[r] = fast_exp2(lb * (float)(jk + r)); }
                        bf16_t* const kt0 = KDT + ((((size_t)((tk >> 12) * 4 + h) * 8 + (sk >> 9)) * 2) * 256) * 512 + (size_t)(jk >> 3) * 128 + fr * 8 + (jk & 7);
#pragma unroll
                        for (int bj = 0; bj < 2; ++bj)
#pragma unroll
                            for (int hf = 0; hf < 2; ++hf) {
                                const f32x4 z4 = {0.f, 0.f, 0.f, 0.f};
                                const f32x4 dt = __builtin_amdgcn_mfma_f32_16x16x32_bf16(__builtin_bit_cast(bf16x8, bj ? f1 : f0), hf ? iy2 : iy1, z4, 0, 0, 0);
                                bf16_t* dp = kt0 + (size_t)(bj * 8 + wc * 2 + hf) * (64 * 128);
                                *(GAS u32x2*)dp = pack4(dt * dfv); *(GAS u32x2*)(dp + 256 * 512) = pack4(dt * dbv);
                            }
                    }
                    __builtin_amdgcn_sched_barrier(0);
                }
            }
        } else if (kind == KPL_SILU || kind == KPL_SCALE || kind == KPL_SIG) {
            const int t0 = u.b;
            bf16_t* dst; int ld; float sc = 1.f;
            if (kind == KPL_SILU) { dst = SG; ld = 2048; }
            else if (kind == KPL_SIG) { dst = Gt; ld = 2048; }
            else { ld = 1024; if (u.c == 0) { dst = QN; sc = 0.125f * LOG2E; } else { dst = KN; } }
            dst += u.a + c8;
#pragma unroll
            for (int ai = 0; ai < 2; ++ai)
#pragma unroll
                for (int m = 0; m < 4; ++m) {
                    const int t = t0 + ai * 128 + wr * 64 + m * 16 + fr;
#pragma unroll
                    for (int bj = 0; bj < 2; ++bj) {
                        f32x4 v0 = acc[ai][bj][m][0], v1 = acc[ai][bj][m][1];
                        if (kind == KPL_SCALE) { v0 = v0 * sc; v1 = v1 * sc; }
                        else if (kind == KPL_SIG) {
#pragma unroll
                            for (int i = 0; i < 4; ++i) { v0[i] = sigmoid_f(v0[i]); v1[i] = sigmoid_f(v1[i]); }
                        }
                        NT16((dst + (size_t)t * ld + bj * 128), pack8(v0, v1));
                    }
                }
        } else {
            const int t0 = u.b, bb = t0 >> 12, s0 = t0 & 4095, cc = s0 >> 9, j0 = s0 & 511;
            if (kind == KVT) {
                const int h = u.a;
#pragma unroll
                for (int ai = 0; ai < 2; ++ai)
#pragma unroll
                    for (int m = 0; m < 4; ++m) {
                        const int e = u.c * 256 + ai * 128 + wr * 64 + m * 16 + fr;
                        bf16_t* vp = BCAT + (((size_t)(bb * 4 + h) * 8 + cc) * 512 + e) * 1024 + j0 + c8;
#pragma unroll
                        for (int bj = 0; bj < 2; ++bj) NT16((vp + bj * 128), pack8(acc[ai][bj][m][0], acc[ai][bj][m][1]));
                    }
            } else {
#pragma unroll
                for (int ai = 0; ai < 2; ++ai)
#pragma unroll
                    for (int m = 0; m < 4; ++m) {
                        const int ch = u.a * 256 + ai * 128 + wr * 64 + m * 16 + fr;
                        bf16_t* vp = VNT + ((size_t)bb * 1024 + ch) * 4096 + s0 + c8;
#pragma unroll
                        for (int bj = 0; bj < 2; ++bj) NT16((vp + bj * 128), pack8(acc[ai][bj][m][0], acc[ai][bj][m][1]));
                    }
            }
        }
    }
};

__device__ __forceinline__ int xcd_perm(int u, int rs, int nunits) {
    const int i = u / rs, b = u - i * rs;
    return ((i + 1) * rs <= nunits) ? i * rs + (b & 7) * (rs >> 3) + (b >> 3) : u;
}
struct DecR1 {
    const char* Q; const char* Kb; int rs;
    __device__ __forceinline__ void operator()(int u0, Unit& o) const {
        const int u = xcd_perm(u0, rs, 512);
        const int pn2 = u & 1, pm2 = (u >> 1) & 1, cc = (u >> 2) & 7, bh = u >> 5, b = bh >> 2, h = bh & 3;
        const int ti = b * 4096 + cc * 512 + pm2 * 256, tj = b * 4096 + cc * 512 + pn2 * 256;
        o.A = Q + ((size_t)ti * 1024 + h * 256) * 2; o.B = Kb + ((size_t)tj * 1024 + h * 256) * 2;
        o.kind = 0; o.a = h; o.b = ti; o.c = pm2 * 2 + pn2;
    }
};
struct EpiR1 {
    bf16_t* ACAT; const float* decay;
    __device__ __forceinline__ void operator()(const f32x4 (&acc)[2][2][4][2], const Unit& u, int wr, int wc, int fr, int fq) const {
        const int h = u.a, ti0 = u.b, i0 = (u.c >> 1) * 256, j0 = (u.c & 1) * 256, c8 = wc * 32 + fq * 8;
        const float lf = log2_sigmoid(decay[h]), lb = log2_sigmoid(decay[4 + h]);
#pragma unroll
        for (int ai = 0; ai < 2; ++ai)
#pragma unroll
            for (int m = 0; m < 4; ++m) {
                const int r = ai * 128 + wr * 64 + m * 16 + fr, i = i0 + r;
                bf16_t* ap = ACAT + ((size_t)(ti0 + r) * 4 + h) * 1024 + j0 + c8;
#pragma unroll
                for (int bj = 0; bj < 2; ++bj) {
                    f32x4 v0 = acc[ai][bj][m][0], v1 = acc[ai][bj][m][1];
                    const int jb = j0 + bj * 128 + c8;
#pragma unroll
                    for (int q = 0; q < 4; ++q) {
                        const int d0 = i - (jb + q), d1 = i - (jb + 4 + q);
                        v0[q] *= fast_exp2(d0 >= 0 ? lf * (float)d0 : lb * (float)(-d0));
                        v1[q] *= fast_exp2(d1 >= 0 ? lf * (float)d1 : lb * (float)(-d1));
                    }
                    *(GAS u32x4*)(ap + bj * 128) = pack8(v0, v1);
                }
                __builtin_amdgcn_sched_barrier(0);
            }
    }
};
struct DecR2c {
    const char* BCAT; const char* KDT;
    __device__ __forceinline__ void operator()(int u, Unit& o) const {
        const int ch = u & 63, i = u >> 6, pm2 = ch & 1, dir = (ch >> 1) & 1, bh = ch >> 2;
        const int cs = dir ? 7 - i : i, ct = dir ? 6 - i : i + 1;
        o.A = BCAT + (((size_t)(bh * 8 + cs) * 512 + pm2 * 256) * 1024) * 2;
        o.B = KDT + ((((size_t)(bh * 8 + cs) * 2 + dir) * 256) * 512) * 2;
        o.kind = i; o.a = (bh * 8 + ct) * 512 + pm2 * 256; o.b = dir; o.c = dir * 4 + (bh & 3);
    }
};
struct EpiR2c {
    bf16_t* BCAT; const float* decay;
    __device__ __forceinline__ void carry(f32x4 (&acc)[2][2][4][2], const Unit& nx) const {
        const float cd = fast_exp2(log2_sigmoid(decay[nx.c]) * 512.0f);
#pragma unroll
        for (int a = 0; a < 2; ++a)
#pragma unroll
            for (int b = 0; b < 2; ++b)
#pragma unroll
                for (int m = 0; m < 4; ++m)
#pragma unroll
                    for (int n = 0; n < 2; ++n) acc[a][b][m][n] = acc[a][b][m][n] * cd;
    }
    __device__ __forceinline__ void operator()(const f32x4 (&acc)[2][2][4][2], const Unit& u, int wr, int wc, int fr, int fq) const {
        const int c8 = wc * 32 + fq * 8, dir = u.b;
#pragma unroll
        for (int ai = 0; ai < 2; ++ai)
#pragma unroll
            for (int m = 0; m < 4; ++m) {
                const int row = ai * 128 + wr * 64 + m * 16 + fr;
                bf16_t* sp = BCAT + ((size_t)u.a + row) * 1024 + 512 + dir * 256 + c8;
#pragma unroll
                for (int bj = 0; bj < 2; ++bj) *(GAS u32x4*)(sp + bj * 128) = pack8(acc[ai][bj][m][0], acc[ai][bj][m][1]);
                if (u.kind == 0) {
                    bf16_t* zp = dir ? sp + (size_t)512 * 1024 : sp - (size_t)512 * 1024;
                    const u32x4 z = {0u, 0u, 0u, 0u};
#pragma unroll
                    for (int bj = 0; bj < 2; ++bj) *(GAS u32x4*)(zp + bj * 128) = z;
                }
            }
    }
};
struct DecR4 {
    const char* ACAT; const char* BCAT; int rs;
    static __device__ __forceinline__ int panel_of(int wg) { return (wg & 7) * 32 + (wg >> 3); }
    __device__ __forceinline__ void operator()(int u0, Unit& o) const {
        const int pn2 = u0 >> 8, p = panel_of(u0 & 255);
        const int pm2 = p & 1, cc = (p >> 1) & 7, bh = p >> 4, b = bh >> 2, h = bh & 3;
        const int ti = b * 4096 + cc * 512 + pm2 * 256;
        o.A = ACAT + (((size_t)ti * 4 + h) * 1024) * 2; o.B = BCAT + (((size_t)(bh * 8 + cc) * 512 + pn2 * 256) * 1024) * 2;
        o.kind = 0; o.a = h * 512 + pn2 * 256; o.b = ti; o.c = 0;
    }
};
struct EpiR4 {
    bf16_t* RET;
    __device__ __forceinline__ void operator()(const f32x4 (&acc)[2][2][4][2], const Unit& u, int wr, int wc, int fr, int fq) const {
        const int c8 = wc * 32 + fq * 8;
#pragma unroll
        for (int ai = 0; ai < 2; ++ai)
#pragma unroll
            for (int m = 0; m < 4; ++m) {
                const int t = u.b + ai * 128 + wr * 64 + m * 16 + fr;
                bf16_t* rp = RET + (size_t)t * 2048 + u.a + c8;
#pragma unroll
                for (int bj = 0; bj < 2; ++bj) *(GAS u32x4*)(rp + bj * 128) = pack8(acc[ai][bj][m][0], acc[ai][bj][m][1]);
            }
    }
};
constexpr int LM_HN_PART = 4096, LM_HN_FIN0 = 12288, LM_HN_FIN1 = 14336;
struct EpiR4f {
    unsigned char* ws_; LAS unsigned char* lds;
    __device__ __forceinline__ void operator()(const f32x4 (&acc)[2][2][4][2], const Unit& u, int wr, int wc, int fr_, int fq) const {
        unsigned char* w = launder_s(ws_);
        const int fr = launder_v(fr_);
        bf16_t* const RET = (bf16_t*)(w + WS_KV); const bf16_t* const SG = (const bf16_t*)(w + WS_SG); bf16_t* const AR = (bf16_t*)(w + WS_KDT);
        LAS f32x2* part = (LAS f32x2*)(lds + LDS_MISC + LM_HN_PART); LAS f32x2* fin0 = (LAS f32x2*)(lds + LDS_MISC + LM_HN_FIN0); LAS f32x2* fin1 = (LAS f32x2*)(lds + LDS_MISC + LM_HN_FIN1);
        const int c8 = wc * 32 + fq * 8; const bool second = (u.a & 256) != 0;
#pragma unroll
        for (int ai = 0; ai < 2; ++ai)
#pragma unroll
            for (int m = 0; m < 4; ++m) {
                float s1 = 0.f, s2 = 0.f;
#pragma unroll
                for (int bj = 0; bj < 2; ++bj)
#pragma unroll
                    for (int n = 0; n < 2; ++n)
#pragma unroll
                        for (int i = 0; i < 4; ++i) { const float v = acc[ai][bj][m][n][i]; s1 += v; s2 += v * v; }
                s1 += __shfl_xor(s1, 16); s2 += __shfl_xor(s2, 16); s1 += __shfl_xor(s1, 32); s2 += __shfl_xor(s2, 32);
                if (fq == 0) { f32x2 ps; ps.x = s1; ps.y = s2; part[(ai * 128 + wr * 64 + m * 16 + fr) * 4 + wc] = ps; }
            }
        if (!second) {
#pragma unroll
            for (int ai = 0; ai < 2; ++ai)
#pragma unroll
                for (int m = 0; m < 4; ++m) {
                    const int t = u.b + ai * 128 + wr * 64 + m * 16 + fr;
                    bf16_t* rp = RET + (size_t)t * 2048 + u.a + c8;
#pragma unroll
                    for (int bj = 0; bj < 2; ++bj) *(GAS u32x4*)(rp + bj * 128) = pack8(acc[ai][bj][m][0], acc[ai][bj][m][1]);
                }
            LDS_WAIT(); __builtin_amdgcn_s_barrier();
            const int tid = (wr * 4 + wc) * 64 + fq * 16 + fr;
            if (tid < 256) { const f32x2 a = part[tid * 4], b = part[tid * 4 + 1], c = part[tid * 4 + 2], d = part[tid * 4 + 3]; f32x2 f; f.x = (a.x + b.x) + (c.x + d.x); f.y = (a.y + b.y) + (c.y + d.y); fin0[tid] = f; }
            LDS_WAIT();
        } else {
            LDS_WAIT(); __builtin_amdgcn_s_barrier();
#pragma unroll
            for (int am = 0; am < 4; ++am) {
                const int ai = am >> 1;
                u32x4 gv[2][2];
#pragma unroll
                for (int mm = 0; mm < 2; ++mm)
#pragma unroll
                    for (int bj = 0; bj < 2; ++bj) gv[mm][bj] = *(const GAS u32x4*)(SG + (size_t)(u.b + ai * 128 + wr * 64 + ((am & 1) * 2 + mm) * 16 + fr) * 2048 + u.a + bj * 128 + c8);
                __builtin_amdgcn_sched_barrier(0);
#pragma unroll
                for (int mm = 0; mm < 2; ++mm) {
                    const int m = (am & 1) * 2 + mm;
                    const int row = ai * 128 + wr * 64 + m * 16 + fr, t = u.b + row;
                    const f32x2 a = part[row * 4], b = part[row * 4 + 1], c = part[row * 4 + 2], d = part[row * 4 + 3], f0 = fin0[row];
                    const float S1 = ((a.x + b.x) + (c.x + d.x)) + f0.x, S2 = ((a.y + b.y) + (c.y + d.y)) + f0.y;
                    const float mean = S1 * (1.0f / 512.0f), var = fmaxf(S2 * (1.0f / 512.0f) - mean * mean, 0.f), rstd = 1.0f / sqrtf(var + 1e-5f);
                    if (wc == 0 && fq == 0) { f32x2 st; st.x = mean; st.y = rstd; fin1[row] = st; }
#pragma unroll
                    for (int bj = 0; bj < 2; ++bj) {
                        const u32x4 g = gv[mm][bj];
                        const float gg[8] = {bf_lo(g.x), bf_hi(g.x), bf_lo(g.y), bf_hi(g.y), bf_lo(g.z), bf_hi(g.z), bf_lo(g.w), bf_hi(g.w)};
                        f32x4 v0 = acc[ai][bj][m][0], v1 = acc[ai][bj][m][1];
#pragma unroll
                        for (int i = 0; i < 4; ++i) { v0[i] = (v0[i] - mean) * (gg[i] * sigmoid_f(gg[i]) * rstd); v1[i] = (v1[i] - mean) * (gg[4 + i] * sigmoid_f(gg[4 + i]) * rstd); }
                        *(GAS u32x4*)(AR + (size_t)t * 2048 + u.a + bj * 128 + c8) = pack8(v0, v1);
                    }
                }
                __builtin_amdgcn_sched_barrier(0);
            }
            LDS_WAIT();
        }
    }
};
struct DecDense {
    const char* A; const char* B; int lda2, ldb2;
    __device__ __forceinline__ void operator()(int u, Unit& o) const {
        const int pn = u >> 6, pm = u & 63;
        o.A = A + (size_t)pm * 256 * lda2; o.B = B + (size_t)pn * 256 * ldb2; o.kind = 0; o.a = pn * 256; o.b = pm * 256; o.c = 0;
    }
};
template <int MODE> struct EpiMerge {
    bf16_t* MG; const bf16_t* Gt;
    __device__ __forceinline__ void operator()(const f32x4 (&acc)[2][2][4][2], const Unit& u, int wr, int wc, int fr, int fq) const {
        const int c8 = wc * 32 + fq * 8;
#pragma unroll
        for (int ai = 0; ai < 2; ++ai) {
            u32x4 gv[4][2], ov[4][2];
#pragma unroll
            for (int m = 0; m < 4; ++m)
#pragma unroll
                for (int bj = 0; bj < 2; ++bj) { const int t = u.b + ai * 128 + wr * 64 + m * 16 + fr, c = u.a + bj * 128 + c8;
                    gv[m][bj] = *(const GAS u32x4*)(Gt + (size_t)t * 2048 + MODE * 1024 + c);
                    if (MODE == 1) ov[m][bj] = *(const GAS u32x4*)(MG + (size_t)t * 1024 + c); }
            __builtin_amdgcn_sched_barrier(0);
#pragma unroll
            for (int m = 0; m < 4; ++m) {
                const int t = u.b + ai * 128 + wr * 64 + m * 16 + fr;
#pragma unroll
                for (int bj = 0; bj < 2; ++bj) {
                    const int c = u.a + bj * 128 + c8; const u32x4 g = gv[m][bj];
                    f32x4 v0 = acc[ai][bj][m][0], v1 = acc[ai][bj][m][1];
                    v0[0] *= bf_lo(g.x); v0[1] *= bf_hi(g.x); v0[2] *= bf_lo(g.y); v0[3] *= bf_hi(g.y);
                    v1[0] *= bf_lo(g.z); v1[1] *= bf_hi(g.z); v1[2] *= bf_lo(g.w); v1[3] *= bf_hi(g.w);
                    if (MODE == 1) { const u32x4 o = ov[m][bj];
                        v0[0] += bf_lo(o.x); v0[1] += bf_hi(o.x); v0[2] += bf_lo(o.y); v0[3] += bf_hi(o.y);
                        v1[0] += bf_lo(o.z); v1[1] += bf_hi(o.z); v1[2] += bf_lo(o.w); v1[3] += bf_hi(o.w); }
                    *(GAS u32x4*)(MG + (size_t)t * 1024 + c) = pack8(v0, v1);
                }
            }
            __builtin_amdgcn_sched_barrier(0);
        }
    }
};
struct EpiPre {
    float* PRE; const bf16_t* xb;
    __device__ __forceinline__ void operator()(const f32x4 (&acc)[2][2][4][2], const Unit& u, int wr, int wc, int fr, int fq) const {
        const int c8 = wc * 32 + fq * 8;
        u32x4 xv[2][4][2];
#pragma unroll
        for (int ai = 0; ai < 2; ++ai)
#pragma unroll
            for (int m = 0; m < 4; ++m)
#pragma unroll
                for (int bj = 0; bj < 2; ++bj) xv[ai][m][bj] = *(const GAS u32x4*)(xb + (size_t)(u.b + ai * 128 + wr * 64 + m * 16 + fr) * 1024 + u.a + bj * 128 + c8);
        __builtin_amdgcn_sched_barrier(0);
#pragma unroll
        for (int ai = 0; ai < 2; ++ai)
#pragma unroll
            for (int m = 0; m < 4; ++m) {
                const int t = u.b + ai * 128 + wr * 64 + m * 16 + fr;
#pragma unroll
                for (int bj = 0; bj < 2; ++bj) {
                    const size_t o = (size_t)t * 1024 + u.a + bj * 128 + c8; const u32x4 x = xv[ai][m][bj];
                    const f32x4 x0 = {bf_lo(x.x), bf_hi(x.x), bf_lo(x.y), bf_hi(x.y)}, x1 = {bf_lo(x.z), bf_hi(x.z), bf_lo(x.w), bf_hi(x.w)};
                    *(GAS f32x4*)(PRE + o) = x0 * ALPHA + acc[ai][bj][m][0]; *(GAS f32x4*)(PRE + o + 4) = x1 * ALPHA + acc[ai][bj][m][1];
                }
            }
    }
};
struct DecMoe {
    const char* A; const char* W; int lda2, wexp2, ldb2; const LAS int* tile_e; int rs, nunits;
    __device__ __forceinline__ void operator()(int u0, Unit& o) const {
        const int u = xcd_perm(u0, rs, nunits);
        const int a = u >> 2, pn = u & 3, e = tile_e[a];
        o.A = A + (size_t)a * 256 * lda2; o.B = W + (size_t)e * wexp2 + (size_t)pn * 256 * ldb2; o.kind = 0; o.a = pn; o.b = a * 256; o.c = 0;
    }
};
struct EpiUp {
    bf16_t* H;
    __device__ __forceinline__ void operator()(const f32x4 (&acc)[2][2][4][2], const Unit& u, int wr, int wc, int fr, int fq) const {
        const int c8 = wc * 32 + fq * 8;
#pragma unroll
        for (int ai = 0; ai < 2; ++ai)
#pragma unroll
            for (int m = 0; m < 4; ++m) {
                const int r = u.b + ai * 128 + wr * 64 + m * 16 + fr;
                f32x4 g0 = acc[ai][0][m][0], g1 = acc[ai][0][m][1]; const f32x4 u0 = acc[ai][1][m][0], u1 = acc[ai][1][m][1];
#pragma unroll
                for (int i = 0; i < 4; ++i) { g0[i] = g0[i] * sigmoid_f(g0[i]) * u0[i]; g1[i] = g1[i] * sigmoid_f(g1[i]) * u1[i]; }
                *(GAS u32x4*)(H + (size_t)r * 512 + u.a * 128 + c8) = pack8(g0, g1);
            }
    }
};
struct EpiDown {
    bf16_t* Y;
    __device__ __forceinline__ void operator()(const f32x4 (&acc)[2][2][4][2], const Unit& u, int wr, int wc, int fr, int fq) const {
        const int c8 = wc * 32 + fq * 8;
#pragma unroll
        for (int ai = 0; ai < 2; ++ai)
#pragma unroll
            for (int m = 0; m < 4; ++m) {
                const int r = u.b + ai * 128 + wr * 64 + m * 16 + fr;
                bf16_t* yp = Y + (size_t)r * 1024 + u.a * 256 + c8;
#pragma unroll
                for (int bj = 0; bj < 2; ++bj) *(GAS u32x4*)(yp + bj * 128) = pack8(acc[ai][bj][m][0], acc[ai][bj][m][1]);
            }
    }
};

struct Params {
    const float* x; const float* w_in; const float* decay; const float* w_ret_o; const float* rpb; const float* w_na_o; const float* w_out;
    const float* ln_mix_g; const float* ln_mix_b; const float* router_w; const float* router_bias;
    const float* w_gate; const float* w_up; const float* w_down; const float* ln_ffn_g; const float* ln_ffn_b;
    float* out; unsigned char* ws; int ph_lo, ph_hi;
};
__device__ __forceinline__ Params load_params() {
    typedef __attribute__((address_space(4))) const Params CP;
    CP* pk = (CP*)__builtin_amdgcn_kernarg_segment_ptr();
    asm volatile("" : "+s"(pk));
    Params r;
    r.x = pk->x; r.w_in = pk->w_in; r.decay = pk->decay; r.w_ret_o = pk->w_ret_o; r.rpb = pk->rpb; r.w_na_o = pk->w_na_o; r.w_out = pk->w_out;
    r.ln_mix_g = pk->ln_mix_g; r.ln_mix_b = pk->ln_mix_b; r.router_w = pk->router_w; r.router_bias = pk->router_bias;
    r.w_gate = pk->w_gate; r.w_up = pk->w_up; r.w_down = pk->w_down; r.ln_ffn_g = pk->ln_ffn_g; r.ln_ffn_b = pk->ln_ffn_b;
    r.out = pk->out; r.ws = pk->ws; r.ph_lo = pk->ph_lo; r.ph_hi = pk->ph_hi;
    return r;
}
constexpr int CV_NIT = 16 * 352 + 32 * 32 + 16 * 32 + 16 * 32 + 3 * 32 * 256;
struct CvItem { const float* src; bf16_t* dst; int ldw, ldwt; };
__device__ __forceinline__ CvItem cv_decode(const Params& P, int l, unsigned char* ws, int r) {
    constexpr int I0 = 16 * 352, I1 = 32 * 32, I2 = 16 * 32, I3 = 16 * 32, I4 = 32 * 256;
    CvItem c;
    if (r < I0) { const int kb = r / 352, nb = r % 352; c.src = P.w_in + (size_t)l * 1024 * DIN + (size_t)kb * 64 * DIN + nb * 32; c.ldw = DIN; c.dst = (bf16_t*)(ws + WO_WIN) + (size_t)nb * 32 * 1024 + kb * 64; c.ldwt = 1024; return c; } r -= I0;
    if (r < I1) { const int kb = r >> 5, nb = r & 31; c.src = P.w_ret_o + (size_t)l * 2048 * 1024 + (size_t)kb * 64 * 1024 + nb * 32; c.ldw = 1024; c.dst = (bf16_t*)(ws + WO_WRET) + (size_t)nb * 32 * 2048 + kb * 64; c.ldwt = 2048; return c; } r -= I1;
    if (r < I2) { const int kb = r >> 5, nb = r & 31; c.src = P.w_na_o + (size_t)l * 1024 * 1024 + (size_t)kb * 64 * 1024 + nb * 32; c.ldw = 1024; c.dst = (bf16_t*)(ws + WO_WNA) + (size_t)nb * 32 * 1024 + kb * 64; c.ldwt = 1024; return c; } r -= I2;
    if (r < I3) { const int kb = r >> 5, nb = r & 31; c.src = P.w_out + (size_t)l * 1024 * 1024 + (size_t)kb * 64 * 1024 + nb * 32; c.ldw = 1024; c.dst = (bf16_t*)(ws + WO_WOUT) + (size_t)nb * 32 * 1024 + kb * 64; c.ldwt = 1024; return c; } r -= I3;
    if (r < 2 * I4) { const int up = r >= I4 ? 1 : 0; if (up) r -= I4; const int e = r >> 8, q = r & 255, kb = q >> 4, nb = q & 15, n0 = nb * 32;
        c.src = (up ? P.w_up : P.w_gate) + ((size_t)l * NE + e) * 1024 * 512 + (size_t)kb * 64 * 512 + n0; c.ldw = 512;
        c.dst = (bf16_t*)(ws + WO_WGU) + (size_t)(e * 1024 + (n0 >> 7) * 256 + up * 128 + (n0 & 127)) * 1024 + kb * 64; c.ldwt = 1024; return c; } r -= 2 * I4;
    { const int e = r >> 8, q = r & 255, kb = q >> 5, nb = q & 31;
      c.src = P.w_down + ((size_t)l * NE + e) * 512 * 1024 + (size_t)kb * 64 * 1024 + nb * 32; c.ldw = 1024; c.dst = (bf16_t*)(ws + WO_WD) + (size_t)(e * 1024 + nb * 32) * 512 + kb * 64; c.ldwt = 512; return c; }
}
__device__ __forceinline__ void cv_load(const CvItem& c, float (&wv)[32], int lane) {
#pragma unroll
    for (int i = 0; i < 32; ++i) wv[i] = ((const GAS float*)c.src)[(size_t)(2 * i + (lane >> 5)) * c.ldw + (lane & 31)];
}
__device__ __forceinline__ int cv_slot_items(int slot, int l) { return slot == 0 ? 7680 : slot == 1 ? (l == 0 ? 16384 : 8960) : slot == 2 ? (l + 1 < DEPTH ? 13824 : 8192) : (l + 1 < DEPTH ? 9472 : 0); }
__device__ __forceinline__ CvItem cv_item(const Params& P, int slot, int l, int v) {
    int ll = l, r;
    if (slot == 0) r = v;
    else if (slot == 1) r = 7680 + v;
    else if (slot == 2) { if (v < 8192) r = 24064 + v; else { ll = l + 1; r = v - 8192; } }
    else { ll = l + 1; r = v < 2048 ? 5632 + v : 16640 + (v - 2048); }
    return cv_decode(P, ll, P.ws + ws_wset(ll), r);
}
__device__ __forceinline__ void cv_transpose(const CvItem& cur, const float (&wv)[32], LAS float* scr, int lane) {
#pragma unroll
    for (int i = 0; i < 32; ++i) scr[(2 * i + (lane >> 5)) * 33 + (lane & 31)] = wv[i];
    LDS_WAIT();
    const int c = lane & 7;
#pragma unroll
    for (int j = 0; j < 4; ++j) { const int n = (lane >> 3) + 8 * j; const LAS float* s = scr + (8 * c) * 33 + n;
        u32x4 o; o.x = cvt_pk_bf16(s[0 * 33], s[1 * 33]); o.y = cvt_pk_bf16(s[2 * 33], s[3 * 33]); o.z = cvt_pk_bf16(s[4 * 33], s[5 * 33]); o.w = cvt_pk_bf16(s[6 * 33], s[7 * 33]);
        *(GAS u32x4*)(cur.dst + (size_t)n * cur.ldwt + 8 * c) = o; }
    LDS_WAIT();
}
__device__ __forceinline__ void convert_range(const Params& P, int slot, int l, LAS unsigned char* lds, int it0, int itend, int wave, int lane) {
    LAS float* scr = (LAS float*)(lds + wave * 16384);
    { const int tot = cv_slot_items(slot, l); if (itend > tot) itend = tot; }
    int it = it0 + wave; if (it >= itend) return;
    float wa[32], wb[32]; CvItem ca = cv_item(P, slot, l, it), cb = ca; cv_load(ca, wa, lane);
    if (it + 8 < itend) { cb = cv_item(P, slot, l, it + 8); cv_load(cb, wb, lane); }
    for (;;) {
        const int n2 = it + 16; const bool has2 = n2 < itend, has1 = it + 8 < itend;
        float wc[32]; CvItem cc = cb;
        if (has2) { cc = cv_item(P, slot, l, n2); cv_load(cc, wc, lane); }
        else {
#pragma unroll
            for (int i = 0; i < 32; ++i) wc[i] = 0.f;
        }
        cv_transpose(ca, wa, scr, lane);
        if (!has1) break;
#pragma unroll
        for (int i = 0; i < 32; ++i) { wa[i] = wb[i]; wb[i] = wc[i]; }
        ca = cb; cb = cc; it += 8;
    }
}
__device__ __forceinline__ void convert_share(const Params& P, int slot, int l, LAS unsigned char* lds, int a, int b, int idle, int part, int cap, int G, int bid, int wave, int lane) {
    const int S = b - a; int first = idle * cap; if (first > S) first = S;
    if (idle > 0 && part >= 0) { const int sl = (first + idle - 1) / idle, i0 = a + part * sl; int i1 = i0 + sl; if (i1 > a + first) i1 = a + first; if (i0 < i1) convert_range(P, slot, l, lds, i0, i1, wave, lane); }
    const int rest = S - first;
    if (rest > 0) { const int sl = (rest + G - 1) / G, i0 = a + first + bid * sl; int i1 = i0 + sl; if (i1 > b) i1 = b; if (i0 < i1) convert_range(P, slot, l, lds, i0, i1, wave, lane); }
}
__device__ __forceinline__ void sincos_d(double a, float& s, float& c) {
    const double k = rint(a * 0.63661977236758134308);
    double y = fma(-k, 1.5707963267948966192, a); y = fma(-k, 6.123233995736766036e-17, y);
    const double y2 = y * y;
    double sp = -1.0 / 1307674368000.0; sp = fma(sp, y2, 1.0 / 6227020800.0); sp = fma(sp, y2, -1.0 / 39916800.0); sp = fma(sp, y2, 1.0 / 362880.0); sp = fma(sp, y2, -1.0 / 5040.0); sp = fma(sp, y2, 1.0 / 120.0); sp = fma(sp, y2, -1.0 / 6.0); sp = fma(sp * y2, y, y);
    double cp = 1.0 / 20922789888000.0; cp = fma(cp, y2, -1.0 / 87178291200.0); cp = fma(cp, y2, 1.0 / 479001600.0); cp = fma(cp, y2, -1.0 / 3628800.0); cp = fma(cp, y2, 1.0 / 40320.0); cp = fma(cp, y2, -1.0 / 720.0); cp = fma(cp, y2, 1.0 / 24.0); cp = fma(cp, y2, -0.5); cp = fma(cp, y2, 1.0);
    const int q = (int)((long long)k & 3);
    const double sv = (q == 0) ? sp : (q == 1) ? cp : (q == 2) ? -sp : -cp;
    const double cv = (q == 0) ? cp : (q == 1) ? -sp : (q == 2) ? -cp : sp;
    s = (float)sv; c = (float)cv;
}
__device__ __forceinline__ void phase_init(const Params& P, LAS unsigned char* lds, int gw, int NGW, int wave, int lane) {
    unsigned char* ws = P.ws;
    float* frqt = (float*)(ws + WS_TAB);
    const int gtid = gw * 64 + lane, NT_ = NGW * 64;
    if (gtid < 128) {
        const double f = exp(-(double)gtid * (9.210340371976184 / 128.0)) * 0.15915494309189533577;
        const float fh = __uint_as_float(__float_as_uint((float)f) & 0xFFFFF000u);
        frqt[gtid] = fh; frqt[128 + gtid] = (float)(f - (double)fh);
    }
    bf16_t* wrt = (bf16_t*)(ws + WS_WRT);
    for (int i = gtid; i < DEPTH * 32 * 1024; i += NT_) {
        const int ll = i >> 15, e = (i >> 10) & 31, d = i & 1023; const float w = ((const GAS float*)P.router_w)[d * 32 + e] * ((const GAS float*)P.ln_mix_g)[ll * 1024 + d];
        const unsigned h = cvt_pk_bf16(w, 0.f) & 0xffffu; const unsigned lo = cvt_pk_bf16(w - bf_lo(h), 0.f) & 0xffffu;
        wrt[(size_t)ll * 65536 + e * 1024 + d] = (bf16_t)h; wrt[(size_t)ll * 65536 + 32768 + e * 1024 + d] = (bf16_t)lo;
    }
    float* rgc = (float*)(ws + WS_RGC);
    for (int it = gw; it < DEPTH * 32; it += NGW) {
        const int ll = it >> 5, e = it & 31; float sg = 0.f, sb = 0.f;
        for (int d = lane; d < 1024; d += 64) { const float w = ((const GAS float*)P.router_w)[d * 32 + e]; sg += w * ((const GAS float*)P.ln_mix_g)[ll * 1024 + d]; sb += w * ((const GAS float*)P.ln_mix_b)[ll * 1024 + d]; }
        sg = wave_sum(sg); sb = wave_sum(sb);
        if (lane == 0) { rgc[ll * 64 + e] = sg; rgc[ll * 64 + 32 + e] = sb; }
    }
    bf16_t* xb = (bf16_t*)(ws + WS_XB);
    for (int i = gtid; i < T * D / 8; i += NT_) {
        const f32x4 a = *(const GAS f32x4*)(P.x + (size_t)i * 8), b = *(const GAS f32x4*)(P.x + (size_t)i * 8 + 4);
        *(GAS u32x4*)(xb + (size_t)i * 8) = pack8(a, b);
    }
    convert_range(P, 0, 0, lds, (int)blockIdx.x * 30, (int)blockIdx.x * 30 + 30, wave, lane);
}
__device__ __forceinline__ void phase_prefix(const Params& P, int l, int gw, int NGW, int lane) {
    const float* KV = (const float*)(P.ws + WS_KV); bf16_t* BCAT = (bf16_t*)(P.ws + WS_BCAT);
    const float* decay = P.decay + l * 8;
    const int gtid = gw * 64 + lane, NT_ = NGW * 64;
    for (int idx = gtid; idx < 16 * 2 * 512 * 32; idx += NT_) {
        const int dg = idx & 31, e = (idx >> 5) & 511, dir = (idx >> 14) & 1, bh = idx >> 15, h = bh & 3;
        const float cd = fast_exp2(log2_sigmoid(decay[dir * 4 + h]) * 512.0f);
        f32x4 s0 = {0.f, 0.f, 0.f, 0.f}, s1 = {0.f, 0.f, 0.f, 0.f};
        for (int q = 0; q < 8; ++q) {
            const int cc = dir ? 7 - q : q;
            *(GAS u32x4*)(BCAT + ((size_t)(bh * 8 + cc) * 512 + e) * 1024 + 512 + dir * 256 + dg * 8) = pack8(s0, s1);
            if (q < 7) { const float* kp = KV + ((size_t)((bh * 8 + cc) * 2 + dir) * 512 + e) * 256 + dg * 8;
                s0 = s0 * cd + *(const GAS f32x4*)kp; s1 = s1 * cd + *(const GAS f32x4*)(kp + 4); }
        }
    }
}
__device__ __forceinline__ void phase_headnorm(const Params& P, int gw, int NGW, int lane) {
    const bf16_t* RET = (const bf16_t*)(P.ws + WS_KV); const bf16_t* SG = (const bf16_t*)(P.ws + WS_SG); bf16_t* AR = (bf16_t*)(P.ws + WS_KDT);
    for (int it0 = gw; it0 < T * 4; it0 += 4 * NGW) {
        u32x4 r[4], g[4];
#pragma unroll
        for (int k = 0; k < 4; ++k) { const int it = it0 + k * NGW; if (it < T * 4) { const size_t off = (size_t)it * 512 + lane * 8; r[k] = *(const GAS u32x4*)(RET + off); g[k] = *(const GAS u32x4*)(SG + off); } }
#pragma unroll
        for (int k = 0; k < 4; ++k) {
            const int it = it0 + k * NGW; if (it >= T * 4) break;
            const size_t off = (size_t)it * 512 + lane * 8;
            float v[8] = {bf_lo(r[k].x), bf_hi(r[k].x), bf_lo(r[k].y), bf_hi(r[k].y), bf_lo(r[k].z), bf_hi(r[k].z), bf_lo(r[k].w), bf_hi(r[k].w)};
            float s = 0.f;
#pragma unroll
            for (int i = 0; i < 8; ++i) s += v[i];
            const float mean = wave_sum(s) * (1.0f / 512.0f);
            float q = 0.f;
#pragma unroll
            for (int i = 0; i < 8; ++i) { v[i] -= mean; q += v[i] * v[i]; }
            const float rstd = 1.0f / sqrtf(wave_sum(q) * (1.0f / 512.0f) + 1e-5f);
            float gg[8] = {bf_lo(g[k].x), bf_hi(g[k].x), bf_lo(g[k].y), bf_hi(g[k].y), bf_lo(g[k].z), bf_hi(g[k].z), bf_lo(g[k].w), bf_hi(g[k].w)};
#pragma unroll
            for (int i = 0; i < 8; ++i) gg[i] = gg[i] * sigmoid_f(gg[i]) * rstd;
            u32x4 o; o.x = cvt_pk_bf16(v[0] * gg[0], v[1] * gg[1]); o.y = cvt_pk_bf16(v[2] * gg[2], v[3] * gg[3]);
            o.z = cvt_pk_bf16(v[4] * gg[4], v[5] * gg[5]); o.w = cvt_pk_bf16(v[6] * gg[6], v[7] * gg[7]);
            *(GAS u32x4*)(AR + off) = o;
        }
    }
}
__device__ __forceinline__ void headnorm_rows(const Params& P, int t0, int h, int wave, int lane) {
    const bf16_t* RET = (const bf16_t*)(P.ws + WS_KV); const bf16_t* SG = (const bf16_t*)(P.ws + WS_SG); bf16_t* AR = (bf16_t*)(P.ws + WS_KDT);
#pragma nounroll
    for (int rb = 0; rb < 32; rb += 4) {
        u32x4 r[4], g[4];
#pragma unroll
        for (int k = 0; k < 4; ++k) { const size_t off = ((size_t)(t0 + wave * 32 + rb + k) * 4 + h) * 512 + lane * 8; r[k] = *(const GAS u32x4*)(RET + off); g[k] = *(const GAS u32x4*)(SG + off); }
#pragma unroll
        for (int k = 0; k < 4; ++k) {
            const size_t off = ((size_t)(t0 + wave * 32 + rb + k) * 4 + h) * 512 + lane * 8;
            float v[8] = {bf_lo(r[k].x), bf_hi(r[k].x), bf_lo(r[k].y), bf_hi(r[k].y), bf_lo(r[k].z), bf_hi(r[k].z), bf_lo(r[k].w), bf_hi(r[k].w)};
            float s = 0.f;
#pragma unroll
            for (int i = 0; i < 8; ++i) s += v[i];
            const float mean = wave_sum(s) * (1.0f / 512.0f);
            float q = 0.f;
#pragma unroll
            for (int i = 0; i < 8; ++i) { v[i] -= mean; q += v[i] * v[i]; }
            const float rstd = 1.0f / sqrtf(wave_sum(q) * (1.0f / 512.0f) + 1e-5f);
            float gg[8] = {bf_lo(g[k].x), bf_hi(g[k].x), bf_lo(g[k].y), bf_hi(g[k].y), bf_lo(g[k].z), bf_hi(g[k].z), bf_lo(g[k].w), bf_hi(g[k].w)};
#pragma unroll
            for (int i = 0; i < 8; ++i) gg[i] = gg[i] * sigmoid_f(gg[i]) * rstd;
            u32x4 o; o.x = cvt_pk_bf16(v[0] * gg[0], v[1] * gg[1]); o.y = cvt_pk_bf16(v[2] * gg[2], v[3] * gg[3]);
            o.z = cvt_pk_bf16(v[4] * gg[4], v[5] * gg[5]); o.w = cvt_pk_bf16(v[6] * gg[6], v[7] * gg[7]);
            *(GAS u32x4*)(AR + off) = o;
        }
    }
}
__device__ __forceinline__ void headnorm_half0(const Params& P, LAS unsigned char* lds, int t0, int h, int wave, int lane) {
    const bf16_t* RET = (const bf16_t*)(P.ws + WS_KV); const bf16_t* SG = (const bf16_t*)(P.ws + WS_SG); bf16_t* AR = (bf16_t*)(P.ws + WS_KDT);
    const LAS f32x2* fin1 = (const LAS f32x2*)(lds + LDS_MISC + LM_HN_FIN1);
#pragma nounroll
    for (int rb = 0; rb < 32; rb += 8) {
        u32x4 r[4], g[4];
#pragma unroll
        for (int k = 0; k < 4; ++k) { const size_t off = ((size_t)(t0 + wave * 32 + rb + 2 * k + (lane >> 5)) * 4 + h) * 512 + (lane & 31) * 8; r[k] = *(const GAS u32x4*)(RET + off); g[k] = *(const GAS u32x4*)(SG + off); }
#pragma unroll
        for (int k = 0; k < 4; ++k) {
            const int row = wave * 32 + rb + 2 * k + (lane >> 5);
            const size_t off = ((size_t)(t0 + row) * 4 + h) * 512 + (lane & 31) * 8;
            const f32x2 st = fin1[row];
            const float v[8] = {bf_lo(r[k].x), bf_hi(r[k].x), bf_lo(r[k].y), bf_hi(r[k].y), bf_lo(r[k].z), bf_hi(r[k].z), bf_lo(r[k].w), bf_hi(r[k].w)};
            const float gg[8] = {bf_lo(g[k].x), bf_hi(g[k].x), bf_lo(g[k].y), bf_hi(g[k].y), bf_lo(g[k].z), bf_hi(g[k].z), bf_lo(g[k].w), bf_hi(g[k].w)};
            float o8[8];
#pragma unroll
            for (int i = 0; i < 8; ++i) o8[i] = (v[i] - st.x) * (gg[i] * sigmoid_f(gg[i]) * st.y);
            u32x4 o; o.x = cvt_pk_bf16(o8[0], o8[1]); o.y = cvt_pk_bf16(o8[2], o8[3]); o.z = cvt_pk_bf16(o8[4], o8[5]); o.w = cvt_pk_bf16(o8[6], o8[7]);
            *(GAS u32x4*)(AR + off) = o;
        }
    }
}
__device__ __forceinline__ void phase_na(const Params& P, int l, int gw, int NGW, int lane) {
    const bf16_t* QN = (const bf16_t*)(P.ws + WS_QN); const bf16_t* KN = (const bf16_t*)(P.ws + WS_KN); const bf16_t* VNT = (const bf16_t*)(P.ws + WS_VNT);
    bf16_t* NAO = (bf16_t*)(P.ws + WS_NAO);
    const float* rpb = P.rpb + (size_t)l * 16 * 15 * 31;
    const int fr = lane & 15, fq = lane >> 4;
    for (int id = gw; id < 16384; id += NGW) {
        const int cb = id & 3, r = (id >> 2) & 63, h = (id >> 8) & 15, b = id >> 12;
        const int rs = min(max(r - 4, 0), 56), c0 = cb * 16, cs = min(max(c0 - 8, 0), 32);
        const int c = c0 + fr, cst = min(max(c - 8, 0), 48);
        const size_t tq = (size_t)b * 4096 + r * 64 + c;
        const bf16x8 yq0 = *(const GAS bf16x8*)(QN + tq * 1024 + h * 64 + 8 * fq), yq1 = *(const GAS bf16x8*)(QN + tq * 1024 + h * 64 + 32 + 8 * fq);
        f32x4 S[16];
#pragma unroll
        for (int kt = 0; kt < 16; ++kt) {
            const int kr = rs + (kt >> 1), kcb = cs + (kt & 1) * 16;
            const size_t tk = (size_t)b * 4096 + kr * 64 + kcb + fr;
            const bf16x8 xk0 = *(const GAS bf16x8*)(KN + tk * 1024 + h * 64 + 8 * fq), xk1 = *(const GAS bf16x8*)(KN + tk * 1024 + h * 64 + 32 + 8 * fq);
            f32x4 z = {0.f, 0.f, 0.f, 0.f};
            z = __builtin_amdgcn_mfma_f32_16x16x32_bf16(xk0, yq0, z, 0, 0, 0);
            z = __builtin_amdgcn_mfma_f32_16x16x32_bf16(xk1, yq1, z, 0, 0, 0);
            const float* bp = rpb + (h * 15 + (kr - r + 7)) * 31;
#pragma unroll
            for (int j = 0; j < 4; ++j) {
                const int kc = kcb + 4 * fq + j; const bool valid = (kc >= cst) && (kc < cst + 16);
                const int co = min(max(kc - c + 15, 0), 30);
                const float bias = ((const GAS float*)bp)[co];
                z[j] = valid ? z[j] + bias : -INFINITY;
            }
            S[kt] = z;
        }
        float mx = -INFINITY;
#pragma unroll
        for (int kt = 0; kt < 16; ++kt)
#pragma unroll
            for (int j = 0; j < 4; ++j) mx = fmaxf(mx, S[kt][j]);
        mx = fmaxf(mx, __shfl_xor(mx, 16)); mx = fmaxf(mx, __shfl_xor(mx, 32));
        float sum = 0.f;
#pragma unroll
        for (int kt = 0; kt < 16; ++kt)
#pragma unroll
            for (int j = 0; j < 4; ++j) { const float p = fast_exp2((S[kt][j] - mx) * LOG2E); S[kt][j] = p; sum += p; }
        sum += __shfl_xor(sum, 16); sum += __shfl_xor(sum, 32);
        f32x4 O[4];
#pragma unroll
        for (int ht = 0; ht < 4; ++ht) O[ht] = (f32x4){0.f, 0.f, 0.f, 0.f};
#pragma unroll
        for (int p = 0; p < 8; ++p) {
            const u32x4 yw = pack8(S[2 * p], S[2 * p + 1]);
            const bf16x8 yp = __builtin_bit_cast(bf16x8, yw);
            const size_t sk = (size_t)(rs + p) * 64 + cs + 4 * fq;
#pragma unroll
            for (int ht = 0; ht < 4; ++ht) {
                const bf16_t* vp = VNT + ((size_t)b * 1024 + h * 64 + ht * 16 + fr) * 4096 + sk;
                const u32x2 lo = *(const GAS u32x2*)vp, hi = *(const GAS u32x2*)(vp + 16);
                const u32x4 xw = {lo.x, lo.y, hi.x, hi.y};
                O[ht] = __builtin_amdgcn_mfma_f32_16x16x32_bf16(__builtin_bit_cast(bf16x8, xw), yp, O[ht], 0, 0, 0);
            }
        }
        const float inv = 1.0f / sum;
#pragma unroll
        for (int ht = 0; ht < 4; ++ht) *(GAS u32x2*)(NAO + tq * 1024 + h * 64 + ht * 16 + 4 * fq) = pack4(O[ht] * inv);
    }
}
constexpr int LM_BIAS = 4096;
__device__ __forceinline__ void phase_na2(const Params& P, int l, LAS unsigned char* lds, int tid, int wave, int lane, int vG, int vbid) {
    const bf16_t* QN = (const bf16_t*)(P.ws + WS_QN); const bf16_t* KN = (const bf16_t*)(P.ws + WS_KN); const bf16_t* VNT = (const bf16_t*)(P.ws + WS_VNT);
    bf16_t* NAO = (bf16_t*)(P.ws + WS_NAO);
    const float* rpb = P.rpb + (size_t)l * 16 * 15 * 31;
    LAS unsigned char* Ks = lds; LAS unsigned char* Vs = lds + 65536;
    LAS float* bias_s = (LAS float*)(lds + LDS_MISC + LM_BIAS);
    const int fr = lane & 15, fq = lane >> 4;
    const int prow = tid >> 3, pc = (tid & 7) ^ ((prow >> 1) & 7);
#define NA_BAR() do { asm volatile("s_waitcnt lgkmcnt(0)" ::: "memory"); __builtin_amdgcn_s_barrier(); asm volatile("" ::: "memory"); } while (0)
#define NA_LOAD_K(kr) __builtin_amdgcn_global_load_lds((const unsigned*)(kbase + ((size_t)((kr) * 64 + prow)) * 2048 + pc * 16), (LAS unsigned*)(Ks + ((kr) & 7) * 8192 + wave * 1024), 16, 0, 0)
#define NA_LOAD_V(kr) __builtin_amdgcn_global_load_lds((const unsigned*)(vbase + (size_t)prow * 8192 + (kr) * 128 + pc * 16), (LAS unsigned*)(Vs + ((kr) & 7) * 8192 + wave * 1024), 16, 0, 0)
    for (int bu = launder_si(vbid); bu < 256; bu += vG) {
        const int sg = bu & 3, h = (bu >> 2) & 15, b = bu >> 6;
        const char* kbase = (const char*)(KN + (size_t)b * 4096 * 1024 + h * 64);
        const char* vbase = (const char*)(VNT + ((size_t)b * 1024 + h * 64) * 4096);
        asm volatile("s_waitcnt vmcnt(0)" ::: "memory"); NA_BAR();
        for (int i = tid; i < 465; i += 512) bias_s[i] = ((const GAS float*)rpb)[h * 465 + i];
        const int r0 = sg * 16, rs0 = min(max(r0 - 4, 0), 56);
#pragma unroll
        for (int q = 0; q < 8; ++q) { NA_LOAD_K(rs0 + q); NA_LOAD_V(rs0 + q); }
        const int cb = wave & 3, c0 = cb * 16, cs = min(max(c0 - 8, 0), 32), c = c0 + fr, cst = min(max(c - 8, 0), 48);
        bf16x8 yq0, yq1;
        { const size_t tq = (size_t)b * 4096 + r0 * 64 + c; yq0 = *(const GAS bf16x8*)(QN + tq * 1024 + h * 64 + 8 * fq); yq1 = *(const GAS bf16x8*)(QN + tq * 1024 + h * 64 + 32 + 8 * fq); }
#pragma nounroll
        for (int r = r0; r < r0 + 16; ++r) {
            const int rs = min(max(r - 4, 0), 56), rsn = min(max(r - 3, 0), 56);
            const bool mv = (r + 1 < r0 + 16) && (rsn != rs);
            asm volatile("s_waitcnt vmcnt(0)" ::: "memory"); NA_BAR();
            const bf16x8 q0 = yq0, q1 = yq1;
            const size_t tq = (size_t)b * 4096 + r * 64 + c;
            if (r + 1 < r0 + 16) { const size_t tn = tq + 64; yq0 = *(const GAS bf16x8*)(QN + tn * 1024 + h * 64 + 8 * fq); yq1 = *(const GAS bf16x8*)(QN + tn * 1024 + h * 64 + 32 + 8 * fq); }
            f32x4 S[16];
            if (wave < 4) {
#pragma unroll
                for (int kt = 0; kt < 16; ++kt) {
                    const int kr = rs + (kt >> 1), kcb = cs + (kt & 1) * 16, key = kcb + fr;
                    const LAS unsigned char* kp = Ks + (kr & 7) * 8192 + key * 128; const int sw = (key >> 1) & 7;
                    const bf16x8 xk0 = *(const LAS bf16x8*)(kp + ((fq ^ sw) << 4)), xk1 = *(const LAS bf16x8*)(kp + (((4 + fq) ^ sw) << 4));
                    f32x4 z = {0.f, 0.f, 0.f, 0.f};
                    z = __builtin_amdgcn_mfma_f32_16x16x32_bf16(xk0, q0, z, 0, 0, 0);
                    z = __builtin_amdgcn_mfma_f32_16x16x32_bf16(xk1, q1, z, 0, 0, 0);
                    const LAS float* bp = bias_s + (kr - r + 7) * 31;
#pragma unroll
                    for (int j = 0; j < 4; ++j) {
                        const int kc = kcb + 4 * fq + j; const bool valid = (kc >= cst) && (kc < cst + 16);
                        const int co = min(max(kc - c + 15, 0), 30);
                        z[j] = valid ? z[j] + bp[co] : -INFINITY;
                    }
                    S[kt] = z;
                }
            }
            NA_BAR();
            if (mv) NA_LOAD_K(rs + 8);
            f32x4 O[4]; float inv = 0.f;
            if (wave < 4) {
                float mx = -INFINITY;
#pragma unroll
                for (int kt = 0; kt < 16; ++kt)
#pragma unroll
                    for (int j = 0; j < 4; ++j) mx = fmaxf(mx, S[kt][j]);
                mx = fmaxf(mx, __shfl_xor(mx, 16)); mx = fmaxf(mx, __shfl_xor(mx, 32));
                float sum = 0.f;
#pragma unroll
                for (int kt = 0; kt < 16; ++kt)
#pragma unroll
                    for (int j = 0; j < 4; ++j) { const float p = fast_exp2((S[kt][j] - mx) * LOG2E); S[kt][j] = p; sum += p; }
                sum += __shfl_xor(sum, 16); sum += __shfl_xor(sum, 32);
                inv = 1.0f / sum;
#pragma unroll
                for (int ht = 0; ht < 4; ++ht) O[ht] = (f32x4){0.f, 0.f, 0.f, 0.f};
            }
#pragma unroll
            for (int p = 0; p < 8; ++p) {
                if (wave < 4) {
                    const bf16x8 yp = __builtin_bit_cast(bf16x8, pack8(S[2 * p], S[2 * p + 1]));
                    const LAS unsigned char* vrow = Vs + ((rs + p) & 7) * 8192;
#pragma unroll
                    for (int ht = 0; ht < 4; ++ht) {
                        const int ch = ht * 16 + fr, sw = (ch >> 1) & 7, pc0 = (cs >> 3) + (fq >> 1);
                        const LAS unsigned char* vp = vrow + ch * 128 + (fq & 1) * 8;
                        const u32x2 lo = *(const LAS u32x2*)(vp + ((pc0 ^ sw) << 4)), hi = *(const LAS u32x2*)(vp + (((pc0 + 2) ^ sw) << 4));
                        const u32x4 xw = {lo.x, lo.y, hi.x, hi.y};
                        O[ht] = __builtin_amdgcn_mfma_f32_16x16x32_bf16(__builtin_bit_cast(bf16x8, xw), yp, O[ht], 0, 0, 0);
                    }
                }
                if (p == 0) { NA_BAR(); if (mv) NA_LOAD_V(rs + 8); }
            }
            if (wave < 4) {
#pragma unroll
                for (int ht = 0; ht < 4; ++ht) *(GAS u32x2*)(NAO + tq * 1024 + h * 64 + ht * 16 + 4 * fq) = pack4(O[ht] * inv);
            }
        }
    }
    asm volatile("s_waitcnt vmcnt(0)" ::: "memory"); NA_BAR();
#undef NA_BAR
#undef NA_LOAD_K
#undef NA_LOAD_V
}
__device__ __forceinline__ void glds16_asm(const void* gsrc, unsigned lds_dst) {
    unsigned keep;
    asm volatile("s_mov_b32 %0, m0\n\ts_mov_b32 m0, %2\n\ts_nop 0\n\tglobal_load_lds_dwordx4 %1, off\n\ts_mov_b32 m0, %0" : "=&s"(keep) : "v"(gsrc), "s"(lds_dst) : "memory");
}
__device__ __forceinline__ void phase_na3(const Params& P, int l, LAS unsigned char* lds, int tid, int wave, int lane, int vG, int vbid) {
    const bf16_t* QN = (const bf16_t*)(P.ws + WS_QN); const bf16_t* KN = (const bf16_t*)(P.ws + WS_KN); const bf16_t* VNT = (const bf16_t*)(P.ws + WS_VNT);
    bf16_t* NAO = (bf16_t*)(P.ws + WS_NAO);
    const float* rpb = P.rpb + (size_t)l * 16 * 15 * 31;
    LAS unsigned char* Ks = lds; LAS unsigned char* Vs = lds + 73728;
    const unsigned ks_lds = (unsigned)(uintptr_t)Ks, vs_lds = (unsigned)(uintptr_t)Vs;
    LAS float* bias_s = (LAS float*)(lds + LDS_MISC + LM_BIAS);
    const int fr = lane & 15, fq = lane >> 4;
    const int prow = tid >> 3, pc = (tid & 7) ^ ((prow >> 1) & 7);
    const int grp = wave >> 2, cb = wave & 3, c0 = cb * 16, cs = min(max(c0 - 8, 0), 32), c = c0 + fr, cst = min(max(c - 8, 0), 48);
    int co[2][4]; bool vd[2][4];
#pragma unroll
    for (int t = 0; t < 2; ++t)
#pragma unroll
        for (int j = 0; j < 4; ++j) { const int kc = cs + 8 * fq + 4 * t + j;     vd[t][j] = (kc >= cst) && (kc < cst + 16); co[t][j] = min(max(kc - c + 15, 0), 30); }
#define NA_BAR() do { asm volatile("s_waitcnt lgkmcnt(0)" ::: "memory"); __builtin_amdgcn_s_barrier(); asm volatile("" ::: "memory"); } while (0)
#define NA_LOAD_K(kr) glds16_asm(kbase + ((size_t)((kr) * 64 + prow)) * 2048 + pc * 16, ks_lds + (unsigned)(((kr) % 9) * 8192 + wave * 1024))
#define NA_LOAD_V(kr) glds16_asm(vbase + (size_t)prow * 8192 + (kr) * 128 + pc * 16, vs_lds + (unsigned)(((kr) % 9) * 8192 + wave * 1024))
    for (int bu = launder_si(vbid); bu < 256; bu += vG) {
        const int sg = bu & 3, h = (bu >> 2) & 15, b = bu >> 6;
        const char* kbase = (const char*)(KN + (size_t)b * 4096 * 1024 + h * 64);
        const char* vbase = (const char*)(VNT + ((size_t)b * 1024 + h * 64) * 4096);
        asm volatile("s_waitcnt vmcnt(0)" ::: "memory"); NA_BAR();
        for (int i = tid; i < 465; i += 512) bias_s[i] = ((const GAS float*)rpb)[h * 465 + i] * LOG2E;
        const int r0 = sg * 16;
        { const int lo = min(max(r0 - 4, 0), 56), hi = min(max(r0 - 3, 0), 56) + 7;
#pragma nounroll
          for (int kr = lo; kr <= hi; ++kr) { NA_LOAD_K(kr); NA_LOAD_V(kr); } }
        bf16x8 yq0, yq1;
        { const size_t tq = (size_t)b * 4096 + (r0 + grp) * 64 + c; yq0 = *(const GAS bf16x8*)(QN + tq * 1024 + h * 64 + 8 * fq); yq1 = *(const GAS bf16x8*)(QN + tq * 1024 + h * 64 + 32 + 8 * fq); }
        int boff = -100; f32x4 breg[16]; int nprev = -1;
        asm volatile("" : "+v"(yq0), "+v"(yq1));
#pragma unroll
        for (int kt = 0; kt < 16; ++kt) breg[kt] = (f32x4){0.f, 0.f, 0.f, 0.f};
#pragma nounroll
        for (int st = 0; st < 8; ++st) {
            const int rA = r0 + 2 * st, r = rA + grp, rs = min(max(r - 4, 0), 56);
            const int chi = min(max(rA - 3, 0), 56) + 7, nhi = min(max(rA - 1, 0), 56) + 7;
            const bool more = st < 7;
            if (nprev < 0) asm volatile("s_waitcnt vmcnt(0)" ::: "memory"); else if (nprev == 2) asm volatile("s_waitcnt vmcnt(6)" ::: "memory"); else asm volatile("s_waitcnt vmcnt(5)" ::: "memory");
            NA_BAR();
            const bf16x8 q0 = yq0, q1 = yq1;
            const size_t tq = (size_t)b * 4096 + r * 64 + c;
            if (more) { const size_t tn = tq + 128; yq0 = *(const GAS bf16x8*)(QN + tn * 1024 + h * 64 + 8 * fq); yq1 = *(const GAS bf16x8*)(QN + tn * 1024 + h * 64 + 32 + 8 * fq); }
            const int off = rs - r + 7;
            if (off != boff) {
                boff = off;
#pragma unroll
                for (int kt = 0; kt < 16; ++kt)
#pragma unroll
                    for (int j = 0; j < 4; ++j) { const float bv = bias_s[(off + (kt >> 1)) * 31 + co[kt & 1][j]]; breg[kt][j] = vd[kt & 1][j] ? bv : -INFINITY; }
            }
            f32x4 S[16];
#pragma unroll
            for (int kb = 0; kb < 16; kb += 4) {
                bf16x8 xk[4][2];
#pragma unroll
                for (int q = 0; q < 4; ++q) { const int kt = kb + q;
                    const int kr = rs + (kt >> 1), key = cs + 8 * (fr >> 2) + 4 * (kt & 1) + (fr & 3);
                    const LAS unsigned char* kp = Ks + (kr % 9) * 8192 + key * 128; const int sw = (key >> 1) & 7;
                    xk[q][0] = *(const LAS bf16x8*)(kp + ((fq ^ sw) << 4)); xk[q][1] = *(const LAS bf16x8*)(kp + (((4 + fq) ^ sw) << 4)); }
                __builtin_amdgcn_sched_barrier(0);
#pragma unroll
                for (int q = 0; q < 4; ++q) S[kb + q] = __builtin_amdgcn_mfma_f32_16x16x32_bf16(xk[q][0], q0, breg[kb + q], 0, 0, 0);
#pragma unroll
                for (int q = 0; q < 4; ++q) S[kb + q] = __builtin_amdgcn_mfma_f32_16x16x32_bf16(xk[q][1], q1, S[kb + q], 0, 0, 0);
                __builtin_amdgcn_sched_barrier(0);
            }
            if (more) asm volatile("s_waitcnt vmcnt(6)" ::: "memory"); else asm volatile("s_waitcnt vmcnt(4)" ::: "memory");
            NA_BAR();
            asm volatile("" : "+v"(yq0), "+v"(yq1));
            if (more) {
#pragma nounroll
                for (int kr = chi + 1; kr <= nhi; ++kr) NA_LOAD_K(kr);
            }
            nprev = more ? nhi - chi : 0;
            float mx = -INFINITY;
#pragma unroll
            for (int kt = 0; kt < 16; ++kt)
#pragma unroll
                for (int j = 0; j < 4; ++j) mx = fmaxf(mx, S[kt][j]);
            mx = fmaxf(mx, __shfl_xor(mx, 16)); mx = fmaxf(mx, __shfl_xor(mx, 32));
            float sum = 0.f;
#pragma unroll
            for (int kt = 0; kt < 16; ++kt)
#pragma unroll
                for (int j = 0; j < 4; ++j) { const float p = fast_exp2(S[kt][j] - mx); S[kt][j] = p; sum += p; }
            sum += __shfl_xor(sum, 16); sum += __shfl_xor(sum, 32);
            const float inv = 1.0f / sum;
            f32x4 O[4];
#pragma unroll
            for (int ht = 0; ht < 4; ++ht) O[ht] = (f32x4){0.f, 0.f, 0.f, 0.f};
#pragma unroll
            for (int p = 0; p < 8; ++p) {
                const bf16x8 yp = __builtin_bit_cast(bf16x8, pack8(S[2 * p], S[2 * p + 1]));
                const LAS unsigned char* vrow = Vs + ((rs + p) % 9) * 8192;
                bf16x8 xv[4];
#pragma unroll
                for (int ht = 0; ht < 4; ++ht) {
                    const int ch = ht * 16 + fr, sw = (ch >> 1) & 7, pc0 = (cs >> 3) + fq;
                    xv[ht] = *(const LAS bf16x8*)(vrow + ch * 128 + ((pc0 ^ sw) << 4));
                }
#pragma unroll
                for (int ht = 0; ht < 4; ++ht) O[ht] = __builtin_amdgcn_mfma_f32_16x16x32_bf16(xv[ht], yp, O[ht], 0, 0, 0);
                if (p == 1) {
                    NA_BAR();
                    if (more) {
#pragma nounroll
                        for (int kr = chi + 1; kr <= nhi; ++kr) NA_LOAD_V(kr);
                    }
                }
            }
#pragma unroll
            for (int ht = 0; ht < 4; ++ht) *(GAS u32x2*)(NAO + tq * 1024 + h * 64 + ht * 16 + 4 * fq) = pack4(O[ht] * inv);
        }
    }
    asm volatile("s_waitcnt vmcnt(0)" ::: "memory"); NA_BAR();
#undef NA_BAR
#undef NA_LOAD_K
#undef NA_LOAD_V
}
__device__ __forceinline__ void ln_row(f32x4 (&v)[4], const f32x4 (&g)[4], const f32x4 (&bb)[4]) {
    float s = 0.f;
#pragma unroll
    for (int j = 0; j < 4; ++j) s += (v[j][0] + v[j][1]) + (v[j][2] + v[j][3]);
    const float mean = wave_sum(s) * (1.0f / 1024.0f);
    float q = 0.f;
#pragma unroll
    for (int j = 0; j < 4; ++j) { v[j] = v[j] - mean; q += (v[j][0] * v[j][0] + v[j][1] * v[j][1]) + (v[j][2] * v[j][2] + v[j][3] * v[j][3]); }
    const float rstd = 1.0f / sqrtf(wave_sum(q) * (1.0f / 1024.0f) + 1e-5f);
#pragma unroll
    for (int j = 0; j < 4; ++j) v[j] = v[j] * rstd * g[j] + bb[j];
}
__device__ __forceinline__ void ln_row_stats(f32x4 (&v)[4], const f32x4 (&g)[4], const f32x4 (&bb)[4], float& mean_o, float& rstd_o) {
    float s = 0.f;
#pragma unroll
    for (int j = 0; j < 4; ++j) s += (v[j][0] + v[j][1]) + (v[j][2] + v[j][3]);
    const float mean = wave_sum(s) * (1.0f / 1024.0f);
    float q = 0.f;
#pragma unroll
    for (int j = 0; j < 4; ++j) { v[j] = v[j] - mean; q += (v[j][0] * v[j][0] + v[j][1] * v[j][1]) + (v[j][2] * v[j][2] + v[j][3] * v[j][3]); }
    const float rstd = 1.0f / sqrtf(wave_sum(q) * (1.0f / 1024.0f) + 1e-5f);
#pragma unroll
    for (int j = 0; j < 4; ++j) v[j] = v[j] * rstd * g[j] + bb[j];
    mean_o = mean; rstd_o = rstd;
}
__device__ __forceinline__ void phase_ln_router(const Params& P, int l, LAS unsigned char* lds, int wave, int lane) {
    unsigned char* ws = P.ws;
    const float* PRE = (const float*)(ws + WS_ACAT); bf16_t* X1B = (bf16_t*)(ws + WS_K);
    const bf16_t* WRT = (const bf16_t*)(ws + WS_WRT) + (size_t)l * 65536;
    const float* rgc = (const float*)(ws + WS_RGC) + l * 64;
    LAS float* rstat = (LAS float*)(lds + LDS_MISC + LM_RSTAT);
    int* tok_e = (int*)(ws + WS_TOK); int* tok_rank = tok_e + T * 2; float* tok_w = (float*)(tok_rank + T * 2);
    int* HT = (int*)(ws + WS_HT) + (size_t)l * (T / 64) * 32;
    LAS int* hist = (LAS int*)(lds + LDS_MISC + LM_HIST); LAS int* basee = (LAS int*)(lds + LDS_MISC + LM_BASE); LAS int* rowi = (LAS int*)(lds + LDS_MISC + LM_ROW);
    const int tid = launder_v((int)threadIdx.x);
    const int fr = lane & 15, fq = lane >> 4;
    f32x4 g[4], bb[4];
#pragma unroll
    for (int j = 0; j < 4; ++j) { g[j] = *(const GAS f32x4*)(P.ln_mix_g + l * 1024 + 4 * lane + 256 * j); bb[j] = *(const GAS f32x4*)(P.ln_mix_b + l * 1024 + 4 * lane + 256 * j); }
    if ((int)blockIdx.x < 80) ((GAS int*)(ws + WS_SRC))[(int)blockIdx.x * 512 + tid] = 0;
    for (int chunk = launder_si((int)blockIdx.x); chunk < T / 64; chunk += gridDim.x) {
        if (tid < 32) hist[tid] = 0;
#pragma nounroll
        for (int rr = 0; rr < 8; rr += 8) {
            const int ta = chunk * 64 + wave * 8 + rr;
            f32x4 va[8][4];
#pragma unroll
            for (int k = 0; k < 8; ++k)
#pragma unroll
                for (int j = 0; j < 4; ++j) va[k][j] = *(const GAS f32x4*)(PRE + (size_t)(ta + k) * 1024 + 4 * lane + 256 * j);
            __builtin_amdgcn_sched_barrier(0);
#pragma unroll
            for (int k = 0; k < 8; ++k) {
                float mean, rstd; ln_row_stats(va[k], g, bb, mean, rstd);
                if (lane == 0) { rstat[(wave * 8 + rr + k) * 2] = mean; rstat[(wave * 8 + rr + k) * 2 + 1] = rstd; }
#pragma unroll
                for (int j = 0; j < 4; ++j) *(GAS u32x2*)(X1B + (size_t)(ta + k) * 1024 + 4 * lane + 256 * j) = pack4(va[k][j]);
            }
        }
        VM_WAIT();
        __syncthreads();
        if (wave < 4) {
            const int t0 = chunk * 64 + wave * 16;
            f32x4 acc0 = {0.f, 0.f, 0.f, 0.f}, acc1 = {0.f, 0.f, 0.f, 0.f};
            const float* yp = PRE + (size_t)(t0 + fr) * 1024 + 8 * fq;
            const bf16_t* wp = WRT + (size_t)fr * 1024 + 8 * fq;
#pragma unroll 4
            for (int s = 0; s < 32; ++s) {
                const f32x4 ya = *(const GAS f32x4*)(yp + 32 * s), yb = *(const GAS f32x4*)(yp + 32 * s + 4);
                const bf16x8 w0h = *(const GAS bf16x8*)(wp + 32 * s), w1h = *(const GAS bf16x8*)(wp + 16 * 1024 + 32 * s);
                const bf16x8 w0l = *(const GAS bf16x8*)(wp + 32 * 1024 + 32 * s), w1l = *(const GAS bf16x8*)(wp + 48 * 1024 + 32 * s);
                u32x4 yh; yh.x = cvt_pk_bf16(ya[0], ya[1]); yh.y = cvt_pk_bf16(ya[2], ya[3]); yh.z = cvt_pk_bf16(yb[0], yb[1]); yh.w = cvt_pk_bf16(yb[2], yb[3]);
                u32x4 yl; yl.x = cvt_pk_bf16(ya[0] - bf_lo(yh.x), ya[1] - bf_hi(yh.x)); yl.y = cvt_pk_bf16(ya[2] - bf_lo(yh.y), ya[3] - bf_hi(yh.y));
                yl.z = cvt_pk_bf16(yb[0] - bf_lo(yh.z), yb[1] - bf_hi(yh.z)); yl.w = cvt_pk_bf16(yb[2] - bf_lo(yh.w), yb[3] - bf_hi(yh.w));
                const bf16x8 yhv = __builtin_bit_cast(bf16x8, yh), ylv = __builtin_bit_cast(bf16x8, yl);
                acc0 = __builtin_amdgcn_mfma_f32_16x16x32_bf16(w0h, yhv, acc0, 0, 0, 0); acc1 = __builtin_amdgcn_mfma_f32_16x16x32_bf16(w1h, yhv, acc1, 0, 0, 0);
                acc0 = __builtin_amdgcn_mfma_f32_16x16x32_bf16(w0h, ylv, acc0, 0, 0, 0); acc1 = __builtin_amdgcn_mfma_f32_16x16x32_bf16(w1h, ylv, acc1, 0, 0, 0);
                acc0 = __builtin_amdgcn_mfma_f32_16x16x32_bf16(w0l, yhv, acc0, 0, 0, 0); acc1 = __builtin_amdgcn_mfma_f32_16x16x32_bf16(w1l, yhv, acc1, 0, 0, 0);
            }
            const f32x4 rb0 = *(const GAS f32x4*)(P.router_bias + 4 * fq), rb1 = *(const GAS f32x4*)(P.router_bias + 16 + 4 * fq);
            const f32x4 gw0 = *(const GAS f32x4*)(rgc + 4 * fq), gw1 = *(const GAS f32x4*)(rgc + 16 + 4 * fq), cc0 = *(const GAS f32x4*)(rgc + 32 + 4 * fq), cc1 = *(const GAS f32x4*)(rgc + 48 + 4 * fq);
            const float rmean = rstat[(wave * 16 + fr) * 2], rrstd = rstat[(wave * 16 + fr) * 2 + 1];
            f32x4 sc0, sc1, se0, se1;
#pragma unroll
            for (int j = 0; j < 4; ++j) { const float l0 = rrstd * (acc0[j] - rmean * gw0[j]) + cc0[j], l1 = rrstd * (acc1[j] - rmean * gw1[j]) + cc1[j];
                sc0[j] = 1.0f / (1.0f + expf(-l0)); sc1[j] = 1.0f / (1.0f + expf(-l1)); se0[j] = sc0[j] + rb0[j]; se1[j] = sc1[j] + rb1[j]; }
            float gs0, gs1;
            { const float a = fmaxf(se0[0], se0[1]), b2 = fminf(se0[0], se0[1]), c = fmaxf(se0[2], se0[3]), d2 = fminf(se0[2], se0[3]); gs0 = fmaxf(a, c) + fmaxf(fminf(a, c), fmaxf(b2, d2)); }
            { const float a = fmaxf(se1[0], se1[1]), b2 = fminf(se1[0], se1[1]), c = fmaxf(se1[2], se1[3]), d2 = fminf(se1[2], se1[3]); gs1 = fmaxf(a, c) + fmaxf(fminf(a, c), fmaxf(b2, d2)); }
            float bs = gs0; int bg = fq;
            if (gs1 > gs0) { bs = gs1; bg = 4 + fq; }
#pragma unroll
            for (int o = 16; o < 64; o <<= 1) { const float os = __shfl_xor(bs, o); const int og = __shfl_xor(bg, o); if (os > bs || (os == bs && og < bg)) { bs = os; bg = og; } }
            if ((bg & 3) == fq) {
                const bool hi = bg >= 4;
                const float u0 = hi ? se1[0] : se0[0], u1 = hi ? se1[1] : se0[1], u2 = hi ? se1[2] : se0[2], u3 = hi ? se1[3] : se0[3];
                const float p0 = hi ? sc1[0] : sc0[0], p1 = hi ? sc1[1] : sc0[1], p2 = hi ? sc1[2] : sc0[2], p3 = hi ? sc1[3] : sc0[3];
                int i1 = 0; float t1 = u0;
                if (u1 > t1) { t1 = u1; i1 = 1; } if (u2 > t1) { t1 = u2; i1 = 2; } if (u3 > t1) { t1 = u3; i1 = 3; }
                int i2 = -1; float t2 = -INFINITY;
                if (i1 != 0 && u0 > t2) { t2 = u0; i2 = 0; } if (i1 != 1 && u1 > t2) { t2 = u1; i2 = 1; } if (i1 != 2 && u2 > t2) { t2 = u2; i2 = 2; } if (i1 != 3 && u3 > t2) { t2 = u3; i2 = 3; }
                if (i2 < 0) i2 = (i1 + 1) & 3;
                const float s1 = i1 == 0 ? p0 : i1 == 1 ? p1 : i1 == 2 ? p2 : p3, s2 = i2 == 0 ? p0 : i2 == 1 ? p1 : i2 == 2 ? p2 : p3, inv = 1.0f / (s1 + s2);
                const int e1 = 4 * bg + i1, e2 = 4 * bg + i2;
                const int r1 = __hip_atomic_fetch_add(hist + e1, 1, __ATOMIC_RELAXED, __HIP_MEMORY_SCOPE_WORKGROUP);
                const int r2 = __hip_atomic_fetch_add(hist + e2, 1, __ATOMIC_RELAXED, __HIP_MEMORY_SCOPE_WORKGROUP);
                const int q = wave * 16 + fr;
                rowi[q] = e1; rowi[64 + q] = e2; rowi[128 + q] = r1; rowi[192 + q] = r2; rowi[256 + q] = __float_as_int(s1 * inv); rowi[320 + q] = __float_as_int(s2 * inv);
            }
        }
        __syncthreads();
        if (tid < 32) HT[chunk * 32 + tid] = hist[tid];
        if (tid < 64) {
            const int t = chunk * 64 + tid, e1 = rowi[tid], e2 = rowi[64 + tid];
            tok_e[2 * t] = e1; tok_e[2 * t + 1] = e2;
            tok_rank[2 * t] = rowi[128 + tid]; tok_rank[2 * t + 1] = rowi[192 + tid];
            tok_w[2 * t] = __int_as_float(rowi[256 + tid]); tok_w[2 * t + 1] = __int_as_float(rowi[320 + tid]);
        }
        __syncthreads();
    }
}
constexpr int LM_BASES = 3584;
constexpr int LM_GSRC = 8192;
__device__ __forceinline__ void build_tiles(const Params& P, int l, LAS unsigned char* lds, int mychunk) {
    const int* HT = (const int*)(P.ws + WS_HT) + (size_t)l * (T / 64) * 32;
    LAS int* tstart = (LAS int*)(lds + LDS_MISC + LM_TSTART); LAS int* tile_e = (LAS int*)(lds + LDS_MISC + LM_TILEE); LAS int* ntp = (LAS int*)(lds + LDS_MISC + LM_NT);
    LAS int* bases = (LAS int*)(lds + LDS_MISC + LM_BASES);
    LAS int* part = (LAS int*)lds;
    const int tid = launder_v((int)threadIdx.x), e = tid & 31, seg = tid >> 5;
    __syncthreads();
    { int tot = 0, bas = 0;
#pragma unroll
      for (int i = 0; i < 16; ++i) { const int c = seg * 16 + i, v = ((const GAS int*)HT)[c * 32 + e]; tot += v; bas += (c < mychunk) ? v : 0; }
      part[seg * 32 + e] = tot; part[512 + seg * 32 + e] = bas; }
    __syncthreads();
    if (tid < 32) { int tot = 0, bas = 0;
#pragma unroll
        for (int s = 0; s < 16; ++s) { tot += part[s * 32 + tid]; bas += part[512 + s * 32 + tid]; }
        bases[tid] = bas;
        const int nte = (tot + 255) >> 8; int v = nte;
#pragma unroll
        for (int o = 1; o < 32; o <<= 1) { const int u = __shfl_up(v, o); if (tid >= o) v += u; }
        tstart[tid] = v - nte; if (tid == 31) { tstart[32] = v; ntp[0] = v < 160 ? v : 160; } }
    __syncthreads();
    if (tid < 192) { int q = 0;
#pragma unroll
        for (int j = 1; j < 32; ++j) q += (tid >= tstart[j]) ? 1 : 0;
        if (tid < tstart[32]) tile_e[tid] = q; }
    __syncthreads();
}
__device__ __forceinline__ void phase_gather(const Params& P, int l, LAS unsigned char* lds, int wave, int lane) {
    unsigned char* ws = P.ws;
    const int* tok_e = (const int*)(ws + WS_TOK); const int* tok_rank = tok_e + T * 2; int* tok_dest = (int*)(ws + WS_TOK) + T * 6; int* srcmap = (int*)(ws + WS_SRC);
    const LAS int* tstart = (const LAS int*)(lds + LDS_MISC + LM_TSTART); const LAS int* bases = (const LAS int*)(lds + LDS_MISC + LM_BASES);
    const int tid = launder_v((int)threadIdx.x);
    for (int chunk = launder_si((int)blockIdx.x); chunk < T / 64; chunk += gridDim.x) {
        build_tiles(P, l, lds, chunk);
        if (tid < 128) { const int pr = chunk * 128 + tid, ex = ((const GAS int*)tok_e)[pr];
            const int dest = tstart[ex] * 256 + bases[ex] + ((const GAS int*)tok_rank)[pr];
            ((GAS int*)tok_dest)[pr] = dest; ((GAS int*)srcmap)[dest] = pr >> 1; }
    }
}
__device__ __forceinline__ void phase_combine(const Params& P, int l, int gw, int NGW, int lane) {
    unsigned char* ws = P.ws;
    const bf16_t* X1B = (const bf16_t*)(ws + WS_K); const bf16_t* Y = (const bf16_t*)(ws + WS_BCAT + 40 * MiB);
    const float* tok_w = (const float*)(ws + WS_TOK) + T * 4; const int* tok_dest = (const int*)(ws + WS_TOK) + T * 6;
    bf16_t* xb = (bf16_t*)(ws + WS_XB);
    f32x4 g[4], bb[4];
#pragma unroll
    for (int j = 0; j < 4; ++j) { g[j] = *(const GAS f32x4*)(P.ln_ffn_g + l * 1024 + 4 * lane + 256 * j); bb[j] = *(const GAS f32x4*)(P.ln_ffn_b + l * 1024 + 4 * lane + 256 * j); }
    for (int tb = gw; tb < T; tb += 4 * NGW) {
        u32x2 x1[4][4], y0[4][4], y1[4][4]; float w0[4], w1[4];
#pragma unroll
        for (int k = 0; k < 4; ++k) { const int t = tb + k * NGW; if (t < T) {
            const int d0 = tok_dest[2 * t], d1 = tok_dest[2 * t + 1]; w0[k] = tok_w[2 * t]; w1[k] = tok_w[2 * t + 1];
#pragma unroll
            for (int j = 0; j < 4; ++j) { x1[k][j] = *(const GAS u32x2*)(X1B + (size_t)t * 1024 + 4 * lane + 256 * j);
                y0[k][j] = *(const GAS u32x2*)(Y + (size_t)d0 * 1024 + 4 * lane + 256 * j); y1[k][j] = *(const GAS u32x2*)(Y + (size_t)d1 * 1024 + 4 * lane + 256 * j); } } }
#pragma unroll
        for (int k = 0; k < 4; ++k) { const int t = tb + k * NGW; if (t >= T) break;
            f32x4 v[4];
#pragma unroll
            for (int j = 0; j < 4; ++j) {
                v[j][0] = bf_lo(x1[k][j].x) * ALPHA + w0[k] * bf_lo(y0[k][j].x) + w1[k] * bf_lo(y1[k][j].x); v[j][1] = bf_hi(x1[k][j].x) * ALPHA + w0[k] * bf_hi(y0[k][j].x) + w1[k] * bf_hi(y1[k][j].x);
                v[j][2] = bf_lo(x1[k][j].y) * ALPHA + w0[k] * bf_lo(y0[k][j].y) + w1[k] * bf_lo(y1[k][j].y); v[j][3] = bf_hi(x1[k][j].y) * ALPHA + w0[k] * bf_hi(y0[k][j].y) + w1[k] * bf_hi(y1[k][j].y);
            }
            ln_row(v, g, bb);
#pragma unroll
            for (int j = 0; j < 4; ++j) { if (l == DEPTH - 1) *(GAS f32x4*)(P.out + (size_t)t * 1024 + 4 * lane + 256 * j) = v[j]; else *(GAS u32x2*)(xb + (size_t)t * 1024 + 4 * lane + 256 * j) = pack4(v[j]); }
        }
    }
}

#ifndef PROBE_BAR
#define PROBE_BAR 0
#endif
#ifndef PROBE_K1
#define PROBE_K1 0
#endif
#define K1_BODY() do { \
            if (bid < 64) { \
                DecR2c dec{(const char*)(ws + WS_BCAT), (const char*)(ws + WS_KDT)}; EpiR2c E{(bf16_t*)(ws + WS_BCAT), decay}; \
                REP(2) pg::gemm_phase<1, true, 1, true, false, 16>(lds, 512, 1024, 512, 448, dec, E, 64, bid); \
                  \
            } else if (bid < 128) { \
                REP(3) phase_na3(PP, l, lds, tid, wave, lane, 192, bid - 64); \
                { const int pa = l == 0 ? 60 : 30, pb2 = l == 0 ? 136 : 80; convert_range(PP, 1, l, lds, 128 * pa + (bid - 64) * pb2, 128 * pa + (bid - 64) * pb2 + pb2, wave, lane); } \
                if (DEFER_SILU) { __syncthreads(); DecInProjD dec{(const char*)(ws + WS_XB), (const char*)(ws + ws_wset(l) + WO_WIN), 1}; EpiInProj E{ws, decay}; \
                  pg::gemm_phase<1, false, 1, false, false, 16>(lds, 1024, 1024, 1024, 128, dec, E, 64, bid - 64); } \
            } else { \
                { const int pa = l == 0 ? 60 : 30; convert_range(PP, 1, l, lds, (bid - 128) * pa, (bid - 128) * pa + pa, wave, lane); } \
                __syncthreads(); \
                { DecR1 dec{(const char*)(ws + WS_Q), (const char*)(ws + WS_K), 128}; EpiR1 E{(bf16_t*)(ws + WS_ACAT), decay}; \
                  REP(1) pg::gemm_phase<1, false, 1, false, false, 16>(lds, 256, 1024, 1024, 512, dec, E, 128, bid - 128); } \
                if (DEFER_SILU) { DecInProjD dec{(const char*)(ws + WS_XB), (const char*)(ws + ws_wset(l) + WO_WIN), 0}; EpiInProj E{ws, decay}; \
                  pg::gemm_phase<1, false, 1, false, false, 16>(lds, 1024, 1024, 1024, 128, dec, E, 128, bid - 128); } \
                REP(3) phase_na3(PP, l, lds, tid, wave, lane, 192, bid - 64); \
            } \
            } while (0)
__global__ void __launch_bounds__(512, 2) fwd_kernel(Params P) {
    extern __shared__ __attribute__((aligned(16))) unsigned char lds_raw[];
    LAS unsigned char* lds = (LAS unsigned char*)lds_raw;
    const int NGW = gridDim.x * 8;
    for (int u = threadIdx.x; u < (LDS_BYTES - LDS_MISC) / 4; u += 512) ((LAS unsigned*)(lds + LDS_MISC))[u] = 0u;
#define PHASE_CTX() const Params PP = load_params(); unsigned char* ws = PP.ws; const int tid = launder_v((int)threadIdx.x), lane = tid & 63, wave = __builtin_amdgcn_readfirstlane(tid >> 6), gw = launder_si((int)blockIdx.x) * 8 + wave; (void)ws; (void)lane; (void)gw
    __syncthreads();
#if MK_ONE_LAUNCH
    XcdBarrier bar = xcd_barrier_post((unsigned*)(P.ws + WS_CTL) + CW_BAR, (volatile LAS unsigned*)(lds + LDS_MISC + LM_BAR));
#define GRID_BAR() xcd_barrier(bar)
#else
#define GRID_BAR() do { } while (0)
#endif
    const int lo = P.ph_lo, hi = P.ph_hi;
#define IN(k) (lo <= (k) && (k) < hi)
#define SEAM(k) do { if (IN(k) && IN((k) + 1)) GRID_BAR(); } while (0)
#ifndef PROBE_MASK
#define PROBE_MASK 0
#endif
#define REP(b) for (int rep_ = 0; rep_ < (((PROBE_MASK) >> (b)) & 1) + 1; ++rep_)

    if (IN(0)) { PHASE_CTX(); phase_init(PP, lds, gw, NGW, wave, lane); SEAM(0); }

    for (int l = 0; l < DEPTH; ++l) {
        const int pb = 1 + l * 12;
        if (IN(pb + 0)) { PHASE_CTX(); const float* decay = PP.decay + l * 8; (void)decay;
            DecInProj dec{(const char*)(ws + WS_XB), (const char*)(ws + ws_wset(l) + WO_WIN)};
            EpiInProj E{ws, decay};
#if STAGGER_TICKS > 0
            { const unsigned long long t0 = __builtin_amdgcn_s_memrealtime(); const unsigned dl = ((blockIdx.x >> 3) & 7) * STAGGER_TICKS;
              while (__builtin_amdgcn_s_memrealtime() - t0 < dl) __builtin_amdgcn_s_sleep(8); }
#endif
            REP(0) pg::gemm_phase<1 + PROBE_EPI2, false, 1 + PROBE_K2, false, false, 16>(lds, 1024, 1024, 1024, DEFER_SILU ? 2560 : 2816, dec, E, (int)gridDim.x, (int)blockIdx.x);
            SEAM(pb + 0);
        }
        if (IN(pb + 1)) { PHASE_CTX(); const float* decay = PP.decay + l * 8; (void)decay;
            const int bid = launder_si((int)blockIdx.x);
            K1_BODY();
#if PROBE_K1
            __syncthreads(); K1_BODY();
#endif
            SEAM(pb + 1);
        }
        if (IN(pb + 3)) { PHASE_CTX(); const float* decay = PP.decay + l * 8; (void)decay;
            DecR4 dec{(const char*)(ws + WS_ACAT), (const char*)(ws + WS_BCAT), (int)gridDim.x}; EpiR4f E{ws, lds};
            REP(5) pg::gemm_phase<1, false, 1, false, false, 16>(lds, 1024, 4096, 1024, 512, dec, E, 256, (int)blockIdx.x);
            if (blockIdx.x < 256) { const int p = DecR4::panel_of((int)blockIdx.x), pm2 = p & 1, cc = (p >> 1) & 7, bh = p >> 4;
              REP(6) headnorm_half0(PP, lds, (bh >> 2) * 4096 + cc * 512 + pm2 * 256, bh & 3, wave, lane); }
            SEAM(pb + 3);
        }
        if (IN(pb + 5)) { PHASE_CTX(); const float* decay = PP.decay + l * 8; (void)decay;
            REP(7) {
            { DecDense dec{(const char*)(ws + WS_KDT), (const char*)(ws + ws_wset(l) + WO_WRET), 2048 * 2, 2048 * 2}; EpiMerge<0> E{(bf16_t*)(ws + WS_Q), (const bf16_t*)(ws + WS_G)};
              pg::gemm_phase(lds, 2048, 2048, 2048, 256, dec, E, (int)gridDim.x, (int)blockIdx.x); }
            { DecDense dec{(const char*)(ws + WS_NAO), (const char*)(ws + ws_wset(l) + WO_WNA), 1024 * 2, 1024 * 2}; EpiMerge<1> E{(bf16_t*)(ws + WS_Q), (const bf16_t*)(ws + WS_G)};
              pg::gemm_phase(lds, 1024, 1024, 1024, 256, dec, E, (int)gridDim.x, (int)blockIdx.x); }
            }
            SEAM(pb + 5);
        }
        if (IN(pb + 6)) { PHASE_CTX(); const float* decay = PP.decay + l * 8; (void)decay;
            DecDense dec{(const char*)(ws + WS_Q), (const char*)(ws + ws_wset(l) + WO_WOUT), 1024 * 2, 1024 * 2}; EpiPre E{(float*)(ws + WS_ACAT), (const bf16_t*)(ws + WS_XB)};
            REP(8) pg::gemm_phase<1 + PROBE_EPI6>(lds, 1024, 1024, 1024, 256, dec, E, (int)gridDim.x, (int)blockIdx.x);
            SEAM(pb + 6);
#if PROBE_BAR
            SEAM(pb + 6); SEAM(pb + 6); SEAM(pb + 6); SEAM(pb + 6);
#endif
        }
        if (IN(pb + 7)) { PHASE_CTX(); const float* decay = PP.decay + l * 8; (void)decay; phase_ln_router(PP, l, lds, wave, lane); SEAM(pb + 7); }
        if (IN(pb + 8)) { PHASE_CTX(); const float* decay = PP.decay + l * 8; (void)decay; REP(9) phase_gather(PP, l, lds, wave, lane); SEAM(pb + 8); }
        if (IN(pb + 9)) { PHASE_CTX(); const float* decay = PP.decay + l * 8; (void)decay;
            if (!IN(pb + 8)) build_tiles(PP, l, lds, -1);
            const int nt = *(const LAS int*)(lds + LDS_MISC + LM_NT);
            int vG = (int)gridDim.x; { const int nu = nt * 4, rounds = (nu + vG - 1) / vG; if (rounds > 0) { int v = ((nu + rounds - 1) / rounds + 7) & ~7; if (v < vG) vG = v; } }
            LAS int* gsrc = (LAS int*)(lds + LDS_MISC + LM_GSRC);
            if ((int)blockIdx.x < vG && tid < 256) {
#pragma unroll
                for (int j = 0; j < 3; ++j) { const int u0 = (int)blockIdx.x + j * vG; if (u0 < nt * 4) { const int a = xcd_perm(u0, vG, nt * 4) >> 2; gsrc[j * 256 + tid] = ((const GAS int*)(ws + WS_SRC))[a * 256 + tid]; } }
            }
            __syncthreads();
            DecMoe dec{(const char*)(ws + WS_K), (const char*)(ws + ws_wset(l) + WO_WGU), 0, 1024 * 1024 * 2, 1024 * 2, (const LAS int*)(lds + LDS_MISC + LM_TILEE), vG, nt * 4}; EpiUp E{(bf16_t*)(ws + WS_BCAT)};
            REP(10) pg::gemm_phase<1, false, 1, false, true, 8>(lds, 1024, 1024, 1024, nt * 4, dec, E, vG, (int)blockIdx.x < vG ? (int)blockIdx.x : -1, gsrc);
            { const int G_ = (int)gridDim.x, bid = (int)blockIdx.x;
              convert_share(PP, 2, l, lds, 0, cv_slot_items(2, l), G_ - vG, bid >= vG ? bid - vG : -1, 215, G_, bid, wave, lane); }
            SEAM(pb + 9);
        }
        if (IN(pb + 10)) { PHASE_CTX(); const float* decay = PP.decay + l * 8; (void)decay;
            if (!IN(pb + 8)) build_tiles(PP, l, lds, -1);
            const int nt = *(const LAS int*)(lds + LDS_MISC + LM_NT);
            int vG = (int)gridDim.x; if (l + 1 < DEPTH) { const int nu = nt * 4, rounds = (nu + vG - 1) / vG; if (rounds > 0) { int v = ((nu + rounds - 1) / rounds + 7) & ~7; if (v < vG) vG = v; } }
            DecMoe dec{(const char*)(ws + WS_BCAT), (const char*)(ws + ws_wset(l) + WO_WD), 512 * 2, 1024 * 512 * 2, 512 * 2, (const LAS int*)(lds + LDS_MISC + LM_TILEE), vG, nt * 4}; EpiDown E{(bf16_t*)(ws + WS_BCAT + 40 * MiB)};
            REP(11) pg::gemm_phase<1, false, 1, false, false, 16>(lds, 512, 512, 512, nt * 4, dec, E, vG, (int)blockIdx.x < vG ? (int)blockIdx.x : -1);
            if (l + 1 < DEPTH) { const int G_ = (int)gridDim.x, bid = (int)blockIdx.x;
              convert_share(PP, 3, l, lds, 0, cv_slot_items(3, l), G_ - vG, bid >= vG ? bid - vG : -1, 135, G_, bid, wave, lane); }
            SEAM(pb + 10);
        }
        if (IN(pb + 11)) { PHASE_CTX(); const float* decay = PP.decay + l * 8; (void)decay;
            REP(12) phase_combine(PP, l, gw, NGW, lane);
            SEAM(pb + 11);
        }
    }
#undef IN
#undef SEAM
}

extern "C" void kernel_launch(void* const* d_in, const int* in_sizes, int n_in, void* d_out, int out_size, void* d_ws, size_t ws_size, hipStream_t stream) {
    static int grid = 0;
    if (grid == 0) {
        if (n_in != 16 || in_sizes[0] != T * D || out_size != T * D || ws_size < WS_END) {
            fprintf(stderr, "kernel_launch: unexpected shapes / workspace (n_in %d, in0 %d, out %d, ws %zu < %zu); nothing launched\n", n_in, n_in > 0 ? in_sizes[0] : -1, out_size, ws_size, (size_t)WS_END); grid = -1; return; }
        int dev = 0, cus = 0, per_cu = 0;
        if (hipGetDevice(&dev) != hipSuccess || hipDeviceGetAttribute(&cus, hipDeviceAttributeMultiprocessorCount, dev) != hipSuccess) { grid = -1; return; }
        if (hipFuncSetAttribute((const void*)fwd_kernel, hipFuncAttributeMaxDynamicSharedMemorySize, LDS_BYTES) != hipSuccess) { fprintf(stderr, "kernel_launch: hipFuncSetAttribute failed\n"); grid = -1; return; }
        if (hipOccupancyMaxActiveBlocksPerMultiprocessor(&per_cu, (const void*)fwd_kernel, 512, LDS_BYTES) != hipSuccess || per_cu < 1)
            fprintf(stderr, "kernel_launch: occupancy query reports %d workgroups per CU\n", per_cu);
        (void)hipGetLastError();
        if (cus != 256) { fprintf(stderr, "kernel_launch: built for a 256-CU device (static phase partitions), found %d CUs; nothing launched\n", cus); grid = -1; return; }
        grid = cus;
    }
    if (grid < 0) return;
    if (hipMemsetAsync((char*)d_ws + WS_CTL, 0, CTL_ZERO_BYTES, stream) != hipSuccess) return;
    Params p{};
    p.x = (const float*)d_in[0]; p.w_in = (const float*)d_in[1]; p.decay = (const float*)d_in[2]; p.w_ret_o = (const float*)d_in[3]; p.rpb = (const float*)d_in[4];
    p.w_na_o = (const float*)d_in[5]; p.w_out = (const float*)d_in[6]; p.ln_mix_g = (const float*)d_in[7]; p.ln_mix_b = (const float*)d_in[8];
    p.router_w = (const float*)d_in[9]; p.router_bias = (const float*)d_in[10]; p.w_gate = (const float*)d_in[11]; p.w_up = (const float*)d_in[12]; p.w_down = (const float*)d_in[13];
    p.ln_ffn_g = (const float*)d_in[14]; p.ln_ffn_b = (const float*)d_in[15];
    p.out = (float*)d_out; p.ws = (unsigned char*)d_ws;
#if MK_ONE_LAUNCH
    p.ph_lo = 0; p.ph_hi = NPH;
    hipLaunchKernelGGL(fwd_kernel, dim3(grid), dim3(512), LDS_BYTES, stream, p);
#else
    for (int ph = 0; ph < NPH; ++ph) { p.ph_lo = ph; p.ph_hi = ph + 1; hipLaunchKernelGGL(fwd_kernel, dim3(grid), dim3(512), LDS_BYTES, stream, p); }
#endif
}
```

```cpp
#include <hip/hip_runtime.h>
#include <cstdio>
#include <cstdint>

#ifndef STAGGER_TICKS
#define STAGGER_TICKS 0
#endif
#ifndef PROBE_K2
#define PROBE_K2 0
#endif
#ifndef PROBE_EPI6
#define PROBE_EPI6 0
#endif
#ifndef PROBE_EPIKIND
#define PROBE_EPIKIND -1
#endif
#ifndef PROBE_EPI2
#define PROBE_EPI2 0
#endif
#ifndef DEFER_SILU
#define DEFER_SILU 1
#endif
#ifndef MK_ONE_LAUNCH
#define MK_ONE_LAUNCH 1
#endif

#define LAS __attribute__((address_space(3)))
#define GAS __attribute__((address_space(1)))
typedef unsigned short bf16_t;
typedef short bf16x8 __attribute__((ext_vector_type(8)));
typedef float f32x4 __attribute__((ext_vector_type(4)));
typedef float f32x2 __attribute__((ext_vector_type(2)));
typedef unsigned u32x4 __attribute__((ext_vector_type(4)));
typedef unsigned u32x2 __attribute__((ext_vector_type(2)));

constexpr int D = 1024, BATCH = 4, SEQ = 4096, T = BATCH * SEQ, DEPTH = 4;
constexpr int DIN = 11264;
constexpr int NE = 32;
constexpr int NPH = 1 + DEPTH * 12;
constexpr float ALPHA = 1.681792830507429f;
constexpr float LOG2E = 1.4426950408889634f;

constexpr size_t MiB = 1u << 20;
constexpr size_t WS_CTL = 0, CTL_ZERO_BYTES = 1 * MiB;
constexpr size_t WS_SRC = 10 * MiB + 640 * 1024;
constexpr size_t WS_TAB = 2 * MiB;
constexpr size_t WS_TOK = 10 * MiB;
constexpr size_t WS_HT = 10 * MiB + 512 * 1024;
constexpr size_t WS_WRT = 11 * MiB;
constexpr size_t WS_RGC = 11 * MiB + 512 * 1024;
constexpr size_t WS_W0 = 12 * MiB;
constexpr size_t WO_WIN = 0;
constexpr size_t WO_WRET = 22 * MiB;
constexpr size_t WO_WNA = 26 * MiB;
constexpr size_t WO_WOUT = 28 * MiB;
constexpr size_t WO_WGU = 30 * MiB;
constexpr size_t WO_WD = 94 * MiB;
constexpr size_t WS_XB = 138 * MiB;
constexpr size_t WS_Q = 170 * MiB;
constexpr size_t WS_K = 202 * MiB;
constexpr size_t WS_ACAT = 234 * MiB;
constexpr size_t WS_BCAT = 362 * MiB;
constexpr size_t WS_KDT = 490 * MiB;
constexpr size_t WS_KV = 554 * MiB;
constexpr size_t WS_SG = 634 * MiB;
constexpr size_t WS_QN = 698 * MiB;
constexpr size_t WS_KN = 730 * MiB;
constexpr size_t WS_VNT = 762 * MiB;
constexpr size_t WS_G = 794 * MiB;
constexpr size_t WS_NAO = 858 * MiB;
constexpr size_t WS_W1 = 890 * MiB;
constexpr size_t WS_END = 1016 * MiB;
__host__ __device__ __forceinline__ constexpr size_t ws_wset(int l) { return (l & 1) ? WS_W1 : WS_W0; }
constexpr int CW_BAR = 4096;
constexpr int CW_CNT = 16384;

constexpr int LDS_STAGE = 131072;
constexpr int LDS_MISC = 147456;
constexpr int LM_BAR = 0;
constexpr int LM_HIST = 64;
constexpr int LM_BASE = 192;
constexpr int LM_ROW = 512;
constexpr int LM_NT = 2048;
constexpr int LM_TSTART = 2112;
constexpr int LM_TILEE = 2304;
constexpr int LM_RSTAT = 3072;
constexpr int LDS_BYTES = 163840;

#define LDS_WAIT() asm volatile("s_waitcnt lgkmcnt(0)" ::: "memory")
#define VM_WAIT() asm volatile("s_waitcnt vmcnt(0)" ::: "memory")
__device__ __forceinline__ unsigned cvt_pk_bf16(float lo, float hi) { unsigned r; asm("v_cvt_pk_bf16_f32 %0, %1, %2" : "=v"(r) : "v"(lo), "v"(hi)); return r; }
__device__ __forceinline__ u32x4 pack8(const f32x4 a, const f32x4 b) { u32x4 w; w.x = cvt_pk_bf16(a[0], a[1]); w.y = cvt_pk_bf16(a[2], a[3]); w.z = cvt_pk_bf16(b[0], b[1]); w.w = cvt_pk_bf16(b[2], b[3]); return w; }
__device__ __forceinline__ u32x2 pack4(const f32x4 a) { u32x2 w; w.x = cvt_pk_bf16(a[0], a[1]); w.y = cvt_pk_bf16(a[2], a[3]); return w; }
#ifndef NT_STORES
#define NT_STORES 0
#endif
#if NT_STORES
#define NT16(p, v) __builtin_nontemporal_store((v), (GAS u32x4*)(p))
#else
#define NT16(p, v) (*(GAS u32x4*)(p) = (v))
#endif
__device__ __forceinline__ float bf_lo(unsigned u) { return __uint_as_float(u << 16); }
__device__ __forceinline__ float bf_hi(unsigned u) { return __uint_as_float(u & 0xffff0000u); }
__device__ __forceinline__ float wave_sum(float v) {
#pragma unroll
    for (int o = 1; o < 64; o <<= 1) v += __shfl_xor(v, o);
    return v;
}
template <class Tp> __device__ __forceinline__ Tp* launder_s(Tp* p) { asm volatile("" : "+s"(p)); return p; }
__device__ __forceinline__ int launder_v(int v) { asm volatile("" : "+v"(v)); return v; }
__device__ __forceinline__ int launder_si(int v) { asm volatile("" : "+s"(v)); return v; }
__device__ __forceinline__ float fast_exp2(float x) { return __builtin_amdgcn_exp2f(x); }
__device__ __forceinline__ float fast_rcp(float x) { return __builtin_amdgcn_rcpf(x); }
__device__ __forceinline__ float sigmoid_f(float v) { return fast_rcp(1.0f + fast_exp2(-v * LOG2E)); }
__device__ __forceinline__ float log2_sigmoid(float x) { return -log1pf(expf(-x)) * LOG2E; }

#define XB_TMO      128
#define XB_XCNT(j)  (256  + 64 * (j))
#define XB_XSUB(j)  (1280 + 64 * (j))
#define XB_XGEN(j)  (2304 + 64 * (j))
#define XB_TOP      3328
#define XB_TOPGEN   3392
#define XCD_BAR_WORDS 3456
#define XB_SPIN_CAP (1u << 18)

__device__ __forceinline__ unsigned xb_ld(unsigned* p)              { return __hip_atomic_load(p, __ATOMIC_RELAXED, __HIP_MEMORY_SCOPE_AGENT); }
__device__ __forceinline__ unsigned xb_add(unsigned* p, unsigned v) { return __hip_atomic_fetch_add(p, v, __ATOMIC_RELAXED, __HIP_MEMORY_SCOPE_AGENT); }
__device__ __forceinline__ unsigned xb_xcc_id() { return (unsigned)__builtin_amdgcn_s_getreg((3 << 11) | 20) & 0xFu; }
#define XB_SPIN(cond, bar) do { unsigned _sp = 0; while (cond) { __builtin_amdgcn_s_sleep(1); \
    if ((++_sp & 255u) == 0u) { if (xb_ld(&(bar)[XB_TMO])) break; if (_sp > XB_SPIN_CAP) { atomicAdd(&(bar)[XB_TMO], 1u); break; } } } } while (0)

struct XcdBarrier {
    unsigned* bar; unsigned x;
    volatile LAS unsigned* st;
};
__device__ __forceinline__ XcdBarrier xcd_barrier_post(unsigned* bar, volatile LAS unsigned* st) {
    XcdBarrier b; b.bar = bar; b.x = xb_xcc_id(); b.st = st;
    if (threadIdx.x == 0) (void)xb_add(&bar[XB_XCNT(b.x)], 1u);
    return b;
}
__device__ __forceinline__ void xcd_barrier_complete(unsigned* bar, unsigned x, unsigned& nloc, unsigned& nx) {
    const unsigned G = gridDim.x * gridDim.y * gridDim.z;
    unsigned sum, cnt, mine, sp = 0u;
    for (;;) {
        sum = 0u; cnt = 0u; mine = 0u;
#pragma unroll
        for (unsigned j = 0; j < 16; ++j) { const unsigned c = xb_ld(&bar[XB_XCNT(j)]); sum += c; cnt += (c > 0u) ? 1u : 0u; mine = (j == x) ? c : mine; }
        if (sum == G) break;
        __builtin_amdgcn_s_sleep(1);
        if ((++sp & 255u) == 0u) { if (xb_ld(&bar[XB_TMO])) break; if (sp > XB_SPIN_CAP) { atomicAdd(&bar[XB_TMO], 1u); break; } }
    }
    nloc = mine > 0u ? mine : 1u; nx = cnt > 0u ? cnt : 1u;
}
__device__ __forceinline__ void xcd_barrier(const XcdBarrier& b) {
    asm volatile("s_waitcnt vmcnt(0)" ::: "memory");
    __syncthreads();
    if (threadIdx.x == 0) {
        unsigned* bar = b.bar;
        __builtin_amdgcn_s_waitcnt(0);
        unsigned nloc = b.st[0], nx = b.st[1];
        if (nloc == 0u) { xcd_barrier_complete(bar, b.x, nloc, nx); b.st[0] = nloc; b.st[1] = nx; }
        const unsigned old = xb_add(&bar[XB_XSUB(b.x)], 1u);
        const unsigned gen = old / nloc;
        if (old + 1u == (gen + 1u) * nloc) {
            __builtin_amdgcn_fence(__ATOMIC_RELEASE, "agent");
            asm volatile("s_waitcnt vmcnt(0)" ::: "memory");
            const unsigned og = xb_add(&bar[XB_TOP], 1u);
            const unsigned tg = og / nx;
            if (og + 1u == (tg + 1u) * nx) xb_add(&bar[XB_TOPGEN], 1u);
            else XB_SPIN(xb_ld(&bar[XB_TOPGEN]) == tg, bar);
            __builtin_amdgcn_fence(__ATOMIC_ACQUIRE, "agent");
            xb_add(&bar[XB_XGEN(b.x)], 1u);
            asm volatile("s_waitcnt vmcnt(0)" ::: "memory");
        } else {
            XB_SPIN(xb_ld(&bar[XB_XGEN(b.x)]) == gen, bar);
            __builtin_amdgcn_fence(__ATOMIC_ACQUIRE, "agent");
            asm volatile("s_waitcnt vmcnt(0)" ::: "memory");
        }
    }
    __syncthreads();
}

namespace pg {
constexpr int BM = 256, BK = 64, HALF = 128, HTB = HALF * BK * 2, STAGE_BYTES = 8 * HTB;
__device__ __forceinline__ int lds_byte(int r, int c) { const int st = (r >> 4) * 2 + (c >> 5), rr = r & 15, cc = c & 31, ob = rr * 64 + cc * 2; return st * 1024 + (ob ^ (((ob >> 9) & 1) << 5)); }
__device__ __forceinline__ void stage_rc(int b, int& R, int& C) { const int st = b / 1024, sb = b % 1024, swz = sb ^ (((sb >> 9) & 1) << 5); R = (st >> 1) * 16 + swz / 64; C = (st & 1) * 32 + (swz % 64) / 2; }
__device__ __forceinline__ int perm32(int rho) { const int n = rho >> 4, i = rho & 15; return 8 * (i >> 2) + 4 * n + (i & 3); }

struct Unit { const char* A; const char* B; int kind, a, b, c; };

template <int EPI_REP = 1, bool CHAIN = false, int KREP = 1, bool BLOCKB = false, bool GATHA = false, int EPI_ST = 0, class Epi, class Dec>
__device__ __forceinline__ void gemm_phase(LAS unsigned char* lds, const int K, const int lda, const int ldb, const int nunits, const Dec& dec, const Epi& E, const int vG, const int vbid, const LAS int* gsrc = nullptr) {
    const int tid = launder_v((int)threadIdx.x), wid = __builtin_amdgcn_readfirstlane(tid >> 6), lane = tid & 63, wr = wid >> 2, wc = wid & 3, fr = lane & 15, fq = lane >> 4;
    const int nt1 = K / BK, nt = nt1 * KREP;
    const int G = launder_si(vG); int uidx = launder_si(vbid);
    if (uidx < 0 || uidx >= nunits) return;
    unsigned voffA[2], voffB[2];
#pragma unroll
    for (int i = 0; i < 2; ++i) { int R, C; stage_rc(tid * 16 + i * 8192, R, C); const int Rb = (R & ~31) + perm32(R & 31);
        voffA[i] = (unsigned)(R * lda + C) * 2u; voffB[i] = BLOCKB ? (unsigned)(((Rb >> 4) * 64 + (C >> 3)) * 128 + (Rb & 15) * 8) * 2u : (unsigned)(Rb * ldb + C) * 2u; }
    const size_t kstep = (size_t)(BK * 2), kstepB = BLOCKB ? (size_t)2048 : kstep;
    const size_t hstepA = GATHA ? (size_t)0 : (size_t)HALF * lda * 2, hstepB = BLOCKB ? (size_t)131072 : (size_t)HALF * ldb * 2;
    int gR[2], gC[2]; unsigned vA0[2], vA1[2], nA0[2], nA1[2];
    if constexpr (GATHA) {
#pragma unroll
        for (int i = 0; i < 2; ++i) { stage_rc(tid * 16 + i * 8192, gR[i], gC[i]);
            vA0[i] = ((unsigned)gsrc[gR[i]] * (unsigned)lda + (unsigned)gC[i]) * 2u; vA1[i] = ((unsigned)gsrc[128 + gR[i]] * (unsigned)lda + (unsigned)gC[i]) * 2u; nA0[i] = vA0[i]; nA1[i] = vA1[i]; }
    }
    int uj = 0;
    const unsigned ldsw = (unsigned)wid * 1024u;
    const int aoff = lds_byte(wr * 64 + fr, fq * 8), boff = lds_byte(wc * 32 + fr, fq * 8);
#define PG_SA(b, h) (((b) * 2 + (h)) * HTB)
#define PG_SB(b, h) ((4 + (b) * 2 + (h)) * HTB)
#define PG_STAGE(bufoff, gbase, voff) do { _Pragma("unroll") for (int _i = 0; _i < 2; ++_i) \
        __builtin_amdgcn_global_load_lds((const unsigned*)((const char*)(gbase) + (voff)[_i]), (LAS unsigned*)(lds + (bufoff) + ldsw + _i * 8192), 16, 0, 0); } while (0)
#define PG_STAGE_A0(bufoff, gbase, nx) do { if constexpr (GATHA) { unsigned v_[2] = {(nx) ? nA0[0] : vA0[0], (nx) ? nA0[1] : vA0[1]}; PG_STAGE(bufoff, gbase, v_); } else PG_STAGE(bufoff, gbase, voffA); } while (0)
#define PG_STAGE_A1(bufoff, gbase, nx) do { if constexpr (GATHA) { unsigned v_[2] = {(nx) ? nA1[0] : vA1[0], (nx) ? nA1[1] : vA1[1]}; PG_STAGE(bufoff, gbase, v_); } else PG_STAGE(bufoff, (gbase) + hstepA, voffA); } while (0)
#define PG_LDA(dst, b, h) do { _Pragma("unroll") for (int m = 0; m < 4; ++m) _Pragma("unroll") for (int k = 0; k < 2; ++k) dst[m][k] = *(const LAS bf16x8*)(lds + PG_SA(b, h) + aoff + m * 2048 + k * 1024); } while (0)
#define PG_LDB(dst, b, h) do { _Pragma("unroll") for (int n = 0; n < 2; ++n) _Pragma("unroll") for (int k = 0; k < 2; ++k) dst[n][k] = *(const LAS bf16x8*)(lds + PG_SB(b, h) + boff + n * 2048 + k * 1024); } while (0)
#define PG_MMA(ai, bj, At, Bt) do { __builtin_amdgcn_s_setprio(1); _Pragma("unroll") for (int m = 0; m < 4; ++m) _Pragma("unroll") for (int n = 0; n < 2; ++n) _Pragma("unroll") for (int k = 0; k < 2; ++k) \
        acc[ai][bj][m][n] = __builtin_amdgcn_mfma_f32_16x16x32_bf16(Bt[n][k], At[m][k], acc[ai][bj][m][n], 0, 0, 0); __builtin_amdgcn_s_setprio(0); } while (0)
#define PG_WAIT_V(n) asm volatile("s_waitcnt vmcnt(" #n ")" ::: "memory")
#define PG_WAIT_V8R() do { if (relax) asm volatile("s_waitcnt vmcnt(%0)" :: "n"(8 + EPI_ST) : "memory"); else asm volatile("s_waitcnt vmcnt(8)" ::: "memory"); } while (0)
#define PG_WAIT_L(n) asm volatile("s_waitcnt lgkmcnt(" #n ")" ::: "memory")
#define PG_BAR __builtin_amdgcn_s_barrier()
#define PG_SCHED __builtin_amdgcn_sched_barrier(0)
    Unit cur, nxt;
    dec(uidx, cur);
    f32x4 acc[2][2][4][2];
#pragma unroll
    for (int a = 0; a < 2; ++a)
#pragma unroll
        for (int b = 0; b < 2; ++b)
#pragma unroll
            for (int m = 0; m < 4; ++m)
#pragma unroll
                for (int n = 0; n < 2; ++n) acc[a][b][m][n] = (f32x4){0.f, 0.f, 0.f, 0.f};
    bf16x8 At[4][2], B0[2][2], B1[2][2];
    const char* cA = cur.A; const char* cB = cur.B;
    PG_STAGE(PG_SB(0, 0), cB, voffB); PG_STAGE(PG_SB(0, 1), cB + hstepB, voffB); PG_STAGE_A0(PG_SA(0, 0), cA, false); PG_STAGE_A1(PG_SA(0, 1), cA, false);
    if (wr == 1) PG_BAR;
    PG_WAIT_V(2); PG_BAR;
    PG_STAGE(PG_SB(1, 0), cB + kstepB, voffB); PG_STAGE_A0(PG_SA(1, 0), cA + kstep, false); PG_STAGE(PG_SB(1, 1), cB + hstepB + kstepB, voffB);
    PG_WAIT_V(6); PG_BAR;
    bool after_epi = false;
    for (;;) {
        const bool has_next = (uidx + G < nunits);
        if (has_next) dec(uidx + G, nxt);
        const char* nA = has_next ? nxt.A : cA; const char* nB = has_next ? nxt.B : cB;
        if constexpr (GATHA) { if (has_next) {
#pragma unroll
            for (int i = 0; i < 2; ++i) { nA0[i] = ((unsigned)gsrc[(uj + 1) * 256 + gR[i]] * (unsigned)lda + (unsigned)gC[i]) * 2u; nA1[i] = ((unsigned)gsrc[(uj + 1) * 256 + 128 + gR[i]] * (unsigned)lda + (unsigned)gC[i]) * 2u; } } }
#pragma nounroll
        for (int t = 0; t < nt; t += 2) {
            const bool last = (t == nt - 2);
            const bool relax = EPI_ST > 0 && after_epi && t == 0;
            const int t1 = KREP > 1 ? (t + 1) % nt1 : t + 1, t2 = KREP > 1 ? (t + 2) % nt1 : t + 2;
            const char* a1 = cA + (size_t)t1 * kstep;
            const char* a2 = last ? nA : cA + (size_t)t2 * kstep; const char* b2 = last ? nB : cB + (size_t)t2 * kstepB;
            const char* a3 = a2 + kstep; const char* b3 = b2 + kstepB;
            PG_LDB(B0, 0, 0); PG_LDB(B1, 0, 1); PG_SCHED; PG_LDA(At, 0, 0); PG_STAGE_A1(PG_SA(1, 1), a1, false);
            PG_WAIT_V8R(); PG_WAIT_L(0); PG_BAR; PG_MMA(0, 0, At, B0); PG_MMA(0, 1, At, B1); PG_BAR; PG_SCHED;
            PG_LDA(At, 0, 1); PG_STAGE(PG_SB(0, 0), b2, voffB); PG_STAGE(PG_SB(0, 1), b2 + hstepB, voffB); PG_STAGE_A0(PG_SA(0, 0), a2, last);
            PG_WAIT_V8R(); PG_WAIT_L(0); PG_BAR; PG_MMA(1, 0, At, B0); PG_MMA(1, 1, At, B1); PG_BAR; PG_SCHED;
            PG_LDB(B0, 1, 0); PG_LDB(B1, 1, 1); PG_SCHED; PG_LDA(At, 1, 0); PG_STAGE_A1(PG_SA(0, 1), a2, last);
            PG_WAIT_V(8); PG_WAIT_L(0); PG_BAR; PG_MMA(0, 0, At, B0); PG_MMA(0, 1, At, B1); PG_BAR; PG_SCHED;
            PG_LDA(At, 1, 1); PG_STAGE(PG_SB(1, 0), b3, voffB); PG_STAGE(PG_SB(1, 1), b3 + hstepB, voffB); PG_STAGE_A0(PG_SA(1, 0), a3, last);
            PG_WAIT_V(8); PG_WAIT_L(0); PG_BAR; PG_MMA(1, 0, At, B0); PG_MMA(1, 1, At, B1); PG_BAR; PG_SCHED;
        }
        if (wr == 0) PG_BAR;
        if constexpr (KREP > 1) {
#pragma unroll
            for (int a = 0; a < 2; ++a)
#pragma unroll
                for (int b = 0; b < 2; ++b)
#pragma unroll
                    for (int m = 0; m < 4; ++m)
#pragma unroll
                        for (int n = 0; n < 2; ++n) acc[a][b][m][n] = acc[a][b][m][n] * (1.0f / KREP);
        }
        E(acc, cur, wr, wc, fr, fq);
        if constexpr (EPI_REP > 1) { if (PROBE_EPIKIND < 0 || cur.kind == PROBE_EPIKIND) E(acc, cur, wr, wc, fr, fq); }
        if (!has_next) break;
        if constexpr (CHAIN) E.carry(acc, nxt);
        else {
#pragma unroll
        for (int a = 0; a < 2; ++a)
#pragma unroll
            for (int b = 0; b < 2; ++b)
#pragma unroll
                for (int m = 0; m < 4; ++m)
#pragma unroll
                    for (int n = 0; n < 2; ++n) acc[a][b][m][n] = (f32x4){0.f, 0.f, 0.f, 0.f};
        }
        cur = nxt; cA = nA; cB = nB; uidx += G; after_epi = true;
        if constexpr (GATHA) { vA0[0] = nA0[0]; vA0[1] = nA0[1]; vA1[0] = nA1[0]; vA1[1] = nA1[1]; ++uj; }
        if (wr == 1) PG_BAR;
    }
    PG_WAIT_V(0);
    PG_BAR;
#undef PG_SA
#undef PG_SB
#undef PG_STAGE
#undef PG_LDA
#undef PG_STAGE_A0
#undef PG_STAGE_A1
#undef PG_LDB
#undef PG_MMA
#undef PG_WAIT_V
#undef PG_WAIT_L
#undef PG_WAIT_V8R
#undef PG_BAR
#undef PG_SCHED
}
}
using pg::Unit;

enum { KQ = 0, KK = 1, KPL_SILU = 2, KPL_SCALE = 3, KPL_SIG = 4, KKT = 5, KVT = 6, KVNT = 7 };

struct DecInProj {
    const char* xb; const char* WinT;
    __device__ __forceinline__ void operator()(int u, Unit& o) const {
#if DEFER_SILU
        if (u < 1792) {
            const int g = u >> 8, r = u & 255, x = r & 7, idx = r >> 3, cell = g * 8 + x, pg = cell / 7, jg7 = cell - pg * 7, pm = pg * 8 + (idx & 7), j = (jg7 < 2 ? jg7 : jg7 + 1) * 4 + (idx >> 3);
            const int wt = j < 8 ? j : (j < 24 ? j + 8 : j + 12);
#else
        if (u < 2048) {
            const int g = u >> 8, r = u & 255, x = r & 7, idx = r >> 3, pm = g * 8 + (idx & 7), j = ((x + g) & 7) * 4 + (idx >> 3);
            const int wt = j < 8 ? j : (j < 24 ? j + 8 : j + 12);
#endif
            o.A = xb + (size_t)pm * (256 * 1024 * 2); o.B = WinT + (size_t)wt * (256 * 1024 * 2); o.b = pm * 256; o.c = 0;
            if (wt < 4) { o.kind = KQ; o.a = wt; }
            else if (wt < 8) { o.kind = KK; o.a = wt - 4; }
            else if (wt < 24) { o.kind = KPL_SILU; o.a = (wt - 16) * 256; }
            else if (wt < 28) { o.kind = KPL_SCALE; o.a = (wt - 24) * 256; o.c = 0; }
            else if (wt < 32) { o.kind = KPL_SCALE; o.a = (wt - 28) * 256; o.c = 1; }
            else { o.kind = KPL_SIG; o.a = (wt - 36) * 256; }
        } else {
            const int v = u - (DEFER_SILU ? 1792 : 2048), g = v >> 8, r = v & 255, x = r & 7, idx = r >> 3, ci = 4 * g + (idx >> 3), tt = x * 8 + (idx & 7);
            int ct;
            if (ci < 8) { ct = 8 + ci; o.kind = KVT; o.a = ci >> 1; o.c = ci & 1; }
            else { ct = 32 + (ci - 8); o.kind = KVNT; o.a = ci - 8; o.c = 0; }
            o.A = WinT + (size_t)ct * (256 * 1024 * 2); o.B = xb + (size_t)tt * (256 * 1024 * 2); o.b = tt * 256;
        }
    }
};
struct DecInProjD {
    const char* xb; const char* WinT; int mode;
    __device__ __forceinline__ void operator()(int u, Unit& o) const {
        int pm, t4;
        if (mode == 0) { const int x = u & 7, i = u >> 3; pm = x * 4 + (i & 3); t4 = i >> 2; }
        else { const int k = u >> 6, r = u & 63, x = r & 7, i = r >> 3; pm = 32 + x * 4 + (i & 3); t4 = (i >> 2) * 2 + k; }
        o.A = xb + (size_t)pm * (256 * 1024 * 2); o.B = WinT + (size_t)(16 + t4) * (256 * 1024 * 2); o.b = pm * 256; o.c = 0; o.kind = KPL_SILU; o.a = t4 * 256;
    }
};
struct EpiInProj {
    unsigned char* ws_;
    const float* decay;
    __device__ __forceinline__ void operator()(const f32x4 (&acc)[2][2][4][2], const Unit& u, int wr, int wc, int fr, int fq) const {
        unsigned char* w = launder_s(ws_);
        bf16_t* const Q = (bf16_t*)(w + WS_Q); bf16_t* const Kb = (bf16_t*)(w + WS_K); bf16_t* const ACAT = (bf16_t*)(w + WS_ACAT); bf16_t* const BCAT = (bf16_t*)(w + WS_BCAT);
        bf16_t* const KDT = (bf16_t*)(w + WS_KDT); bf16_t* const SG = (bf16_t*)(w + WS_SG); bf16_t* const QN = (bf16_t*)(w + WS_QN); bf16_t* const KN = (bf16_t*)(w + WS_KN);
        bf16_t* const VNT = (bf16_t*)(w + WS_VNT); bf16_t* const Gt = (bf16_t*)(w + WS_G);
        const float* const frq = (const float*)(w + WS_TAB);
        const int kind = u.kind, c8 = wc * 32 + fq * 8;
        if (kind == KQ || kind == KK) {
            const int h = u.a, t0 = u.b;
            float lf = 0.f, lb = 0.f;
            lf = log2_sigmoid(decay[h]); lb = log2_sigmoid(decay[4 + h]);
            bf16x8 iy1, iy2;
#pragma unroll
            for (int i = 0; i < 8; ++i) { iy1[i] = (8 * fq + i == fr) ? (short)0x3F80 : (short)0; iy2[i] = (8 * fq + i == 16 + fr) ? (short)0x3F80 : (short)0; }
            const f32x4 fh0 = *(const GAS f32x4*)(frq + c8), fh1 = *(const GAS f32x4*)(frq + c8 + 4), fl0 = *(const GAS f32x4*)(frq + 128 + c8), fl1 = *(const GAS f32x4*)(frq + 128 + c8 + 4);
#pragma unroll
            for (int am = 0; am < 4; ++am) {
                const int ai = am >> 1;
#pragma unroll
                for (int mm = 0; mm < 2; ++mm) {
                    const int m = (am & 1) * 2 + mm;
                    const int t = t0 + ai * 128 + wr * 64 + m * 16 + fr;
                    const float pf = (float)(t & 4095);
                    f32x4 c0, c1, s0, s1;
#pragma unroll
                    for (int i = 0; i < 4; ++i) {
                        const float r0 = fmaf(pf, fl0[i], __builtin_amdgcn_fractf(pf * fh0[i])), r1 = fmaf(pf, fl1[i], __builtin_amdgcn_fractf(pf * fh1[i]));
                        c0[i] = __builtin_amdgcn_cosf(r0); s0[i] = __builtin_amdgcn_sinf(r0); c1[i] = __builtin_amdgcn_cosf(r1); s1[i] = __builtin_amdgcn_sinf(r1);
                    }
                    const f32x4 x1a = acc[ai][0][m][0], x1b = acc[ai][0][m][1], x2a = acc[ai][1][m][0], x2b = acc[ai][1][m][1];
                    f32x4 q1a = x1a * c0 - x2a * s0, q1b = x1b * c1 - x2b * s1, q2a = x1a * s0 + x2a * c0, q2b = x1b * s1 + x2b * c1;
                    if (kind == KQ) {
                        bf16_t* qp = Q + (size_t)t * 1024 + h * 256 + c8;
                        NT16(qp, pack8(q1a, q1b)); NT16((qp + 128), pack8(q2a, q2b));
                        const int p = t & 511; const float df = fast_exp2(lf * (float)(p + 1)), db = fast_exp2(lb * (float)(512 - p));
                        bf16_t* ap = ACAT + ((size_t)t * 4 + h) * 1024 + 512 + c8;
                        NT16(ap, pack8(q1a * df, q1b * df)); NT16((ap + 128), pack8(q2a * df, q2b * df));
                        NT16((ap + 256), pack8(q1a * db, q1b * db)); NT16((ap + 384), pack8(q2a * db, q2b * db));
                    } else {
                        bf16_t* kp = Kb + (size_t)t * 1024 + h * 256 + c8;
                        const u32x4 f0 = pack8(q1a * 0.0625f, q1b * 0.0625f), f1 = pack8(q2a * 0.0625f, q2b * 0.0625f);
                        NT16(kp, f0); NT16((kp + 128), f1);
                        const int tk = t0 + ai * 128 + wr * 64 + m * 16 + 4 * fq, sk = tk & 4095, jk = sk & 511;
                        f32x4 dfv, dbv;
#pragma unroll
                        for (int r = 0; r < 4; ++r) { dfv[r] = fast_exp2(lf * (float)(511 - (jk + r))); dbv[r] = fast_exp2(lb * (float)(jk + r)); }
                        bf16_t* const kt0 = KDT + ((((size_t)((tk >> 12) * 4 + h) * 8 + (sk >> 9)) * 2) * 256) * 512 + (size_t)(jk >> 3) * 128 + fr * 8 + (jk & 7);
#pragma unroll
                        for (int bj = 0; bj < 2; ++bj)
#pragma unroll
                            for (int hf = 0; hf < 2; ++hf) {
                                const f32x4 z4 = {0.f, 0.f, 0.f, 0.f};
                                const f32x4 dt = __builtin_amdgcn_mfma_f32_16x16x32_bf16(__builtin_bit_cast(bf16x8, bj ? f1 : f0), hf ? iy2 : iy1, z4, 0, 0, 0);
                                bf16_t* dp = kt0 + (size_t)(bj * 8 + wc * 2 + hf) * (64 * 128);
                                *(GAS u32x2*)dp = pack4(dt * dfv); *(GAS u32x2*)(dp + 256 * 512) = pack4(dt * dbv);
                            }
                    }
                    __builtin_amdgcn_sched_barrier(0);
                }
            }
        } else if (kind == KPL_SILU || kind == KPL_SCALE || kind == KPL_SIG) {
            const int t0 = u.b;
            bf16_t* dst; int ld; float sc = 1.f;
            if (kind == KPL_SILU) { dst = SG; ld = 2048; }
            else if (kind == KPL_SIG) { dst = Gt; ld = 2048; }
            else { ld = 1024; if (u.c == 0) { dst = QN; sc = 0.125f * LOG2E; } else { dst = KN; } }
            dst += u.a + c8;
#pragma unroll
            for (int ai = 0; ai < 2; ++ai)
#pragma unroll
                for (int m = 0; m < 4; ++m) {
                    const int t = t0 + ai * 128 + wr * 64 + m * 16 + fr;
#pragma unroll
                    for (int bj = 0; bj < 2; ++bj) {
                        f32x4 v0 = acc[ai][bj][m][0], v1 = acc[ai][bj][m][1];
                        if (kind == KPL_SCALE) { v0 = v0 * sc; v1 = v1 * sc; }
                        else if (kind == KPL_SIG) {
#pragma unroll
                            for (int i = 0; i < 4; ++i) { v0[i] = sigmoid_f(v0[i]); v1[i] = sigmoid_f(v1[i]); }
                        }
                        NT16((dst + (size_t)t * ld + bj * 128), pack8(v0, v1));
                    }
                }
        } else {
            const int t0 = u.b, bb = t0 >> 12, s0 = t0 & 4095, cc = s0 >> 9, j0 = s0 & 511;
            if (kind == KVT) {
                const int h = u.a;
#pragma unroll
                for (int ai = 0; ai < 2; ++ai)
#pragma unroll
                    for (int m = 0; m < 4; ++m) {
                        const int e = u.c * 256 + ai * 128 + wr * 64 + m * 16 + fr;
                        bf16_t* vp = BCAT + (((size_t)(bb * 4 + h) * 8 + cc) * 512 + e) * 1024 + j0 + c8;
#pragma unroll
                        for (int bj = 0; bj < 2; ++bj) NT16((vp + bj * 128), pack8(acc[ai][bj][m][0], acc[ai][bj][m][1]));
                    }
            } else {
#pragma unroll
                for (int ai = 0; ai < 2; ++ai)
#pragma unroll
                    for (int m = 0; m < 4; ++m) {
                        const int ch = u.a * 256 + ai * 128 + wr * 64 + m * 16 + fr;
                        bf16_t* vp = VNT + ((size_t)bb * 1024 + ch) * 4096 + s0 + c8;
#pragma unroll
                        for (int bj = 0; bj < 2; ++bj) NT16((vp + bj * 128), pack8(acc[ai][bj][m][0], acc[ai][bj][m][1]));
                    }
            }
        }
    }
};

__device__ __forceinline__ int xcd_perm(int u, int rs, int nunits) {
    const int i = u / rs, b = u - i * rs;
    return ((i + 1) * rs <= nunits) ? i * rs + (b & 7) * (rs >> 3) + (b >> 3) : u;
}
struct DecR1 {
    const char* Q; const char* Kb; int rs;
    __device__ __forceinline__ void operator()(int u0, Unit& o) const {
        const int u = xcd_perm(u0, rs, 512);
        const int pn2 = u & 1, pm2 = (u >> 1) & 1, cc = (u >> 2) & 7, bh = u >> 5, b = bh >> 2, h = bh & 3;
        const int ti = b * 4096 + cc * 512 + pm2 * 256, tj = b * 4096 + cc * 512 + pn2 * 256;
        o.A = Q + ((size_t)ti * 1024 + h * 256) * 2; o.B = Kb + ((size_t)tj * 1024 + h * 256) * 2;
        o.kind = 0; o.a = h; o.b = ti; o.c = pm2 * 2 + pn2;
    }
};
struct EpiR1 {
    bf16_t* ACAT; const float* decay;
    __device__ __forceinline__ void operator()(const f32x4 (&acc)[2][2][4][2], const Unit& u, int wr, int wc, int fr, int fq) const {
        const int h = u.a, ti0 = u.b, i0 = (u.c >> 1) * 256, j0 = (u.c & 1) * 256, c8 = wc * 32 + fq * 8;
        const float lf = log2_sigmoid(decay[h]), lb = log2_sigmoid(decay[4 + h]);
#pragma unroll
        for (int ai = 0; ai < 2; ++ai)
#pragma unroll
            for (int m = 0; m < 4; ++m) {
                const int r = ai * 128 + wr * 64 + m * 16 + fr, i = i0 + r;
                bf16_t* ap = ACAT + ((size_t)(ti0 + r) * 4 + h) * 1024 + j0 + c8;
#pragma unroll
                for (int bj = 0; bj < 2; ++bj) {
                    f32x4 v0 = acc[ai][bj][m][0], v1 = acc[ai][bj][m][1];
                    const int jb = j0 + bj * 128 + c8;
#pragma unroll
                    for (int q = 0; q < 4; ++q) {
                        const int d0 = i - (jb + q), d1 = i - (jb + 4 + q);
                        v0[q] *= fast_exp2(d0 >= 0 ? lf * (float)d0 : lb * (float)(-d0));
                        v1[q] *= fast_exp2(d1 >= 0 ? lf * (float)d1 : lb * (float)(-d1));
                    }
                    *(GAS u32x4*)(ap + bj * 128) = pack8(v0, v1);
                }
                __builtin_amdgcn_sched_barrier(0);
            }
    }
};
struct DecR2c {
    const char* BCAT; const char* KDT;
    __device__ __forceinline__ void operator()(int u, Unit& o) const {
        const int ch = u & 63, i = u >> 6, pm2 = ch & 1, dir = (ch >> 1) & 1, bh = ch >> 2;
        const int cs = dir ? 7 - i : i, ct = dir ? 6 - i : i + 1;
        o.A = BCAT + (((size_t)(bh * 8 + cs) * 512 + pm2 * 256) * 1024) * 2;
        o.B = KDT + ((((size_t)(bh * 8 + cs) * 2 + dir) * 256) * 512) * 2;
        o.kind = i; o.a = (bh * 8 + ct) * 512 + pm2 * 256; o.b = dir; o.c = dir * 4 + (bh & 3);
    }
};
struct EpiR2c {
    bf16_t* BCAT; const float* decay;
    __device__ __forceinline__ void carry(f32x4 (&acc)[2][2][4][2], const Unit& nx) const {
        const float cd = fast_exp2(log2_sigmoid(decay[nx.c]) * 512.0f);
#pragma unroll
        for (int a = 0; a < 2; ++a)
#pragma unroll
            for (int b = 0; b < 2; ++b)
#pragma unroll
                for (int m = 0; m < 4; ++m)
#pragma unroll
                    for (int n = 0; n < 2; ++n) acc[a][b][m][n] = acc[a][b][m][n] * cd;
    }
    __device__ __forceinline__ void operator()(const f32x4 (&acc)[2][2][4][2], const Unit& u, int wr, int wc, int fr, int fq) const {
        const int c8 = wc * 32 + fq * 8, dir = u.b;
#pragma unroll
        for (int ai = 0; ai < 2; ++ai)
#pragma unroll
            for (int m = 0; m < 4; ++m) {
                const int row = ai * 128 + wr * 64 + m * 16 + fr;
                bf16_t* sp = BCAT + ((size_t)u.a + row) * 1024 + 512 + dir * 256 + c8;
#pragma unroll
                for (int bj = 0; bj < 2; ++bj) *(GAS u32x4*)(sp + bj * 128) = pack8(acc[ai][bj][m][0], acc[ai][bj][m][1]);
                if (u.kind == 0) {
                    bf16_t* zp = dir ? sp + (size_t)512 * 1024 : sp - (size_t)512 * 1024;
                    const u32x4 z = {0u, 0u, 0u, 0u};
#pragma unroll
                    for (int bj = 0; bj < 2; ++bj) *(GAS u32x4*)(zp + bj * 128) = z;
                }
            }
    }
};
struct DecR4 {
    const char* ACAT; const char* BCAT; int rs;
    static __device__ __forceinline__ int panel_of(int wg) { return (wg & 7) * 32 + (wg >> 3); }
    __device__ __forceinline__ void operator()(int u0, Unit& o) const {
        const int pn2 = u0 >> 8, p = panel_of(u0 & 255);
        const int pm2 = p & 1, cc = (p >> 1) & 7, bh = p >> 4, b = bh >> 2, h = bh & 3;
        const int ti = b * 4096 + cc * 512 + pm2 * 256;
        o.A = ACAT + (((size_t)ti * 4 + h) * 1024) * 2; o.B = BCAT + (((size_t)(bh * 8 + cc) * 512 + pn2 * 256) * 1024) * 2;
        o.kind = 0; o.a = h * 512 + pn2 * 256; o.b = ti; o.c = 0;
    }
};
struct EpiR4 {
    bf16_t* RET;
    __device__ __forceinline__ void operator()(const f32x4 (&acc)[2][2][4][2], const Unit& u, int wr, int wc, int fr, int fq) const {
        const int c8 = wc * 32 + fq * 8;
#pragma unroll
        for (int ai = 0; ai < 2; ++ai)
#pragma unroll
            for (int m = 0; m < 4; ++m) {
                const int t = u.b + ai * 128 + wr * 64 + m * 16 + fr;
                bf16_t* rp = RET + (size_t)t * 2048 + u.a + c8;
#pragma unroll
                for (int bj = 0; bj < 2; ++bj) *(GAS u32x4*)(rp + bj * 128) = pack8(acc[ai][bj][m][0], acc[ai][bj][m][1]);
            }
    }
};
constexpr int LM_HN_PART = 4096, LM_HN_FIN0 = 12288, LM_HN_FIN1 = 14336;
struct EpiR4f {
    unsigned char* ws_; LAS unsigned char* lds;
    __device__ __forceinline__ void operator()(const f32x4 (&acc)[2][2][4][2], const Unit& u, int wr, int wc, int fr_, int fq) const {
        unsigned char* w = launder_s(ws_);
        const int fr = launder_v(fr_);
        bf16_t* const RET = (bf16_t*)(w + WS_KV); const bf16_t* const SG = (const bf16_t*)(w + WS_SG); bf16_t* const AR = (bf16_t*)(w + WS_KDT);
        LAS f32x2* part = (LAS f32x2*)(lds + LDS_MISC + LM_HN_PART); LAS f32x2* fin0 = (LAS f32x2*)(lds + LDS_MISC + LM_HN_FIN0); LAS f32x2* fin1 = (LAS f32x2*)(lds + LDS_MISC + LM_HN_FIN1);
        const int c8 = wc * 32 + fq * 8; const bool second = (u.a & 256) != 0;
#pragma unroll
        for (int ai = 0; ai < 2; ++ai)
#pragma unroll
            for (int m = 0; m < 4; ++m) {
                float s1 = 0.f, s2 = 0.f;
#pragma unroll
                for (int bj = 0; bj < 2; ++bj)
#pragma unroll
                    for (int n = 0; n < 2; ++n)
#pragma unroll
                        for (int i = 0; i < 4; ++i) { const float v = acc[ai][bj][m][n][i]; s1 += v; s2 += v * v; }
                s1 += __shfl_xor(s1, 16); s2 += __shfl_xor(s2, 16); s1 += __shfl_xor(s1, 32); s2 += __shfl_xor(s2, 32);
                if (fq == 0) { f32x2 ps; ps.x = s1; ps.y = s2; part[(ai * 128 + wr * 64 + m * 16 + fr) * 4 + wc] = ps; }
            }
        if (!second) {
#pragma unroll
            for (int ai = 0; ai < 2; ++ai)
#pragma unroll
                for (int m = 0; m < 4; ++m) {
                    const int t = u.b + ai * 128 + wr * 64 + m * 16 + fr;
                    bf16_t* rp = RET + (size_t)t * 2048 + u.a + c8;
#pragma unroll
                    for (int bj = 0; bj < 2; ++bj) *(GAS u32x4*)(rp + bj * 128) = pack8(acc[ai][bj][m][0], acc[ai][bj][m][1]);
                }
            LDS_WAIT(); __builtin_amdgcn_s_barrier();
            const int tid = (wr * 4 + wc) * 64 + fq * 16 + fr;
            if (tid < 256) { const f32x2 a = part[tid * 4], b = part[tid * 4 + 1], c = part[tid * 4 + 2], d = part[tid * 4 + 3]; f32x2 f; f.x = (a.x + b.x) + (c.x + d.x); f.y = (a.y + b.y) + (c.y + d.y); fin0[tid] = f; }
            LDS_WAIT();
        } else {
            LDS_WAIT(); __builtin_amdgcn_s_barrier();
#pragma unroll
            for (int am = 0; am < 4; ++am) {
                const int ai = am >> 1;
                u32x4 gv[2][2];
#pragma unroll
                for (int mm = 0; mm < 2; ++mm)
#pragma unroll
                    for (int bj = 0; bj < 2; ++bj) gv[mm][bj] = *(const GAS u32x4*)(SG + (size_t)(u.b + ai * 128 + wr * 64 + ((am & 1) * 2 + mm) * 16 + fr) * 2048 + u.a + bj * 128 + c8);
                __builtin_amdgcn_sched_barrier(0);
#pragma unroll
                for (int mm = 0; mm < 2; ++mm) {
                    const int m = (am & 1) * 2 + mm;
                    const int row = ai * 128 + wr * 64 + m * 16 + fr, t = u.b + row;
                    const f32x2 a = part[row * 4], b = part[row * 4 + 1], c = part[row * 4 + 2], d = part[row * 4 + 3], f0 = fin0[row];
                    const float S1 = ((a.x + b.x) + (c.x + d.x)) + f0.x, S2 = ((a.y + b.y) + (c.y + d.y)) + f0.y;
                    const float mean = S1 * (1.0f / 512.0f), var = fmaxf(S2 * (1.0f / 512.0f) - mean * mean, 0.f), rstd = 1.0f / sqrtf(var + 1e-5f);
                    if (wc == 0 && fq == 0) { f32x2 st; st.x = mean; st.y = rstd; fin1[row] = st; }
#pragma unroll
                    for (int bj = 0; bj < 2; ++bj) {
                        const u32x4 g = gv[mm][bj];
                        const float gg[8] = {bf_lo(g.x), bf_hi(g.x), bf_lo(g.y), bf_hi(g.y), bf_lo(g.z), bf_hi(g.z), bf_lo(g.w), bf_hi(g.w)};
                        f32x4 v0 = acc[ai][bj][m][0], v1 = acc[ai][bj][m][1];
#pragma unroll
                        for (int i = 0; i < 4; ++i) { v0[i] = (v0[i] - mean) * (gg[i] * sigmoid_f(gg[i]) * rstd); v1[i] = (v1[i] - mean) * (gg[4 + i] * sigmoid_f(gg[4 + i]) * rstd); }
                        *(GAS u32x4*)(AR + (size_t)t * 2048 + u.a + bj * 128 + c8) = pack8(v0, v1);
                    }
                }
                __builtin_amdgcn_sched_barrier(0);
            }
            LDS_WAIT();
        }
    }
};
struct DecDense {
    const char* A; const char* B; int lda2, ldb2;
    __device__ __forceinline__ void operator()(int u, Unit& o) const {
        const int pn = u >> 6, pm = u & 63;
        o.A = A + (size_t)pm * 256 * lda2; o.B = B + (size_t)pn * 256 * ldb2; o.kind = 0; o.a = pn * 256; o.b = pm * 256; o.c = 0;
    }
};
template <int MODE> struct EpiMerge {
    bf16_t* MG; const bf16_t* Gt;
    __device__ __forceinline__ void operator()(const f32x4 (&acc)[2][2][4][2], const Unit& u, int wr, int wc, int fr, int fq) const {
        const int c8 = wc * 32 + fq * 8;
#pragma unroll
        for (int ai = 0; ai < 2; ++ai) {
            u32x4 gv[4][2], ov[4][2];
#pragma unroll
            for (int m = 0; m < 4; ++m)
#pragma unroll
                for (int bj = 0; bj < 2; ++bj) { const int t = u.b + ai * 128 + wr * 64 + m * 16 + fr, c = u.a + bj * 128 + c8;
                    gv[m][bj] = *(const GAS u32x4*)(Gt + (size_t)t * 2048 + MODE * 1024 + c);
                    if (MODE == 1) ov[m][bj] = *(const GAS u32x4*)(MG + (size_t)t * 1024 + c); }
            __builtin_amdgcn_sched_barrier(0);
#pragma unroll
            for (int m = 0; m < 4; ++m) {
                const int t = u.b + ai * 128 + wr * 64 + m * 16 + fr;
#pragma unroll
                for (int bj = 0; bj < 2; ++bj) {
                    const int c = u.a + bj * 128 + c8; const u32x4 g = gv[m][bj];
                    f32x4 v0 = acc[ai][bj][m][0], v1 = acc[ai][bj][m][1];
                    v0[0] *= bf_lo(g.x); v0[1] *= bf_hi(g.x); v0[2] *= bf_lo(g.y); v0[3] *= bf_hi(g.y);
                    v1[0] *= bf_lo(g.z); v1[1] *= bf_hi(g.z); v1[2] *= bf_lo(g.w); v1[3] *= bf_hi(g.w);
                    if (MODE == 1) { const u32x4 o = ov[m][bj];
                        v0[0] += bf_lo(o.x); v0[1] += bf_hi(o.x); v0[2] += bf_lo(o.y); v0[3] += bf_hi(o.y);
                        v1[0] += bf_lo(o.z); v1[1] += bf_hi(o.z); v1[2] += bf_lo(o.w); v1[3] += bf_hi(o.w); }
                    *(GAS u32x4*)(MG + (size_t)t * 1024 + c) = pack8(v0, v1);
                }
            }
            __builtin_amdgcn_sched_barrier(0);
        }
    }
};
struct EpiPre {
    float* PRE; const bf16_t* xb;
    __device__ __forceinline__ void operator()(const f32x4 (&acc)[2][2][4][2], const Unit& u, int wr, int wc, int fr, int fq) const {
        const int c8 = wc * 32 + fq * 8;
        u32x4 xv[2][4][2];
#pragma unroll
        for (int ai = 0; ai < 2; ++ai)
#pragma unroll
            for (int m = 0; m < 4; ++m)
#pragma unroll
                for (int bj = 0; bj < 2; ++bj) xv[ai][m][bj] = *(const GAS u32x4*)(xb + (size_t)(u.b + ai * 128 + wr * 64 + m * 16 + fr) * 1024 + u.a + bj * 128 + c8);
        __builtin_amdgcn_sched_barrier(0);
#pragma unroll
        for (int ai = 0; ai < 2; ++ai)
#pragma unroll
            for (int m = 0; m < 4; ++m) {
                const int t = u.b + ai * 128 + wr * 64 + m * 16 + fr;
#pragma unroll
                for (int bj = 0; bj < 2; ++bj) {
                    const size_t o = (size_t)t * 1024 + u.a + bj * 128 + c8; const u32x4 x = xv[ai][m][bj];
                    const f32x4 x0 = {bf_lo(x.x), bf_hi(x.x), bf_lo(x.y), bf_hi(x.y)}, x1 = {bf_lo(x.z), bf_hi(x.z), bf_lo(x.w), bf_hi(x.w)};
                    *(GAS f32x4*)(PRE + o) = x0 * ALPHA + acc[ai][bj][m][0]; *(GAS f32x4*)(PRE + o + 4) = x1 * ALPHA + acc[ai][bj][m][1];
                }
            }
    }
};
struct DecMoe {
    const char* A; const char* W; int lda2, wexp2, ldb2; const LAS int* tile_e; int rs, nunits;
    __device__ __forceinline__ void operator()(int u0, Unit& o) const {
        const int u = xcd_perm(u0, rs, nunits);
        const int a = u >> 2, pn = u & 3, e = tile_e[a];
        o.A = A + (size_t)a * 256 * lda2; o.B = W + (size_t)e * wexp2 + (size_t)pn * 256 * ldb2; o.kind = 0; o.a = pn; o.b = a * 256; o.c = 0;
    }
};
struct EpiUp {
    bf16_t* H;
    __device__ __forceinline__ void operator()(const f32x4 (&acc)[2][2][4][2], const Unit& u, int wr, int wc, int fr, int fq) const {
        const int c8 = wc * 32 + fq * 8;
#pragma unroll
        for (int ai = 0; ai < 2; ++ai)
#pragma unroll
            for (int m = 0; m < 4; ++m) {
                const int r = u.b + ai * 128 + wr * 64 + m * 16 + fr;
                f32x4 g0 = acc[ai][0][m][0], g1 = acc[ai][0][m][1]; const f32x4 u0 = acc[ai][1][m][0], u1 = acc[ai][1][m][1];
#pragma unroll
                for (int i = 0; i < 4; ++i) { g0[i] = g0[i] * sigmoid_f(g0[i]) * u0[i]; g1[i] = g1[i] * sigmoid_f(g1[i]) * u1[i]; }
                *(GAS u32x4*)(H + (size_t)r * 512 + u.a * 128 + c8) = pack8(g0, g1);
            }
    }
};
struct EpiDown {
    bf16_t* Y;
    __device__ __forceinline__ void operator()(const f32x4 (&acc)[2][2][4][2], const Unit& u, int wr, int wc, int fr, int fq) const {
        const int c8 = wc * 32 + fq * 8;
#pragma unroll
        for (int ai = 0; ai < 2; ++ai)
#pragma unroll
            for (int m = 0; m < 4; ++m) {
                const int r = u.b + ai * 128 + wr * 64 + m * 16 + fr;
                bf16_t* yp = Y + (size_t)r * 1024 + u.a * 256 + c8;
#pragma unroll
                for (int bj = 0; bj < 2; ++bj) *(GAS u32x4*)(yp + bj * 128) = pack8(acc[ai][bj][m][0], acc[ai][bj][m][1]);
            }
    }
};

struct Params {
    const float* x; const float* w_in; const float* decay; const float* w_ret_o; const float* rpb; const float* w_na_o; const float* w_out;
    const float* ln_mix_g; const float* ln_mix_b; const float* router_w; const float* router_bias;
    const float* w_gate; const float* w_up; const float* w_down; const float* ln_ffn_g; const float* ln_ffn_b;
    float* out; unsigned char* ws; int ph_lo, ph_hi;
};
__device__ __forceinline__ Params load_params() {
    typedef __attribute__((address_space(4))) const Params CP;
    CP* pk = (CP*)__builtin_amdgcn_kernarg_segment_ptr();
    asm volatile("" : "+s"(pk));
    Params r;
    r.x = pk->x; r.w_in = pk->w_in; r.decay = pk->decay; r.w_ret_o = pk->w_ret_o; r.rpb = pk->rpb; r.w_na_o = pk->w_na_o; r.w_out = pk->w_out;
    r.ln_mix_g = pk->ln_mix_g; r.ln_mix_b = pk->ln_mix_b; r.router_w = pk->router_w; r.router_bias = pk->router_bias;
    r.w_gate = pk->w_gate; r.w_up = pk->w_up; r.w_down = pk->w_down; r.ln_ffn_g = pk->ln_ffn_g; r.ln_ffn_b = pk->ln_ffn_b;
    r.out = pk->out; r.ws = pk->ws; r.ph_lo = pk->ph_lo; r.ph_hi = pk->ph_hi;
    return r;
}
constexpr int CV_NIT = 16 * 352 + 32 * 32 + 16 * 32 + 16 * 32 + 3 * 32 * 256;
struct CvItem { const float* src; bf16_t* dst; int ldw, ldwt; };
__device__ __forceinline__ CvItem cv_decode(const Params& P, int l, unsigned char* ws, int r) {
    constexpr int I0 = 16 * 352, I1 = 32 * 32, I2 = 16 * 32, I3 = 16 * 32, I4 = 32 * 256;
    CvItem c;
    if (r < I0) { const int kb = r / 352, nb = r % 352; c.src = P.w_in + (size_t)l * 1024 * DIN + (size_t)kb * 64 * DIN + nb * 32; c.ldw = DIN; c.dst = (bf16_t*)(ws + WO_WIN) + (size_t)nb * 32 * 1024 + kb * 64; c.ldwt = 1024; return c; } r -= I0;
    if (r < I1) { const int kb = r >> 5, nb = r & 31; c.src = P.w_ret_o + (size_t)l * 2048 * 1024 + (size_t)kb * 64 * 1024 + nb * 32; c.ldw = 1024; c.dst = (bf16_t*)(ws + WO_WRET) + (size_t)nb * 32 * 2048 + kb * 64; c.ldwt = 2048; return c; } r -= I1;
    if (r < I2) { const int kb = r >> 5, nb = r & 31; c.src = P.w_na_o + (size_t)l * 1024 * 1024 + (size_t)kb * 64 * 1024 + nb * 32; c.ldw = 1024; c.dst = (bf16_t*)(ws + WO_WNA) + (size_t)nb * 32 * 1024 + kb * 64; c.ldwt = 1024; return c; } r -= I2;
    if (r < I3) { const int kb = r >> 5, nb = r & 31; c.src = P.w_out + (size_t)l * 1024 * 1024 + (size_t)kb * 64 * 1024 + nb * 32; c.ldw = 1024; c.dst = (bf16_t*)(ws + WO_WOUT) + (size_t)nb * 32 * 1024 + kb * 64; c.ldwt = 1024; return c; } r -= I3;
    if (r < 2 * I4) { const int up = r >= I4 ? 1 : 0; if (up) r -= I4; const int e = r >> 8, q = r & 255, kb = q >> 4, nb = q & 15, n0 = nb * 32;
        c.src = (up ? P.w_up : P.w_gate) + ((size_t)l * NE + e) * 1024 * 512 + (size_t)kb * 64 * 512 + n0; c.ldw = 512;
        c.dst = (bf16_t*)(ws + WO_WGU) + (size_t)(e * 1024 + (n0 >> 7) * 256 + up * 128 + (n0 & 127)) * 1024 + kb * 64; c.ldwt = 1024; return c; } r -= 2 * I4;
    { const int e = r >> 8, q = r & 255, kb = q >> 5, nb = q & 31;
      c.src = P.w_down + ((size_t)l * NE + e) * 512 * 1024 + (size_t)kb * 64 * 1024 + nb * 32; c.ldw = 1024; c.dst = (bf16_t*)(ws + WO_WD) + (size_t)(e * 1024 + nb * 32) * 512 + kb * 64; c.ldwt = 512; return c; }
}
__device__ __forceinline__ void cv_load(const CvItem& c, float (&wv)[32], int lane) {
#pragma unroll
    for (int i = 0; i < 32; ++i) wv[i] = ((const GAS float*)c.src)[(size_t)(2 * i + (lane >> 5)) * c.ldw + (lane & 31)];
}
__device__ __forceinline__ int cv_slot_items(int slot, int l) { return slot == 0 ? 7680 : slot == 1 ? (l == 0 ? 16384 : 8960) : slot == 2 ? (l + 1 < DEPTH ? 13824 : 8192) : (l + 1 < DEPTH ? 9472 : 0); }
__device__ __forceinline__ CvItem cv_item(const Params& P, int slot, int l, int v) {
    int ll = l, r;
    if (slot == 0) r = v;
    else if (slot == 1) r = 7680 + v;
    else if (slot == 2) { if (v < 8192) r = 24064 + v; else { ll = l + 1; r = v - 8192; } }
    else { ll = l + 1; r = v < 2048 ? 5632 + v : 16640 + (v - 2048); }
    return cv_decode(P, ll, P.ws + ws_wset(ll), r);
}
__device__ __forceinline__ void cv_transpose(const CvItem& cur, const float (&wv)[32], LAS float* scr, int lane) {
#pragma unroll
    for (int i = 0; i < 32; ++i) scr[(2 * i + (lane >> 5)) * 33 + (lane & 31)] = wv[i];
    LDS_WAIT();
    const int c = lane & 7;
#pragma unroll
    for (int j = 0; j < 4; ++j) { const int n = (lane >> 3) + 8 * j; const LAS float* s = scr + (8 * c) * 33 + n;
        u32x4 o; o.x = cvt_pk_bf16(s[0 * 33], s[1 * 33]); o.y = cvt_pk_bf16(s[2 * 33], s[3 * 33]); o.z = cvt_pk_bf16(s[4 * 33], s[5 * 33]); o.w = cvt_pk_bf16(s[6 * 33], s[7 * 33]);
        *(GAS u32x4*)(cur.dst + (size_t)n * cur.ldwt + 8 * c) = o; }
    LDS_WAIT();
}
__device__ __forceinline__ void convert_range(const Params& P, int slot, int l, LAS unsigned char* lds, int it0, int itend, int wave, int lane) {
    LAS float* scr = (LAS float*)(lds + wave * 16384);
    { const int tot = cv_slot_items(slot, l); if (itend > tot) itend = tot; }
    int it = it0 + wave; if (it >= itend) return;
    float wa[32], wb[32]; CvItem ca = cv_item(P, slot, l, it), cb = ca; cv_load(ca, wa, lane);
    if (it + 8 < itend) { cb = cv_item(P, slot, l, it + 8); cv_load(cb, wb, lane); }
    for (;;) {
        const int n2 = it + 16; const bool has2 = n2 < itend, has1 = it + 8 < itend;
        float wc[32]; CvItem cc = cb;
        if (has2) { cc = cv_item(P, slot, l, n2); cv_load(cc, wc, lane); }
        else {
#pragma unroll
            for (int i = 0; i < 32; ++i) wc[i] = 0.f;
        }
        cv_transpose(ca, wa, scr, lane);
        if (!has1) break;
#pragma unroll
        for (int i = 0; i < 32; ++i) { wa[i] = wb[i]; wb[i] = wc[i]; }
        ca = cb; cb = cc; it += 8;
    }
}
__device__ __forceinline__ void convert_share(const Params& P, int slot, int l, LAS unsigned char* lds, int a, int b, int idle, int part, int cap, int G, int bid, int wave, int lane) {
    const int S = b - a; int first = idle * cap; if (first > S) first = S;
    if (idle > 0 && part >= 0) { const int sl = (first + idle - 1) / idle, i0 = a + part * sl; int i1 = i0 + sl; if (i1 > a + first) i1 = a + first; if (i0 < i1) convert_range(P, slot, l, lds, i0, i1, wave, lane); }
    const int rest = S - first;
    if (rest > 0) { const int sl = (rest + G - 1) / G, i0 = a + first + bid * sl; int i1 = i0 + sl; if (i1 > b) i1 = b; if (i0 < i1) convert_range(P, slot, l, lds, i0, i1, wave, lane); }
}
__device__ __forceinline__ void sincos_d(double a, float& s, float& c) {
    const double k = rint(a * 0.63661977236758134308);
    double y = fma(-k, 1.5707963267948966192, a); y = fma(-k, 6.123233995736766036e-17, y);
    const double y2 = y * y;
    double sp = -1.0 / 1307674368000.0; sp = fma(sp, y2, 1.0 / 6227020800.0); sp = fma(sp, y2, -1.0 / 39916800.0); sp = fma(sp, y2, 1.0 / 362880.0); sp = fma(sp, y2, -1.0 / 5040.0); sp = fma(sp, y2, 1.0 / 120.0); sp = fma(sp, y2, -1.0 / 6.0); sp = fma(sp * y2, y, y);
    double cp = 1.0 / 20922789888000.0; cp = fma(cp, y2, -1.0 / 87178291200.0); cp = fma(cp, y2, 1.0 / 479001600.0); cp = fma(cp, y2, -1.0 / 3628800.0); cp = fma(cp, y2, 1.0 / 40320.0); cp = fma(cp, y2, -1.0 / 720.0); cp = fma(cp, y2, 1.0 / 24.0); cp = fma(cp, y2, -0.5); cp = fma(cp, y2, 1.0);
    const int q = (int)((long long)k & 3);
    const double sv = (q == 0) ? sp : (q == 1) ? cp : (q == 2) ? -sp : -cp;
    const double cv = (q == 0) ? cp : (q == 1) ? -sp : (q == 2) ? -cp : sp;
    s = (float)sv; c = (float)cv;
}
__device__ __forceinline__ void phase_init(const Params& P, LAS unsigned char* lds, int gw, int NGW, int wave, int lane) {
    unsigned char* ws = P.ws;
    float* frqt = (float*)(ws + WS_TAB);
    const int gtid = gw * 64 + lane, NT_ = NGW * 64;
    if (gtid < 128) {
        const double f = exp(-(double)gtid * (9.210340371976184 / 128.0)) * 0.15915494309189533577;
        const float fh = __uint_as_float(__float_as_uint((float)f) & 0xFFFFF000u);
        frqt[gtid] = fh; frqt[128 + gtid] = (float)(f - (double)fh);
    }
    bf16_t* wrt = (bf16_t*)(ws + WS_WRT);
    for (int i = gtid; i < DEPTH * 32 * 1024; i += NT_) {
        const int ll = i >> 15, e = (i >> 10) & 31, d = i & 1023; const float w = ((const GAS float*)P.router_w)[d * 32 + e] * ((const GAS float*)P.ln_mix_g)[ll * 1024 + d];
        const unsigned h = cvt_pk_bf16(w, 0.f) & 0xffffu; const unsigned lo = cvt_pk_bf16(w - bf_lo(h), 0.f) & 0xffffu;
        wrt[(size_t)ll * 65536 + e * 1024 + d] = (bf16_t)h; wrt[(size_t)ll * 65536 + 32768 + e * 1024 + d] = (bf16_t)lo;
    }
    float* rgc = (float*)(ws + WS_RGC);
    for (int it = gw; it < DEPTH * 32; it += NGW) {
        const int ll = it >> 5, e = it & 31; float sg = 0.f, sb = 0.f;
        for (int d = lane; d < 1024; d += 64) { const float w = ((const GAS float*)P.router_w)[d * 32 + e]; sg += w * ((const GAS float*)P.ln_mix_g)[ll * 1024 + d]; sb += w * ((const GAS float*)P.ln_mix_b)[ll * 1024 + d]; }
        sg = wave_sum(sg); sb = wave_sum(sb);
        if (lane == 0) { rgc[ll * 64 + e] = sg; rgc[ll * 64 + 32 + e] = sb; }
    }
    bf16_t* xb = (bf16_t*)(ws + WS_XB);
    for (int i = gtid; i < T * D / 8; i += NT_) {
        const f32x4 a = *(const GAS f32x4*)(P.x + (size_t)i * 8), b = *(const GAS f32x4*)(P.x + (size_t)i * 8 + 4);
        *(GAS u32x4*)(xb + (size_t)i * 8) = pack8(a, b);
    }
    convert_range(P, 0, 0, lds, (int)blockIdx.x * 30, (int)blockIdx.x * 30 + 30, wave, lane);
}
__device__ __forceinline__ void phase_prefix(const Params& P, int l, int gw, int NGW, int lane) {
    const float* KV = (const float*)(P.ws + WS_KV); bf16_t* BCAT = (bf16_t*)(P.ws + WS_BCAT);
    const float* decay = P.decay + l * 8;
    const int gtid = gw * 64 + lane, NT_ = NGW * 64;
    for (int idx = gtid; idx < 16 * 2 * 512 * 32; idx += NT_) {
        const int dg = idx & 31, e = (idx >> 5) & 511, dir = (idx >> 14) & 1, bh = idx >> 15, h = bh & 3;
        const float cd = fast_exp2(log2_sigmoid(decay[dir * 4 + h]) * 512.0f);
        f32x4 s0 = {0.f, 0.f, 0.f, 0.f}, s1 = {0.f, 0.f, 0.f, 0.f};
        for (int q = 0; q < 8; ++q) {
            const int cc = dir ? 7 - q : q;
            *(GAS u32x4*)(BCAT + ((size_t)(bh * 8 + cc) * 512 + e) * 1024 + 512 + dir * 256 + dg * 8) = pack8(s0, s1);
            if (q < 7) { const float* kp = KV + ((size_t)((bh * 8 + cc) * 2 + dir) * 512 + e) * 256 + dg * 8;
                s0 = s0 * cd + *(const GAS f32x4*)kp; s1 = s1 * cd + *(const GAS f32x4*)(kp + 4); }
        }
    }
}
__device__ __forceinline__ void phase_headnorm(const Params& P, int gw, int NGW, int lane) {
    const bf16_t* RET = (const bf16_t*)(P.ws + WS_KV); const bf16_t* SG = (const bf16_t*)(P.ws + WS_SG); bf16_t* AR = (bf16_t*)(P.ws + WS_KDT);
    for (int it0 = gw; it0 < T * 4; it0 += 4 * NGW) {
        u32x4 r[4], g[4];
#pragma unroll
        for (int k = 0; k < 4; ++k) { const int it = it0 + k * NGW; if (it < T * 4) { const size_t off = (size_t)it * 512 + lane * 8; r[k] = *(const GAS u32x4*)(RET + off); g[k] = *(const GAS u32x4*)(SG + off); } }
#pragma unroll
        for (int k = 0; k < 4; ++k) {
            const int it = it0 + k * NGW; if (it >= T * 4) break;
            const size_t off = (size_t)it * 512 + lane * 8;
            float v[8] = {bf_lo(r[k].x), bf_hi(r[k].x), bf_lo(r[k].y), bf_hi(r[k].y), bf_lo(r[k].z), bf_hi(r[k].z), bf_lo(r[k].w), bf_hi(r[k].w)};
            float s = 0.f;
#pragma unroll
            for (int i = 0; i < 8; ++i) s += v[i];
            const float mean = wave_sum(s) * (1.0f / 512.0f);
            float q = 0.f;
#pragma unroll
            for (int i = 0; i < 8; ++i) { v[i] -= mean; q += v[i] * v[i]; }
            const float rstd = 1.0f / sqrtf(wave_sum(q) * (1.0f / 512.0f) + 1e-5f);
            float gg[8] = {bf_lo(g[k].x), bf_hi(g[k].x), bf_lo(g[k].y), bf_hi(g[k].y), bf_lo(g[k].z), bf_hi(g[k].z), bf_lo(g[k].w), bf_hi(g[k].w)};
#pragma unroll
            for (int i = 0; i < 8; ++i) gg[i] = gg[i] * sigmoid_f(gg[i]) * rstd;
            u32x4 o; o.x = cvt_pk_bf16(v[0] * gg[0], v[1] * gg[1]); o.y = cvt_pk_bf16(v[2] * gg[2], v[3] * gg[3]);
            o.z = cvt_pk_bf16(v[4] * gg[4], v[5] * gg[5]); o.w = cvt_pk_bf16(v[6] * gg[6], v[7] * gg[7]);
            *(GAS u32x4*)(AR + off) = o;
        }
    }
}
__device__ __forceinline__ void headnorm_rows(const Params& P, int t0, int h, int wave, int lane) {
    const bf16_t* RET = (const bf16_t*)(P.ws + WS_KV); const bf16_t* SG = (const bf16_t*)(P.ws + WS_SG); bf16_t* AR = (bf16_t*)(P.ws + WS_KDT);
#pragma nounroll
    for (int rb = 0; rb < 32; rb += 4) {
        u32x4 r[4], g[4];
#pragma unroll
        for (int k = 0; k < 4; ++k) { const size_t off = ((size_t)(t0 + wave * 32 + rb + k) * 4 + h) * 512 + lane * 8; r[k] = *(const GAS u32x4*)(RET + off); g[k] = *(const GAS u32x4*)(SG + off); }
#pragma unroll
        for (int k = 0; k < 4; ++k) {
            const size_t off = ((size_t)(t0 + wave * 32 + rb + k) * 4 + h) * 512 + lane * 8;
            float v[8] = {bf_lo(r[k].x), bf_hi(r[k].x), bf_lo(r[k].y), bf_hi(r[k].y), bf_lo(r[k].z), bf_hi(r[k].z), bf_lo(r[k].w), bf_hi(r[k].w)};
            float s = 0.f;
#pragma unroll
            for (int i = 0; i < 8; ++i) s += v[i];
            const float mean = wave_sum(s) * (1.0f / 512.0f);
            float q = 0.f;
#pragma unroll
            for (int i = 0; i < 8; ++i) { v[i] -= mean; q += v[i] * v[i]; }
            const float rstd = 1.0f / sqrtf(wave_sum(q) * (1.0f / 512.0f) + 1e-5f);
            float gg[8] = {bf_lo(g[k].x), bf_hi(g[k].x), bf_lo(g[k].y), bf_hi(g[k].y), bf_lo(g[k].z), bf_hi(g[k].z), bf_lo(g[k].w), bf_hi(g[k].w)};
#pragma unroll
            for (int i = 0; i < 8; ++i) gg[i] = gg[i] * sigmoid_f(gg[i]) * rstd;
            u32x4 o; o.x = cvt_pk_bf16(v[0] * gg[0], v[1] * gg[1]); o.y = cvt_pk_bf16(v[2] * gg[2], v[3] * gg[3]);
            o.z = cvt_pk_bf16(v[4] * gg[4], v[5] * gg[5]); o.w = cvt_pk_bf16(v[6] * gg[6], v[7] * gg[7]);
            *(GAS u32x4*)(AR + off) = o;
        }
    }
}
__device__ __forceinline__ void headnorm_half0(const Params& P, LAS unsigned char* lds, int t0, int h, int wave, int lane) {
    const bf16_t* RET = (const bf16_t*)(P.ws + WS_KV); const bf16_t* SG = (const bf16_t*)(P.ws + WS_SG); bf16_t* AR = (bf16_t*)(P.ws + WS_KDT);
    const LAS f32x2* fin1 = (const LAS f32x2*)(lds + LDS_MISC + LM_HN_FIN1);
#pragma nounroll
    for (int rb = 0; rb < 32; rb += 8) {
        u32x4 r[4], g[4];
#pragma unroll
        for (int k = 0; k < 4; ++k) { const size_t off = ((size_t)(t0 + wave * 32 + rb + 2 * k + (lane >> 5)) * 4 + h) * 512 + (lane & 31) * 8; r[k] = *(const GAS u32x4*)(RET + off); g[k] = *(const GAS u32x4*)(SG + off); }
#pragma unroll
        for (int k = 0; k < 4; ++k) {
            const int row = wave * 32 + rb + 2 * k + (lane >> 5);
            const size_t off = ((size_t)(t0 + row) * 4 + h) * 512 + (lane & 31) * 8;
            const f32x2 st = fin1[row];
            const float v[8] = {bf_lo(r[k].x), bf_hi(r[k].x), bf_lo(r[k].y), bf_hi(r[k].y), bf_lo(r[k].z), bf_hi(r[k].z), bf_lo(r[k].w), bf_hi(r[k].w)};
            const float gg[8] = {bf_lo(g[k].x), bf_hi(g[k].x), bf_lo(g[k].y), bf_hi(g[k].y), bf_lo(g[k].z), bf_hi(g[k].z), bf_lo(g[k].w), bf_hi(g[k].w)};
            float o8[8];
#pragma unroll
            for (int i = 0; i < 8; ++i) o8[i] = (v[i] - st.x) * (gg[i] * sigmoid_f(gg[i]) * st.y);
            u32x4 o; o.x = cvt_pk_bf16(o8[0], o8[1]); o.y = cvt_pk_bf16(o8[2], o8[3]); o.z = cvt_pk_bf16(o8[4], o8[5]); o.w = cvt_pk_bf16(o8[6], o8[7]);
            *(GAS u32x4*)(AR + off) = o;
        }
    }
}
__device__ __forceinline__ void phase_na(const Params& P, int l, int gw, int NGW, int lane) {
    const bf16_t* QN = (const bf16_t*)(P.ws + WS_QN); const bf16_t* KN = (const bf16_t*)(P.ws + WS_KN); const bf16_t* VNT = (const bf16_t*)(P.ws + WS_VNT);
    bf16_t* NAO = (bf16_t*)(P.ws + WS_NAO);
    const float* rpb = P.rpb + (size_t)l * 16 * 15 * 31;
    const int fr = lane & 15, fq = lane >> 4;
    for (int id = gw; id < 16384; id += NGW) {
        const int cb = id & 3, r = (id >> 2) & 63, h = (id >> 8) & 15, b = id >> 12;
        const int rs = min(max(r - 4, 0), 56), c0 = cb * 16, cs = min(max(c0 - 8, 0), 32);
        const int c = c0 + fr, cst = min(max(c - 8, 0), 48);
        const size_t tq = (size_t)b * 4096 + r * 64 + c;
        const bf16x8 yq0 = *(const GAS bf16x8*)(QN + tq * 1024 + h * 64 + 8 * fq), yq1 = *(const GAS bf16x8*)(QN + tq * 1024 + h * 64 + 32 + 8 * fq);
        f32x4 S[16];
#pragma unroll
        for (int kt = 0; kt < 16; ++kt) {
            const int kr = rs + (kt >> 1), kcb = cs + (kt & 1) * 16;
            const size_t tk = (size_t)b * 4096 + kr * 64 + kcb + fr;
            const bf16x8 xk0 = *(const GAS bf16x8*)(KN + tk * 1024 + h * 64 + 8 * fq), xk1 = *(const GAS bf16x8*)(KN + tk * 1024 + h * 64 + 32 + 8 * fq);
            f32x4 z = {0.f, 0.f, 0.f, 0.f};
            z = __builtin_amdgcn_mfma_f32_16x16x32_bf16(xk0, yq0, z, 0, 0, 0);
            z = __builtin_amdgcn_mfma_f32_16x16x32_bf16(xk1, yq1, z, 0, 0, 0);
            const float* bp = rpb + (h * 15 + (kr - r + 7)) * 31;
#pragma unroll
            for (int j = 0; j < 4; ++j) {
                const int kc = kcb + 4 * fq + j; const bool valid = (kc >= cst) && (kc < cst + 16);
                const int co = min(max(kc - c + 15, 0), 30);
                const float bias = ((const GAS float*)bp)[co];
                z[j] = valid ? z[j] + bias : -INFINITY;
            }
            S[kt] = z;
        }
        float mx = -INFINITY;
#pragma unroll
        for (int kt = 0; kt < 16; ++kt)
#pragma unroll
            for (int j = 0; j < 4; ++j) mx = fmaxf(mx, S[kt][j]);
        mx = fmaxf(mx, __shfl_xor(mx, 16)); mx = fmaxf(mx, __shfl_xor(mx, 32));
        float sum = 0.f;
#pragma unroll
        for (int kt = 0; kt < 16; ++kt)
#pragma unroll
            for (int j = 0; j < 4; ++j) { const float p = fast_exp2((S[kt][j] - mx) * LOG2E); S[kt][j] = p; sum += p; }
        sum += __shfl_xor(sum, 16); sum += __shfl_xor(sum, 32);
        f32x4 O[4];
#pragma unroll
        for (int ht = 0; ht < 4; ++ht) O[ht] = (f32x4){0.f, 0.f, 0.f, 0.f};
#pragma unroll
        for (int p = 0; p < 8; ++p) {
            const u32x4 yw = pack8(S[2 * p], S[2 * p + 1]);
            const bf16x8 yp = __builtin_bit_cast(bf16x8, yw);
            const size_t sk = (size_t)(rs + p) * 64 + cs + 4 * fq;
#pragma unroll
            for (int ht = 0; ht < 4; ++ht) {
                const bf16_t* vp = VNT + ((size_t)b * 1024 + h * 64 + ht * 16 + fr) * 4096 + sk;
                const u32x2 lo = *(const GAS u32x2*)vp, hi = *(const GAS u32x2*)(vp + 16);
                const u32x4 xw = {lo.x, lo.y, hi.x, hi.y};
                O[ht] = __builtin_amdgcn_mfma_f32_16x16x32_bf16(__builtin_bit_cast(bf16x8, xw), yp, O[ht], 0, 0, 0);
            }
        }
        const float inv = 1.0f / sum;
#pragma unroll
        for (int ht = 0; ht < 4; ++ht) *(GAS u32x2*)(NAO + tq * 1024 + h * 64 + ht * 16 + 4 * fq) = pack4(O[ht] * inv);
    }
}
constexpr int LM_BIAS = 4096;
__device__ __forceinline__ void phase_na2(const Params& P, int l, LAS unsigned char* lds, int tid, int wave, int lane, int vG, int vbid) {
    const bf16_t* QN = (const bf16_t*)(P.ws + WS_QN); const bf16_t* KN = (const bf16_t*)(P.ws + WS_KN); const bf16_t* VNT = (const bf16_t*)(P.ws + WS_VNT);
    bf16_t* NAO = (bf16_t*)(P.ws + WS_NAO);
    const float* rpb = P.rpb + (size_t)l * 16 * 15 * 31;
    LAS unsigned char* Ks = lds; LAS unsigned char* Vs = lds + 65536;
    LAS float* bias_s = (LAS float*)(lds + LDS_MISC + LM_BIAS);
    const int fr = lane & 15, fq = lane >> 4;
    const int prow = tid >> 3, pc = (tid & 7) ^ ((prow >> 1) & 7);
#define NA_BAR() do { asm volatile("s_waitcnt lgkmcnt(0)" ::: "memory"); __builtin_amdgcn_s_barrier(); asm volatile("" ::: "memory"); } while (0)
#define NA_LOAD_K(kr) __builtin_amdgcn_global_load_lds((const unsigned*)(kbase + ((size_t)((kr) * 64 + prow)) * 2048 + pc * 16), (LAS unsigned*)(Ks + ((kr) & 7) * 8192 + wave * 1024), 16, 0, 0)
#define NA_LOAD_V(kr) __builtin_amdgcn_global_load_lds((const unsigned*)(vbase + (size_t)prow * 8192 + (kr) * 128 + pc * 16), (LAS unsigned*)(Vs + ((kr) & 7) * 8192 + wave * 1024), 16, 0, 0)
    for (int bu = launder_si(vbid); bu < 256; bu += vG) {
        const int sg = bu & 3, h = (bu >> 2) & 15, b = bu >> 6;
        const char* kbase = (const char*)(KN + (size_t)b * 4096 * 1024 + h * 64);
        const char* vbase = (const char*)(VNT + ((size_t)b * 1024 + h * 64) * 4096);
        asm volatile("s_waitcnt vmcnt(0)" ::: "memory"); NA_BAR();
        for (int i = tid; i < 465; i += 512) bias_s[i] = ((const GAS float*)rpb)[h * 465 + i];
        const int r0 = sg * 16, rs0 = min(max(r0 - 4, 0), 56);
#pragma unroll
        for (int q = 0; q < 8; ++q) { NA_LOAD_K(rs0 + q); NA_LOAD_V(rs0 + q); }
        const int cb = wave & 3, c0 = cb * 16, cs = min(max(c0 - 8, 0), 32), c = c0 + fr, cst = min(max(c - 8, 0), 48);
        bf16x8 yq0, yq1;
        { const size_t tq = (size_t)b * 4096 + r0 * 64 + c; yq0 = *(const GAS bf16x8*)(QN + tq * 1024 + h * 64 + 8 * fq); yq1 = *(const GAS bf16x8*)(QN + tq * 1024 + h * 64 + 32 + 8 * fq); }
#pragma nounroll
        for (int r = r0; r < r0 + 16; ++r) {
            const int rs = min(max(r - 4, 0), 56), rsn = min(max(r - 3, 0), 56);
            const bool mv = (r + 1 < r0 + 16) && (rsn != rs);
            asm volatile("s_waitcnt vmcnt(0)" ::: "memory"); NA_BAR();
            const bf16x8 q0 = yq0, q1 = yq1;
            const size_t tq = (size_t)b * 4096 + r * 64 + c;
            if (r + 1 < r0 + 16) { const size_t tn = tq + 64; yq0 = *(const GAS bf16x8*)(QN + tn * 1024 + h * 64 + 8 * fq); yq1 = *(const GAS bf16x8*)(QN + tn * 1024 + h * 64 + 32 + 8 * fq); }
            f32x4 S[16];
            if (wave < 4) {
#pragma unroll
                for (int kt = 0; kt < 16; ++kt) {
                    const int kr = rs + (kt >> 1), kcb = cs + (kt & 1) * 16, key = kcb + fr;
                    const LAS unsigned char* kp = Ks + (kr & 7) * 8192 + key * 128; const int sw = (key >> 1) & 7;
                    const bf16x8 xk0 = *(const LAS bf16x8*)(kp + ((fq ^ sw) << 4)), xk1 = *(const LAS bf16x8*)(kp + (((4 + fq) ^ sw) << 4));
                    f32x4 z = {0.f, 0.f, 0.f, 0.f};
                    z = __builtin_amdgcn_mfma_f32_16x16x32_bf16(xk0, q0, z, 0, 0, 0);
                    z = __builtin_amdgcn_mfma_f32_16x16x32_bf16(xk1, q1, z, 0, 0, 0);
                    const LAS float* bp = bias_s + (kr - r + 7) * 31;
#pragma unroll
                    for (int j = 0; j < 4; ++j) {
                        const int kc = kcb + 4 * fq + j; const bool valid = (kc >= cst) && (kc < cst + 16);
                        const int co = min(max(kc - c + 15, 0), 30);
                        z[j] = valid ? z[j] + bp[co] : -INFINITY;
                    }
                    S[kt] = z;
                }
            }
            NA_BAR();
            if (mv) NA_LOAD_K(rs + 8);
            f32x4 O[4]; float inv = 0.f;
            if (wave < 4) {
                float mx = -INFINITY;
#pragma unroll
                for (int kt = 0; kt < 16; ++kt)
#pragma unroll
                    for (int j = 0; j < 4; ++j) mx = fmaxf(mx, S[kt][j]);
                mx = fmaxf(mx, __shfl_xor(mx, 16)); mx = fmaxf(mx, __shfl_xor(mx, 32));
                float sum = 0.f;
#pragma unroll
                for (int kt = 0; kt < 16; ++kt)
#pragma unroll
                    for (int j = 0; j < 4; ++j) { const float p = fast_exp2((S[kt][j] - mx) * LOG2E); S[kt][j] = p; sum += p; }
                sum += __shfl_xor(sum, 16); sum += __shfl_xor(sum, 32);
                inv = 1.0f / sum;
#pragma unroll
                for (int ht = 0; ht < 4; ++ht) O[ht] = (f32x4){0.f, 0.f, 0.f, 0.f};
            }
#pragma unroll
            for (int p = 0; p < 8; ++p) {
                if (wave < 4) {
                    const bf16x8 yp = __builtin_bit_cast(bf16x8, pack8(S[2 * p], S[2 * p + 1]));
                    const LAS unsigned char* vrow = Vs + ((rs + p) & 7) * 8192;
#pragma unroll
                    for (int ht = 0; ht < 4; ++ht) {
                        const int ch = ht * 16 + fr, sw = (ch >> 1) & 7, pc0 = (cs >> 3) + (fq >> 1);
                        const LAS unsigned char* vp = vrow + ch * 128 + (fq & 1) * 8;
                        const u32x2 lo = *(const LAS u32x2*)(vp + ((pc0 ^ sw) << 4)), hi = *(const LAS u32x2*)(vp + (((pc0 + 2) ^ sw) << 4));
                        const u32x4 xw = {lo.x, lo.y, hi.x, hi.y};
                        O[ht] = __builtin_amdgcn_mfma_f32_16x16x32_bf16(__builtin_bit_cast(bf16x8, xw), yp, O[ht], 0, 0, 0);
                    }
                }
                if (p == 0) { NA_BAR(); if (mv) NA_LOAD_V(rs + 8); }
            }
            if (wave < 4) {
#pragma unroll
                for (int ht = 0; ht < 4; ++ht) *(GAS u32x2*)(NAO + tq * 1024 + h * 64 + ht * 16 + 4 * fq) = pack4(O[ht] * inv);
            }
        }
    }
    asm volatile("s_waitcnt vmcnt(0)" ::: "memory"); NA_BAR();
#undef NA_BAR
#undef NA_LOAD_K
#undef NA_LOAD_V
}
__device__ __forceinline__ void glds16_asm(const void* gsrc, unsigned lds_dst) {
    unsigned keep;
    asm volatile("s_mov_b32 %0, m0\n\ts_mov_b32 m0, %2\n\ts_nop 0\n\tglobal_load_lds_dwordx4 %1, off\n\ts_mov_b32 m0, %0" : "=&s"(keep) : "v"(gsrc), "s"(lds_dst) : "memory");
}
__device__ __forceinline__ void phase_na3(const Params& P, int l, LAS unsigned char* lds, int tid, int wave, int lane, int vG, int vbid) {
    const bf16_t* QN = (const bf16_t*)(P.ws + WS_QN); const bf16_t* KN = (const bf16_t*)(P.ws + WS_KN); const bf16_t* VNT = (const bf16_t*)(P.ws + WS_VNT);
    bf16_t* NAO = (bf16_t*)(P.ws + WS_NAO);
    const float* rpb = P.rpb + (size_t)l * 16 * 15 * 31;
    LAS unsigned char* Ks = lds; LAS unsigned char* Vs = lds + 73728;
    const unsigned ks_lds = (unsigned)(uintptr_t)Ks, vs_lds = (unsigned)(uintptr_t)Vs;
    LAS float* bias_s = (LAS float*)(lds + LDS_MISC + LM_BIAS);
    const int fr = lane & 15, fq = lane >> 4;
    const int prow = tid >> 3, pc = (tid & 7) ^ ((prow >> 1) & 7);
    const int grp = wave >> 2, cb = wave & 3, c0 = cb * 16, cs = min(max(c0 - 8, 0), 32), c = c0 + fr, cst = min(max(c - 8, 0), 48);
    int co[2][4]; bool vd[2][4];
#pragma unroll
    for (int t = 0; t < 2; ++t)
#pragma unroll
        for (int j = 0; j < 4; ++j) { const int kc = cs + 8 * fq + 4 * t + j;     vd[t][j] = (kc >= cst) && (kc < cst + 16); co[t][j] = min(max(kc - c + 15, 0), 30); }
#define NA_BAR() do { asm volatile("s_waitcnt lgkmcnt(0)" ::: "memory"); __builtin_amdgcn_s_barrier(); asm volatile("" ::: "memory"); } while (0)
#define NA_LOAD_K(kr) glds16_asm(kbase + ((size_t)((kr) * 64 + prow)) * 2048 + pc * 16, ks_lds + (unsigned)(((kr) % 9) * 8192 + wave * 1024))
#define NA_LOAD_V(kr) glds16_asm(vbase + (size_t)prow * 8192 + (kr) * 128 + pc * 16, vs_lds + (unsigned)(((kr) % 9) * 8192 + wave * 1024))
    for (int bu = launder_si(vbid); bu < 256; bu += vG) {
        const int sg = bu & 3, h = (bu >> 2) & 15, b = bu >> 6;
        const char* kbase = (const char*)(KN + (size_t)b * 4096 * 1024 + h * 64);
        const char* vbase = (const char*)(VNT + ((size_t)b * 1024 + h * 64) * 4096);
        asm volatile("s_waitcnt vmcnt(0)" ::: "memory"); NA_BAR();
        for (int i = tid; i < 465; i += 512) bias_s[i] = ((const GAS float*)rpb)[h * 465 + i] * LOG2E;
        const int r0 = sg * 16;
        { const int lo = min(max(r0 - 4, 0), 56), hi = min(max(r0 - 3, 0), 56) + 7;
#pragma nounroll
          for (int kr = lo; kr <= hi; ++kr) { NA_LOAD_K(kr); NA_LOAD_V(kr); } }
        bf16x8 yq0, yq1;
        { const size_t tq = (size_t)b * 4096 + (r0 + grp) * 64 + c; yq0 = *(const GAS bf16x8*)(QN + tq * 1024 + h * 64 + 8 * fq); yq1 = *(const GAS bf16x8*)(QN + tq * 1024 + h * 64 + 32 + 8 * fq); }
        int boff = -100; f32x4 breg[16]; int nprev = -1;
        asm volatile("" : "+v"(yq0), "+v"(yq1));
#pragma unroll
        for (int kt = 0; kt < 16; ++kt) breg[kt] = (f32x4){0.f, 0.f, 0.f, 0.f};
#pragma nounroll
        for (int st = 0; st < 8; ++st) {
            const int rA = r0 + 2 * st, r = rA + grp, rs = min(max(r - 4, 0), 56);
            const int chi = min(max(rA - 3, 0), 56) + 7, nhi = min(max(rA - 1, 0), 56) + 7;
            const bool more = st < 7;
            if (nprev < 0) asm volatile("s_waitcnt vmcnt(0)" ::: "memory"); else if (nprev == 2) asm volatile("s_waitcnt vmcnt(6)" ::: "memory"); else asm volatile("s_waitcnt vmcnt(5)" ::: "memory");
            NA_BAR();
            const bf16x8 q0 = yq0, q1 = yq1;
            const size_t tq = (size_t)b * 4096 + r * 64 + c;
            if (more) { const size_t tn = tq + 128; yq0 = *(const GAS bf16x8*)(QN + tn * 1024 + h * 64 + 8 * fq); yq1 = *(const GAS bf16x8*)(QN + tn * 1024 + h * 64 + 32 + 8 * fq); }
            const int off = rs - r + 7;
            if (off != boff) {
                boff = off;
#pragma unroll
                for (int kt = 0; kt < 16; ++kt)
#pragma unroll
                    for (int j = 0; j < 4; ++j) { const float bv = bias_s[(off + (kt >> 1)) * 31 + co[kt & 1][j]]; breg[kt][j] = vd[kt & 1][j] ? bv : -INFINITY; }
            }
            f32x4 S[16];
#pragma unroll
            for (int kb = 0; kb < 16; kb += 4) {
                bf16x8 xk[4][2];
#pragma unroll
                for (int q = 0; q < 4; ++q) { const int kt = kb + q;
                    const int kr = rs + (kt >> 1), key = cs + 8 * (fr >> 2) + 4 * (kt & 1) + (fr & 3);
                    const LAS unsigned char* kp = Ks + (kr % 9) * 8192 + key * 128; const int sw = (key >> 1) & 7;
                    xk[q][0] = *(const LAS bf16x8*)(kp + ((fq ^ sw) << 4)); xk[q][1] = *(const LAS bf16x8*)(kp + (((4 + fq) ^ sw) << 4)); }
                __builtin_amdgcn_sched_barrier(0);
#pragma unroll
                for (int q = 0; q < 4; ++q) S[kb + q] = __builtin_amdgcn_mfma_f32_16x16x32_bf16(xk[q][0], q0, breg[kb + q], 0, 0, 0);
#pragma unroll
                for (int q = 0; q < 4; ++q) S[kb + q] = __builtin_amdgcn_mfma_f32_16x16x32_bf16(xk[q][1], q1, S[kb + q], 0, 0, 0);
                __builtin_amdgcn_sched_barrier(0);
            }
            if (more) asm volatile("s_waitcnt vmcnt(6)" ::: "memory"); else asm volatile("s_waitcnt vmcnt(4)" ::: "memory");
            NA_BAR();
            asm volatile("" : "+v"(yq0), "+v"(yq1));
            if (more) {
#pragma nounroll
                for (int kr = chi + 1; kr <= nhi; ++kr) NA_LOAD_K(kr);
            }
            nprev = more ? nhi - chi : 0;
            float mx = -INFINITY;
#pragma unroll
            for (int kt = 0; kt < 16; ++kt)
#pragma unroll
                for (int j = 0; j < 4; ++j) mx = fmaxf(mx, S[kt][j]);
            mx = fmaxf(mx, __shfl_xor(mx, 16)); mx = fmaxf(mx, __shfl_xor(mx, 32));
            float sum = 0.f;
#pragma unroll
            for (int kt = 0; kt < 16; ++kt)
#pragma unroll
                for (int j = 0; j < 4; ++j) { const float p = fast_exp2(S[kt][j] - mx); S[kt][j] = p; sum += p; }
            sum += __shfl_xor(sum, 16); sum += __shfl_xor(sum, 32);
            const float inv = 1.0f / sum;
            f32x4 O[4];
#pragma unroll
            for (int ht = 0; ht < 4; ++ht) O[ht] = (f32x4){0.f, 0.f, 0.f, 0.f};
#pragma unroll
            for (int p = 0; p < 8; ++p) {
                const bf16x8 yp = __builtin_bit_cast(bf16x8, pack8(S[2 * p], S[2 * p + 1]));
                const LAS unsigned char* vrow = Vs + ((rs + p) % 9) * 8192;
                bf16x8 xv[4];
#pragma unroll
                for (int ht = 0; ht < 4; ++ht) {
                    const int ch = ht * 16 + fr, sw = (ch >> 1) & 7, pc0 = (cs >> 3) + fq;
                    xv[ht] = *(const LAS bf16x8*)(vrow + ch * 128 + ((pc0 ^ sw) << 4));
                }
#pragma unroll
                for (int ht = 0; ht < 4; ++ht) O[ht] = __builtin_amdgcn_mfma_f32_16x16x32_bf16(xv[ht], yp, O[ht], 0, 0, 0);
                if (p == 1) {
                    NA_BAR();
                    if (more) {
#pragma nounroll
                        for (int kr = chi + 1; kr <= nhi; ++kr) NA_LOAD_V(kr);
                    }
                }
            }
#pragma unroll
            for (int ht = 0; ht < 4; ++ht) *(GAS u32x2*)(NAO + tq * 1024 + h * 64 + ht * 16 + 4 * fq) = pack4(O[ht] * inv);
        }
    }
    asm volatile("s_waitcnt vmcnt(0)" ::: "memory"); NA_BAR();
#undef NA_BAR
#undef NA_LOAD_K
#undef NA_LOAD_V
}
__device__ __forceinline__ void ln_row(f32x4 (&v)[4], const f32x4 (&g)[4], const f32x4 (&bb)[4]) {
    float s = 0.f;
#pragma unroll
    for (int j = 0; j < 4; ++j) s += (v[j][0] + v[j][1]) + (v[j][2] + v[j][3]);
    const float mean = wave_sum(s) * (1.0f / 1024.0f);
    float q = 0.f;
#pragma unroll
    for (int j = 0; j < 4; ++j) { v[j] = v[j] - mean; q += (v[j][0] * v[j][0] + v[j][1] * v[j][1]) + (v[j][2] * v[j][2] + v[j][3] * v[j][3]); }
    const float rstd = 1.0f / sqrtf(wave_sum(q) * (1.0f / 1024.0f) + 1e-5f);
#pragma unroll
    for (int j = 0; j < 4; ++j) v[j] = v[j] * rstd * g[j] + bb[j];
}
__device__ __forceinline__ void ln_row_stats(f32x4 (&v)[4], const f32x4 (&g)[4], const f32x4 (&bb)[4], float& mean_o, float& rstd_o) {
    float s = 0.f;
#pragma unroll
    for (int j = 0; j < 4; ++j) s += (v[j][0] + v[j][1]) + (v[j][2] + v[j][3]);
    const float mean = wave_sum(s) * (1.0f / 1024.0f);
    float q = 0.f;
#pragma unroll
    for (int j = 0; j < 4; ++j) { v[j] = v[j] - mean; q += (v[j][0] * v[j][0] + v[j][1] * v[j][1]) + (v[j][2] * v[j][2] + v[j][3] * v[j][3]); }
    const float rstd = 1.0f / sqrtf(wave_sum(q) * (1.0f / 1024.0f) + 1e-5f);
#pragma unroll
    for (int j = 0; j < 4; ++j) v[j] = v[j] * rstd * g[j] + bb[j];
    mean_o = mean; rstd_o = rstd;
}
__device__ __forceinline__ void phase_ln_router(const Params& P, int l, LAS unsigned char* lds, int wave, int lane) {
    unsigned char* ws = P.ws;
    const float* PRE = (const float*)(ws + WS_ACAT); bf16_t* X1B = (bf16_t*)(ws + WS_K);
    const bf16_t* WRT = (const bf16_t*)(ws + WS_WRT) + (size_t)l * 65536;
    const float* rgc = (const float*)(ws + WS_RGC) + l * 64;
    LAS float* rstat = (LAS float*)(lds + LDS_MISC + LM_RSTAT);
    int* tok_e = (int*)(ws + WS_TOK); int* tok_rank = tok_e + T * 2; float* tok_w = (float*)(tok_rank + T * 2);
    int* HT = (int*)(ws + WS_HT) + (size_t)l * (T / 64) * 32;
    LAS int* hist = (LAS int*)(lds + LDS_MISC + LM_HIST); LAS int* basee = (LAS int*)(lds + LDS_MISC + LM_BASE); LAS int* rowi = (LAS int*)(lds + LDS_MISC + LM_ROW);
    const int tid = launder_v((int)threadIdx.x);
    const int fr = lane & 15, fq = lane >> 4;
    f32x4 g[4], bb[4];
#pragma unroll
    for (int j = 0; j < 4; ++j) { g[j] = *(const GAS f32x4*)(P.ln_mix_g + l * 1024 + 4 * lane + 256 * j); bb[j] = *(const GAS f32x4*)(P.ln_mix_b + l * 1024 + 4 * lane + 256 * j); }
    if ((int)blockIdx.x < 80) ((GAS int*)(ws + WS_SRC))[(int)blockIdx.x * 512 + tid] = 0;
    for (int chunk = launder_si((int)blockIdx.x); chunk < T / 64; chunk += gridDim.x) {
        if (tid < 32) hist[tid] = 0;
#pragma nounroll
        for (int rr = 0; rr < 8; rr += 8) {
            const int ta = chunk * 64 + wave * 8 + rr;
            f32x4 va[8][4];
#pragma unroll
            for (int k = 0; k < 8; ++k)
#pragma unroll
                for (int j = 0; j < 4; ++j) va[k][j] = *(const GAS f32x4*)(PRE + (size_t)(ta + k) * 1024 + 4 * lane + 256 * j);
            __builtin_amdgcn_sched_barrier(0);
#pragma unroll
            for (int k = 0; k < 8; ++k) {
                float mean, rstd; ln_row_stats(va[k], g, bb, mean, rstd);
                if (lane == 0) { rstat[(wave * 8 + rr + k) * 2] = mean; rstat[(wave * 8 + rr + k) * 2 + 1] = rstd; }
#pragma unroll
                for (int j = 0; j < 4; ++j) *(GAS u32x2*)(X1B + (size_t)(ta + k) * 1024 + 4 * lane + 256 * j) = pack4(va[k][j]);
            }
        }
        VM_WAIT();
        __syncthreads();
        if (wave < 4) {
            const int t0 = chunk * 64 + wave * 16;
            f32x4 acc0 = {0.f, 0.f, 0.f, 0.f}, acc1 = {0.f, 0.f, 0.f, 0.f};
            const float* yp = PRE + (size_t)(t0 + fr) * 1024 + 8 * fq;
            const bf16_t* wp = WRT + (size_t)fr * 1024 + 8 * fq;
#pragma unroll 4
            for (int s = 0; s < 32; ++s) {
                const f32x4 ya = *(const GAS f32x4*)(yp + 32 * s), yb = *(const GAS f32x4*)(yp + 32 * s + 4);
                const bf16x8 w0h = *(const GAS bf16x8*)(wp + 32 * s), w1h = *(const GAS bf16x8*)(wp + 16 * 1024 + 32 * s);
                const bf16x8 w0l = *(const GAS bf16x8*)(wp + 32 * 1024 + 32 * s), w1l = *(const GAS bf16x8*)(wp + 48 * 1024 + 32 * s);
                u32x4 yh; yh.x = cvt_pk_bf16(ya[0], ya[1]); yh.y = cvt_pk_bf16(ya[2], ya[3]); yh.z = cvt_pk_bf16(yb[0], yb[1]); yh.w = cvt_pk_bf16(yb[2], yb[3]);
                u32x4 yl; yl.x = cvt_pk_bf16(ya[0] - bf_lo(yh.x), ya[1] - bf_hi(yh.x)); yl.y = cvt_pk_bf16(ya[2] - bf_lo(yh.y), ya[3] - bf_hi(yh.y));
                yl.z = cvt_pk_bf16(yb[0] - bf_lo(yh.z), yb[1] - bf_hi(yh.z)); yl.w = cvt_pk_bf16(yb[2] - bf_lo(yh.w), yb[3] - bf_hi(yh.w));
                const bf16x8 yhv = __builtin_bit_cast(bf16x8, yh), ylv = __builtin_bit_cast(bf16x8, yl);
                acc0 = __builtin_amdgcn_mfma_f32_16x16x32_bf16(w0h, yhv, acc0, 0, 0, 0); acc1 = __builtin_amdgcn_mfma_f32_16x16x32_bf16(w1h, yhv, acc1, 0, 0, 0);
                acc0 = __builtin_amdgcn_mfma_f32_16x16x32_bf16(w0h, ylv, acc0, 0, 0, 0); acc1 = __builtin_amdgcn_mfma_f32_16x16x32_bf16(w1h, ylv, acc1, 0, 0, 0);
                acc0 = __builtin_amdgcn_mfma_f32_16x16x32_bf16(w0l, yhv, acc0, 0, 0, 0); acc1 = __builtin_amdgcn_mfma_f32_16x16x32_bf16(w1l, yhv, acc1, 0, 0, 0);
            }
            const f32x4 rb0 = *(const GAS f32x4*)(P.router_bias + 4 * fq), rb1 = *(const GAS f32x4*)(P.router_bias + 16 + 4 * fq);
            const f32x4 gw0 = *(const GAS f32x4*)(rgc + 4 * fq), gw1 = *(const GAS f32x4*)(rgc + 16 + 4 * fq), cc0 = *(const GAS f32x4*)(rgc + 32 + 4 * fq), cc1 = *(const GAS f32x4*)(rgc + 48 + 4 * fq);
            const float rmean = rstat[(wave * 16 + fr) * 2], rrstd = rstat[(wave * 16 + fr) * 2 + 1];
            f32x4 sc0, sc1, se0, se1;
#pragma unroll
            for (int j = 0; j < 4; ++j) { const float l0 = rrstd * (acc0[j] - rmean * gw0[j]) + cc0[j], l1 = rrstd * (acc1[j] - rmean * gw1[j]) + cc1[j];
                sc0[j] = 1.0f / (1.0f + expf(-l0)); sc1[j] = 1.0f / (1.0f + expf(-l1)); se0[j] = sc0[j] + rb0[j]; se1[j] = sc1[j] + rb1[j]; }
            float gs0, gs1;
            { const float a = fmaxf(se0[0], se0[1]), b2 = fminf(se0[0], se0[1]), c = fmaxf(se0[2], se0[3]), d2 = fminf(se0[2], se0[3]); gs0 = fmaxf(a, c) + fmaxf(fminf(a, c), fmaxf(b2, d2)); }
            { const float a = fmaxf(se1[0], se1[1]), b2 = fminf(se1[0], se1[1]), c = fmaxf(se1[2], se1[3]), d2 = fminf(se1[2], se1[3]); gs1 = fmaxf(a, c) + fmaxf(fminf(a, c), fmaxf(b2, d2)); }
            float bs = gs0; int bg = fq;
            if (gs1 > gs0) { bs = gs1; bg = 4 + fq; }
#pragma unroll
            for (int o = 16; o < 64; o <<= 1) { const float os = __shfl_xor(bs, o); const int og = __shfl_xor(bg, o); if (os > bs || (os == bs && og < bg)) { bs = os; bg = og; } }
            if ((bg & 3) == fq) {
                const bool hi = bg >= 4;
                const float u0 = hi ? se1[0] : se0[0], u1 = hi ? se1[1] : se0[1], u2 = hi ? se1[2] : se0[2], u3 = hi ? se1[3] : se0[3];
                const float p0 = hi ? sc1[0] : sc0[0], p1 = hi ? sc1[1] : sc0[1], p2 = hi ? sc1[2] : sc0[2], p3 = hi ? sc1[3] : sc0[3];
                int i1 = 0; float t1 = u0;
                if (u1 > t1) { t1 = u1; i1 = 1; } if (u2 > t1) { t1 = u2; i1 = 2; } if (u3 > t1) { t1 = u3; i1 = 3; }
                int i2 = -1; float t2 = -INFINITY;
                if (i1 != 0 && u0 > t2) { t2 = u0; i2 = 0; } if (i1 != 1 && u1 > t2) { t2 = u1; i2 = 1; } if (i1 != 2 && u2 > t2) { t2 = u2; i2 = 2; } if (i1 != 3 && u3 > t2) { t2 = u3; i2 = 3; }
                if (i2 < 0) i2 = (i1 + 1) & 3;
                const float s1 = i1 == 0 ? p0 : i1 == 1 ? p1 : i1 == 2 ? p2 : p3, s2 = i2 == 0 ? p0 : i2 == 1 ? p1 : i2 == 2 ? p2 : p3, inv = 1.0f / (s1 + s2);
                const int e1 = 4 * bg + i1, e2 = 4 * bg + i2;
                const int r1 = __hip_atomic_fetch_add(hist + e1, 1, __ATOMIC_RELAXED, __HIP_MEMORY_SCOPE_WORKGROUP);
                const int r2 = __hip_atomic_fetch_add(hist + e2, 1, __ATOMIC_RELAXED, __HIP_MEMORY_SCOPE_WORKGROUP);
                const int q = wave * 16 + fr;
                rowi[q] = e1; rowi[64 + q] = e2; rowi[128 + q] = r1; rowi[192 + q] = r2; rowi[256 + q] = __float_as_int(s1 * inv); rowi[320 + q] = __float_as_int(s2 * inv);
            }
        }
        __syncthreads();
        if (tid < 32) HT[chunk * 32 + tid] = hist[tid];
        if (tid < 64) {
            const int t = chunk * 64 + tid, e1 = rowi[tid], e2 = rowi[64 + tid];
            tok_e[2 * t] = e1; tok_e[2 * t + 1] = e2;
            tok_rank[2 * t] = rowi[128 + tid]; tok_rank[2 * t + 1] = rowi[192 + tid];
            tok_w[2 * t] = __int_as_float(rowi[256 + tid]); tok_w[2 * t + 1] = __int_as_float(rowi[320 + tid]);
        }
        __syncthreads();
    }
}
constexpr int LM_BASES = 3584;
constexpr int LM_GSRC = 8192;
__device__ __forceinline__ void build_tiles(const Params& P, int l, LAS unsigned char* lds, int mychunk) {
    const int* HT = (const int*)(P.ws + WS_HT) + (size_t)l * (T / 64) * 32;
    LAS int* tstart = (LAS int*)(lds + LDS_MISC + LM_TSTART); LAS int* tile_e = (LAS int*)(lds + LDS_MISC + LM_TILEE); LAS int* ntp = (LAS int*)(lds + LDS_MISC + LM_NT);
    LAS int* bases = (LAS int*)(lds + LDS_MISC + LM_BASES);
    LAS int* part = (LAS int*)lds;
    const int tid = launder_v((int)threadIdx.x), e = tid & 31, seg = tid >> 5;
    __syncthreads();
    { int tot = 0, bas = 0;
#pragma unroll
      for (int i = 0; i < 16; ++i) { const int c = seg * 16 + i, v = ((const GAS int*)HT)[c * 32 + e]; tot += v; bas += (c < mychunk) ? v : 0; }
      part[seg * 32 + e] = tot; part[512 + seg * 32 + e] = bas; }
    __syncthreads();
    if (tid < 32) { int tot = 0, bas = 0;
#pragma unroll
        for (int s = 0; s < 16; ++s) { tot += part[s * 32 + tid]; bas += part[512 + s * 32 + tid]; }
        bases[tid] = bas;
        const int nte = (tot + 255) >> 8; int v = nte;
#pragma unroll
        for (int o = 1; o < 32; o <<= 1) { const int u = __shfl_up(v, o); if (tid >= o) v += u; }
        tstart[tid] = v - nte; if (tid == 31) { tstart[32] = v; ntp[0] = v < 160 ? v : 160; } }
    __syncthreads();
    if (tid < 192) { int q = 0;
#pragma unroll
        for (int j = 1; j < 32; ++j) q += (tid >= tstart[j]) ? 1 : 0;
        if (tid < tstart[32]) tile_e[tid] = q; }
    __syncthreads();
}
__device__ __forceinline__ void phase_gather(const Params& P, int l, LAS unsigned char* lds, int wave, int lane) {
    unsigned char* ws = P.ws;
    const int* tok_e = (const int*)(ws + WS_TOK); const int* tok_rank = tok_e + T * 2; int* tok_dest = (int*)(ws + WS_TOK) + T * 6; int* srcmap = (int*)(ws + WS_SRC);
    const LAS int* tstart = (const LAS int*)(lds + LDS_MISC + LM_TSTART); const LAS int* bases = (const LAS int*)(lds + LDS_MISC + LM_BASES);
    const int tid = launder_v((int)threadIdx.x);
    for (int chunk = launder_si((int)blockIdx.x); chunk < T / 64; chunk += gridDim.x) {
        build_tiles(P, l, lds, chunk);
        if (tid < 128) { const int pr = chunk * 128 + tid, ex = ((const GAS int*)tok_e)[pr];
            const int dest = tstart[ex] * 256 + bases[ex] + ((const GAS int*)tok_rank)[pr];
            ((GAS int*)tok_dest)[pr] = dest; ((GAS int*)srcmap)[dest] = pr >> 1; }
    }
}
__device__ __forceinline__ void phase_combine(const Params& P, int l, int gw, int NGW, int lane) {
    unsigned char* ws = P.ws;
    const bf16_t* X1B = (const bf16_t*)(ws + WS_K); const bf16_t* Y = (const bf16_t*)(ws + WS_BCAT + 40 * MiB);
    const float* tok_w = (const float*)(ws + WS_TOK) + T * 4; const int* tok_dest = (const int*)(ws + WS_TOK) + T * 6;
    bf16_t* xb = (bf16_t*)(ws + WS_XB);
    f32x4 g[4], bb[4];
#pragma unroll
    for (int j = 0; j < 4; ++j) { g[j] = *(const GAS f32x4*)(P.ln_ffn_g + l * 1024 + 4 * lane + 256 * j); bb[j] = *(const GAS f32x4*)(P.ln_ffn_b + l * 1024 + 4 * lane + 256 * j); }
    for (int tb = gw; tb < T; tb += 4 * NGW) {
        u32x2 x1[4][4], y0[4][4], y1[4][4]; float w0[4], w1[4];
#pragma unroll
        for (int k = 0; k < 4; ++k) { const int t = tb + k * NGW; if (t < T) {
            const int d0 = tok_dest[2 * t], d1 = tok_dest[2 * t + 1]; w0[k] = tok_w[2 * t]; w1[k] = tok_w[2 * t + 1];
#pragma unroll
            for (int j = 0; j < 4; ++j) { x1[k][j] = *(const GAS u32x2*)(X1B + (size_t)t * 1024 + 4 * lane + 256 * j);
                y0[k][j] = *(const GAS u32x2*)(Y + (size_t)d0 * 1024 + 4 * lane + 256 * j); y1[k][j] = *(const GAS u32x2*)(Y + (size_t)d1 * 1024 + 4 * lane + 256 * j); } } }
#pragma unroll
        for (int k = 0; k < 4; ++k) { const int t = tb + k * NGW; if (t >= T) break;
            f32x4 v[4];
#pragma unroll
            for (int j = 0; j < 4; ++j) {
                v[j][0] = bf_lo(x1[k][j].x) * ALPHA + w0[k] * bf_lo(y0[k][j].x) + w1[k] * bf_lo(y1[k][j].x); v[j][1] = bf_hi(x1[k][j].x) * ALPHA + w0[k] * bf_hi(y0[k][j].x) + w1[k] * bf_hi(y1[k][j].x);
                v[j][2] = bf_lo(x1[k][j].y) * ALPHA + w0[k] * bf_lo(y0[k][j].y) + w1[k] * bf_lo(y1[k][j].y); v[j][3] = bf_hi(x1[k][j].y) * ALPHA + w0[k] * bf_hi(y0[k][j].y) + w1[k] * bf_hi(y1[k][j].y);
            }
            ln_row(v, g, bb);
#pragma unroll
            for (int j = 0; j < 4; ++j) { if (l == DEPTH - 1) *(GAS f32x4*)(P.out + (size_t)t * 1024 + 4 * lane + 256 * j) = v[j]; else *(GAS u32x2*)(xb + (size_t)t * 1024 + 4 * lane + 256 * j) = pack4(v[j]); }
        }
    }
}

#ifndef PROBE_BAR
#define PROBE_BAR 0
#endif
#ifndef PROBE_K1
#define PROBE_K1 0
#endif
#define K1_BODY() do { \
            if (bid < 64) { \
                DecR2c dec{(const char*)(ws + WS_BCAT), (const char*)(ws + WS_KDT)}; EpiR2c E{(bf16_t*)(ws + WS_BCAT), decay}; \
                REP(2) pg::gemm_phase<1, true, 1, true, false, 16>(lds, 512, 1024, 512, 448, dec, E, 64, bid); \
                  \
            } else if (bid < 128) { \
                REP(3) phase_na3(PP, l, lds, tid, wave, lane, 192, bid - 64); \
                { const int pa = l == 0 ? 80 : 44, pb2 = l == 0 ? 96 : 52; convert_range(PP, 1, l, lds, 128 * pa + (bid - 64) * pb2, 128 * pa + (bid - 64) * pb2 + pb2, wave, lane); } \
                if (DEFER_SILU) { __syncthreads(); DecInProjD dec{(const char*)(ws + WS_XB), (const char*)(ws + ws_wset(l) + WO_WIN), 1}; EpiInProj E{ws, decay}; \
                  pg::gemm_phase<1, false, 1, false, false, 16>(lds, 1024, 1024, 1024, 128, dec, E, 64, bid - 64); } \
            } else { \
                { const int pa = l == 0 ? 80 : 44; convert_range(PP, 1, l, lds, (bid - 128) * pa, (bid - 128) * pa + pa, wave, lane); } \
                __syncthreads(); \
                { DecR1 dec{(const char*)(ws + WS_Q), (const char*)(ws + WS_K), 128}; EpiR1 E{(bf16_t*)(ws + WS_ACAT), decay}; \
                  REP(1) pg::gemm_phase<1, false, 1, false, false, 16>(lds, 256, 1024, 1024, 512, dec, E, 128, bid - 128); } \
                if (DEFER_SILU) { DecInProjD dec{(const char*)(ws + WS_XB), (const char*)(ws + ws_wset(l) + WO_WIN), 0}; EpiInProj E{ws, decay}; \
                  pg::gemm_phase<1, false, 1, false, false, 16>(lds, 1024, 1024, 1024, 128, dec, E, 128, bid - 128); } \
                REP(3) phase_na3(PP, l, lds, tid, wave, lane, 192, bid - 64); \
            } \
            } while (0)
__global__ void __launch_bounds__(512, 2) fwd_kernel(Params P) {
    extern __shared__ __attribute__((aligned(16))) unsigned char lds_raw[];
    LAS unsigned char* lds = (LAS unsigned char*)lds_raw;
    const int NGW = gridDim.x * 8;
    for (int u = threadIdx.x; u < (LDS_BYTES - LDS_MISC) / 4; u += 512) ((LAS unsigned*)(lds + LDS_MISC))[u] = 0u;
#define PHASE_CTX() const Params PP = load_params(); unsigned char* ws = PP.ws; const int tid = launder_v((int)threadIdx.x), lane = tid & 63, wave = __builtin_amdgcn_readfirstlane(tid >> 6), gw = launder_si((int)blockIdx.x) * 8 + wave; (void)ws; (void)lane; (void)gw
    __syncthreads();
#if MK_ONE_LAUNCH
    XcdBarrier bar = xcd_barrier_post((unsigned*)(P.ws + WS_CTL) + CW_BAR, (volatile LAS unsigned*)(lds + LDS_MISC + LM_BAR));
#define GRID_BAR() xcd_barrier(bar)
#else
#define GRID_BAR() do { } while (0)
#endif
    const int lo = P.ph_lo, hi = P.ph_hi;
#define IN(k) (lo <= (k) && (k) < hi)
#define SEAM(k) do { if (IN(k) && IN((k) + 1)) GRID_BAR(); } while (0)
#ifndef PROBE_MASK
#define PROBE_MASK 0
#endif
#define REP(b) for (int rep_ = 0; rep_ < (((PROBE_MASK) >> (b)) & 1) + 1; ++rep_)

    if (IN(0)) { PHASE_CTX(); phase_init(PP, lds, gw, NGW, wave, lane); SEAM(0); }

    for (int l = 0; l < DEPTH; ++l) {
        const int pb = 1 + l * 12;
        if (IN(pb + 0)) { PHASE_CTX(); const float* decay = PP.decay + l * 8; (void)decay;
            DecInProj dec{(const char*)(ws + WS_XB), (const char*)(ws + ws_wset(l) + WO_WIN)};
            EpiInProj E{ws, decay};
#if STAGGER_TICKS > 0
            { const unsigned long long t0 = __builtin_amdgcn_s_memrealtime(); const unsigned dl = ((blockIdx.x >> 3) & 7) * STAGGER_TICKS;
              while (__builtin_amdgcn_s_memrealtime() - t0 < dl) __builtin_amdgcn_s_sleep(8); }
#endif
            REP(0) pg::gemm_phase<1 + PROBE_EPI2, false, 1 + PROBE_K2, false, false, 16>(lds, 1024, 1024, 1024, DEFER_SILU ? 2560 : 2816, dec, E, (int)gridDim.x, (int)blockIdx.x);
            SEAM(pb + 0);
        }
        if (IN(pb + 1)) { PHASE_CTX(); const float* decay = PP.decay + l * 8; (void)decay;
            const int bid = launder_si((int)blockIdx.x);
            K1_BODY();
#if PROBE_K1
            __syncthreads(); K1_BODY();
#endif
            SEAM(pb + 1);
        }
        if (IN(pb + 3)) { PHASE_CTX(); const float* decay = PP.decay + l * 8; (void)decay;
            DecR4 dec{(const char*)(ws + WS_ACAT), (const char*)(ws + WS_BCAT), (int)gridDim.x}; EpiR4f E{ws, lds};
            REP(5) pg::gemm_phase<1, false, 1, false, false, 16>(lds, 1024, 4096, 1024, 512, dec, E, 256, (int)blockIdx.x);
            if (blockIdx.x < 256) { const int p = DecR4::panel_of((int)blockIdx.x), pm2 = p & 1, cc = (p >> 1) & 7, bh = p >> 4;
              REP(6) headnorm_half0(PP, lds, (bh >> 2) * 4096 + cc * 512 + pm2 * 256, bh & 3, wave, lane); }
            SEAM(pb + 3);
        }
        if (IN(pb + 5)) { PHASE_CTX(); const float* decay = PP.decay + l * 8; (void)decay;
            REP(7) {
            { DecDense dec{(const char*)(ws + WS_KDT), (const char*)(ws + ws_wset(l) + WO_WRET), 2048 * 2, 2048 * 2}; EpiMerge<0> E{(bf16_t*)(ws + WS_Q), (const bf16_t*)(ws + WS_G)};
              pg::gemm_phase(lds, 2048, 2048, 2048, 256, dec, E, (int)gridDim.x, (int)blockIdx.x); }
            { DecDense dec{(const char*)(ws + WS_NAO), (const char*)(ws + ws_wset(l) + WO_WNA), 1024 * 2, 1024 * 2}; EpiMerge<1> E{(bf16_t*)(ws + WS_Q), (const bf16_t*)(ws + WS_G)};
              pg::gemm_phase(lds, 1024, 1024, 1024, 256, dec, E, (int)gridDim.x, (int)blockIdx.x); }
            }
            SEAM(pb + 5);
        }
        if (IN(pb + 6)) { PHASE_CTX(); const float* decay = PP.decay + l * 8; (void)decay;
            DecDense dec{(const char*)(ws + WS_Q), (const char*)(ws + ws_wset(l) + WO_WOUT), 1024 * 2, 1024 * 2}; EpiPre E{(float*)(ws + WS_ACAT), (const bf16_t*)(ws + WS_XB)};
            REP(8) pg::gemm_phase<1 + PROBE_EPI6>(lds, 1024, 1024, 1024, 256, dec, E, (int)gridDim.x, (int)blockIdx.x);
            SEAM(pb + 6);
#if PROBE_BAR
            SEAM(pb + 6); SEAM(pb + 6); SEAM(pb + 6); SEAM(pb + 6);
#endif
        }
        if (IN(pb + 7)) { PHASE_CTX(); const float* decay = PP.decay + l * 8; (void)decay; phase_ln_router(PP, l, lds, wave, lane); SEAM(pb + 7); }
        if (IN(pb + 8)) { PHASE_CTX(); const float* decay = PP.decay + l * 8; (void)decay; REP(9) phase_gather(PP, l, lds, wave, lane); SEAM(pb + 8); }
        if (IN(pb + 9)) { PHASE_CTX(); const float* decay = PP.decay + l * 8; (void)decay;
            if (!IN(pb + 8)) build_tiles(PP, l, lds, -1);
            const int nt = *(const LAS int*)(lds + LDS_MISC + LM_NT);
            int vG = (int)gridDim.x; { const int nu = nt * 4, rounds = (nu + vG - 1) / vG; if (rounds > 0) { int v = ((nu + rounds - 1) / rounds + 7) & ~7; if (v < vG) vG = v; } }
            LAS int* gsrc = (LAS int*)(lds + LDS_MISC + LM_GSRC);
            if ((int)blockIdx.x < vG && tid < 256) {
#pragma unroll
                for (int j = 0; j < 3; ++j) { const int u0 = (int)blockIdx.x + j * vG; if (u0 < nt * 4) { const int a = xcd_perm(u0, vG, nt * 4) >> 2; gsrc[j * 256 + tid] = ((const GAS int*)(ws + WS_SRC))[a * 256 + tid]; } }
            }
            __syncthreads();
            DecMoe dec{(const char*)(ws + WS_K), (const char*)(ws + ws_wset(l) + WO_WGU), 0, 1024 * 1024 * 2, 1024 * 2, (const LAS int*)(lds + LDS_MISC + LM_TILEE), vG, nt * 4}; EpiUp E{(bf16_t*)(ws + WS_BCAT)};
            REP(10) pg::gemm_phase<1, false, 1, false, true, 8>(lds, 1024, 1024, 1024, nt * 4, dec, E, vG, (int)blockIdx.x < vG ? (int)blockIdx.x : -1, gsrc);
            { const int G_ = (int)gridDim.x, bid = (int)blockIdx.x;
              convert_share(PP, 2, l, lds, 0, cv_slot_items(2, l), G_ - vG, bid >= vG ? bid - vG : -1, 215, G_, bid, wave, lane); }
            SEAM(pb + 9);
        }
        if (IN(pb + 10)) { PHASE_CTX(); const float* decay = PP.decay + l * 8; (void)decay;
            if (!IN(pb + 8)) build_tiles(PP, l, lds, -1);
            const int nt = *(const LAS int*)(lds + LDS_MISC + LM_NT);
            int vG = (int)gridDim.x; if (l + 1 < DEPTH) { const int nu = nt * 4, rounds = (nu + vG - 1) / vG; if (rounds > 0) { int v = ((nu + rounds - 1) / rounds + 7) & ~7; if (v < vG) vG = v; } }
            DecMoe dec{(const char*)(ws + WS_BCAT), (const char*)(ws + ws_wset(l) + WO_WD), 512 * 2, 1024 * 512 * 2, 512 * 2, (const LAS int*)(lds + LDS_MISC + LM_TILEE), vG, nt * 4}; EpiDown E{(bf16_t*)(ws + WS_BCAT + 40 * MiB)};
            REP(11) pg::gemm_phase<1, false, 1, false, false, 16>(lds, 512, 512, 512, nt * 4, dec, E, vG, (int)blockIdx.x < vG ? (int)blockIdx.x : -1);
            if (l + 1 < DEPTH) { const int G_ = (int)gridDim.x, bid = (int)blockIdx.x;
              convert_share(PP, 3, l, lds, 0, cv_slot_items(3, l), G_ - vG, bid >= vG ? bid - vG : -1, 135, G_, bid, wave, lane); }
            SEAM(pb + 10);
        }
        if (IN(pb + 11)) { PHASE_CTX(); const float* decay = PP.decay + l * 8; (void)decay;
            REP(12) phase_combine(PP, l, gw, NGW, lane);
            SEAM(pb + 11);
        }
    }
#undef IN
#undef SEAM
}

extern "C" void kernel_launch(void* const* d_in, const int* in_sizes, int n_in, void* d_out, int out_size, void* d_ws, size_t ws_size, hipStream_t stream) {
    static int grid = 0;
    if (grid == 0) {
        if (n_in != 16 || in_sizes[0] != T * D || out_size != T * D || ws_size < WS_END) {
            fprintf(stderr, "kernel_launch: unexpected shapes / workspace (n_in %d, in0 %d, out %d, ws %zu < %zu); nothing launched\n", n_in, n_in > 0 ? in_sizes[0] : -1, out_size, ws_size, (size_t)WS_END); grid = -1; return; }
        int dev = 0, cus = 0, per_cu = 0;
        if (hipGetDevice(&dev) != hipSuccess || hipDeviceGetAttribute(&cus, hipDeviceAttributeMultiprocessorCount, dev) != hipSuccess) { grid = -1; return; }
        if (hipFuncSetAttribute((const void*)fwd_kernel, hipFuncAttributeMaxDynamicSharedMemorySize, LDS_BYTES) != hipSuccess) { fprintf(stderr, "kernel_launch: hipFuncSetAttribute failed\n"); grid = -1; return; }
        if (hipOccupancyMaxActiveBlocksPerMultiprocessor(&per_cu, (const void*)fwd_kernel, 512, LDS_BYTES) != hipSuccess || per_cu < 1)
            fprintf(stderr, "kernel_launch: occupancy query reports %d workgroups per CU\n", per_cu);
        (void)hipGetLastError();
        if (cus != 256) { fprintf(stderr, "kernel_launch: built for a 256-CU device (static phase partitions), found %d CUs; nothing launched\n", cus); grid = -1; return; }
        grid = cus;
    }
    if (grid < 0) return;
    if (hipMemsetAsync((char*)d_ws + WS_CTL, 0, CTL_ZERO_BYTES, stream) != hipSuccess) return;
    Params p{};
    p.x = (const float*)d_in[0]; p.w_in = (const float*)d_in[1]; p.decay = (const float*)d_in[2]; p.w_ret_o = (const float*)d_in[3]; p.rpb = (const float*)d_in[4];
    p.w_na_o = (const float*)d_in[5]; p.w_out = (const float*)d_in[6]; p.ln_mix_g = (const float*)d_in[7]; p.ln_mix_b = (const float*)d_in[8];
    p.router_w = (const float*)d_in[9]; p.router_bias = (const float*)d_in[10]; p.w_gate = (const float*)d_in[11]; p.w_up = (const float*)d_in[12]; p.w_down = (const float*)d_in[13];
    p.ln_ffn_g = (const float*)d_in[14]; p.ln_ffn_b = (const float*)d_in[15];
    p.out = (float*)d_out; p.ws = (unsigned char*)d_ws;
#if MK_ONE_LAUNCH
    p.ph_lo = 0; p.ph_hi = NPH;
    hipLaunchKernelGGL(fwd_kernel, dim3(grid), dim3(512), LDS_BYTES, stream, p);
#else
    for (int ph = 0; ph < NPH; ++ph) { p.ph_lo = ph; p.ph_hi = ph + 1; hipLaunchKernelGGL(fwd_kernel, dim3(grid), dim3(512), LDS_BYTES, stream, p); }
#endif
}
```

```cpp
#include <hip/hip_runtime.h>
#include <cstdio>
#include <cstdint>

#ifndef STAGGER_TICKS
#define STAGGER_TICKS 0
#endif
#ifndef PROBE_K2
#define PROBE_K2 0
#endif
#ifndef PROBE_EPI6
#define PROBE_EPI6 0
#endif
#ifndef PROBE_EPIKIND
#define PROBE_EPIKIND -1
#endif
#ifndef PROBE_EPI2
#define PROBE_EPI2 0
#endif
#ifndef DEFER_SILU
#define DEFER_SILU 1
#endif
#ifndef MK_ONE_LAUNCH
#define MK_ONE_LAUNCH 1
#endif

#define LAS __attribute__((address_space(3)))
#define GAS __attribute__((address_space(1)))
typedef unsigned short bf16_t;
typedef short bf16x8 __attribute__((ext_vector_type(8)));
typedef float f32x4 __attribute__((ext_vector_type(4)));
typedef float f32x2 __attribute__((ext_vector_type(2)));
typedef unsigned u32x4 __attribute__((ext_vector_type(4)));
typedef unsigned u32x2 __attribute__((ext_vector_type(2)));

constexpr int D = 1024, BATCH = 4, SEQ = 4096, T = BATCH * SEQ, DEPTH = 4;
constexpr int DIN = 11264;
constexpr int NE = 32;
constexpr int NPH = 1 + DEPTH * 12;
constexpr float ALPHA = 1.681792830507429f;
constexpr float LOG2E = 1.4426950408889634f;

constexpr size_t MiB = 1u << 20;
constexpr size_t WS_CTL = 0, CTL_ZERO_BYTES = 1 * MiB;
constexpr size_t WS_PL = 618 * MiB;
constexpr size_t WS_PS = 626 * MiB;
constexpr size_t WS_SRC = 10 * MiB + 640 * 1024;
constexpr size_t WS_TAB = 2 * MiB;
constexpr size_t WS_TOK = 10 * MiB;
constexpr size_t WS_HT = 10 * MiB + 512 * 1024;
constexpr size_t WS_WRT = 11 * MiB;
constexpr size_t WS_RGC = 11 * MiB + 512 * 1024;
constexpr size_t WS_W0 = 12 * MiB;
constexpr size_t WO_WIN = 0;
constexpr size_t WO_WRET = 22 * MiB;
constexpr size_t WO_WNA = 26 * MiB;
constexpr size_t WO_WOUT = 28 * MiB;
constexpr size_t WO_WGU = 30 * MiB;
constexpr size_t WO_WD = 94 * MiB;
constexpr size_t WS_XB = 138 * MiB;
constexpr size_t WS_Q = 170 * MiB;
constexpr size_t WS_K = 202 * MiB;
constexpr size_t WS_ACAT = 234 * MiB;
constexpr size_t WS_BCAT = 362 * MiB;
constexpr size_t WS_KDT = 490 * MiB;
constexpr size_t WS_KV = 554 * MiB;
constexpr size_t WS_SG = 634 * MiB;
constexpr size_t WS_QN = 698 * MiB;
constexpr size_t WS_KN = 730 * MiB;
constexpr size_t WS_VNT = 762 * MiB;
constexpr size_t WS_G = 794 * MiB;
constexpr size_t WS_NAO = 858 * MiB;
constexpr size_t WS_W1 = 890 * MiB;
constexpr size_t WS_END = 1016 * MiB;
__host__ __device__ __forceinline__ constexpr size_t ws_wset(int l) { return (l & 1) ? WS_W1 : WS_W0; }
constexpr int CW_BAR = 4096;
constexpr int CW_CNT = 16384;

constexpr int LDS_STAGE = 131072;
constexpr int LDS_MISC = 147456;
constexpr int LM_BAR = 0;
constexpr int LM_HIST = 64;
constexpr int LM_BASE = 192;
constexpr int LM_ROW = 512;
constexpr int LM_NT = 2048;
constexpr int LM_TSTART = 2112;
constexpr int LM_TILEE = 2304;
constexpr int LM_RSTAT = 3072;
constexpr int LDS_BYTES = 163840;

#define LDS_WAIT() asm volatile("s_waitcnt lgkmcnt(0)" ::: "memory")
#define VM_WAIT() asm volatile("s_waitcnt vmcnt(0)" ::: "memory")
__device__ __forceinline__ unsigned cvt_pk_bf16(float lo, float hi) { unsigned r; asm("v_cvt_pk_bf16_f32 %0, %1, %2" : "=v"(r) : "v"(lo), "v"(hi)); return r; }
__device__ __forceinline__ u32x4 pack8(const f32x4 a, const f32x4 b) { u32x4 w; w.x = cvt_pk_bf16(a[0], a[1]); w.y = cvt_pk_bf16(a[2], a[3]); w.z = cvt_pk_bf16(b[0], b[1]); w.w = cvt_pk_bf16(b[2], b[3]); return w; }
__device__ __forceinline__ u32x2 pack4(const f32x4 a) { u32x2 w; w.x = cvt_pk_bf16(a[0], a[1]); w.y = cvt_pk_bf16(a[2], a[3]); return w; }
#ifndef NT_STORES
#define NT_STORES 0
#endif
#if NT_STORES
#define NT16(p, v) __builtin_nontemporal_store((v), (GAS u32x4*)(p))
#else
#define NT16(p, v) (*(GAS u32x4*)(p) = (v))
#endif
__device__ __forceinline__ float bf_lo(unsigned u) { return __uint_as_float(u << 16); }
__device__ __forceinline__ float bf_hi(unsigned u) { return __uint_as_float(u & 0xffff0000u); }
__device__ __forceinline__ float wave_sum(float v) {
#pragma unroll
    for (int o = 1; o < 64; o <<= 1) v += __shfl_xor(v, o);
    return v;
}
template <class Tp> __device__ __forceinline__ Tp* launder_s(Tp* p) { asm volatile("" : "+s"(p)); return p; }
__device__ __forceinline__ int launder_v(int v) { asm volatile("" : "+v"(v)); return v; }
__device__ __forceinline__ int launder_si(int v) { asm volatile("" : "+s"(v)); return v; }
__device__ __forceinline__ float fast_exp2(float x) { return __builtin_amdgcn_exp2f(x); }
__device__ __forceinline__ float fast_rcp(float x) { return __builtin_amdgcn_rcpf(x); }
__device__ __forceinline__ float sigmoid_f(float v) { return fast_rcp(1.0f + fast_exp2(-v * LOG2E)); }
__device__ __forceinline__ float log2_sigmoid(float x) { return -log1pf(expf(-x)) * LOG2E; }

#define XB_TMO      128
#define XB_XCNT(j)  (256  + 64 * (j))
#define XB_XSUB(j)  (1280 + 64 * (j))
#define XB_XGEN(j)  (2304 + 64 * (j))
#define XB_TOP      3328
#define XB_TOPGEN   3392
#define XCD_BAR_WORDS 3456
#define XB_SPIN_CAP (1u << 18)

__device__ __forceinline__ unsigned xb_ld(unsigned* p)              { return __hip_atomic_load(p, __ATOMIC_RELAXED, __HIP_MEMORY_SCOPE_AGENT); }
__device__ __forceinline__ unsigned xb_add(unsigned* p, unsigned v) { return __hip_atomic_fetch_add(p, v, __ATOMIC_RELAXED, __HIP_MEMORY_SCOPE_AGENT); }
__device__ __forceinline__ unsigned xb_xcc_id() { return (unsigned)__builtin_amdgcn_s_getreg((3 << 11) | 20) & 0xFu; }
#define XB_SPIN(cond, bar) do { unsigned _sp = 0; while (cond) { __builtin_amdgcn_s_sleep(1); \
    if ((++_sp & 255u) == 0u) { if (xb_ld(&(bar)[XB_TMO])) break; if (_sp > XB_SPIN_CAP) { atomicAdd(&(bar)[XB_TMO], 1u); break; } } } } while (0)

struct XcdBarrier {
    unsigned* bar; unsigned x;
    volatile LAS unsigned* st;
};
__device__ __forceinline__ XcdBarrier xcd_barrier_post(unsigned* bar, volatile LAS unsigned* st) {
    XcdBarrier b; b.bar = bar; b.x = xb_xcc_id(); b.st = st;
    if (threadIdx.x == 0) (void)xb_add(&bar[XB_XCNT(b.x)], 1u);
    return b;
}
__device__ __forceinline__ void xcd_barrier_complete(unsigned* bar, unsigned x, unsigned& nloc, unsigned& nx) {
    const unsigned G = gridDim.x * gridDim.y * gridDim.z;
    unsigned sum, cnt, mine, sp = 0u;
    for (;;) {
        sum = 0u; cnt = 0u; mine = 0u;
#pragma unroll
        for (unsigned j = 0; j < 16; ++j) { const unsigned c = xb_ld(&bar[XB_XCNT(j)]); sum += c; cnt += (c > 0u) ? 1u : 0u; mine = (j == x) ? c : mine; }
        if (sum == G) break;
        __builtin_amdgcn_s_sleep(1);
        if ((++sp & 255u) == 0u) { if (xb_ld(&bar[XB_TMO])) break; if (sp > XB_SPIN_CAP) { atomicAdd(&bar[XB_TMO], 1u); break; } }
    }
    nloc = mine > 0u ? mine : 1u; nx = cnt > 0u ? cnt : 1u;
}
__device__ __forceinline__ void xcd_barrier(const XcdBarrier& b) {
    asm volatile("s_waitcnt vmcnt(0)" ::: "memory");
    __syncthreads();
    if (threadIdx.x == 0) {
        unsigned* bar = b.bar;
        __builtin_amdgcn_s_waitcnt(0);
        unsigned nloc = b.st[0], nx = b.st[1];
        if (nloc == 0u) { xcd_barrier_complete(bar, b.x, nloc, nx); b.st[0] = nloc; b.st[1] = nx; }
        const unsigned old = xb_add(&bar[XB_XSUB(b.x)], 1u);
        const unsigned gen = old / nloc;
        if (old + 1u == (gen + 1u) * nloc) {
            __builtin_amdgcn_fence(__ATOMIC_RELEASE, "agent");
            asm volatile("s_waitcnt vmcnt(0)" ::: "memory");
            const unsigned og = xb_add(&bar[XB_TOP], 1u);
            const unsigned tg = og / nx;
            if (og + 1u == (tg + 1u) * nx) xb_add(&bar[XB_TOPGEN], 1u);
            else XB_SPIN(xb_ld(&bar[XB_TOPGEN]) == tg, bar);
            __builtin_amdgcn_fence(__ATOMIC_ACQUIRE, "agent");
            xb_add(&bar[XB_XGEN(b.x)], 1u);
            asm volatile("s_waitcnt vmcnt(0)" ::: "memory");
        } else {
            XB_SPIN(xb_ld(&bar[XB_XGEN(b.x)]) == gen, bar);
            __builtin_amdgcn_fence(__ATOMIC_ACQUIRE, "agent");
            asm volatile("s_waitcnt vmcnt(0)" ::: "memory");
        }
    }
    __syncthreads();
}

namespace pg {
constexpr int BM = 256, BK = 64, HALF = 128, HTB = HALF * BK * 2, STAGE_BYTES = 8 * HTB;
__device__ __forceinline__ int lds_byte(int r, int c) { const int st = (r >> 4) * 2 + (c >> 5), rr = r & 15, cc = c & 31, ob = rr * 64 + cc * 2; return st * 1024 + (ob ^ (((ob >> 9) & 1) << 5)); }
__device__ __forceinline__ void stage_rc(int b, int& R, int& C) { const int st = b / 1024, sb = b % 1024, swz = sb ^ (((sb >> 9) & 1) << 5); R = (st >> 1) * 16 + swz / 64; C = (st & 1) * 32 + (swz % 64) / 2; }
__device__ __forceinline__ int perm32(int rho) { const int n = rho >> 4, i = rho & 15; return 8 * (i >> 2) + 4 * n + (i & 3); }

struct Unit { const char* A; const char* B; int kind, a, b, c; };

template <int EPI_REP = 1, bool CHAIN = false, int KREP = 1, bool BLOCKB = false, bool GATHA = false, int EPI_ST = 0, class Epi, class Dec>
__device__ __forceinline__ void gemm_phase(LAS unsigned char* lds, const int K, const int lda, const int ldb, const int nunits, const Dec& dec, const Epi& E, const int vG, const int vbid, const LAS int* gsrc = nullptr) {
    const int tid = launder_v((int)threadIdx.x), wid = __builtin_amdgcn_readfirstlane(tid >> 6), lane = tid & 63, wr = wid >> 2, wc = wid & 3, fr = lane & 15, fq = lane >> 4;
    const int nt1 = K / BK, nt = nt1 * KREP;
    const int G = launder_si(vG); int uidx = launder_si(vbid);
    if (uidx < 0 || uidx >= nunits) return;
    unsigned voffA[2], voffB[2];
#pragma unroll
    for (int i = 0; i < 2; ++i) { int R, C; stage_rc(tid * 16 + i * 8192, R, C); const int Rb = (R & ~31) + perm32(R & 31);
        voffA[i] = (unsigned)(R * lda + C) * 2u; voffB[i] = BLOCKB ? (unsigned)(((Rb >> 4) * 64 + (C >> 3)) * 128 + (Rb & 15) * 8) * 2u : (unsigned)(Rb * ldb + C) * 2u; }
    const size_t kstep = (size_t)(BK * 2), kstepB = BLOCKB ? (size_t)2048 : kstep;
    const size_t hstepA = GATHA ? (size_t)0 : (size_t)HALF * lda * 2, hstepB = BLOCKB ? (size_t)131072 : (size_t)HALF * ldb * 2;
    int gR[2], gC[2]; unsigned vA0[2], vA1[2], nA0[2], nA1[2];
    if constexpr (GATHA) {
#pragma unroll
        for (int i = 0; i < 2; ++i) { stage_rc(tid * 16 + i * 8192, gR[i], gC[i]);
            vA0[i] = ((unsigned)gsrc[gR[i]] * (unsigned)lda + (unsigned)gC[i]) * 2u; vA1[i] = ((unsigned)gsrc[128 + gR[i]] * (unsigned)lda + (unsigned)gC[i]) * 2u; nA0[i] = vA0[i]; nA1[i] = vA1[i]; }
    }
    int uj = 0;
    const unsigned ldsw = (unsigned)wid * 1024u;
    const int aoff = lds_byte(wr * 64 + fr, fq * 8), boff = lds_byte(wc * 32 + fr, fq * 8);
#define PG_SA(b, h) (((b) * 2 + (h)) * HTB)
#define PG_SB(b, h) ((4 + (b) * 2 + (h)) * HTB)
#define PG_STAGE(bufoff, gbase, voff) do { _Pragma("unroll") for (int _i = 0; _i < 2; ++_i) \
        __builtin_amdgcn_global_load_lds((const unsigned*)((const char*)(gbase) + (voff)[_i]), (LAS unsigned*)(lds + (bufoff) + ldsw + _i * 8192), 16, 0, 0); } while (0)
#define PG_STAGE_A0(bufoff, gbase, nx) do { if constexpr (GATHA) { unsigned v_[2] = {(nx) ? nA0[0] : vA0[0], (nx) ? nA0[1] : vA0[1]}; PG_STAGE(bufoff, gbase, v_); } else PG_STAGE(bufoff, gbase, voffA); } while (0)
#define PG_STAGE_A1(bufoff, gbase, nx) do { if constexpr (GATHA) { unsigned v_[2] = {(nx) ? nA1[0] : vA1[0], (nx) ? nA1[1] : vA1[1]}; PG_STAGE(bufoff, gbase, v_); } else PG_STAGE(bufoff, (gbase) + hstepA, voffA); } while (0)
#define PG_LDA(dst, b, h) do { _Pragma("unroll") for (int m = 0; m < 4; ++m) _Pragma("unroll") for (int k = 0; k < 2; ++k) dst[m][k] = *(const LAS bf16x8*)(lds + PG_SA(b, h) + aoff + m * 2048 + k * 1024); } while (0)
#define PG_LDB(dst, b, h) do { _Pragma("unroll") for (int n = 0; n < 2; ++n) _Pragma("unroll") for (int k = 0; k < 2; ++k) dst[n][k] = *(const LAS bf16x8*)(lds + PG_SB(b, h) + boff + n * 2048 + k * 1024); } while (0)
#define PG_MMA(ai, bj, At, Bt) do { __builtin_amdgcn_s_setprio(1); _Pragma("unroll") for (int m = 0; m < 4; ++m) _Pragma("unroll") for (int n = 0; n < 2; ++n) _Pragma("unroll") for (int k = 0; k < 2; ++k) \
        acc[ai][bj][m][n] = __builtin_amdgcn_mfma_f32_16x16x32_bf16(Bt[n][k], At[m][k], acc[ai][bj][m][n], 0, 0, 0); __builtin_amdgcn_s_setprio(0); } while (0)
#define PG_WAIT_V(n) asm volatile("s_waitcnt vmcnt(" #n ")" ::: "memory")
#define PG_WAIT_V8R() do { if (relax) asm volatile("s_waitcnt vmcnt(%0)" :: "n"(8 + EPI_ST) : "memory"); else asm volatile("s_waitcnt vmcnt(8)" ::: "memory"); } while (0)
#define PG_WAIT_L(n) asm volatile("s_waitcnt lgkmcnt(" #n ")" ::: "memory")
#define PG_BAR __builtin_amdgcn_s_barrier()
#define PG_SCHED __builtin_amdgcn_sched_barrier(0)
    Unit cur, nxt;
    dec(uidx, cur);
    f32x4 acc[2][2][4][2];
#pragma unroll
    for (int a = 0; a < 2; ++a)
#pragma unroll
        for (int b = 0; b < 2; ++b)
#pragma unroll
            for (int m = 0; m < 4; ++m)
#pragma unroll
                for (int n = 0; n < 2; ++n) acc[a][b][m][n] = (f32x4){0.f, 0.f, 0.f, 0.f};
    bf16x8 At[4][2], B0[2][2], B1[2][2];
    const char* cA = cur.A; const char* cB = cur.B;
    PG_STAGE(PG_SB(0, 0), cB, voffB); PG_STAGE(PG_SB(0, 1), cB + hstepB, voffB); PG_STAGE_A0(PG_SA(0, 0), cA, false); PG_STAGE_A1(PG_SA(0, 1), cA, false);
    if (wr == 1) PG_BAR;
    PG_WAIT_V(2); PG_BAR;
    PG_STAGE(PG_SB(1, 0), cB + kstepB, voffB); PG_STAGE_A0(PG_SA(1, 0), cA + kstep, false); PG_STAGE(PG_SB(1, 1), cB + hstepB + kstepB, voffB);
    PG_WAIT_V(6); PG_BAR;
    bool after_epi = false;
    for (;;) {
        const bool has_next = (uidx + G < nunits);
        if (has_next) dec(uidx + G, nxt);
        const char* nA = has_next ? nxt.A : cA; const char* nB = has_next ? nxt.B : cB;
        if constexpr (GATHA) { if (has_next) {
#pragma unroll
            for (int i = 0; i < 2; ++i) { nA0[i] = ((unsigned)gsrc[(uj + 1) * 256 + gR[i]] * (unsigned)lda + (unsigned)gC[i]) * 2u; nA1[i] = ((unsigned)gsrc[(uj + 1) * 256 + 128 + gR[i]] * (unsigned)lda + (unsigned)gC[i]) * 2u; } } }
#pragma nounroll
        for (int t = 0; t < nt; t += 2) {
            const bool last = (t == nt - 2);
            const bool relax = EPI_ST > 0 && after_epi && t == 0;
            const int t1 = KREP > 1 ? (t + 1) % nt1 : t + 1, t2 = KREP > 1 ? (t + 2) % nt1 : t + 2;
            const char* a1 = cA + (size_t)t1 * kstep;
            const char* a2 = last ? nA : cA + (size_t)t2 * kstep; const char* b2 = last ? nB : cB + (size_t)t2 * kstepB;
            const char* a3 = a2 + kstep; const char* b3 = b2 + kstepB;
            PG_LDB(B0, 0, 0); PG_LDB(B1, 0, 1); PG_SCHED; PG_LDA(At, 0, 0); PG_STAGE_A1(PG_SA(1, 1), a1, false);
            PG_WAIT_V8R(); PG_WAIT_L(0); PG_BAR; PG_MMA(0, 0, At, B0); PG_MMA(0, 1, At, B1); PG_BAR; PG_SCHED;
            PG_LDA(At, 0, 1); PG_STAGE(PG_SB(0, 0), b2, voffB); PG_STAGE(PG_SB(0, 1), b2 + hstepB, voffB); PG_STAGE_A0(PG_SA(0, 0), a2, last);
            PG_WAIT_V8R(); PG_WAIT_L(0); PG_BAR; PG_MMA(1, 0, At, B0); PG_MMA(1, 1, At, B1); PG_BAR; PG_SCHED;
            PG_LDB(B0, 1, 0); PG_LDB(B1, 1, 1); PG_SCHED; PG_LDA(At, 1, 0); PG_STAGE_A1(PG_SA(0, 1), a2, last);
            PG_WAIT_V(8); PG_WAIT_L(0); PG_BAR; PG_MMA(0, 0, At, B0); PG_MMA(0, 1, At, B1); PG_BAR; PG_SCHED;
            PG_LDA(At, 1, 1); PG_STAGE(PG_SB(1, 0), b3, voffB); PG_STAGE(PG_SB(1, 1), b3 + hstepB, voffB); PG_STAGE_A0(PG_SA(1, 0), a3, last);
            PG_WAIT_V(8); PG_WAIT_L(0); PG_BAR; PG_MMA(1, 0, At, B0); PG_MMA(1, 1, At, B1); PG_BAR; PG_SCHED;
        }
        if (wr == 0) PG_BAR;
        if constexpr (KREP > 1) {
#pragma unroll
            for (int a = 0; a < 2; ++a)
#pragma unroll
                for (int b = 0; b < 2; ++b)
#pragma unroll
                    for (int m = 0; m < 4; ++m)
#pragma unroll
                        for (int n = 0; n < 2; ++n) acc[a][b][m][n] = acc[a][b][m][n] * (1.0f / KREP);
        }
        E(acc, cur, wr, wc, fr, fq);
        if constexpr (EPI_REP > 1) { if (PROBE_EPIKIND < 0 || cur.kind == PROBE_EPIKIND) E(acc, cur, wr, wc, fr, fq); }
        if (!has_next) break;
        if constexpr (CHAIN) E.carry(acc, nxt);
        else {
#pragma unroll
        for (int a = 0; a < 2; ++a)
#pragma unroll
            for (int b = 0; b < 2; ++b)
#pragma unroll
                for (int m = 0; m < 4; ++m)
#pragma unroll
                    for (int n = 0; n < 2; ++n) acc[a][b][m][n] = (f32x4){0.f, 0.f, 0.f, 0.f};
        }
        cur = nxt; cA = nA; cB = nB; uidx += G; after_epi = true;
        if constexpr (GATHA) { vA0[0] = nA0[0]; vA0[1] = nA0[1]; vA1[0] = nA1[0]; vA1[1] = nA1[1]; ++uj; }
        if (wr == 1) PG_BAR;
    }
    PG_WAIT_V(0);
    PG_BAR;
#undef PG_SA
#undef PG_SB
#undef PG_STAGE
#undef PG_LDA
#undef PG_STAGE_A0
#undef PG_STAGE_A1
#undef PG_LDB
#undef PG_MMA
#undef PG_WAIT_V
#undef PG_WAIT_L
#undef PG_WAIT_V8R
#undef PG_BAR
#undef PG_SCHED
}
}
using pg::Unit;

enum { KQ = 0, KK = 1, KPL_SILU = 2, KPL_SCALE = 3, KPL_SIG = 4, KKT = 5, KVT = 6, KVNT = 7 };

struct DecInProj {
    const char* xb; const char* WinT;
    __device__ __forceinline__ void operator()(int u, Unit& o) const {
#if DEFER_SILU
        if (u < 1792) {
            const int g = u >> 8, r = u & 255, x = r & 7, idx = r >> 3, cell = g * 8 + x, pg = cell / 7, jg7 = cell - pg * 7, pm = pg * 8 + (idx & 7), j = (jg7 < 2 ? jg7 : jg7 + 1) * 4 + (idx >> 3);
            const int wt = j < 8 ? j : (j < 24 ? j + 8 : j + 12);
#else
        if (u < 2048) {
            const int g = u >> 8, r = u & 255, x = r & 7, idx = r >> 3, pm = g * 8 + (idx & 7), j = ((x + g) & 7) * 4 + (idx >> 3);
            const int wt = j < 8 ? j : (j < 24 ? j + 8 : j + 12);
#endif
            o.A = xb + (size_t)pm * (256 * 1024 * 2); o.B = WinT + (size_t)wt * (256 * 1024 * 2); o.b = pm * 256; o.c = 0;
            if (wt < 4) { o.kind = KQ; o.a = wt; }
            else if (wt < 8) { o.kind = KK; o.a = wt - 4; }
            else if (wt < 24) { o.kind = KPL_SILU; o.a = (wt - 16) * 256; }
            else if (wt < 28) { o.kind = KPL_SCALE; o.a = (wt - 24) * 256; o.c = 0; }
            else if (wt < 32) { o.kind = KPL_SCALE; o.a = (wt - 28) * 256; o.c = 1; }
            else { o.kind = KPL_SIG; o.a = (wt - 36) * 256; }
        } else {
            const int v = u - (DEFER_SILU ? 1792 : 2048), g = v >> 8, r = v & 255, x = r & 7, idx = r >> 3, ci = 4 * g + (idx >> 3), tt = x * 8 + (idx & 7);
            int ct;
            if (ci < 8) { ct = 8 + ci; o.kind = KVT; o.a = ci >> 1; o.c = ci & 1; }
            else { ct = 32 + (ci - 8); o.kind = KVNT; o.a = ci - 8; o.c = 0; }
            o.A = WinT + (size_t)ct * (256 * 1024 * 2); o.B = xb + (size_t)tt * (256 * 1024 * 2); o.b = tt * 256;
        }
    }
};
struct DecInProjD {
    const char* xb; const char* WinT; int mode;
    __device__ __forceinline__ void operator()(int u, Unit& o) const {
        int pm, t4;
        if (mode == 0) { const int x = u & 7, i = u >> 3; pm = x * 4 + (i & 3); t4 = i >> 2; }
        else { const int k = u >> 6, r = u & 63, x = r & 7, i = r >> 3; pm = 32 + x * 4 + (i & 3); t4 = (i >> 2) * 2 + k; }
        o.A = xb + (size_t)pm * (256 * 1024 * 2); o.B = WinT + (size_t)(16 + t4) * (256 * 1024 * 2); o.b = pm * 256; o.c = 0; o.kind = KPL_SILU; o.a = t4 * 256;
    }
};
struct EpiInProj {
    unsigned char* ws_;
    const float* decay;
    __device__ __forceinline__ void operator()(const f32x4 (&acc)[2][2][4][2], const Unit& u, int wr, int wc, int fr, int fq) const {
        unsigned char* w = launder_s(ws_);
        bf16_t* const Q = (bf16_t*)(w + WS_Q); bf16_t* const Kb = (bf16_t*)(w + WS_K); bf16_t* const ACAT = (bf16_t*)(w + WS_ACAT); bf16_t* const BCAT = (bf16_t*)(w + WS_BCAT);
        bf16_t* const KDT = (bf16_t*)(w + WS_KDT); bf16_t* const SG = (bf16_t*)(w + WS_SG); bf16_t* const QN = (bf16_t*)(w + WS_QN); bf16_t* const KN = (bf16_t*)(w + WS_KN);
        bf16_t* const VNT = (bf16_t*)(w + WS_VNT); bf16_t* const Gt = (bf16_t*)(w + WS_G);
        const float* const frq = (const float*)(w + WS_TAB);
        const int kind = u.kind, c8 = wc * 32 + fq * 8;
        if (kind == KQ || kind == KK) {
            const int h = u.a, t0 = u.b;
            float lf = 0.f, lb = 0.f;
            lf = log2_sigmoid(decay[h]); lb = log2_sigmoid(decay[4 + h]);
            bf16x8 iy1, iy2;
#pragma unroll
            for (int i = 0; i < 8; ++i) { iy1[i] = (8 * fq + i == fr) ? (short)0x3F80 : (short)0; iy2[i] = (8 * fq + i == 16 + fr) ? (short)0x3F80 : (short)0; }
            const f32x4 fh0 = *(const GAS f32x4*)(frq + c8), fh1 = *(const GAS f32x4*)(frq + c8 + 4), fl0 = *(const GAS f32x4*)(frq + 128 + c8), fl1 = *(const GAS f32x4*)(frq + 128 + c8 + 4);
#pragma unroll
            for (int am = 0; am < 4; ++am) {
                const int ai = am >> 1;
#pragma unroll
                for (int mm = 0; mm < 2; ++mm) {
                    const int m = (am & 1) * 2 + mm;
                    const int t = t0 + ai * 128 + wr * 64 + m * 16 + fr;
                    const float pf = (float)(t & 4095);
                    f32x4 c0, c1, s0, s1;
#pragma unroll
                    for (int i = 0; i < 4; ++i) {
                        const float r0 = fmaf(pf, fl0[i], __builtin_amdgcn_fractf(pf * fh0[i])), r1 = fmaf(pf, fl1[i], __builtin_amdgcn_fractf(pf * fh1[i]));
                        c0[i] = __builtin_amdgcn_cosf(r0); s0[i] = __builtin_amdgcn_sinf(r0); c1[i] = __builtin_amdgcn_cosf(r1); s1[i] = __builtin_amdgcn_sinf(r1);
                    }
                    const f32x4 x1a = acc[ai][0][m][0], x1b = acc[ai][0][m][1], x2a = acc[ai][1][m][0], x2b = acc[ai][1][m][1];
                    f32x4 q1a = x1a * c0 - x2a * s0, q1b = x1b * c1 - x2b * s1, q2a = x1a * s0 + x2a * c0, q2b = x1b * s1 + x2b * c1;
                    if (kind == KQ) {
                        bf16_t* qp = Q + (size_t)t * 1024 + h * 256 + c8;
                        NT16(qp, pack8(q1a, q1b)); NT16((qp + 128), pack8(q2a, q2b));
                        const int p = t & 511; const float df = fast_exp2(lf * (float)(p + 1)), db = fast_exp2(lb * (float)(512 - p));
                        bf16_t* ap = ACAT + ((size_t)t * 4 + h) * 1024 + 512 + c8;
                        NT16(ap, pack8(q1a * df, q1b * df)); NT16((ap + 128), pack8(q2a * df, q2b * df));
                        NT16((ap + 256), pack8(q1a * db, q1b * db)); NT16((ap + 384), pack8(q2a * db, q2b * db));
                    } else {
                        bf16_t* kp = Kb + (size_t)t * 1024 + h * 256 + c8;
                        const u32x4 f0 = pack8(q1a * 0.0625f, q1b * 0.0625f), f1 = pack8(q2a * 0.0625f, q2b * 0.0625f);
                        NT16(kp, f0); NT16((kp + 128), f1);
                        const int tk = t0 + ai * 128 + wr * 64 + m * 16 + 4 * fq, sk = tk & 4095, jk = sk & 511;
                        f32x4 dfv, dbv;
#pragma unroll
                        for (int r = 0; r < 4; ++r) { dfv[r] = fast_exp2(lf * (float)(511 - (jk + r))); dbv[r] = fast_exp2(lb * (float)(jk + r)); }
                        bf16_t* const kt0 = KDT + ((((size_t)((tk >> 12) * 4 + h) * 8 + (sk >> 9)) * 2) * 256) * 512 + (size_t)(jk >> 3) * 128 + fr * 8 + (jk & 7);
#pragma unroll
                        for (int bj = 0; bj < 2; ++bj)
#pragma unroll
                            for (int hf = 0; hf < 2; ++hf) {
                                const f32x4 z4 = {0.f, 0.f, 0.f, 0.f};
                                const f32x4 dt = __builtin_amdgcn_mfma_f32_16x16x32_bf16(__builtin_bit_cast(bf16x8, bj ? f1 : f0), hf ? iy2 : iy1, z4, 0, 0, 0);
                                bf16_t* dp = kt0 + (size_t)(bj * 8 + wc * 2 + hf) * (64 * 128);
                                *(GAS u32x2*)dp = pack4(dt * dfv); *(GAS u32x2*)(dp + 256 * 512) = pack4(dt * dbv);
                            }
                    }
                    __builtin_amdgcn_sched_barrier(0);
                }
            }
        } else if (kind == KPL_SILU || kind == KPL_SCALE || kind == KPL_SIG) {
            const int t0 = u.b;
            bf16_t* dst; int ld; float sc = 1.f;
            if (kind == KPL_SILU) { dst = SG; ld = 2048; }
            else if (kind == KPL_SIG) { dst = Gt; ld = 2048; }
            else { ld = 1024; if (u.c == 0) { dst = QN; sc = 0.125f * LOG2E; } else { dst = KN; } }
            dst += u.a + c8;
#pragma unroll
            for (int ai = 0; ai < 2; ++ai)
#pragma unroll
                for (int m = 0; m < 4; ++m) {
                    const int t = t0 + ai * 128 + wr * 64 + m * 16 + fr;
#pragma unroll
                    for (int bj = 0; bj < 2; ++bj) {
                        f32x4 v0 = acc[ai][bj][m][0], v1 = acc[ai][bj][m][1];
                        if (kind == KPL_SCALE) { v0 = v0 * sc; v1 = v1 * sc; }
                        else if (kind == KPL_SIG) {
#pragma unroll
                            for (int i = 0; i < 4; ++i) { v0[i] = sigmoid_f(v0[i]); v1[i] = sigmoid_f(v1[i]); }
                        }
                        NT16((dst + (size_t)t * ld + bj * 128), pack8(v0, v1));
                    }
                }
        } else {
            const int t0 = u.b, bb = t0 >> 12, s0 = t0 & 4095, cc = s0 >> 9, j0 = s0 & 511;
            if (kind == KVT) {
                const int h = u.a;
#pragma unroll
                for (int ai = 0; ai < 2; ++ai)
#pragma unroll
                    for (int m = 0; m < 4; ++m) {
                        const int e = u.c * 256 + ai * 128 + wr * 64 + m * 16 + fr;
                        bf16_t* vp = BCAT + (((size_t)(bb * 4 + h) * 8 + cc) * 512 + e) * 1024 + j0 + c8;
#pragma unroll
                        for (int bj = 0; bj < 2; ++bj) NT16((vp + bj * 128), pack8(acc[ai][bj][m][0], acc[ai][bj][m][1]));
                    }
            } else {
#pragma unroll
                for (int ai = 0; ai < 2; ++ai)
#pragma unroll
                    for (int m = 0; m < 4; ++m) {
                        const int ch = u.a * 256 + ai * 128 + wr * 64 + m * 16 + fr;
                        bf16_t* vp = VNT + ((size_t)bb * 1024 + ch) * 4096 + s0 + c8;
#pragma unroll
                        for (int bj = 0; bj < 2; ++bj) NT16((vp + bj * 128), pack8(acc[ai][bj][m][0], acc[ai][bj][m][1]));
                    }
            }
        }
    }
};

__device__ __forceinline__ int xcd_perm(int u, int rs, int nunits) {
    const int i = u / rs, b = u - i * rs;
    return ((i + 1) * rs <= nunits) ? i * rs + (b & 7) * (rs >> 3) + (b >> 3) : u;
}
struct DecR1 {
    const char* Q; const char* Kb; int rs;
    __device__ __forceinline__ void operator()(int u0, Unit& o) const {
        const int u = xcd_perm(u0, rs, 512);
        const int pn2 = u & 1, pm2 = (u >> 1) & 1, cc = (u >> 2) & 7, bh = u >> 5, b = bh >> 2, h = bh & 3;
        const int ti = b * 4096 + cc * 512 + pm2 * 256, tj = b * 4096 + cc * 512 + pn2 * 256;
        o.A = Q + ((size_t)ti * 1024 + h * 256) * 2; o.B = Kb + ((size_t)tj * 1024 + h * 256) * 2;
        o.kind = 0; o.a = h; o.b = ti; o.c = pm2 * 2 + pn2;
    }
};
struct EpiR1 {
    bf16_t* ACAT; const float* decay;
    __device__ __forceinline__ void operator()(const f32x4 (&acc)[2][2][4][2], const Unit& u, int wr, int wc, int fr, int fq) const {
        const int h = u.a, ti0 = u.b, i0 = (u.c >> 1) * 256, j0 = (u.c & 1) * 256, c8 = wc * 32 + fq * 8;
        const float lf = log2_sigmoid(decay[h]), lb = log2_sigmoid(decay[4 + h]);
#pragma unroll
        for (int ai = 0; ai < 2; ++ai)
#pragma unroll
            for (int m = 0; m < 4; ++m) {
                const int r = ai * 128 + wr * 64 + m * 16 + fr, i = i0 + r;
                bf16_t* ap = ACAT + ((size_t)(ti0 + r) * 4 + h) * 1024 + j0 + c8;
#pragma unroll
                for (int bj = 0; bj < 2; ++bj) {
                    f32x4 v0 = acc[ai][bj][m][0], v1 = acc[ai][bj][m][1];
                    const int jb = j0 + bj * 128 + c8;
#pragma unroll
                    for (int q = 0; q < 4; ++q) {
                        const int d0 = i - (jb + q), d1 = i - (jb + 4 + q);
                        v0[q] *= fast_exp2(d0 >= 0 ? lf * (float)d0 : lb * (float)(-d0));
                        v1[q] *= fast_exp2(d1 >= 0 ? lf * (float)d1 : lb * (float)(-d1));
                    }
                    *(GAS u32x4*)(ap + bj * 128) = pack8(v0, v1);
                }
                __builtin_amdgcn_sched_barrier(0);
            }
    }
};
struct DecR2c {
    const char* BCAT; const char* KDT;
    __device__ __forceinline__ void operator()(int u, Unit& o) const {
        const int ch = u & 63, i = u >> 6, pm2 = ch & 1, dir = (ch >> 1) & 1, bh = ch >> 2;
        const int cs = dir ? 7 - i : i, ct = dir ? 6 - i : i + 1;
        o.A = BCAT + (((size_t)(bh * 8 + cs) * 512 + pm2 * 256) * 1024) * 2;
        o.B = KDT + ((((size_t)(bh * 8 + cs) * 2 + dir) * 256) * 512) * 2;
        o.kind = i; o.a = (bh * 8 + ct) * 512 + pm2 * 256; o.b = dir; o.c = dir * 4 + (bh & 3);
    }
};
struct EpiR2c {
    bf16_t* BCAT; const float* decay;
    __device__ __forceinline__ void carry(f32x4 (&acc)[2][2][4][2], const Unit& nx) const {
        const float cd = fast_exp2(log2_sigmoid(decay[nx.c]) * 512.0f);
#pragma unroll
        for (int a = 0; a < 2; ++a)
#pragma unroll
            for (int b = 0; b < 2; ++b)
#pragma unroll
                for (int m = 0; m < 4; ++m)
#pragma unroll
                    for (int n = 0; n < 2; ++n) acc[a][b][m][n] = acc[a][b][m][n] * cd;
    }
    __device__ __forceinline__ void operator()(const f32x4 (&acc)[2][2][4][2], const Unit& u, int wr, int wc, int fr, int fq) const {
        const int c8 = wc * 32 + fq * 8, dir = u.b;
#pragma unroll
        for (int ai = 0; ai < 2; ++ai)
#pragma unroll
            for (int m = 0; m < 4; ++m) {
                const int row = ai * 128 + wr * 64 + m * 16 + fr;
                bf16_t* sp = BCAT + ((size_t)u.a + row) * 1024 + 512 + dir * 256 + c8;
#pragma unroll
                for (int bj = 0; bj < 2; ++bj) *(GAS u32x4*)(sp + bj * 128) = pack8(acc[ai][bj][m][0], acc[ai][bj][m][1]);
                if (u.kind == 0) {
                    bf16_t* zp = dir ? sp + (size_t)512 * 1024 : sp - (size_t)512 * 1024;
                    const u32x4 z = {0u, 0u, 0u, 0u};
#pragma unroll
                    for (int bj = 0; bj < 2; ++bj) *(GAS u32x4*)(zp + bj * 128) = z;
                }
            }
    }
};
struct DecR4 {
    const char* ACAT; const char* BCAT; int rs;
    static __device__ __forceinline__ int panel_of(int wg) { return (wg & 7) * 32 + (wg >> 3); }
    __device__ __forceinline__ void operator()(int u0, Unit& o) const {
        const int pn2 = u0 >> 8, p = panel_of(u0 & 255);
        const int pm2 = p & 1, cc = (p >> 1) & 7, bh = p >> 4, b = bh >> 2, h = bh & 3;
        const int ti = b * 4096 + cc * 512 + pm2 * 256;
        o.A = ACAT + (((size_t)ti * 4 + h) * 1024) * 2; o.B = BCAT + (((size_t)(bh * 8 + cc) * 512 + pn2 * 256) * 1024) * 2;
        o.kind = 0; o.a = h * 512 + pn2 * 256; o.b = ti; o.c = 0;
    }
};
struct EpiR4 {
    bf16_t* RET;
    __device__ __forceinline__ void operator()(const f32x4 (&acc)[2][2][4][2], const Unit& u, int wr, int wc, int fr, int fq) const {
        const int c8 = wc * 32 + fq * 8;
#pragma unroll
        for (int ai = 0; ai < 2; ++ai)
#pragma unroll
            for (int m = 0; m < 4; ++m) {
                const int t = u.b + ai * 128 + wr * 64 + m * 16 + fr;
                bf16_t* rp = RET + (size_t)t * 2048 + u.a + c8;
#pragma unroll
                for (int bj = 0; bj < 2; ++bj) *(GAS u32x4*)(rp + bj * 128) = pack8(acc[ai][bj][m][0], acc[ai][bj][m][1]);
            }
    }
};
constexpr int LM_HN_PART = 4096, LM_HN_FIN0 = 12288, LM_HN_FIN1 = 14336;
struct EpiR4f {
    unsigned char* ws_; LAS unsigned char* lds;
    __device__ __forceinline__ void operator()(const f32x4 (&acc)[2][2][4][2], const Unit& u, int wr, int wc, int fr_, int fq) const {
        unsigned char* w = launder_s(ws_);
        const int fr = launder_v(fr_);
        bf16_t* const RET = (bf16_t*)(w + WS_KV); const bf16_t* const SG = (const bf16_t*)(w + WS_SG); bf16_t* const AR = (bf16_t*)(w + WS_KDT);
        LAS f32x2* part = (LAS f32x2*)(lds + LDS_MISC + LM_HN_PART); LAS f32x2* fin0 = (LAS f32x2*)(lds + LDS_MISC + LM_HN_FIN0); LAS f32x2* fin1 = (LAS f32x2*)(lds + LDS_MISC + LM_HN_FIN1);
        const int c8 = wc * 32 + fq * 8; const bool second = (u.a & 256) != 0;
#pragma unroll
        for (int ai = 0; ai < 2; ++ai)
#pragma unroll
            for (int m = 0; m < 4; ++m) {
                float s1 = 0.f, s2 = 0.f;
#pragma unroll
                for (int bj = 0; bj < 2; ++bj)
#pragma unroll
                    for (int n = 0; n < 2; ++n)
#pragma unroll
                        for (int i = 0; i < 4; ++i) { const float v = acc[ai][bj][m][n][i]; s1 += v; s2 += v * v; }
                s1 += __shfl_xor(s1, 16); s2 += __shfl_xor(s2, 16); s1 += __shfl_xor(s1, 32); s2 += __shfl_xor(s2, 32);
                if (fq == 0) { f32x2 ps; ps.x = s1; ps.y = s2; part[(ai * 128 + wr * 64 + m * 16 + fr) * 4 + wc] = ps; }
            }
        if (!second) {
#pragma unroll
            for (int ai = 0; ai < 2; ++ai)
#pragma unroll
                for (int m = 0; m < 4; ++m) {
                    const int t = u.b + ai * 128 + wr * 64 + m * 16 + fr;
                    bf16_t* rp = RET + (size_t)t * 2048 + u.a + c8;
#pragma unroll
                    for (int bj = 0; bj < 2; ++bj) *(GAS u32x4*)(rp + bj * 128) = pack8(acc[ai][bj][m][0], acc[ai][bj][m][1]);
                }
            LDS_WAIT(); __builtin_amdgcn_s_barrier();
            const int tid = (wr * 4 + wc) * 64 + fq * 16 + fr;
            if (tid < 256) { const f32x2 a = part[tid * 4], b = part[tid * 4 + 1], c = part[tid * 4 + 2], d = part[tid * 4 + 3]; f32x2 f; f.x = (a.x + b.x) + (c.x + d.x); f.y = (a.y + b.y) + (c.y + d.y); fin0[tid] = f; }
            LDS_WAIT();
        } else {
            LDS_WAIT(); __builtin_amdgcn_s_barrier();
#pragma unroll
            for (int am = 0; am < 4; ++am) {
                const int ai = am >> 1;
                u32x4 gv[2][2];
#pragma unroll
                for (int mm = 0; mm < 2; ++mm)
#pragma unroll
                    for (int bj = 0; bj < 2; ++bj) gv[mm][bj] = *(const GAS u32x4*)(SG + (size_t)(u.b + ai * 128 + wr * 64 + ((am & 1) * 2 + mm) * 16 + fr) * 2048 + u.a + bj * 128 + c8);
                __builtin_amdgcn_sched_barrier(0);
#pragma unroll
                for (int mm = 0; mm < 2; ++mm) {
                    const int m = (am & 1) * 2 + mm;
                    const int row = ai * 128 + wr * 64 + m * 16 + fr, t = u.b + row;
                    const f32x2 a = part[row * 4], b = part[row * 4 + 1], c = part[row * 4 + 2], d = part[row * 4 + 3], f0 = fin0[row];
                    const float S1 = ((a.x + b.x) + (c.x + d.x)) + f0.x, S2 = ((a.y + b.y) + (c.y + d.y)) + f0.y;
                    const float mean = S1 * (1.0f / 512.0f), var = fmaxf(S2 * (1.0f / 512.0f) - mean * mean, 0.f), rstd = 1.0f / sqrtf(var + 1e-5f);
                    if (wc == 0 && fq == 0) { f32x2 st; st.x = mean; st.y = rstd; fin1[row] = st; }
#pragma unroll
                    for (int bj = 0; bj < 2; ++bj) {
                        const u32x4 g = gv[mm][bj];
                        const float gg[8] = {bf_lo(g.x), bf_hi(g.x), bf_lo(g.y), bf_hi(g.y), bf_lo(g.z), bf_hi(g.z), bf_lo(g.w), bf_hi(g.w)};
                        f32x4 v0 = acc[ai][bj][m][0], v1 = acc[ai][bj][m][1];
#pragma unroll
                        for (int i = 0; i < 4; ++i) { v0[i] = (v0[i] - mean) * (gg[i] * sigmoid_f(gg[i]) * rstd); v1[i] = (v1[i] - mean) * (gg[4 + i] * sigmoid_f(gg[4 + i]) * rstd); }
                        *(GAS u32x4*)(AR + (size_t)t * 2048 + u.a + bj * 128 + c8) = pack8(v0, v1);
                    }
                }
                __builtin_amdgcn_sched_barrier(0);
            }
            LDS_WAIT();
        }
    }
};
struct DecDense {
    const char* A; const char* B; int lda2, ldb2;
    __device__ __forceinline__ void operator()(int u, Unit& o) const {
        const int pn = u >> 6, pm = u & 63;
        o.A = A + (size_t)pm * 256 * lda2; o.B = B + (size_t)pn * 256 * ldb2; o.kind = 0; o.a = pn * 256; o.b = pm * 256; o.c = 0;
    }
};
template <int MODE> struct EpiMerge {
    bf16_t* MG; const bf16_t* Gt;
    __device__ __forceinline__ void operator()(const f32x4 (&acc)[2][2][4][2], const Unit& u, int wr, int wc, int fr, int fq) const {
        const int c8 = wc * 32 + fq * 8;
#pragma unroll
        for (int ai = 0; ai < 2; ++ai) {
            u32x4 gv[4][2], ov[4][2];
#pragma unroll
            for (int m = 0; m < 4; ++m)
#pragma unroll
                for (int bj = 0; bj < 2; ++bj) { const int t = u.b + ai * 128 + wr * 64 + m * 16 + fr, c = u.a + bj * 128 + c8;
                    gv[m][bj] = *(const GAS u32x4*)(Gt + (size_t)t * 2048 + MODE * 1024 + c);
                    if (MODE == 1) ov[m][bj] = *(const GAS u32x4*)(MG + (size_t)t * 1024 + c); }
            __builtin_amdgcn_sched_barrier(0);
#pragma unroll
            for (int m = 0; m < 4; ++m) {
                const int t = u.b + ai * 128 + wr * 64 + m * 16 + fr;
#pragma unroll
                for (int bj = 0; bj < 2; ++bj) {
                    const int c = u.a + bj * 128 + c8; const u32x4 g = gv[m][bj];
                    f32x4 v0 = acc[ai][bj][m][0], v1 = acc[ai][bj][m][1];
                    v0[0] *= bf_lo(g.x); v0[1] *= bf_hi(g.x); v0[2] *= bf_lo(g.y); v0[3] *= bf_hi(g.y);
                    v1[0] *= bf_lo(g.z); v1[1] *= bf_hi(g.z); v1[2] *= bf_lo(g.w); v1[3] *= bf_hi(g.w);
                    if (MODE == 1) { const u32x4 o = ov[m][bj];
                        v0[0] += bf_lo(o.x); v0[1] += bf_hi(o.x); v0[2] += bf_lo(o.y); v0[3] += bf_hi(o.y);
                        v1[0] += bf_lo(o.z); v1[1] += bf_hi(o.z); v1[2] += bf_lo(o.w); v1[3] += bf_hi(o.w); }
                    *(GAS u32x4*)(MG + (size_t)t * 1024 + c) = pack8(v0, v1);
                }
            }
            __builtin_amdgcn_sched_barrier(0);
        }
    }
};
struct EpiPreR {
    unsigned char* ws_; const bf16_t* WRT; LAS unsigned char* lds;
    __device__ __forceinline__ void operator()(const f32x4 (&acc)[2][2][4][2], const Unit& u, int wr, int wc, int fr_, int fq) const {
        unsigned char* w = launder_s(ws_);
        const int fr = launder_v(fr_);
        bf16_t* const PREB = (bf16_t*)(w + WS_ACAT); const bf16_t* const xb = (const bf16_t*)(w + WS_XB); float* const PL = (float*)(w + WS_PL); float* const PS = (float*)(w + WS_PS);
        const int c8 = wc * 32 + fq * 8, pn = u.a >> 8, lane = fq * 16 + fr, tid = (wr * 4 + wc) * 64 + lane;
        asm volatile("s_waitcnt vmcnt(0)" ::: "memory"); __builtin_amdgcn_s_barrier();
        bf16x8 Wf[2][2][2];
#pragma unroll
        for (int bj = 0; bj < 2; ++bj)
#pragma unroll
            for (int hf = 0; hf < 2; ++hf) { const bf16_t* wp = WRT + (size_t)(fr + 16 * hf) * 1024 + u.a + bj * 128 + c8; Wf[bj][hf][0] = *(const GAS bf16x8*)wp; Wf[bj][hf][1] = *(const GAS bf16x8*)(wp + 32768); }
        LAS f32x4* red = (LAS f32x4*)lds;
        LAS f32x2* pst = (LAS f32x2*)(lds + LDS_MISC + 4096);
#pragma unroll
        for (int am = 0; am < 4; ++am) {
            const int ai = am >> 1;
            u32x4 xv[2][2];
#pragma unroll
            for (int mm = 0; mm < 2; ++mm)
#pragma unroll
                for (int bj = 0; bj < 2; ++bj) xv[mm][bj] = *(const GAS u32x4*)(xb + (size_t)(u.b + ai * 128 + wr * 64 + ((am & 1) * 2 + mm) * 16 + fr) * 1024 + u.a + bj * 128 + c8);
            __builtin_amdgcn_sched_barrier(0);
#pragma unroll
            for (int mm = 0; mm < 2; ++mm) {
                const int m = (am & 1) * 2 + mm, row = ai * 128 + wr * 64 + m * 16 + fr;
                f32x4 L0 = {0.f, 0.f, 0.f, 0.f}, L1 = {0.f, 0.f, 0.f, 0.f};
                float s1 = 0.f, s2 = 0.f;
#pragma unroll
                for (int bj = 0; bj < 2; ++bj) {
                    const u32x4 x = xv[mm][bj];
                    const f32x4 x0 = {bf_lo(x.x), bf_hi(x.x), bf_lo(x.y), bf_hi(x.y)}, x1 = {bf_lo(x.z), bf_hi(x.z), bf_lo(x.w), bf_hi(x.w)};
                    const f32x4 p0 = x0 * ALPHA + acc[ai][bj][m][0], p1 = x1 * ALPHA + acc[ai][bj][m][1];
#pragma unroll
                    for (int i = 0; i < 4; ++i) { s1 += p0[i] + p1[i]; s2 += p0[i] * p0[i] + p1[i] * p1[i]; }
                    const u32x4 hi = pack8(p0, p1);
                    *(GAS u32x4*)(PREB + (size_t)(u.b + row) * 1024 + u.a + bj * 128 + c8) = hi;
                    const f32x4 h0 = {bf_lo(hi.x), bf_hi(hi.x), bf_lo(hi.y), bf_hi(hi.y)}, h1 = {bf_lo(hi.z), bf_hi(hi.z), bf_lo(hi.w), bf_hi(hi.w)};
                    const u32x4 lo = pack8(p0 - h0, p1 - h1);
                    const bf16x8 hv = __builtin_bit_cast(bf16x8, hi), lv = __builtin_bit_cast(bf16x8, lo);
                    L0 = __builtin_amdgcn_mfma_f32_16x16x32_bf16(Wf[bj][0][0], hv, L0, 0, 0, 0); L1 = __builtin_amdgcn_mfma_f32_16x16x32_bf16(Wf[bj][1][0], hv, L1, 0, 0, 0);
                    L0 = __builtin_amdgcn_mfma_f32_16x16x32_bf16(Wf[bj][0][0], lv, L0, 0, 0, 0); L1 = __builtin_amdgcn_mfma_f32_16x16x32_bf16(Wf[bj][1][0], lv, L1, 0, 0, 0);
                    L0 = __builtin_amdgcn_mfma_f32_16x16x32_bf16(Wf[bj][0][1], hv, L0, 0, 0, 0); L1 = __builtin_amdgcn_mfma_f32_16x16x32_bf16(Wf[bj][1][1], hv, L1, 0, 0, 0);
                }
                const int rg = ai * 8 + wr * 4 + m;
                red[((wc * 16 + rg) * 64 + lane) * 2] = L0; red[((wc * 16 + rg) * 64 + lane) * 2 + 1] = L1;
                s1 += __shfl_xor(s1, 16); s2 += __shfl_xor(s2, 16); s1 += __shfl_xor(s1, 32); s2 += __shfl_xor(s2, 32);
                if (fq == 0) { f32x2 ps; ps.x = s1; ps.y = s2; pst[row * 4 + wc] = ps; }
            }
            __builtin_amdgcn_sched_barrier(0);
        }
        LDS_WAIT(); __builtin_amdgcn_s_barrier();
#pragma unroll
        for (int q = 0; q < 2; ++q) {
            const int idx = tid * 2 + q, rg = idx >> 6, ln = idx & 63;
            f32x4 a0 = red[((0 * 16 + rg) * 64 + ln) * 2], a1 = red[((0 * 16 + rg) * 64 + ln) * 2 + 1];
#pragma unroll
            for (int k = 1; k < 4; ++k) { a0 = a0 + red[((k * 16 + rg) * 64 + ln) * 2]; a1 = a1 + red[((k * 16 + rg) * 64 + ln) * 2 + 1]; }
            const int row = (rg >> 3) * 128 + ((rg >> 2) & 1) * 64 + (rg & 3) * 16 + (ln & 15);
            float* pl = PL + ((size_t)(u.b + row) * 4 + pn) * 32 + 4 * (ln >> 4);
            *(GAS f32x4*)pl = a0; *(GAS f32x4*)(pl + 16) = a1;
        }
        if (tid < 256) { const f32x2 a = pst[tid * 4], b = pst[tid * 4 + 1], c = pst[tid * 4 + 2], d = pst[tid * 4 + 3]; f32x2 f; f.x = (a.x + b.x) + (c.x + d.x); f.y = (a.y + b.y) + (c.y + d.y);
            *(GAS f32x2*)(PS + ((size_t)(u.b + tid) * 4 + pn) * 2) = f; }
        LDS_WAIT();
    }
};
struct EpiPre {
    float* PRE; const bf16_t* xb;
    __device__ __forceinline__ void operator()(const f32x4 (&acc)[2][2][4][2], const Unit& u, int wr, int wc, int fr, int fq) const {
        const int c8 = wc * 32 + fq * 8;
        u32x4 xv[2][4][2];
#pragma unroll
        for (int ai = 0; ai < 2; ++ai)
#pragma unroll
            for (int m = 0; m < 4; ++m)
#pragma unroll
                for (int bj = 0; bj < 2; ++bj) xv[ai][m][bj] = *(const GAS u32x4*)(xb + (size_t)(u.b + ai * 128 + wr * 64 + m * 16 + fr) * 1024 + u.a + bj * 128 + c8);
        __builtin_amdgcn_sched_barrier(0);
#pragma unroll
        for (int ai = 0; ai < 2; ++ai)
#pragma unroll
            for (int m = 0; m < 4; ++m) {
                const int t = u.b + ai * 128 + wr * 64 + m * 16 + fr;
#pragma unroll
                for (int bj = 0; bj < 2; ++bj) {
                    const size_t o = (size_t)t * 1024 + u.a + bj * 128 + c8; const u32x4 x = xv[ai][m][bj];
                    const f32x4 x0 = {bf_lo(x.x), bf_hi(x.x), bf_lo(x.y), bf_hi(x.y)}, x1 = {bf_lo(x.z), bf_hi(x.z), bf_lo(x.w), bf_hi(x.w)};
                    *(GAS f32x4*)(PRE + o) = x0 * ALPHA + acc[ai][bj][m][0]; *(GAS f32x4*)(PRE + o + 4) = x1 * ALPHA + acc[ai][bj][m][1];
                }
            }
    }
};
struct DecMoe {
    const char* A; const char* W; int lda2, wexp2, ldb2; const LAS int* tile_e; int rs, nunits;
    __device__ __forceinline__ void operator()(int u0, Unit& o) const {
        const int u = xcd_perm(u0, rs, nunits);
        const int a = u >> 2, pn = u & 3, e = tile_e[a];
        o.A = A + (size_t)a * 256 * lda2; o.B = W + (size_t)e * wexp2 + (size_t)pn * 256 * ldb2; o.kind = 0; o.a = pn; o.b = a * 256; o.c = 0;
    }
};
struct EpiUp {
    bf16_t* H;
    __device__ __forceinline__ void operator()(const f32x4 (&acc)[2][2][4][2], const Unit& u, int wr, int wc, int fr, int fq) const {
        const int c8 = wc * 32 + fq * 8;
#pragma unroll
        for (int ai = 0; ai < 2; ++ai)
#pragma unroll
            for (int m = 0; m < 4; ++m) {
                const int r = u.b + ai * 128 + wr * 64 + m * 16 + fr;
                f32x4 g0 = acc[ai][0][m][0], g1 = acc[ai][0][m][1]; const f32x4 u0 = acc[ai][1][m][0], u1 = acc[ai][1][m][1];
#pragma unroll
                for (int i = 0; i < 4; ++i) { g0[i] = g0[i] * sigmoid_f(g0[i]) * u0[i]; g1[i] = g1[i] * sigmoid_f(g1[i]) * u1[i]; }
                *(GAS u32x4*)(H + (size_t)r * 512 + u.a * 128 + c8) = pack8(g0, g1);
            }
    }
};
struct EpiDown {
    bf16_t* Y;
    __device__ __forceinline__ void operator()(const f32x4 (&acc)[2][2][4][2], const Unit& u, int wr, int wc, int fr, int fq) const {
        const int c8 = wc * 32 + fq * 8;
#pragma unroll
        for (int ai = 0; ai < 2; ++ai)
#pragma unroll
            for (int m = 0; m < 4; ++m) {
                const int r = u.b + ai * 128 + wr * 64 + m * 16 + fr;
                bf16_t* yp = Y + (size_t)r * 1024 + u.a * 256 + c8;
#pragma unroll
                for (int bj = 0; bj < 2; ++bj) *(GAS u32x4*)(yp + bj * 128) = pack8(acc[ai][bj][m][0], acc[ai][bj][m][1]);
            }
    }
};

struct Params {
    const float* x; const float* w_in; const float* decay; const float* w_ret_o; const float* rpb; const float* w_na_o; const float* w_out;
    const float* ln_mix_g; const float* ln_mix_b; const float* router_w; const float* router_bias;
    const float* w_gate; const float* w_up; const float* w_down; const float* ln_ffn_g; const float* ln_ffn_b;
    float* out; unsigned char* ws; int ph_lo, ph_hi;
};
__device__ __forceinline__ Params load_params() {
    typedef __attribute__((address_space(4))) const Params CP;
    CP* pk = (CP*)__builtin_amdgcn_kernarg_segment_ptr();
    asm volatile("" : "+s"(pk));
    Params r;
    r.x = pk->x; r.w_in = pk->w_in; r.decay = pk->decay; r.w_ret_o = pk->w_ret_o; r.rpb = pk->rpb; r.w_na_o = pk->w_na_o; r.w_out = pk->w_out;
    r.ln_mix_g = pk->ln_mix_g; r.ln_mix_b = pk->ln_mix_b; r.router_w = pk->router_w; r.router_bias = pk->router_bias;
    r.w_gate = pk->w_gate; r.w_up = pk->w_up; r.w_down = pk->w_down; r.ln_ffn_g = pk->ln_ffn_g; r.ln_ffn_b = pk->ln_ffn_b;
    r.out = pk->out; r.ws = pk->ws; r.ph_lo = pk->ph_lo; r.ph_hi = pk->ph_hi;
    return r;
}
constexpr int CV_NIT = 16 * 352 + 32 * 32 + 16 * 32 + 16 * 32 + 3 * 32 * 256;
struct CvItem { const float* src; bf16_t* dst; int ldw, ldwt; };
__device__ __forceinline__ CvItem cv_decode(const Params& P, int l, unsigned char* ws, int r) {
    constexpr int I0 = 16 * 352, I1 = 32 * 32, I2 = 16 * 32, I3 = 16 * 32, I4 = 32 * 256;
    CvItem c;
    if (r < I0) { const int kb = r / 352, nb = r % 352; c.src = P.w_in + (size_t)l * 1024 * DIN + (size_t)kb * 64 * DIN + nb * 32; c.ldw = DIN; c.dst = (bf16_t*)(ws + WO_WIN) + (size_t)nb * 32 * 1024 + kb * 64; c.ldwt = 1024; return c; } r -= I0;
    if (r < I1) { const int kb = r >> 5, nb = r & 31; c.src = P.w_ret_o + (size_t)l * 2048 * 1024 + (size_t)kb * 64 * 1024 + nb * 32; c.ldw = 1024; c.dst = (bf16_t*)(ws + WO_WRET) + (size_t)nb * 32 * 2048 + kb * 64; c.ldwt = 2048; return c; } r -= I1;
    if (r < I2) { const int kb = r >> 5, nb = r & 31; c.src = P.w_na_o + (size_t)l * 1024 * 1024 + (size_t)kb * 64 * 1024 + nb * 32; c.ldw = 1024; c.dst = (bf16_t*)(ws + WO_WNA) + (size_t)nb * 32 * 1024 + kb * 64; c.ldwt = 1024; return c; } r -= I2;
    if (r < I3) { const int kb = r >> 5, nb = r & 31; c.src = P.w_out + (size_t)l * 1024 * 1024 + (size_t)kb * 64 * 1024 + nb * 32; c.ldw = 1024; c.dst = (bf16_t*)(ws + WO_WOUT) + (size_t)nb * 32 * 1024 + kb * 64; c.ldwt = 1024; return c; } r -= I3;
    if (r < 2 * I4) { const int up = r >= I4 ? 1 : 0; if (up) r -= I4; const int e = r >> 8, q = r & 255, kb = q >> 4, nb = q & 15, n0 = nb * 32;
        c.src = (up ? P.w_up : P.w_gate) + ((size_t)l * NE + e) * 1024 * 512 + (size_t)kb * 64 * 512 + n0; c.ldw = 512;
        c.dst = (bf16_t*)(ws + WO_WGU) + (size_t)(e * 1024 + (n0 >> 7) * 256 + up * 128 + (n0 & 127)) * 1024 + kb * 64; c.ldwt = 1024; return c; } r -= 2 * I4;
    { const int e = r >> 8, q = r & 255, kb = q >> 5, nb = q & 31;
      c.src = P.w_down + ((size_t)l * NE + e) * 512 * 1024 + (size_t)kb * 64 * 1024 + nb * 32; c.ldw = 1024; c.dst = (bf16_t*)(ws + WO_WD) + (size_t)(e * 1024 + nb * 32) * 512 + kb * 64; c.ldwt = 512; return c; }
}
__device__ __forceinline__ void cv_load(const CvItem& c, float (&wv)[32], int lane) {
#pragma unroll
    for (int i = 0; i < 32; ++i) wv[i] = ((const GAS float*)c.src)[(size_t)(2 * i + (lane >> 5)) * c.ldw + (lane & 31)];
}
__device__ __forceinline__ int cv_slot_items(int slot, int l) { return slot == 0 ? 7680 : slot == 1 ? (l == 0 ? 16384 : 8960) : slot == 2 ? (l + 1 < DEPTH ? 13824 : 8192) : (l + 1 < DEPTH ? 9472 : 0); }
__device__ __forceinline__ CvItem cv_item(const Params& P, int slot, int l, int v) {
    int ll = l, r;
    if (slot == 0) r = v;
    else if (slot == 1) r = 7680 + v;
    else if (slot == 2) { if (v < 8192) r = 24064 + v; else { ll = l + 1; r = v - 8192; } }
    else { ll = l + 1; r = v < 2048 ? 5632 + v : 16640 + (v - 2048); }
    return cv_decode(P, ll, P.ws + ws_wset(ll), r);
}
__device__ __forceinline__ void cv_transpose(const CvItem& cur, const float (&wv)[32], LAS float* scr, int lane) {
#pragma unroll
    for (int i = 0; i < 32; ++i) scr[(2 * i + (lane >> 5)) * 33 + (lane & 31)] = wv[i];
    LDS_WAIT();
    const int c = lane & 7;
#pragma unroll
    for (int j = 0; j < 4; ++j) { const int n = (lane >> 3) + 8 * j; const LAS float* s = scr + (8 * c) * 33 + n;
        u32x4 o; o.x = cvt_pk_bf16(s[0 * 33], s[1 * 33]); o.y = cvt_pk_bf16(s[2 * 33], s[3 * 33]); o.z = cvt_pk_bf16(s[4 * 33], s[5 * 33]); o.w = cvt_pk_bf16(s[6 * 33], s[7 * 33]);
        *(GAS u32x4*)(cur.dst + (size_t)n * cur.ldwt + 8 * c) = o; }
    LDS_WAIT();
}
__device__ __forceinline__ void convert_range(const Params& P, int slot, int l, LAS unsigned char* lds, int it0, int itend, int wave, int lane) {
    LAS float* scr = (LAS float*)(lds + wave * 16384);
    { const int tot = cv_slot_items(slot, l); if (itend > tot) itend = tot; }
    int it = it0 + wave; if (it >= itend) return;
    float wa[32], wb[32]; CvItem ca = cv_item(P, slot, l, it), cb = ca; cv_load(ca, wa, lane);
    if (it + 8 < itend) { cb = cv_item(P, slot, l, it + 8); cv_load(cb, wb, lane); }
    for (;;) {
        const int n2 = it + 16; const bool has2 = n2 < itend, has1 = it + 8 < itend;
        float wc[32]; CvItem cc = cb;
        if (has2) { cc = cv_item(P, slot, l, n2); cv_load(cc, wc, lane); }
        else {
#pragma unroll
            for (int i = 0; i < 32; ++i) wc[i] = 0.f;
        }
        cv_transpose(ca, wa, scr, lane);
        if (!has1) break;
#pragma unroll
        for (int i = 0; i < 32; ++i) { wa[i] = wb[i]; wb[i] = wc[i]; }
        ca = cb; cb = cc; it += 8;
    }
}
__device__ __forceinline__ void convert_share(const Params& P, int slot, int l, LAS unsigned char* lds, int a, int b, int idle, int part, int cap, int G, int bid, int wave, int lane) {
    const int S = b - a; int first = idle * cap; if (first > S) first = S;
    if (idle > 0 && part >= 0) { const int sl = (first + idle - 1) / idle, i0 = a + part * sl; int i1 = i0 + sl; if (i1 > a + first) i1 = a + first; if (i0 < i1) convert_range(P, slot, l, lds, i0, i1, wave, lane); }
    const int rest = S - first;
    if (rest > 0) { const int sl = (rest + G - 1) / G, i0 = a + first + bid * sl; int i1 = i0 + sl; if (i1 > b) i1 = b; if (i0 < i1) convert_range(P, slot, l, lds, i0, i1, wave, lane); }
}
__device__ __forceinline__ void sincos_d(double a, float& s, float& c) {
    const double k = rint(a * 0.63661977236758134308);
    double y = fma(-k, 1.5707963267948966192, a); y = fma(-k, 6.123233995736766036e-17, y);
    const double y2 = y * y;
    double sp = -1.0 / 1307674368000.0; sp = fma(sp, y2, 1.0 / 6227020800.0); sp = fma(sp, y2, -1.0 / 39916800.0); sp = fma(sp, y2, 1.0 / 362880.0); sp = fma(sp, y2, -1.0 / 5040.0); sp = fma(sp, y2, 1.0 / 120.0); sp = fma(sp, y2, -1.0 / 6.0); sp = fma(sp * y2, y, y);
    double cp = 1.0 / 20922789888000.0; cp = fma(cp, y2, -1.0 / 87178291200.0); cp = fma(cp, y2, 1.0 / 479001600.0); cp = fma(cp, y2, -1.0 / 3628800.0); cp = fma(cp, y2, 1.0 / 40320.0); cp = fma(cp, y2, -1.0 / 720.0); cp = fma(cp, y2, 1.0 / 24.0); cp = fma(cp, y2, -0.5); cp = fma(cp, y2, 1.0);
    const int q = (int)((long long)k & 3);
    const double sv = (q == 0) ? sp : (q == 1) ? cp : (q == 2) ? -sp : -cp;
    const double cv = (q == 0) ? cp : (q == 1) ? -sp : (q == 2) ? -cp : sp;
    s = (float)sv; c = (float)cv;
}
__device__ __forceinline__ void phase_init(const Params& P, LAS unsigned char* lds, int gw, int NGW, int wave, int lane) {
    unsigned char* ws = P.ws;
    float* frqt = (float*)(ws + WS_TAB);
    const int gtid = gw * 64 + lane, NT_ = NGW * 64;
    if (gtid < 128) {
        const double f = exp(-(double)gtid * (9.210340371976184 / 128.0)) * 0.15915494309189533577;
        const float fh = __uint_as_float(__float_as_uint((float)f) & 0xFFFFF000u);
        frqt[gtid] = fh; frqt[128 + gtid] = (float)(f - (double)fh);
    }
    bf16_t* wrt = (bf16_t*)(ws + WS_WRT);
    for (int i = gtid; i < DEPTH * 32 * 1024; i += NT_) {
        const int ll = i >> 15, e = (i >> 10) & 31, d = i & 1023; const float w = ((const GAS float*)P.router_w)[d * 32 + e] * ((const GAS float*)P.ln_mix_g)[ll * 1024 + d];
        const unsigned h = cvt_pk_bf16(w, 0.f) & 0xffffu; const unsigned lo = cvt_pk_bf16(w - bf_lo(h), 0.f) & 0xffffu;
        wrt[(size_t)ll * 65536 + e * 1024 + d] = (bf16_t)h; wrt[(size_t)ll * 65536 + 32768 + e * 1024 + d] = (bf16_t)lo;
    }
    float* rgc = (float*)(ws + WS_RGC);
    for (int it = gw; it < DEPTH * 32; it += NGW) {
        const int ll = it >> 5, e = it & 31; float sg = 0.f, sb = 0.f;
        for (int d = lane; d < 1024; d += 64) { const float w = ((const GAS float*)P.router_w)[d * 32 + e]; sg += w * ((const GAS float*)P.ln_mix_g)[ll * 1024 + d]; sb += w * ((const GAS float*)P.ln_mix_b)[ll * 1024 + d]; }
        sg = wave_sum(sg); sb = wave_sum(sb);
        if (lane == 0) { rgc[ll * 64 + e] = sg; rgc[ll * 64 + 32 + e] = sb; }
    }
    bf16_t* xb = (bf16_t*)(ws + WS_XB);
    for (int i = gtid; i < T * D / 8; i += NT_) {
        const f32x4 a = *(const GAS f32x4*)(P.x + (size_t)i * 8), b = *(const GAS f32x4*)(P.x + (size_t)i * 8 + 4);
        *(GAS u32x4*)(xb + (size_t)i * 8) = pack8(a, b);
    }
    convert_range(P, 0, 0, lds, (int)blockIdx.x * 30, (int)blockIdx.x * 30 + 30, wave, lane);
}
__device__ __forceinline__ void phase_prefix(const Params& P, int l, int gw, int NGW, int lane) {
    const float* KV = (const float*)(P.ws + WS_KV); bf16_t* BCAT = (bf16_t*)(P.ws + WS_BCAT);
    const float* decay = P.decay + l * 8;
    const int gtid = gw * 64 + lane, NT_ = NGW * 64;
    for (int idx = gtid; idx < 16 * 2 * 512 * 32; idx += NT_) {
        const int dg = idx & 31, e = (idx >> 5) & 511, dir = (idx >> 14) & 1, bh = idx >> 15, h = bh & 3;
        const float cd = fast_exp2(log2_sigmoid(decay[dir * 4 + h]) * 512.0f);
        f32x4 s0 = {0.f, 0.f, 0.f, 0.f}, s1 = {0.f, 0.f, 0.f, 0.f};
        for (int q = 0; q < 8; ++q) {
            const int cc = dir ? 7 - q : q;
            *(GAS u32x4*)(BCAT + ((size_t)(bh * 8 + cc) * 512 + e) * 1024 + 512 + dir * 256 + dg * 8) = pack8(s0, s1);
            if (q < 7) { const float* kp = KV + ((size_t)((bh * 8 + cc) * 2 + dir) * 512 + e) * 256 + dg * 8;
                s0 = s0 * cd + *(const GAS f32x4*)kp; s1 = s1 * cd + *(const GAS f32x4*)(kp + 4); }
        }
    }
}
__device__ __forceinline__ void phase_headnorm(const Params& P, int gw, int NGW, int lane) {
    const bf16_t* RET = (const bf16_t*)(P.ws + WS_KV); const bf16_t* SG = (const bf16_t*)(P.ws + WS_SG); bf16_t* AR = (bf16_t*)(P.ws + WS_KDT);
    for (int it0 = gw; it0 < T * 4; it0 += 4 * NGW) {
        u32x4 r[4], g[4];
#pragma unroll
        for (int k = 0; k < 4; ++k) { const int it = it0 + k * NGW; if (it < T * 4) { const size_t off = (size_t)it * 512 + lane * 8; r[k] = *(const GAS u32x4*)(RET + off); g[k] = *(const GAS u32x4*)(SG + off); } }
#pragma unroll
        for (int k = 0; k < 4; ++k) {
            const int it = it0 + k * NGW; if (it >= T * 4) break;
            const size_t off = (size_t)it * 512 + lane * 8;
            float v[8] = {bf_lo(r[k].x), bf_hi(r[k].x), bf_lo(r[k].y), bf_hi(r[k].y), bf_lo(r[k].z), bf_hi(r[k].z), bf_lo(r[k].w), bf_hi(r[k].w)};
            float s = 0.f;
#pragma unroll
            for (int i = 0; i < 8; ++i) s += v[i];
            const float mean = wave_sum(s) * (1.0f / 512.0f);
            float q = 0.f;
#pragma unroll
            for (int i = 0; i < 8; ++i) { v[i] -= mean; q += v[i] * v[i]; }
            const float rstd = 1.0f / sqrtf(wave_sum(q) * (1.0f / 512.0f) + 1e-5f);
            float gg[8] = {bf_lo(g[k].x), bf_hi(g[k].x), bf_lo(g[k].y), bf_hi(g[k].y), bf_lo(g[k].z), bf_hi(g[k].z), bf_lo(g[k].w), bf_hi(g[k].w)};
#pragma unroll
            for (int i = 0; i < 8; ++i) gg[i] = gg[i] * sigmoid_f(gg[i]) * rstd;
            u32x4 o; o.x = cvt_pk_bf16(v[0] * gg[0], v[1] * gg[1]); o.y = cvt_pk_bf16(v[2] * gg[2], v[3] * gg[3]);
            o.z = cvt_pk_bf16(v[4] * gg[4], v[5] * gg[5]); o.w = cvt_pk_bf16(v[6] * gg[6], v[7] * gg[7]);
            *(GAS u32x4*)(AR + off) = o;
        }
    }
}
__device__ __forceinline__ void headnorm_rows(const Params& P, int t0, int h, int wave, int lane) {
    const bf16_t* RET = (const bf16_t*)(P.ws + WS_KV); const bf16_t* SG = (const bf16_t*)(P.ws + WS_SG); bf16_t* AR = (bf16_t*)(P.ws + WS_KDT);
#pragma nounroll
    for (int rb = 0; rb < 32; rb += 4) {
        u32x4 r[4], g[4];
#pragma unroll
        for (int k = 0; k < 4; ++k) { const size_t off = ((size_t)(t0 + wave * 32 + rb + k) * 4 + h) * 512 + lane * 8; r[k] = *(const GAS u32x4*)(RET + off); g[k] = *(const GAS u32x4*)(SG + off); }
#pragma unroll
        for (int k = 0; k < 4; ++k) {
            const size_t off = ((size_t)(t0 + wave * 32 + rb + k) * 4 + h) * 512 + lane * 8;
            float v[8] = {bf_lo(r[k].x), bf_hi(r[k].x), bf_lo(r[k].y), bf_hi(r[k].y), bf_lo(r[k].z), bf_hi(r[k].z), bf_lo(r[k].w), bf_hi(r[k].w)};
            float s = 0.f;
#pragma unroll
            for (int i = 0; i < 8; ++i) s += v[i];
            const float mean = wave_sum(s) * (1.0f / 512.0f);
            float q = 0.f;
#pragma unroll
            for (int i = 0; i < 8; ++i) { v[i] -= mean; q += v[i] * v[i]; }
            const float rstd = 1.0f / sqrtf(wave_sum(q) * (1.0f / 512.0f) + 1e-5f);
            float gg[8] = {bf_lo(g[k].x), bf_hi(g[k].x), bf_lo(g[k].y), bf_hi(g[k].y), bf_lo(g[k].z), bf_hi(g[k].z), bf_lo(g[k].w), bf_hi(g[k].w)};
#pragma unroll
            for (int i = 0; i < 8; ++i) gg[i] = gg[i] * sigmoid_f(gg[i]) * rstd;
            u32x4 o; o.x = cvt_pk_bf16(v[0] * gg[0], v[1] * gg[1]); o.y = cvt_pk_bf16(v[2] * gg[2], v[3] * gg[3]);
            o.z = cvt_pk_bf16(v[4] * gg[4], v[5] * gg[5]); o.w = cvt_pk_bf16(v[6] * gg[6], v[7] * gg[7]);
            *(GAS u32x4*)(AR + off) = o;
        }
    }
}
__device__ __forceinline__ void headnorm_half0(const Params& P, LAS unsigned char* lds, int t0, int h, int wave, int lane) {
    const bf16_t* RET = (const bf16_t*)(P.ws + WS_KV); const bf16_t* SG = (const bf16_t*)(P.ws + WS_SG); bf16_t* AR = (bf16_t*)(P.ws + WS_KDT);
    const LAS f32x2* fin1 = (const LAS f32x2*)(lds + LDS_MISC + LM_HN_FIN1);
#pragma nounroll
    for (int rb = 0; rb < 32; rb += 8) {
        u32x4 r[4], g[4];
#pragma unroll
        for (int k = 0; k < 4; ++k) { const size_t off = ((size_t)(t0 + wave * 32 + rb + 2 * k + (lane >> 5)) * 4 + h) * 512 + (lane & 31) * 8; r[k] = *(const GAS u32x4*)(RET + off); g[k] = *(const GAS u32x4*)(SG + off); }
#pragma unroll
        for (int k = 0; k < 4; ++k) {
            const int row = wave * 32 + rb + 2 * k + (lane >> 5);
            const size_t off = ((size_t)(t0 + row) * 4 + h) * 512 + (lane & 31) * 8;
            const f32x2 st = fin1[row];
            const float v[8] = {bf_lo(r[k].x), bf_hi(r[k].x), bf_lo(r[k].y), bf_hi(r[k].y), bf_lo(r[k].z), bf_hi(r[k].z), bf_lo(r[k].w), bf_hi(r[k].w)};
            const float gg[8] = {bf_lo(g[k].x), bf_hi(g[k].x), bf_lo(g[k].y), bf_hi(g[k].y), bf_lo(g[k].z), bf_hi(g[k].z), bf_lo(g[k].w), bf_hi(g[k].w)};
            float o8[8];
#pragma unroll
            for (int i = 0; i < 8; ++i) o8[i] = (v[i] - st.x) * (gg[i] * sigmoid_f(gg[i]) * st.y);
            u32x4 o; o.x = cvt_pk_bf16(o8[0], o8[1]); o.y = cvt_pk_bf16(o8[2], o8[3]); o.z = cvt_pk_bf16(o8[4], o8[5]); o.w = cvt_pk_bf16(o8[6], o8[7]);
            *(GAS u32x4*)(AR + off) = o;
        }
    }
}
__device__ __forceinline__ void phase_na(const Params& P, int l, int gw, int NGW, int lane) {
    const bf16_t* QN = (const bf16_t*)(P.ws + WS_QN); const bf16_t* KN = (const bf16_t*)(P.ws + WS_KN); const bf16_t* VNT = (const bf16_t*)(P.ws + WS_VNT);
    bf16_t* NAO = (bf16_t*)(P.ws + WS_NAO);
    const float* rpb = P.rpb + (size_t)l * 16 * 15 * 31;
    const int fr = lane & 15, fq = lane >> 4;
    for (int id = gw; id < 16384; id += NGW) {
        const int cb = id & 3, r = (id >> 2) & 63, h = (id >> 8) & 15, b = id >> 12;
        const int rs = min(max(r - 4, 0), 56), c0 = cb * 16, cs = min(max(c0 - 8, 0), 32);
        const int c = c0 + fr, cst = min(max(c - 8, 0), 48);
        const size_t tq = (size_t)b * 4096 + r * 64 + c;
        const bf16x8 yq0 = *(const GAS bf16x8*)(QN + tq * 1024 + h * 64 + 8 * fq), yq1 = *(const GAS bf16x8*)(QN + tq * 1024 + h * 64 + 32 + 8 * fq);
        f32x4 S[16];
#pragma unroll
        for (int kt = 0; kt < 16; ++kt) {
            const int kr = rs + (kt >> 1), kcb = cs + (kt & 1) * 16;
            const size_t tk = (size_t)b * 4096 + kr * 64 + kcb + fr;
            const bf16x8 xk0 = *(const GAS bf16x8*)(KN + tk * 1024 + h * 64 + 8 * fq), xk1 = *(const GAS bf16x8*)(KN + tk * 1024 + h * 64 + 32 + 8 * fq);
            f32x4 z = {0.f, 0.f, 0.f, 0.f};
            z = __builtin_amdgcn_mfma_f32_16x16x32_bf16(xk0, yq0, z, 0, 0, 0);
            z = __builtin_amdgcn_mfma_f32_16x16x32_bf16(xk1, yq1, z, 0, 0, 0);
            const float* bp = rpb + (h * 15 + (kr - r + 7)) * 31;
#pragma unroll
            for (int j = 0; j < 4; ++j) {
                const int kc = kcb + 4 * fq + j; const bool valid = (kc >= cst) && (kc < cst + 16);
                const int co = min(max(kc - c + 15, 0), 30);
                const float bias = ((const GAS float*)bp)[co];
                z[j] = valid ? z[j] + bias : -INFINITY;
            }
            S[kt] = z;
        }
        float mx = -INFINITY;
#pragma unroll
        for (int kt = 0; kt < 16; ++kt)
#pragma unroll
            for (int j = 0; j < 4; ++j) mx = fmaxf(mx, S[kt][j]);
        mx = fmaxf(mx, __shfl_xor(mx, 16)); mx = fmaxf(mx, __shfl_xor(mx, 32));
        float sum = 0.f;
#pragma unroll
        for (int kt = 0; kt < 16; ++kt)
#pragma unroll
            for (int j = 0; j < 4; ++j) { const float p = fast_exp2((S[kt][j] - mx) * LOG2E); S[kt][j] = p; sum += p; }
        sum += __shfl_xor(sum, 16); sum += __shfl_xor(sum, 32);
        f32x4 O[4];
#pragma unroll
        for (int ht = 0; ht < 4; ++ht) O[ht] = (f32x4){0.f, 0.f, 0.f, 0.f};
#pragma unroll
        for (int p = 0; p < 8; ++p) {
            const u32x4 yw = pack8(S[2 * p], S[2 * p + 1]);
            const bf16x8 yp = __builtin_bit_cast(bf16x8, yw);
            const size_t sk = (size_t)(rs + p) * 64 + cs + 4 * fq;
#pragma unroll
            for (int ht = 0; ht < 4; ++ht) {
                const bf16_t* vp = VNT + ((size_t)b * 1024 + h * 64 + ht * 16 + fr) * 4096 + sk;
                const u32x2 lo = *(const GAS u32x2*)vp, hi = *(const GAS u32x2*)(vp + 16);
                const u32x4 xw = {lo.x, lo.y, hi.x, hi.y};
                O[ht] = __builtin_amdgcn_mfma_f32_16x16x32_bf16(__builtin_bit_cast(bf16x8, xw), yp, O[ht], 0, 0, 0);
            }
        }
        const float inv = 1.0f / sum;
#pragma unroll
        for (int ht = 0; ht < 4; ++ht) *(GAS u32x2*)(NAO + tq * 1024 + h * 64 + ht * 16 + 4 * fq) = pack4(O[ht] * inv);
    }
}
constexpr int LM_BIAS = 4096;
__device__ __forceinline__ void phase_na2(const Params& P, int l, LAS unsigned char* lds, int tid, int wave, int lane, int vG, int vbid) {
    const bf16_t* QN = (const bf16_t*)(P.ws + WS_QN); const bf16_t* KN = (const bf16_t*)(P.ws + WS_KN); const bf16_t* VNT = (const bf16_t*)(P.ws + WS_VNT);
    bf16_t* NAO = (bf16_t*)(P.ws + WS_NAO);
    const float* rpb = P.rpb + (size_t)l * 16 * 15 * 31;
    LAS unsigned char* Ks = lds; LAS unsigned char* Vs = lds + 65536;
    LAS float* bias_s = (LAS float*)(lds + LDS_MISC + LM_BIAS);
    const int fr = lane & 15, fq = lane >> 4;
    const int prow = tid >> 3, pc = (tid & 7) ^ ((prow >> 1) & 7);
#define NA_BAR() do { asm volatile("s_waitcnt lgkmcnt(0)" ::: "memory"); __builtin_amdgcn_s_barrier(); asm volatile("" ::: "memory"); } while (0)
#define NA_LOAD_K(kr) __builtin_amdgcn_global_load_lds((const unsigned*)(kbase + ((size_t)((kr) * 64 + prow)) * 2048 + pc * 16), (LAS unsigned*)(Ks + ((kr) & 7) * 8192 + wave * 1024), 16, 0, 0)
#define NA_LOAD_V(kr) __builtin_amdgcn_global_load_lds((const unsigned*)(vbase + (size_t)prow * 8192 + (kr) * 128 + pc * 16), (LAS unsigned*)(Vs + ((kr) & 7) * 8192 + wave * 1024), 16, 0, 0)
    for (int bu = launder_si(vbid); bu < 256; bu += vG) {
        const int sg = bu & 3, h = (bu >> 2) & 15, b = bu >> 6;
        const char* kbase = (const char*)(KN + (size_t)b * 4096 * 1024 + h * 64);
        const char* vbase = (const char*)(VNT + ((size_t)b * 1024 + h * 64) * 4096);
        asm volatile("s_waitcnt vmcnt(0)" ::: "memory"); NA_BAR();
        for (int i = tid; i < 465; i += 512) bias_s[i] = ((const GAS float*)rpb)[h * 465 + i];
        const int r0 = sg * 16, rs0 = min(max(r0 - 4, 0), 56);
#pragma unroll
        for (int q = 0; q < 8; ++q) { NA_LOAD_K(rs0 + q); NA_LOAD_V(rs0 + q); }
        const int cb = wave & 3, c0 = cb * 16, cs = min(max(c0 - 8, 0), 32), c = c0 + fr, cst = min(max(c - 8, 0), 48);
        bf16x8 yq0, yq1;
        { const size_t tq = (size_t)b * 4096 + r0 * 64 + c; yq0 = *(const GAS bf16x8*)(QN + tq * 1024 + h * 64 + 8 * fq); yq1 = *(const GAS bf16x8*)(QN + tq * 1024 + h * 64 + 32 + 8 * fq); }
#pragma nounroll
        for (int r = r0; r < r0 + 16; ++r) {
            const int rs = min(max(r - 4, 0), 56), rsn = min(max(r - 3, 0), 56);
            const bool mv = (r + 1 < r0 + 16) && (rsn != rs);
            asm volatile("s_waitcnt vmcnt(0)" ::: "memory"); NA_BAR();
            const bf16x8 q0 = yq0, q1 = yq1;
            const size_t tq = (size_t)b * 4096 + r * 64 + c;
            if (r + 1 < r0 + 16) { const size_t tn = tq + 64; yq0 = *(const GAS bf16x8*)(QN + tn * 1024 + h * 64 + 8 * fq); yq1 = *(const GAS bf16x8*)(QN + tn * 1024 + h * 64 + 32 + 8 * fq); }
            f32x4 S[16];
            if (wave < 4) {
#pragma unroll
                for (int kt = 0; kt < 16; ++kt) {
                    const int kr = rs + (kt >> 1), kcb = cs + (kt & 1) * 16, key = kcb + fr;
                    const LAS unsigned char* kp = Ks + (kr & 7) * 8192 + key * 128; const int sw = (key >> 1) & 7;
                    const bf16x8 xk0 = *(const LAS bf16x8*)(kp + ((fq ^ sw) << 4)), xk1 = *(const LAS bf16x8*)(kp + (((4 + fq) ^ sw) << 4));
                    f32x4 z = {0.f, 0.f, 0.f, 0.f};
                    z = __builtin_amdgcn_mfma_f32_16x16x32_bf16(xk0, q0, z, 0, 0, 0);
                    z = __builtin_amdgcn_mfma_f32_16x16x32_bf16(xk1, q1, z, 0, 0, 0);
                    const LAS float* bp = bias_s + (kr - r + 7) * 31;
#pragma unroll
                    for (int j = 0; j < 4; ++j) {
                        const int kc = kcb + 4 * fq + j; const bool valid = (kc >= cst) && (kc < cst + 16);
                        const int co = min(max(kc - c + 15, 0), 30);
                        z[j] = valid ? z[j] + bp[co] : -INFINITY;
                    }
                    S[kt] = z;
                }
            }
            NA_BAR();
            if (mv) NA_LOAD_K(rs + 8);
            f32x4 O[4]; float inv = 0.f;
            if (wave < 4) {
                float mx = -INFINITY;
#pragma unroll
                for (int kt = 0; kt < 16; ++kt)
#pragma unroll
                    for (int j = 0; j < 4; ++j) mx = fmaxf(mx, S[kt][j]);
                mx = fmaxf(mx, __shfl_xor(mx, 16)); mx = fmaxf(mx, __shfl_xor(mx, 32));
                float sum = 0.f;
#pragma unroll
                for (int kt = 0; kt < 16; ++kt)
#pragma unroll
                    for (int j = 0; j < 4; ++j) { const float p = fast_exp2((S[kt][j] - mx) * LOG2E); S[kt][j] = p; sum += p; }
                sum += __shfl_xor(sum, 16); sum += __shfl_xor(sum, 32);
                inv = 1.0f / sum;
#pragma unroll
                for (int ht = 0; ht < 4; ++ht) O[ht] = (f32x4){0.f, 0.f, 0.f, 0.f};
            }
#pragma unroll
            for (int p = 0; p < 8; ++p) {
                if (wave < 4) {
                    const bf16x8 yp = __builtin_bit_cast(bf16x8, pack8(S[2 * p], S[2 * p + 1]));
                    const LAS unsigned char* vrow = Vs + ((rs + p) & 7) * 8192;
#pragma unroll
                    for (int ht = 0; ht < 4; ++ht) {
                        const int ch = ht * 16 + fr, sw = (ch >> 1) & 7, pc0 = (cs >> 3) + (fq >> 1);
                        const LAS unsigned char* vp = vrow + ch * 128 + (fq & 1) * 8;
                        const u32x2 lo = *(const LAS u32x2*)(vp + ((pc0 ^ sw) << 4)), hi = *(const LAS u32x2*)(vp + (((pc0 + 2) ^ sw) << 4));
                        const u32x4 xw = {lo.x, lo.y, hi.x, hi.y};
                        O[ht] = __builtin_amdgcn_mfma_f32_16x16x32_bf16(__builtin_bit_cast(bf16x8, xw), yp, O[ht], 0, 0, 0);
                    }
                }
                if (p == 0) { NA_BAR(); if (mv) NA_LOAD_V(rs + 8); }
            }
            if (wave < 4) {
#pragma unroll
                for (int ht = 0; ht < 4; ++ht) *(GAS u32x2*)(NAO + tq * 1024 + h * 64 + ht * 16 + 4 * fq) = pack4(O[ht] * inv);
            }
        }
    }
    asm volatile("s_waitcnt vmcnt(0)" ::: "memory"); NA_BAR();
#undef NA_BAR
#undef NA_LOAD_K
#undef NA_LOAD_V
}
__device__ __forceinline__ void glds16_asm(const void* gsrc, unsigned lds_dst) {
    unsigned keep;
    asm volatile("s_mov_b32 %0, m0\n\ts_mov_b32 m0, %2\n\ts_nop 0\n\tglobal_load_lds_dwordx4 %1, off\n\ts_mov_b32 m0, %0" : "=&s"(keep) : "v"(gsrc), "s"(lds_dst) : "memory");
}
__device__ __forceinline__ void phase_na3(const Params& P, int l, LAS unsigned char* lds, int tid, int wave, int lane, int vG, int vbid) {
    const bf16_t* QN = (const bf16_t*)(P.ws + WS_QN); const bf16_t* KN = (const bf16_t*)(P.ws + WS_KN); const bf16_t* VNT = (const bf16_t*)(P.ws + WS_VNT);
    bf16_t* NAO = (bf16_t*)(P.ws + WS_NAO);
    const float* rpb = P.rpb + (size_t)l * 16 * 15 * 31;
    LAS unsigned char* Ks = lds; LAS unsigned char* Vs = lds + 73728;
    const unsigned ks_lds = (unsigned)(uintptr_t)Ks, vs_lds = (unsigned)(uintptr_t)Vs;
    LAS float* bias_s = (LAS float*)(lds + LDS_MISC + LM_BIAS);
    const int fr = lane & 15, fq = lane >> 4;
    const int prow = tid >> 3, pc = (tid & 7) ^ ((prow >> 1) & 7);
    const int grp = wave >> 2, cb = wave & 3, c0 = cb * 16, cs = min(max(c0 - 8, 0), 32), c = c0 + fr, cst = min(max(c - 8, 0), 48);
    int co[2][4]; bool vd[2][4];
#pragma unroll
    for (int t = 0; t < 2; ++t)
#pragma unroll
        for (int j = 0; j < 4; ++j) { const int kc = cs + 8 * fq + 4 * t + j;     vd[t][j] = (kc >= cst) && (kc < cst + 16); co[t][j] = min(max(kc - c + 15, 0), 30); }
#define NA_BAR() do { asm volatile("s_waitcnt lgkmcnt(0)" ::: "memory"); __builtin_amdgcn_s_barrier(); asm volatile("" ::: "memory"); } while (0)
#define NA_LOAD_K(kr) glds16_asm(kbase + ((size_t)((kr) * 64 + prow)) * 2048 + pc * 16, ks_lds + (unsigned)(((kr) % 9) * 8192 + wave * 1024))
#define NA_LOAD_V(kr) glds16_asm(vbase + (size_t)prow * 8192 + (kr) * 128 + pc * 16, vs_lds + (unsigned)(((kr) % 9) * 8192 + wave * 1024))
    for (int bu = launder_si(vbid); bu < 256; bu += vG) {
        const int sg = bu & 3, h = (bu >> 2) & 15, b = bu >> 6;
        const char* kbase = (const char*)(KN + (size_t)b * 4096 * 1024 + h * 64);
        const char* vbase = (const char*)(VNT + ((size_t)b * 1024 + h * 64) * 4096);
        asm volatile("s_waitcnt vmcnt(0)" ::: "memory"); NA_BAR();
        for (int i = tid; i < 465; i += 512) bias_s[i] = ((const GAS float*)rpb)[h * 465 + i] * LOG2E;
        const int r0 = sg * 16;
        { const int lo = min(max(r0 - 4, 0), 56), hi = min(max(r0 - 3, 0), 56) + 7;
#pragma nounroll
          for (int kr = lo; kr <= hi; ++kr) { NA_LOAD_K(kr); NA_LOAD_V(kr); } }
        bf16x8 yq0, yq1;
        { const size_t tq = (size_t)b * 4096 + (r0 + grp) * 64 + c; yq0 = *(const GAS bf16x8*)(QN + tq * 1024 + h * 64 + 8 * fq); yq1 = *(const GAS bf16x8*)(QN + tq * 1024 + h * 64 + 32 + 8 * fq); }
        int boff = -100; f32x4 breg[16]; int nprev = -1;
        asm volatile("" : "+v"(yq0), "+v"(yq1));
#pragma unroll
        for (int kt = 0; kt < 16; ++kt) breg[kt] = (f32x4){0.f, 0.f, 0.f, 0.f};
#pragma nounroll
        for (int st = 0; st < 8; ++st) {
            const int rA = r0 + 2 * st, r = rA + grp, rs = min(max(r - 4, 0), 56);
            const int chi = min(max(rA - 3, 0), 56) + 7, nhi = min(max(rA - 1, 0), 56) + 7;
            const bool more = st < 7;
            if (nprev < 0) asm volatile("s_waitcnt vmcnt(0)" ::: "memory"); else if (nprev == 2) asm volatile("s_waitcnt vmcnt(6)" ::: "memory"); else asm volatile("s_waitcnt vmcnt(5)" ::: "memory");
            NA_BAR();
            const bf16x8 q0 = yq0, q1 = yq1;
            const size_t tq = (size_t)b * 4096 + r * 64 + c;
            if (more) { const size_t tn = tq + 128; yq0 = *(const GAS bf16x8*)(QN + tn * 1024 + h * 64 + 8 * fq); yq1 = *(const GAS bf16x8*)(QN + tn * 1024 + h * 64 + 32 + 8 * fq); }
            const int off = rs - r + 7;
            if (off != boff) {
                boff = off;
#pragma unroll
                for (int kt = 0; kt < 16; ++kt)
#pragma unroll
                    for (int j = 0; j < 4; ++j) { const float bv = bias_s[(off + (kt >> 1)) * 31 + co[kt & 1][j]]; breg[kt][j] = vd[kt & 1][j] ? bv : -INFINITY; }
            }
            f32x4 S[16];
#pragma unroll
            for (int kb = 0; kb < 16; kb += 4) {
                bf16x8 xk[4][2];
#pragma unroll
                for (int q = 0; q < 4; ++q) { const int kt = kb + q;
                    const int kr = rs + (kt >> 1), key = cs + 8 * (fr >> 2) + 4 * (kt & 1) + (fr & 3);
                    const LAS unsigned char* kp = Ks + (kr % 9) * 8192 + key * 128; const int sw = (key >> 1) & 7;
                    xk[q][0] = *(const LAS bf16x8*)(kp + ((fq ^ sw) << 4)); xk[q][1] = *(const LAS bf16x8*)(kp + (((4 + fq) ^ sw) << 4)); }
                __builtin_amdgcn_sched_barrier(0);
#pragma unroll
                for (int q = 0; q < 4; ++q) S[kb + q] = __builtin_amdgcn_mfma_f32_16x16x32_bf16(xk[q][0], q0, breg[kb + q], 0, 0, 0);
#pragma unroll
                for (int q = 0; q < 4; ++q) S[kb + q] = __builtin_amdgcn_mfma_f32_16x16x32_bf16(xk[q][1], q1, S[kb + q], 0, 0, 0);
                __builtin_amdgcn_sched_barrier(0);
            }
            if (more) asm volatile("s_waitcnt vmcnt(6)" ::: "memory"); else asm volatile("s_waitcnt vmcnt(4)" ::: "memory");
            NA_BAR();
            asm volatile("" : "+v"(yq0), "+v"(yq1));
            if (more) {
#pragma nounroll
                for (int kr = chi + 1; kr <= nhi; ++kr) NA_LOAD_K(kr);
            }
            nprev = more ? nhi - chi : 0;
            float mx = -INFINITY;
#pragma unroll
            for (int kt = 0; kt < 16; ++kt)
#pragma unroll
                for (int j = 0; j < 4; ++j) mx = fmaxf(mx, S[kt][j]);
            mx = fmaxf(mx, __shfl_xor(mx, 16)); mx = fmaxf(mx, __shfl_xor(mx, 32));
            float sum = 0.f;
#pragma unroll
            for (int kt = 0; kt < 16; ++kt)
#pragma unroll
                for (int j = 0; j < 4; ++j) { const float p = fast_exp2(S[kt][j] - mx); S[kt][j] = p; sum += p; }
            sum += __shfl_xor(sum, 16); sum += __shfl_xor(sum, 32);
            const float inv = 1.0f / sum;
            f32x4 O[4];
#pragma unroll
            for (int ht = 0; ht < 4; ++ht) O[ht] = (f32x4){0.f, 0.f, 0.f, 0.f};
#pragma unroll
            for (int p = 0; p < 8; ++p) {
                const bf16x8 yp = __builtin_bit_cast(bf16x8, pack8(S[2 * p], S[2 * p + 1]));
                const LAS unsigned char* vrow = Vs + ((rs + p) % 9) * 8192;
                bf16x8 xv[4];
#pragma unroll
                for (int ht = 0; ht < 4; ++ht) {
                    const int ch = ht * 16 + fr, sw = (ch >> 1) & 7, pc0 = (cs >> 3) + fq;
                    xv[ht] = *(const LAS bf16x8*)(vrow + ch * 128 + ((pc0 ^ sw) << 4));
                }
#pragma unroll
                for (int ht = 0; ht < 4; ++ht) O[ht] = __builtin_amdgcn_mfma_f32_16x16x32_bf16(xv[ht], yp, O[ht], 0, 0, 0);
                if (p == 1) {
                    NA_BAR();
                    if (more) {
#pragma nounroll
                        for (int kr = chi + 1; kr <= nhi; ++kr) NA_LOAD_V(kr);
                    }
                }
            }
#pragma unroll
            for (int ht = 0; ht < 4; ++ht) *(GAS u32x2*)(NAO + tq * 1024 + h * 64 + ht * 16 + 4 * fq) = pack4(O[ht] * inv);
        }
    }
    asm volatile("s_waitcnt vmcnt(0)" ::: "memory"); NA_BAR();
#undef NA_BAR
#undef NA_LOAD_K
#undef NA_LOAD_V
}
__device__ __forceinline__ void ln_row(f32x4 (&v)[4], const f32x4 (&g)[4], const f32x4 (&bb)[4]) {
    float s = 0.f;
#pragma unroll
    for (int j = 0; j < 4; ++j) s += (v[j][0] + v[j][1]) + (v[j][2] + v[j][3]);
    const float mean = wave_sum(s) * (1.0f / 1024.0f);
    float q = 0.f;
#pragma unroll
    for (int j = 0; j < 4; ++j) { v[j] = v[j] - mean; q += (v[j][0] * v[j][0] + v[j][1] * v[j][1]) + (v[j][2] * v[j][2] + v[j][3] * v[j][3]); }
    const float rstd = 1.0f / sqrtf(wave_sum(q) * (1.0f / 1024.0f) + 1e-5f);
#pragma unroll
    for (int j = 0; j < 4; ++j) v[j] = v[j] * rstd * g[j] + bb[j];
}
__device__ __forceinline__ void ln_row_stats(f32x4 (&v)[4], const f32x4 (&g)[4], const f32x4 (&bb)[4], float& mean_o, float& rstd_o) {
    float s = 0.f;
#pragma unroll
    for (int j = 0; j < 4; ++j) s += (v[j][0] + v[j][1]) + (v[j][2] + v[j][3]);
    const float mean = wave_sum(s) * (1.0f / 1024.0f);
    float q = 0.f;
#pragma unroll
    for (int j = 0; j < 4; ++j) { v[j] = v[j] - mean; q += (v[j][0] * v[j][0] + v[j][1] * v[j][1]) + (v[j][2] * v[j][2] + v[j][3] * v[j][3]); }
    const float rstd = 1.0f / sqrtf(wave_sum(q) * (1.0f / 1024.0f) + 1e-5f);
#pragma unroll
    for (int j = 0; j < 4; ++j) v[j] = v[j] * rstd * g[j] + bb[j];
    mean_o = mean; rstd_o = rstd;
}
__device__ __forceinline__ void phase_ln_router(const Params& P, int l, LAS unsigned char* lds, int wave, int lane) {
    unsigned char* ws = P.ws;
    const bf16_t* PREB = (const bf16_t*)(ws + WS_ACAT); bf16_t* X1B = (bf16_t*)(ws + WS_K);
    const float* PL = (const float*)(ws + WS_PL); const float* PS = (const float*)(ws + WS_PS);
    const float* rgc = (const float*)(ws + WS_RGC) + l * 64;
    LAS float* rstat = (LAS float*)(lds + LDS_MISC + LM_RSTAT);
    int* tok_e = (int*)(ws + WS_TOK); int* tok_rank = tok_e + T * 2; float* tok_w = (float*)(tok_rank + T * 2);
    int* HT = (int*)(ws + WS_HT) + (size_t)l * (T / 64) * 32;
    LAS int* hist = (LAS int*)(lds + LDS_MISC + LM_HIST); LAS int* basee = (LAS int*)(lds + LDS_MISC + LM_BASE); LAS int* rowi = (LAS int*)(lds + LDS_MISC + LM_ROW);
    const int tid = launder_v((int)threadIdx.x);
    const int fr = lane & 15, fq = lane >> 4;
    f32x4 g[4], bb[4];
#pragma unroll
    for (int j = 0; j < 4; ++j) { g[j] = *(const GAS f32x4*)(P.ln_mix_g + l * 1024 + 4 * lane + 256 * j); bb[j] = *(const GAS f32x4*)(P.ln_mix_b + l * 1024 + 4 * lane + 256 * j); }
    if ((int)blockIdx.x < 80) ((GAS int*)(ws + WS_SRC))[(int)blockIdx.x * 512 + tid] = 0;
    for (int chunk = launder_si((int)blockIdx.x); chunk < T / 64; chunk += gridDim.x) {
        if (tid < 32) hist[tid] = 0;
        {
            const int ta = chunk * 64 + wave * 8;
            u32x2 va[8][4]; f32x4 pa[8], pb2[8];
#pragma unroll
            for (int k = 0; k < 8; ++k) {
#pragma unroll
                for (int j = 0; j < 4; ++j) va[k][j] = *(const GAS u32x2*)(PREB + (size_t)(ta + k) * 1024 + 4 * lane + 256 * j);
                pa[k] = *(const GAS f32x4*)(PS + (size_t)(ta + k) * 8); pb2[k] = *(const GAS f32x4*)(PS + (size_t)(ta + k) * 8 + 4);
            }
            __builtin_amdgcn_sched_barrier(0);
#pragma unroll
            for (int k = 0; k < 8; ++k) {
                const float S1 = (pa[k][0] + pa[k][2]) + (pb2[k][0] + pb2[k][2]), S2 = (pa[k][1] + pa[k][3]) + (pb2[k][1] + pb2[k][3]);
                const float mean = S1 * (1.0f / 1024.0f), var = fmaxf(S2 * (1.0f / 1024.0f) - mean * mean, 0.f), rstd = 1.0f / sqrtf(var + 1e-5f);
                if (lane == 0) { rstat[(wave * 8 + k) * 2] = mean; rstat[(wave * 8 + k) * 2 + 1] = rstd; }
#pragma unroll
                for (int j = 0; j < 4; ++j) {
                    f32x4 v = {bf_lo(va[k][j].x), bf_hi(va[k][j].x), bf_lo(va[k][j].y), bf_hi(va[k][j].y)};
                    v = (v - mean) * rstd * g[j] + bb[j];
                    *(GAS u32x2*)(X1B + (size_t)(ta + k) * 1024 + 4 * lane + 256 * j) = pack4(v);
                }
            }
        }
        VM_WAIT();
        __syncthreads();
        if (wave < 4) {
            const int t0 = chunk * 64 + wave * 16;
            f32x4 acc0 = {0.f, 0.f, 0.f, 0.f}, acc1 = {0.f, 0.f, 0.f, 0.f};
            { const float* pl = PL + (size_t)(t0 + fr) * 128 + 4 * fq;
#pragma unroll
              for (int pn = 0; pn < 4; ++pn) { acc0 = acc0 + *(const GAS f32x4*)(pl + pn * 32); acc1 = acc1 + *(const GAS f32x4*)(pl + pn * 32 + 16); } }
            const f32x4 rb0 = *(const GAS f32x4*)(P.router_bias + 4 * fq), rb1 = *(const GAS f32x4*)(P.router_bias + 16 + 4 * fq);
            const f32x4 gw0 = *(const GAS f32x4*)(rgc + 4 * fq), gw1 = *(const GAS f32x4*)(rgc + 16 + 4 * fq), cc0 = *(const GAS f32x4*)(rgc + 32 + 4 * fq), cc1 = *(const GAS f32x4*)(rgc + 48 + 4 * fq);
            const float rmean = rstat[(wave * 16 + fr) * 2], rrstd = rstat[(wave * 16 + fr) * 2 + 1];
            f32x4 sc0, sc1, se0, se1;
#pragma unroll
            for (int j = 0; j < 4; ++j) { const float l0 = rrstd * (acc0[j] - rmean * gw0[j]) + cc0[j], l1 = rrstd * (acc1[j] - rmean * gw1[j]) + cc1[j];
                sc0[j] = 1.0f / (1.0f + expf(-l0)); sc1[j] = 1.0f / (1.0f + expf(-l1)); se0[j] = sc0[j] + rb0[j]; se1[j] = sc1[j] + rb1[j]; }
            float gs0, gs1;
            { const float a = fmaxf(se0[0], se0[1]), b2 = fminf(se0[0], se0[1]), c = fmaxf(se0[2], se0[3]), d2 = fminf(se0[2], se0[3]); gs0 = fmaxf(a, c) + fmaxf(fminf(a, c), fmaxf(b2, d2)); }
            { const float a = fmaxf(se1[0], se1[1]), b2 = fminf(se1[0], se1[1]), c = fmaxf(se1[2], se1[3]), d2 = fminf(se1[2], se1[3]); gs1 = fmaxf(a, c) + fmaxf(fminf(a, c), fmaxf(b2, d2)); }
            float bs = gs0; int bg = fq;
            if (gs1 > gs0) { bs = gs1; bg = 4 + fq; }
#pragma unroll
            for (int o = 16; o < 64; o <<= 1) { const float os = __shfl_xor(bs, o); const int og = __shfl_xor(bg, o); if (os > bs || (os == bs && og < bg)) { bs = os; bg = og; } }
            if ((bg & 3) == fq) {
                const bool hi = bg >= 4;
                const float u0 = hi ? se1[0] : se0[0], u1 = hi ? se1[1] : se0[1], u2 = hi ? se1[2] : se0[2], u3 = hi ? se1[3] : se0[3];
                const float p0 = hi ? sc1[0] : sc0[0], p1 = hi ? sc1[1] : sc0[1], p2 = hi ? sc1[2] : sc0[2], p3 = hi ? sc1[3] : sc0[3];
                int i1 = 0; float t1 = u0;
                if (u1 > t1) { t1 = u1; i1 = 1; } if (u2 > t1) { t1 = u2; i1 = 2; } if (u3 > t1) { t1 = u3; i1 = 3; }
                int i2 = -1; float t2 = -INFINITY;
                if (i1 != 0 && u0 > t2) { t2 = u0; i2 = 0; } if (i1 != 1 && u1 > t2) { t2 = u1; i2 = 1; } if (i1 != 2 && u2 > t2) { t2 = u2; i2 = 2; } if (i1 != 3 && u3 > t2) { t2 = u3; i2 = 3; }
                if (i2 < 0) i2 = (i1 + 1) & 3;
                const float s1 = i1 == 0 ? p0 : i1 == 1 ? p1 : i1 == 2 ? p2 : p3, s2 = i2 == 0 ? p0 : i2 == 1 ? p1 : i2 == 2 ? p2 : p3, inv = 1.0f / (s1 + s2);
                const int e1 = 4 * bg + i1, e2 = 4 * bg + i2;
                const int r1 = __hip_atomic_fetch_add(hist + e1, 1, __ATOMIC_RELAXED, __HIP_MEMORY_SCOPE_WORKGROUP);
                const int r2 = __hip_atomic_fetch_add(hist + e2, 1, __ATOMIC_RELAXED, __HIP_MEMORY_SCOPE_WORKGROUP);
                const int q = wave * 16 + fr;
                rowi[q] = e1; rowi[64 + q] = e2; rowi[128 + q] = r1; rowi[192 + q] = r2; rowi[256 + q] = __float_as_int(s1 * inv); rowi[320 + q] = __float_as_int(s2 * inv);
            }
        }
        __syncthreads();
        if (tid < 32) HT[chunk * 32 + tid] = hist[tid];
        if (tid < 64) {
            const int t = chunk * 64 + tid, e1 = rowi[tid], e2 = rowi[64 + tid];
            tok_e[2 * t] = e1; tok_e[2 * t + 1] = e2;
            tok_rank[2 * t] = rowi[128 + tid]; tok_rank[2 * t + 1] = rowi[192 + tid];
            tok_w[2 * t] = __int_as_float(rowi[256 + tid]); tok_w[2 * t + 1] = __int_as_float(rowi[320 + tid]);
        }
        __syncthreads();
    }
}
constexpr int LM_BASES = 3584;
constexpr int LM_GSRC = 8192;
__device__ __forceinline__ void build_tiles(const Params& P, int l, LAS unsigned char* lds, int mychunk) {
    const int* HT = (const int*)(P.ws + WS_HT) + (size_t)l * (T / 64) * 32;
    LAS int* tstart = (LAS int*)(lds + LDS_MISC + LM_TSTART); LAS int* tile_e = (LAS int*)(lds + LDS_MISC + LM_TILEE); LAS int* ntp = (LAS int*)(lds + LDS_MISC + LM_NT);
    LAS int* bases = (LAS int*)(lds + LDS_MISC + LM_BASES);
    LAS int* part = (LAS int*)lds;
    const int tid = launder_v((int)threadIdx.x), e = tid & 31, seg = tid >> 5;
    __syncthreads();
    { int tot = 0, bas = 0;
#pragma unroll
      for (int i = 0; i < 16; ++i) { const int c = seg * 16 + i, v = ((const GAS int*)HT)[c * 32 + e]; tot += v; bas += (c < mychunk) ? v : 0; }
      part[seg * 32 + e] = tot; part[512 + seg * 32 + e] = bas; }
    __syncthreads();
    if (tid < 32) { int tot = 0, bas = 0;
#pragma unroll
        for (int s = 0; s < 16; ++s) { tot += part[s * 32 + tid]; bas += part[512 + s * 32 + tid]; }
        bases[tid] = bas;
        const int nte = (tot + 255) >> 8; int v = nte;
#pragma unroll
        for (int o = 1; o < 32; o <<= 1) { const int u = __shfl_up(v, o); if (tid >= o) v += u; }
        tstart[tid] = v - nte; if (tid == 31) { tstart[32] = v; ntp[0] = v < 160 ? v : 160; } }
    __syncthreads();
    if (tid < 192) { int q = 0;
#pragma unroll
        for (int j = 1; j < 32; ++j) q += (tid >= tstart[j]) ? 1 : 0;
        if (tid < tstart[32]) tile_e[tid] = q; }
    __syncthreads();
}
__device__ __forceinline__ void phase_gather(const Params& P, int l, LAS unsigned char* lds, int wave, int lane) {
    unsigned char* ws = P.ws;
    const int* tok_e = (const int*)(ws + WS_TOK); const int* tok_rank = tok_e + T * 2; int* tok_dest = (int*)(ws + WS_TOK) + T * 6; int* srcmap = (int*)(ws + WS_SRC);
    const LAS int* tstart = (const LAS int*)(lds + LDS_MISC + LM_TSTART); const LAS int* bases = (const LAS int*)(lds + LDS_MISC + LM_BASES);
    const int tid = launder_v((int)threadIdx.x);
    for (int chunk = launder_si((int)blockIdx.x); chunk < T / 64; chunk += gridDim.x) {
        build_tiles(P, l, lds, chunk);
        if (tid < 128) { const int pr = chunk * 128 + tid, ex = ((const GAS int*)tok_e)[pr];
            const int dest = tstart[ex] * 256 + bases[ex] + ((const GAS int*)tok_rank)[pr];
            ((GAS int*)tok_dest)[pr] = dest; ((GAS int*)srcmap)[dest] = pr >> 1; }
    }
}
__device__ __forceinline__ void phase_combine(const Params& P, int l, int gw, int NGW, int lane) {
    unsigned char* ws = P.ws;
    const bf16_t* X1B = (const bf16_t*)(ws + WS_K); const bf16_t* Y = (const bf16_t*)(ws + WS_BCAT + 40 * MiB);
    const float* tok_w = (const float*)(ws + WS_TOK) + T * 4; const int* tok_dest = (const int*)(ws + WS_TOK) + T * 6;
    bf16_t* xb = (bf16_t*)(ws + WS_XB);
    f32x4 g[4], bb[4];
#pragma unroll
    for (int j = 0; j < 4; ++j) { g[j] = *(const GAS f32x4*)(P.ln_ffn_g + l * 1024 + 4 * lane + 256 * j); bb[j] = *(const GAS f32x4*)(P.ln_ffn_b + l * 1024 + 4 * lane + 256 * j); }
    for (int tb = gw; tb < T; tb += 4 * NGW) {
        u32x2 x1[4][4], y0[4][4], y1[4][4]; float w0[4], w1[4];
#pragma unroll
        for (int k = 0; k < 4; ++k) { const int t = tb + k * NGW; if (t < T) {
            const int d0 = tok_dest[2 * t], d1 = tok_dest[2 * t + 1]; w0[k] = tok_w[2 * t]; w1[k] = tok_w[2 * t + 1];
#pragma unroll
            for (int j = 0; j < 4; ++j) { x1[k][j] = *(const GAS u32x2*)(X1B + (size_t)t * 1024 + 4 * lane + 256 * j);
                y0[k][j] = *(const GAS u32x2*)(Y + (size_t)d0 * 1024 + 4 * lane + 256 * j); y1[k][j] = *(const GAS u32x2*)(Y + (size_t)d1 * 1024 + 4 * lane + 256 * j); } } }
#pragma unroll
        for (int k = 0; k < 4; ++k) { const int t = tb + k * NGW; if (t >= T) break;
            f32x4 v[4];
#pragma unroll
            for (int j = 0; j < 4; ++j) {
                v[j][0] = bf_lo(x1[k][j].x) * ALPHA + w0[k] * bf_lo(y0[k][j].x) + w1[k] * bf_lo(y1[k][j].x); v[j][1] = bf_hi(x1[k][j].x) * ALPHA + w0[k] * bf_hi(y0[k][j].x) + w1[k] * bf_hi(y1[k][j].x);
                v[j][2] = bf_lo(x1[k][j].y) * ALPHA + w0[k] * bf_lo(y0[k][j].y) + w1[k] * bf_lo(y1[k][j].y); v[j][3] = bf_hi(x1[k][j].y) * ALPHA + w0[k] * bf_hi(y0[k][j].y) + w1[k] * bf_hi(y1[k][j].y);
            }
            ln_row(v, g, bb);
#pragma unroll
            for (int j = 0; j < 4; ++j) { if (l == DEPTH - 1) *(GAS f32x4*)(P.out + (size_t)t * 1024 + 4 * lane + 256 * j) = v[j]; else *(GAS u32x2*)(xb + (size_t)t * 1024 + 4 * lane + 256 * j) = pack4(v[j]); }
        }
    }
}

#ifndef PROBE_BAR
#define PROBE_BAR 0
#endif
#ifndef PROBE_K1
#define PROBE_K1 0
#endif
#define K1_BODY() do { \
            if (bid < 64) { \
                DecR2c dec{(const char*)(ws + WS_BCAT), (const char*)(ws + WS_KDT)}; EpiR2c E{(bf16_t*)(ws + WS_BCAT), decay}; \
                REP(2) pg::gemm_phase<1, true, 1, true, false, 16>(lds, 512, 1024, 512, 448, dec, E, 64, bid); \
                  \
            } else if (bid < 128) { \
                REP(3) phase_na3(PP, l, lds, tid, wave, lane, 192, bid - 64); \
                { const int pa = l == 0 ? 80 : 44, pb2 = l == 0 ? 96 : 52; convert_range(PP, 1, l, lds, 128 * pa + (bid - 64) * pb2, 128 * pa + (bid - 64) * pb2 + pb2, wave, lane); } \
                if (DEFER_SILU) { __syncthreads(); DecInProjD dec{(const char*)(ws + WS_XB), (const char*)(ws + ws_wset(l) + WO_WIN), 1}; EpiInProj E{ws, decay}; \
                  pg::gemm_phase<1, false, 1, false, false, 16>(lds, 1024, 1024, 1024, 128, dec, E, 64, bid - 64); } \
            } else { \
                { const int pa = l == 0 ? 80 : 44; convert_range(PP, 1, l, lds, (bid - 128) * pa, (bid - 128) * pa + pa, wave, lane); } \
                __syncthreads(); \
                { DecR1 dec{(const char*)(ws + WS_Q), (const char*)(ws + WS_K), 128}; EpiR1 E{(bf16_t*)(ws + WS_ACAT), decay}; \
                  REP(1) pg::gemm_phase<1, false, 1, false, false, 16>(lds, 256, 1024, 1024, 512, dec, E, 128, bid - 128); } \
                if (DEFER_SILU) { DecInProjD dec{(const char*)(ws + WS_XB), (const char*)(ws + ws_wset(l) + WO_WIN), 0}; EpiInProj E{ws, decay}; \
                  pg::gemm_phase<1, false, 1, false, false, 16>(lds, 1024, 1024, 1024, 128, dec, E, 128, bid - 128); } \
                REP(3) phase_na3(PP, l, lds, tid, wave, lane, 192, bid - 64); \
            } \
            } while (0)
__global__ void __launch_bounds__(512, 2) fwd_kernel(Params P) {
    extern __shared__ __attribute__((aligned(16))) unsigned char lds_raw[];
    LAS unsigned char* lds = (LAS unsigned char*)lds_raw;
    const int NGW = gridDim.x * 8;
    for (int u = threadIdx.x; u < (LDS_BYTES - LDS_MISC) / 4; u += 512) ((LAS unsigned*)(lds + LDS_MISC))[u] = 0u;
#define PHASE_CTX() const Params PP = load_params(); unsigned char* ws = PP.ws; const int tid = launder_v((int)threadIdx.x), lane = tid & 63, wave = __builtin_amdgcn_readfirstlane(tid >> 6), gw = launder_si((int)blockIdx.x) * 8 + wave; (void)ws; (void)lane; (void)gw
    __syncthreads();
#if MK_ONE_LAUNCH
    XcdBarrier bar = xcd_barrier_post((unsigned*)(P.ws + WS_CTL) + CW_BAR, (volatile LAS unsigned*)(lds + LDS_MISC + LM_BAR));
#define GRID_BAR() xcd_barrier(bar)
#else
#define GRID_BAR() do { } while (0)
#endif
    const int lo = P.ph_lo, hi = P.ph_hi;
#define IN(k) (lo <= (k) && (k) < hi)
#define SEAM(k) do { if (IN(k) && IN((k) + 1)) GRID_BAR(); } while (0)
#ifndef PROBE_MASK
#define PROBE_MASK 0
#endif
#define REP(b) for (int rep_ = 0; rep_ < (((PROBE_MASK) >> (b)) & 1) + 1; ++rep_)

    if (IN(0)) { PHASE_CTX(); phase_init(PP, lds, gw, NGW, wave, lane); SEAM(0); }

    for (int l = 0; l < DEPTH; ++l) {
        const int pb = 1 + l * 12;
        if (IN(pb + 0)) { PHASE_CTX(); const float* decay = PP.decay + l * 8; (void)decay;
            DecInProj dec{(const char*)(ws + WS_XB), (const char*)(ws + ws_wset(l) + WO_WIN)};
            EpiInProj E{ws, decay};
#if STAGGER_TICKS > 0
            { const unsigned long long t0 = __builtin_amdgcn_s_memrealtime(); const unsigned dl = ((blockIdx.x >> 3) & 7) * STAGGER_TICKS;
              while (__builtin_amdgcn_s_memrealtime() - t0 < dl) __builtin_amdgcn_s_sleep(8); }
#endif
            REP(0) pg::gemm_phase<1 + PROBE_EPI2, false, 1 + PROBE_K2, false, false, 16>(lds, 1024, 1024, 1024, DEFER_SILU ? 2560 : 2816, dec, E, (int)gridDim.x, (int)blockIdx.x);
            SEAM(pb + 0);
        }
        if (IN(pb + 1)) { PHASE_CTX(); const float* decay = PP.decay + l * 8; (void)decay;
            const int bid = launder_si((int)blockIdx.x);
            K1_BODY();
#if PROBE_K1
            __syncthreads(); K1_BODY();
#endif
            SEAM(pb + 1);
        }
        if (IN(pb + 3)) { PHASE_CTX(); const float* decay = PP.decay + l * 8; (void)decay;
            DecR4 dec{(const char*)(ws + WS_ACAT), (const char*)(ws + WS_BCAT), (int)gridDim.x}; EpiR4f E{ws, lds};
            REP(5) pg::gemm_phase<1, false, 1, false, false, 16>(lds, 1024, 4096, 1024, 512, dec, E, 256, (int)blockIdx.x);
            if (blockIdx.x < 256) { const int p = DecR4::panel_of((int)blockIdx.x), pm2 = p & 1, cc = (p >> 1) & 7, bh = p >> 4;
              REP(6) headnorm_half0(PP, lds, (bh >> 2) * 4096 + cc * 512 + pm2 * 256, bh & 3, wave, lane); }
            SEAM(pb + 3);
        }
        if (IN(pb + 5)) { PHASE_CTX(); const float* decay = PP.decay + l * 8; (void)decay;
            REP(7) {
            { DecDense dec{(const char*)(ws + WS_KDT), (const char*)(ws + ws_wset(l) + WO_WRET), 2048 * 2, 2048 * 2}; EpiMerge<0> E{(bf16_t*)(ws + WS_Q), (const bf16_t*)(ws + WS_G)};
              pg::gemm_phase(lds, 2048, 2048, 2048, 256, dec, E, (int)gridDim.x, (int)blockIdx.x); }
            { DecDense dec{(const char*)(ws + WS_NAO), (const char*)(ws + ws_wset(l) + WO_WNA), 1024 * 2, 1024 * 2}; EpiMerge<1> E{(bf16_t*)(ws + WS_Q), (const bf16_t*)(ws + WS_G)};
              pg::gemm_phase(lds, 1024, 1024, 1024, 256, dec, E, (int)gridDim.x, (int)blockIdx.x); }
            }
            SEAM(pb + 5);
        }
        if (IN(pb + 6)) { PHASE_CTX(); const float* decay = PP.decay + l * 8; (void)decay;
            DecDense dec{(const char*)(ws + WS_Q), (const char*)(ws + ws_wset(l) + WO_WOUT), 1024 * 2, 1024 * 2}; EpiPreR E{ws, (const bf16_t*)(ws + WS_WRT) + (size_t)l * 65536, lds};
            REP(8) pg::gemm_phase<1 + PROBE_EPI6>(lds, 1024, 1024, 1024, 256, dec, E, (int)gridDim.x, (int)blockIdx.x);
            SEAM(pb + 6);
#if PROBE_BAR
            SEAM(pb + 6); SEAM(pb + 6); SEAM(pb + 6); SEAM(pb + 6);
#endif
        }
        if (IN(pb + 7)) { PHASE_CTX(); const float* decay = PP.decay + l * 8; (void)decay; phase_ln_router(PP, l, lds, wave, lane); SEAM(pb + 7); }
        if (IN(pb + 8)) { PHASE_CTX(); const float* decay = PP.decay + l * 8; (void)decay; REP(9) phase_gather(PP, l, lds, wave, lane); SEAM(pb + 8); }
        if (IN(pb + 9)) { PHASE_CTX(); const float* decay = PP.decay + l * 8; (void)decay;
            if (!IN(pb + 8)) build_tiles(PP, l, lds, -1);
            const int nt = *(const LAS int*)(lds + LDS_MISC + LM_NT);
            int vG = (int)gridDim.x; { const int nu = nt * 4, rounds = (nu + vG - 1) / vG; if (rounds > 0) { int v = ((nu + rounds - 1) / rounds + 7) & ~7; if (v < vG) vG = v; } }
            LAS int* gsrc = (LAS int*)(lds + LDS_MISC + LM_GSRC);
            if ((int)blockIdx.x < vG && tid < 256) {
#pragma unroll
                for (int j = 0; j < 3; ++j) { const int u0 = (int)blockIdx.x + j * vG; if (u0 < nt * 4) { const int a = xcd_perm(u0, vG, nt * 4) >> 2; gsrc[j * 256 + tid] = ((const GAS int*)(ws + WS_SRC))[a * 256 + tid]; } }
            }
            __syncthreads();
            DecMoe dec{(const char*)(ws + WS_K), (const char*)(ws + ws_wset(l) + WO_WGU), 0, 1024 * 1024 * 2, 1024 * 2, (const LAS int*)(lds + LDS_MISC + LM_TILEE), vG, nt * 4}; EpiUp E{(bf16_t*)(ws + WS_BCAT)};
            REP(10) pg::gemm_phase<1, false, 1, false, true, 8>(lds, 1024, 1024, 1024, nt * 4, dec, E, vG, (int)blockIdx.x < vG ? (int)blockIdx.x : -1, gsrc);
            { const int G_ = (int)gridDim.x, bid = (int)blockIdx.x;
              convert_share(PP, 2, l, lds, 0, cv_slot_items(2, l), G_ - vG, bid >= vG ? bid - vG : -1, 215, G_, bid, wave, lane); }
            SEAM(pb + 9);
        }
        if (IN(pb + 10)) { PHASE_CTX(); const float* decay = PP.decay + l * 8; (void)decay;
            if (!IN(pb + 8)) build_tiles(PP, l, lds, -1);
            const int nt = *(const LAS int*)(lds + LDS_MISC + LM_NT);
            int vG = (int)gridDim.x; if (l + 1 < DEPTH) { const int nu = nt * 4, rounds = (nu + vG - 1) / vG; if (rounds > 0) { int v = ((nu + rounds - 1) / rounds + 7) & ~7; if (v < vG) vG = v; } }
            DecMoe dec{(const char*)(ws + WS_BCAT), (const char*)(ws + ws_wset(l) + WO_WD), 512 * 2, 1024 * 512 * 2, 512 * 2, (const LAS int*)(lds + LDS_MISC + LM_TILEE), vG, nt * 4}; EpiDown E{(bf16_t*)(ws + WS_BCAT + 40 * MiB)};
            REP(11) pg::gemm_phase<1, false, 1, false, false, 16>(lds, 512, 512, 512, nt * 4, dec, E, vG, (int)blockIdx.x < vG ? (int)blockIdx.x : -1);
            if (l + 1 < DEPTH) { const int G_ = (int)gridDim.x, bid = (int)blockIdx.x;
              convert_share(PP, 3, l, lds, 0, cv_slot_items(3, l), G_ - vG, bid >= vG ? bid - vG : -1, 135, G_, bid, wave, lane); }
            SEAM(pb + 10);
        }
        if (IN(pb + 11)) { PHASE_CTX(); const float* decay = PP.decay + l * 8; (void)decay;
            REP(12) phase_combine(PP, l, gw, NGW, lane);
            SEAM(pb + 11);
        }
    }
#undef IN
#undef SEAM
}

extern "C" void kernel_launch(void* const* d_in, const int* in_sizes, int n_in, void* d_out, int out_size, void* d_ws, size_t ws_size, hipStream_t stream) {
    static int grid = 0;
    if (grid == 0) {
        if (n_in != 16 || in_sizes[0] != T * D || out_size != T * D || ws_size < WS_END) {
            fprintf(stderr, "kernel_launch: unexpected shapes / workspace (n_in %d, in0 %d, out %d, ws %zu < %zu); nothing launched\n", n_in, n_in > 0 ? in_sizes[0] : -1, out_size, ws_size, (size_t)WS_END); grid = -1; return; }
        int dev = 0, cus = 0, per_cu = 0;
        if (hipGetDevice(&dev) != hipSuccess || hipDeviceGetAttribute(&cus, hipDeviceAttributeMultiprocessorCount, dev) != hipSuccess) { grid = -1; return; }
        if (hipFuncSetAttribute((const void*)fwd_kernel, hipFuncAttributeMaxDynamicSharedMemorySize, LDS_BYTES) != hipSuccess) { fprintf(stderr, "kernel_launch: hipFuncSetAttribute failed\n"); grid = -1; return; }
        if (hipOccupancyMaxActiveBlocksPerMultiprocessor(&per_cu, (const void*)fwd_kernel, 512, LDS_BYTES) != hipSuccess || per_cu < 1)
            fprintf(stderr, "kernel_launch: occupancy query reports %d workgroups per CU\n", per_cu);
        (void)hipGetLastError();
        if (cus != 256) { fprintf(stderr, "kernel_launch: built for a 256-CU device (static phase partitions), found %d CUs; nothing launched\n", cus); grid = -1; return; }
        grid = cus;
    }
    if (grid < 0) return;
    if (hipMemsetAsync((char*)d_ws + WS_CTL, 0, CTL_ZERO_BYTES, stream) != hipSuccess) return;
    Params p{};
    p.x = (const float*)d_in[0]; p.w_in = (const float*)d_in[1]; p.decay = (const float*)d_in[2]; p.w_ret_o = (const float*)d_in[3]; p.rpb = (const float*)d_in[4];
    p.w_na_o = (const float*)d_in[5]; p.w_out = (const float*)d_in[6]; p.ln_mix_g = (const float*)d_in[7]; p.ln_mix_b = (const float*)d_in[8];
    p.router_w = (const float*)d_in[9]; p.router_bias = (const float*)d_in[10]; p.w_gate = (const float*)d_in[11]; p.w_up = (const float*)d_in[12]; p.w_down = (const float*)d_in[13];
    p.ln_ffn_g = (const float*)d_in[14]; p.ln_ffn_b = (const float*)d_in[15];
    p.out = (float*)d_out; p.ws = (unsigned char*)d_ws;
#if MK_ONE_LAUNCH
    p.ph_lo = 0; p.ph_hi = NPH;
    hipLaunchKernelGGL(fwd_kernel, dim3(grid), dim3(512), LDS_BYTES, stream, p);
#else
    for (int ph = 0; ph < NPH; ++ph) { p.ph_lo = ph; p.ph_hi = ph + 1; hipLaunchKernelGGL(fwd_kernel, dim3(grid), dim3(512), LDS_BYTES, stream, p); }
#endif
}
```
